# Optimizing an MI355X kernel written in HIP

```python
import jax, jax.numpy as jnp
from jax import lax
import numpy as np

D_MODEL = 1024
BATCH = 8
SEQ = 4096
DEPTH = 4

CHUNK = 64
N_MIXERS = 3
N_HEADS = 16
HEAD_DIM = D_MODEL // N_HEADS
LEFT_CHUNKS = 8
BAND = (LEFT_CHUNKS + 1) * CHUNK
MAX_REL = 256
N_REL = 2 * MAX_REL + 1
IDX_HEADS = 8
IDX_DIM = 64
TOPK_MAX = 256
B_QBLOCK = 32
B_SPLITS = (D_MODEL, 2 * D_MODEL, 3 * D_MODEL,
            3 * D_MODEL + IDX_HEADS * IDX_DIM,
            3 * D_MODEL + IDX_HEADS * IDX_DIM + IDX_DIM)
B_PROJ = 3 * D_MODEL + IDX_HEADS * IDX_DIM + IDX_DIM + IDX_HEADS
C_QBLOCK = 128
D_FF = 2816
CONV_W = 3
ROPE_THETA = 10000.0
EPS = 1e-6
N_A = (DEPTH + 2) // 3
N_B = (DEPTH + 1) // 3
N_C = DEPTH // 3

kernel_name = "hybrid_chunk_causal_interleaved_trunk"


def rmsnorm(x, g):
    xf = x.astype(jnp.float32)
    y = xf * lax.rsqrt(jnp.mean(xf * xf, axis=-1, keepdims=True) + EPS)
    return (y * g.astype(jnp.float32)).astype(x.dtype)


def rope_tables(seq, dim):
    inv = ROPE_THETA ** (-jnp.arange(0, dim, 2, dtype=jnp.float32) / dim)
    ang = jnp.arange(seq, dtype=jnp.float32)[:, None] * inv[None, :]
    return jnp.cos(ang)[:, None, :], jnp.sin(ang)[:, None, :]


def rope(x, cos, sin):
    half = x.shape[-1] // 2
    c = cos.astype(x.dtype)
    s = sin.astype(x.dtype)
    x1, x2 = x[..., :half], x[..., half:]
    return jnp.concatenate([x1 * c - x2 * s, x2 * c + x1 * s], axis=-1)


def mixer_chunk_relbias(h, w_qkv, q_norm, k_norm, rel_bias, w_o):
    bsz, seq, _ = h.shape
    n_chunks = seq // CHUNK
    pad = LEFT_CHUNKS * CHUNK
    q, k, v = jnp.split((h @ w_qkv).reshape(bsz, seq, 3, N_HEADS, HEAD_DIM), 3, axis=2)
    q = rmsnorm(q[:, :, 0], q_norm)
    k = rmsnorm(k[:, :, 0], k_norm)
    v = v[:, :, 0]
    kp = jnp.pad(k, ((0, 0), (pad, 0), (0, 0), (0, 0)))
    vp = jnp.pad(v, ((0, 0), (pad, 0), (0, 0), (0, 0)))
    rel = jnp.clip(jnp.arange(CHUNK)[:, None] - jnp.arange(BAND)[None, :] + pad,
                   -MAX_REL, MAX_REL) + MAX_REL
    bias = rel_bias.astype(jnp.float32)[:, rel]
    scale = HEAD_DIM ** -0.5
    qc = q.reshape(bsz, n_chunks, CHUNK, N_HEADS, HEAD_DIM).swapaxes(0, 1)

    def one_chunk(args):
        c, q_blk = args
        k_band = lax.dynamic_slice_in_dim(kp, c * CHUNK, BAND, axis=1)
        v_band = lax.dynamic_slice_in_dim(vp, c * CHUNK, BAND, axis=1)
        s = jnp.einsum('bqhd,bkhd->bhqk', q_blk, k_band).astype(jnp.float32) * scale + bias
        valid = (c * CHUNK - pad + jnp.arange(BAND)) >= 0
        s = jnp.where(valid[None, None, None, :], s, -jnp.inf)
        p = jax.nn.softmax(s, axis=-1).astype(v_band.dtype)
        return jnp.einsum('bhqk,bkhd->bqhd', p, v_band)

    o = lax.map(one_chunk, (jnp.arange(n_chunks), qc))
    o = o.swapaxes(0, 1).reshape(bsz, seq, D_MODEL)
    return o @ w_o


def mixer_indexed_sparse(h, w_in, q_norm, k_norm, w_o, cos, sin):
    bsz, seq, _ = h.shape
    q, k, v, qi, ki, wi = jnp.split(h @ w_in, B_SPLITS, axis=-1)
    q = rope(rmsnorm(q.reshape(bsz, seq, N_HEADS, HEAD_DIM), q_norm), cos, sin)
    k = rope(rmsnorm(k.reshape(bsz, seq, N_HEADS, HEAD_DIM), k_norm), cos, sin)
    v = v.reshape(bsz, seq, N_HEADS, HEAD_DIM)
    qi = rope(qi.reshape(bsz, seq, IDX_HEADS, IDX_DIM), cos, sin)
    ki = rope(ki.reshape(bsz, seq, 1, IDX_DIM), cos, sin)[:, :, 0]
    wi = wi.astype(jnp.float32) * IDX_HEADS ** -0.5
    topk = min(TOPK_MAX, seq // 4)
    n_blk = seq // B_QBLOCK
    key_pos = jnp.arange(seq)
    scale = HEAD_DIM ** -0.5

    def to_blocks(a):
        return a.reshape(bsz, n_blk, B_QBLOCK, *a.shape[2:]).swapaxes(0, 1)

    def one_block(args):
        blk, q_b, qi_b, wi_b = args
        t = blk * B_QBLOCK + jnp.arange(B_QBLOCK)
        limit = (t // CHUNK + 1) * CHUNK
        logits = jnp.einsum('bqhd,bsd->bqhs', qi_b, ki).astype(jnp.float32) * IDX_DIM ** -0.5
        score = jnp.einsum('bqh,bqhs->bqs', wi_b, jax.nn.relu(logits))
        adm = key_pos[None, :] < limit[:, None]
        score = jnp.where(adm[None], score, -jnp.inf)
        _, idx = lax.top_k(score, topk)
        sel_ok = idx < limit[None, :, None]
        k_sel = jax.vmap(lambda kb, ib: kb[ib])(k, idx)
        v_sel = jax.vmap(lambda vb, ib: vb[ib])(v, idx)
        s = jnp.einsum('bqhd,bqkhd->bhqk', q_b, k_sel).astype(jnp.float32) * scale
        s = jnp.where(sel_ok[:, None], s, -jnp.inf)
        p = jax.nn.softmax(s, axis=-1).astype(v_sel.dtype)
        return jnp.einsum('bhqk,bqkhd->bqhd', p, v_sel)

    o = lax.map(one_block, (jnp.arange(n_blk), to_blocks(q), to_blocks(qi), to_blocks(wi)))
    o = o.swapaxes(0, 1).reshape(bsz, seq, D_MODEL)
    return o @ w_o


def mixer_stick_breaking(h, w_qkv, w_o):
    bsz, seq, _ = h.shape
    q, k, v = jnp.split((h @ w_qkv).reshape(bsz, seq, 3, N_HEADS, HEAD_DIM), 3, axis=2)
    q, k, v = q[:, :, 0], k[:, :, 0], v[:, :, 0]
    n_blk = seq // C_QBLOCK
    key_pos = jnp.arange(seq)
    scale = HEAD_DIM ** -0.5
    qb = q.reshape(bsz, n_blk, C_QBLOCK, N_HEADS, HEAD_DIM).swapaxes(0, 1)

    def one_block(args):
        blk, q_b = args
        t = blk * C_QBLOCK + jnp.arange(C_QBLOCK)
        z = jnp.einsum('bqhd,bshd->bhqs', q_b, k).astype(jnp.float32) * scale
        causal = (key_pos[None, :] < t[:, None])[None, None]
        log_beta = jax.nn.log_sigmoid(z)
        log_keep = jnp.where(causal, jax.nn.log_sigmoid(-z), 0.0)
        rev = lax.cumsum(log_keep, axis=3, reverse=True)
        after = jnp.concatenate([rev[..., 1:], jnp.zeros_like(rev[..., :1])], axis=-1)
        a = jnp.where(causal, jnp.exp(log_beta + after), 0.0)
        return jnp.einsum('bhqs,bshd->bqhd', a.astype(v.dtype), v)

    o = lax.map(one_block, (jnp.arange(n_blk), qb))
    o = o.swapaxes(0, 1).reshape(bsz, seq, D_MODEL)
    return o @ w_o


def conv_ffn(h, w_in, conv_w, conv_b, w_down):
    seq = h.shape[1]
    a = h @ w_in
    ap = jnp.pad(a, ((0, 0), (CONV_W - 1, 0), (0, 0)))
    c = conv_b + sum(ap[:, i:i + seq] * conv_w[i] for i in range(CONV_W))
    g, u = jnp.split(c, 2, axis=-1)
    return (jax.nn.silu(g) * u) @ w_down


def setup_inputs(seed: int = 0) -> dict:
    key = jax.random.key(seed)
    ks = jax.random.split(key, 20)
    f32 = jnp.float32
    D = D_MODEL

    def w(k, shape, fan_in):
        return jax.random.normal(k, shape, f32) * fan_in ** -0.5

    def gain(k, shape):
        return 1.0 + 0.1 * jax.random.normal(k, shape, f32)

    return {
        "x": jax.random.normal(ks[0], (BATCH, SEQ, D), f32),
        "norm1_g": gain(ks[1], (DEPTH, D)),
        "norm2_g": gain(ks[2], (DEPTH, D)),
        "a_w_qkv": w(ks[3], (N_A, D, 3 * D), D),
        "a_q_norm": gain(ks[4], (N_A, HEAD_DIM)),
        "a_k_norm": gain(ks[5], (N_A, HEAD_DIM)),
        "a_rel_bias": 0.1 * jax.random.normal(ks[6], (N_A, N_HEADS, N_REL), f32),
        "a_w_o": w(ks[7], (N_A, D, D), D),
        "b_w_in": w(ks[8], (N_B, D, B_PROJ), D),
        "b_q_norm": gain(ks[9], (N_B, HEAD_DIM)),
        "b_k_norm": gain(ks[10], (N_B, HEAD_DIM)),
        "b_w_o": w(ks[11], (N_B, D, D), D),
        "c_w_qkv": w(ks[12], (N_C, D, 3 * D), D),
        "c_w_o": w(ks[13], (N_C, D, D), D),
        "ffn_w_in": w(ks[14], (DEPTH, D, 2 * D_FF), D),
        "ffn_conv_w": w(ks[15], (DEPTH, CONV_W, 2 * D_FF), CONV_W),
        "ffn_conv_b": 0.01 * jax.random.normal(ks[16], (DEPTH, 2 * D_FF), f32),
        "ffn_w_down": w(ks[17], (DEPTH, D_FF, D), D_FF),
    }


def reference(x, norm1_g, norm2_g, a_w_qkv, a_q_norm, a_k_norm, a_rel_bias, a_w_o,
              b_w_in, b_q_norm, b_k_norm, b_w_o, c_w_qkv, c_w_o,
              ffn_w_in, ffn_conv_w, ffn_conv_b, ffn_w_down):
    seq = x.shape[1]
    cos, sin = rope_tables(seq, HEAD_DIM)
    ia = ib = ic = 0
    for layer in range(DEPTH):
        h = rmsnorm(x, norm1_g[layer])
        kind = layer % N_MIXERS
        if kind == 0:
            y = mixer_chunk_relbias(h, a_w_qkv[ia], a_q_norm[ia], a_k_norm[ia], a_rel_bias[ia], a_w_o[ia])
            ia += 1
        elif kind == 1:
            y = mixer_indexed_sparse(h, b_w_in[ib], b_q_norm[ib], b_k_norm[ib], b_w_o[ib], cos, sin)
            ib += 1
        else:
            y = mixer_stick_breaking(h, c_w_qkv[ic], c_w_o[ic])
            ic += 1
        x = x + y
        h = rmsnorm(x, norm2_g[layer])
        x = x + conv_ffn(h, ffn_w_in[layer], ffn_conv_w[layer], ffn_conv_b[layer], ffn_w_down[layer])
    return x
```

```cpp
#include <hip/hip_runtime.h>
#include <hip/hip_cooperative_groups.h>
#include <cstdio>
#include <cstdint>
namespace cg = cooperative_groups;
namespace pg8 {
#define PG8_LAS __attribute__((address_space(3)))
typedef unsigned short bf16_t;
typedef short bf16x8 __attribute__((ext_vector_type(8)));
typedef float f32x4 __attribute__((ext_vector_type(4)));
typedef unsigned u32x4 __attribute__((ext_vector_type(4)));
constexpr int BM = 256, BK = 64, HALF = 128, HTB = HALF * BK * 2  , STAGE_BYTES = 8 * HTB, NXCD = 8, WGM = 8;

__host__ __device__ __forceinline__ int lds_byte(int r, int c) { const int st = (r >> 4) * 2 + (c >> 5), rr = r & 15, cc = c & 31, ob = rr * 64 + cc * 2; return st * 1024 + (ob ^ (((ob >> 9) & 1) << 5)); }
__host__ __device__ __forceinline__ void stage_rc(int b, int& R, int& C) { const int st = b / 1024, sb = b % 1024, swz = sb ^ (((sb >> 9) & 1) << 5); R = (st >> 1) * 16 + swz / 64; C = (st & 1) * 32 + (swz % 64) / 2; }
__host__ __device__ __forceinline__ int perm32(int rho) { const int n = rho >> 4, i = rho & 15; return 8 * (i >> 2) + 4 * n + (i & 3); }

struct Unit { int pm, pn; };
struct Gemm { const bf16_t* A; const bf16_t* Bt; int M, N, K; };

struct StaticOrder {
    int nM, nN, nwg, G, c;
    __host__ __device__ void init(int M, int N, int G_, int c_) { nM = M / BM; nN = N / BM; nwg = nM * nN; G = G_; c = c_; }
    __host__ __device__ bool next(int i, Unit& u) const {
        const long L = (long)i * G + c; if (L >= nwg) return false;
        int wgid = (int)L; { const int q = nwg / NXCD, r = nwg % NXCD, xcd = wgid % NXCD, off = wgid / NXCD; wgid = (xcd < r ? xcd * (q + 1) : r * (q + 1) + (xcd - r) * q) + off; }
        const int nig = WGM * nN, gid = wgid / nig, fm = gid * WGM, gsz = (nM - fm) < WGM ? (nM - fm) : WGM;
        u.pm = fm + ((wgid % nig) % gsz); u.pn = (wgid % nig) / gsz; return true;
    }
    __device__ __forceinline__ void a_ready(const Unit&) const {}
    __device__ __forceinline__ void done(const Unit&) const {}
};

__device__ __forceinline__ unsigned cvt_pk_bf16(float lo, float hi) { unsigned r; asm volatile("v_cvt_pk_bf16_f32 %0, %1, %2" : "=v"(r) : "v"(lo), "v"(hi)); return r; }
typedef float f32x2 __attribute__((ext_vector_type(2)));
typedef float f32x2v __attribute__((ext_vector_type(2)));
typedef unsigned u32x2v_t __attribute__((ext_vector_type(2)));
struct EpiBf16Plain {
    static constexpr bool PERM = true, AFTER_DRAIN = false;
    bf16_t* O; int ldc;
    __device__ __forceinline__ void operator()(const f32x4 (&acc)[2][2][4][2], const Unit& u, int wr, int wc, int fr, int fq) const {
        const int row0 = u.pm * BM + wr * 64 + fr; const int col0 = u.pn * BM + wc * 32 + 8 * fq;
#pragma unroll
        for (int ai = 0; ai < 2; ++ai)
#pragma unroll
            for (int m = 0; m < 4; ++m) { bf16_t* rowp = O + (size_t)(row0 + ai * HALF + m * 16) * ldc + col0;
#pragma unroll
                for (int bj = 0; bj < 2; ++bj) { const f32x4 v0 = acc[ai][bj][m][0], v1 = acc[ai][bj][m][1];
                    u32x4 w; w.x = cvt_pk_bf16(v0[0], v0[1]); w.y = cvt_pk_bf16(v0[2], v0[3]); w.z = cvt_pk_bf16(v1[0], v1[1]); w.w = cvt_pk_bf16(v1[2], v1[3]);
                    *(u32x4*)(rowp + bj * HALF) = w; } }
    }
};
__device__ __forceinline__ float rstd_of(const float* SSQ, size_t row) { const f32x4 s4 = *(const f32x4*)(SSQ + row * 4); return rsqrtf(((s4[0] + s4[1]) + (s4[2] + s4[3])) * (1.0f / 1024.0f) + 1e-6f); }
struct EpiRes {
    static constexpr bool PERM = true, AFTER_DRAIN = false;
    const float* base32; const bf16_t* base16; float* out32; int ldc; bf16_t* XB; float* SSQ; PG8_LAS float* part;
    __device__ __forceinline__ void operator()(const f32x4 (&acc)[2][2][4][2], const Unit& u, int wr, int wc, int fr_in, int fq_in) const {
        int fr = fr_in, fq = fq_in; asm volatile("" : "+v"(fr), "+v"(fq));
        const int col0 = u.pn * BM + wc * 32 + 8 * fq;
        u32x4 pre[2][4][2];
        if (!base32) {
#pragma unroll
            for (int ai = 0; ai < 2; ++ai)
#pragma unroll
                for (int m = 0; m < 4; ++m)
#pragma unroll
                    for (int bj = 0; bj < 2; ++bj) pre[ai][m][bj] = *(const u32x4*)(base16 + (size_t)(u.pm * BM + ai * HALF + wr * 64 + m * 16 + fr) * ldc + col0 + bj * HALF);
        }
#pragma unroll
        for (int ai = 0; ai < 2; ++ai)
#pragma unroll
            for (int m = 0; m < 4; ++m) { const int rl = ai * HALF + wr * 64 + m * 16 + fr; const size_t off = (size_t)(u.pm * BM + rl) * ldc + col0;
                float ss = 0.f;
#pragma unroll
                for (int bj = 0; bj < 2; ++bj) {
                    f32x4 b0, b1;
                    if (base32) { b0 = *(const f32x4*)(base32 + off + bj * HALF); b1 = *(const f32x4*)(base32 + off + bj * HALF + 4); }
                    else { const u32x4 r = pre[ai][m][bj];
                        b0 = (f32x4){__uint_as_float(r.x << 16), __uint_as_float(r.x & 0xFFFF0000u), __uint_as_float(r.y << 16), __uint_as_float(r.y & 0xFFFF0000u)};
                        b1 = (f32x4){__uint_as_float(r.z << 16), __uint_as_float(r.z & 0xFFFF0000u), __uint_as_float(r.w << 16), __uint_as_float(r.w & 0xFFFF0000u)}; }
                    const f32x4 v0 = b0 + acc[ai][bj][m][0], v1 = b1 + acc[ai][bj][m][1];
                    if (out32) { *(f32x4*)(out32 + off + bj * HALF) = v0; *(f32x4*)(out32 + off + bj * HALF + 4) = v1; }
                    if (XB) { u32x4 w; w.x = cvt_pk_bf16(v0[0], v0[1]); w.y = cvt_pk_bf16(v0[2], v0[3]); w.z = cvt_pk_bf16(v1[0], v1[1]); w.w = cvt_pk_bf16(v1[2], v1[3]); *(u32x4*)(XB + off + bj * HALF) = w;
                        const f32x4 q0 = (f32x4){__uint_as_float(w.x << 16), __uint_as_float(w.x & 0xFFFF0000u), __uint_as_float(w.y << 16), __uint_as_float(w.y & 0xFFFF0000u)};
                        const f32x4 q1 = (f32x4){__uint_as_float(w.z << 16), __uint_as_float(w.z & 0xFFFF0000u), __uint_as_float(w.w << 16), __uint_as_float(w.w & 0xFFFF0000u)};
                        ss += ((q0[0] * q0[0] + q0[1] * q0[1]) + (q0[2] * q0[2] + q0[3] * q0[3])) + ((q1[0] * q1[0] + q1[1] * q1[1]) + (q1[2] * q1[2] + q1[3] * q1[3])); } }
                ss += __shfl_xor(ss, 16); ss += __shfl_xor(ss, 32);
                if (fq == 0) part[rl * 4 + wc] = ss;
                if (base32 && (m & 1)) asm volatile("" ::: "memory"); }
        asm volatile("s_waitcnt lgkmcnt(0)" ::: "memory"); __builtin_amdgcn_s_barrier(); asm volatile("" ::: "memory");
        const int t = (wr * 4 + wc) * 64 + fq * 16 + fr;
        if (t < 256 && XB) { const f32x4 p4 = *(const PG8_LAS f32x4*)(part + t * 4); SSQ[(size_t)(u.pm * BM + t) * 4 + u.pn] = (p4[0] + p4[1]) + (p4[2] + p4[3]); }
    }
};
struct EpiVt {
    static constexpr bool PERM = true, AFTER_DRAIN = false;
    bf16_t* O; int ldc; const float* SSQ;
    __device__ __forceinline__ void operator()(const f32x4 (&acc)[2][2][4][2], const Unit& u, int wr, int wc, int fr_in, int fq_in) const {
        int fr = fr_in, fq = fq_in; asm volatile("" : "+v"(fr), "+v"(fq));
        const int row0 = u.pm * BM + wr * 64 + fr; const int col0 = u.pn * BM + wc * 32 + 8 * fq;
        float rs[2][8];
#pragma unroll
        for (int bj = 0; bj < 2; ++bj)
#pragma unroll
            for (int c = 0; c < 8; ++c) rs[bj][c] = rstd_of(SSQ, (size_t)(col0 + bj * HALF + c));
#pragma unroll
        for (int ai = 0; ai < 2; ++ai)
#pragma unroll
            for (int m = 0; m < 4; ++m) { bf16_t* rowp = O + (size_t)(row0 + ai * HALF + m * 16) * ldc + col0;
#pragma unroll
                for (int bj = 0; bj < 2; ++bj) { const f32x4 v0 = acc[ai][bj][m][0], v1 = acc[ai][bj][m][1];
                    u32x4 w; w.x = cvt_pk_bf16(v0[0] * rs[bj][0], v0[1] * rs[bj][1]); w.y = cvt_pk_bf16(v0[2] * rs[bj][2], v0[3] * rs[bj][3]); w.z = cvt_pk_bf16(v1[0] * rs[bj][4], v1[1] * rs[bj][5]); w.w = cvt_pk_bf16(v1[2] * rs[bj][6], v1[3] * rs[bj][7]);
                    *(u32x4*)(rowp + bj * HALF) = w; } }
    }
};
struct EpiQKV {
    static constexpr bool PERM = true, AFTER_DRAIN = false;
    int kind;
    bf16_t *Q, *K, *QI, *KI; float* WI;
    const float *gq, *gk; const f32x2v* rope; float qscale, wscale; const float* SSQ;
    __device__ __forceinline__ void operator()(const f32x4 (&acc)[2][2][4][2], const Unit& u, int wr, int wc, int fr_in, int fq_in) const {
        int fr = fr_in, fq = fq_in; asm volatile("" : "+v"(fr), "+v"(fq));
        const int hs = u.pn * 4 + wc;
        bf16_t* dst; int ld, col; bool donorm = false, dorope = false; const float* gain = gq; float sc = 1.f;
        if (hs < 16) { dst = Q; ld = 1024; col = hs * 64; donorm = (kind != 2); dorope = (kind == 1); gain = gq; sc = qscale; }
        else if (hs < 32) { dst = K; ld = 1024; col = (hs - 16) * 64; donorm = (kind != 2); dorope = (kind == 1); gain = gk; }
        else if (hs < 40) { dst = QI; ld = 512; col = (hs - 32) * 64; dorope = true; }
        else if (hs == 40) { dst = KI; ld = 64; col = 0; dorope = true; }
        else if (hs == 41) {
            if (fq == 0) {
#pragma unroll
                for (int ai = 0; ai < 2; ++ai)
#pragma unroll
                    for (int m = 0; m < 4; ++m) { const int row = u.pm * BM + ai * HALF + wr * 64 + m * 16 + fr;
                        const float rsw = rstd_of(SSQ, (size_t)row) * wscale; *(f32x4*)(WI + (size_t)row * 8) = acc[ai][0][m][0] * rsw; *(f32x4*)(WI + (size_t)row * 8 + 4) = acc[ai][0][m][1] * rsw; }
            }
            return;
        } else return;
        float g[2][2][4];
#pragma unroll
        for (int bj = 0; bj < 2; ++bj)
#pragma unroll
            for (int n = 0; n < 2; ++n)
#pragma unroll
                for (int i = 0; i < 4; ++i) g[bj][n][i] = donorm ? gain[32 * bj + 8 * fq + 4 * n + i] * sc : sc;
        f32x4 sq[2][4];
#pragma unroll
        for (int ai = 0; ai < 2; ++ai)
#pragma unroll
            for (int m = 0; m < 4; ++m) sq[ai][m] = *(const f32x4*)(SSQ + (size_t)(u.pm * BM + ai * HALF + wr * 64 + m * 16 + fr) * 4);
#pragma unroll
        for (int ai = 0; ai < 2; ++ai) {
#pragma unroll
          for (int mp = 0; mp < 4; ++mp) {
            f32x4 rp4[4][4];
            if (dorope) {
#pragma unroll
                for (int m = mp; m < mp + 1; ++m) { const f32x4* rp = (const f32x4*)(rope + (size_t)((u.pm * BM + ai * HALF + wr * 64 + m * 16 + fr) & 4095) * 32 + 8 * fq);
#pragma unroll
                    for (int k = 0; k < 4; ++k) rp4[m][k] = rp[k]; }
            }
#pragma unroll
            for (int m = mp; m < mp + 1; ++m) {
                const int row = u.pm * BM + ai * HALF + wr * 64 + m * 16 + fr;
                f32x4 v[2][2];
                const float rs0 = rsqrtf(((sq[ai][m][0] + sq[ai][m][1]) + (sq[ai][m][2] + sq[ai][m][3])) * (1.0f / 1024.0f) + 1e-6f);
#pragma unroll
                for (int bj = 0; bj < 2; ++bj)
#pragma unroll
                    for (int n = 0; n < 2; ++n) v[bj][n] = acc[ai][bj][m][n] * rs0;
                float r = 1.f;
                if (donorm) {
                    float ss = 0.f;
#pragma unroll
                    for (int bj = 0; bj < 2; ++bj)
#pragma unroll
                        for (int n = 0; n < 2; ++n) { const f32x4 x = v[bj][n]; ss += (x[0] * x[0] + x[1] * x[1]) + (x[2] * x[2] + x[3] * x[3]); }
                    ss += __shfl_xor(ss, 16); ss += __shfl_xor(ss, 32);
                    r = rsqrtf(ss * (1.0f / 64.0f) + 1e-6f);
                }
#pragma unroll
                for (int bj = 0; bj < 2; ++bj)
#pragma unroll
                    for (int n = 0; n < 2; ++n)
#pragma unroll
                        for (int i = 0; i < 4; ++i) v[bj][n][i] = v[bj][n][i] * r * g[bj][n][i];
                if (dorope) {
#pragma unroll
                    for (int n = 0; n < 2; ++n) { const f32x4 cs0 = rp4[m][2 * n], cs1 = rp4[m][2 * n + 1];
                        const float c_[4] = {cs0[0], cs0[2], cs1[0], cs1[2]}, s_[4] = {cs0[1], cs0[3], cs1[1], cs1[3]};
#pragma unroll
                        for (int i = 0; i < 4; ++i) { const float x1 = v[0][n][i], x2 = v[1][n][i]; v[0][n][i] = x1 * c_[i] - x2 * s_[i]; v[1][n][i] = x2 * c_[i] + x1 * s_[i]; } }
                }
                bf16_t* rowp = dst + (size_t)row * ld + col + 8 * fq;
#pragma unroll
                for (int bj = 0; bj < 2; ++bj) { u32x4 w; w.x = cvt_pk_bf16(v[bj][0][0], v[bj][0][1]); w.y = cvt_pk_bf16(v[bj][0][2], v[bj][0][3]); w.z = cvt_pk_bf16(v[bj][1][0], v[bj][1][1]); w.w = cvt_pk_bf16(v[bj][1][2], v[bj][1][3]);
                    *(u32x4*)(rowp + 32 * bj) = w; }
            }
            asm volatile("" ::: "memory");
          }
        }
    }
};
template <int CTRL, bool BC> __device__ __forceinline__ float pg8_dpp(float x) { return __int_as_float(__builtin_amdgcn_update_dpp(0, __float_as_int(x), CTRL, 0xf, 0xf, BC)); }
struct EpiFFN {
    static constexpr bool PERM = true, AFTER_DRAIN = false;
    bf16_t* HM; const float* cw; const float* cb; float* EF; float* EL; PG8_LAS f32x4* halo; const float* SSQ;
    __device__ __forceinline__ void operator()(const f32x4 (&acc_)[2][2][4][2], const Unit& u, int wr, int wc, int fr_in, int fq_in) const {
        int fr = fr_in, fq = fq_in; asm volatile("" : "+v"(fr), "+v"(fq));
        f32x4 (&acc)[2][2][4][2] = const_cast<f32x4 (&)[2][2][4][2]>(acc_);
        f32x4 Wn[2][4];
        { const int jc0 = u.pn * 128 + wc * 32 + 8 * fq;
#pragma unroll
          for (int bj = 0; bj < 2; ++bj) { const float* wp = cw + bj * 2816 + jc0;
              Wn[bj][0] = *(const f32x4*)(wp); Wn[bj][1] = *(const f32x4*)(wp + 5632); Wn[bj][2] = *(const f32x4*)(wp + 2 * 5632); Wn[bj][3] = *(const f32x4*)(cb + bj * 2816 + jc0); } }
#pragma unroll
        for (int ai = 0; ai < 2; ++ai)
#pragma unroll
            for (int m = 0; m < 4; ++m) { const float rs0 = rstd_of(SSQ, (size_t)(u.pm * BM + ai * HALF + wr * 64 + m * 16 + fr));
#pragma unroll
                for (int bj = 0; bj < 2; ++bj)
#pragma unroll
                    for (int n = 0; n < 2; ++n) acc[ai][bj][m][n] = acc[ai][bj][m][n] * rs0; }
        const int pcol = u.pn * 256 + wc * 32 + 8 * fq, jcol = u.pn * 128 + wc * 32 + 8 * fq;
        if (fr >= 14) {
            const int rr = fr - 14;
#pragma unroll
            for (int ai = 0; ai < 2; ++ai)
#pragma unroll
                for (int bj = 0; bj < 2; ++bj)
#pragma unroll
                    for (int n = 0; n < 2; ++n) halo[(((((ai * 2 + wr) * 2 + rr) * 4 + wc) * 2 + bj) * 4 + fq) * 2 + n] = acc[ai][bj][3][n];
            if (wr == 1) { float* e = EL + ((size_t)u.pm * 2 + rr) * 5632 + pcol;
#pragma unroll
                for (int bj = 0; bj < 2; ++bj)
#pragma unroll
                    for (int n = 0; n < 2; ++n) *(f32x4*)(e + bj * 128 + n * 4) = acc[1][bj][3][n]; }
        }
        if (wr == 0 && fr < 2) { float* e = EF + ((size_t)u.pm * 2 + fr) * 5632 + pcol;
#pragma unroll
            for (int bj = 0; bj < 2; ++bj)
#pragma unroll
                for (int n = 0; n < 2; ++n) *(f32x4*)(e + bj * 128 + n * 4) = acc[0][bj][0][n]; }
        asm volatile("s_waitcnt lgkmcnt(0)" ::: "memory"); __builtin_amdgcn_s_barrier(); asm volatile("" ::: "memory");
#pragma unroll
        for (int n = 0; n < 2; ++n) {
            f32x4 W0[2], W1[2], W2[2], Bb[2], W0m[2], W1m[2];
#pragma unroll
            for (int bj = 0; bj < 2; ++bj) { const float* wp = cw + bj * 2816 + jcol + 4 * n;
                if (n == 0) { W0[bj] = Wn[bj][0]; W1[bj] = Wn[bj][1]; W2[bj] = Wn[bj][2]; Bb[bj] = Wn[bj][3]; }
                else { W0[bj] = *(const f32x4*)(wp); W1[bj] = *(const f32x4*)(wp + 5632); W2[bj] = *(const f32x4*)(wp + 2 * 5632); Bb[bj] = *(const f32x4*)(cb + bj * 2816 + jcol + 4 * n); }
                W1m[bj] = fr == 0 ? W1[bj] : (f32x4){0.f, 0.f, 0.f, 0.f}; W0m[bj] = fr < 2 ? W0[bj] : (f32x4){0.f, 0.f, 0.f, 0.f}; }
#pragma unroll
            for (int ai = 0; ai < 2; ++ai)
#pragma unroll
                for (int m = 0; m < 4; ++m) {
                    f32x4 c[2];
#pragma unroll
                    for (int bj = 0; bj < 2; ++bj) {
                        const f32x4 a = acc[ai][bj][m][n];
                        f32x4 t1, t2;
                        if (m > 0) { const f32x4 ap = acc[ai][bj][m - 1][n];
#pragma unroll
                            for (int i = 0; i < 4; ++i) { const float apx = ap[i]; t1[i] = pg8_dpp<0x121, false>(apx); t2[i] = pg8_dpp<0x122, false>(apx); }
                        } else {
                            t1 = (f32x4){0.f, 0.f, 0.f, 0.f}; t2 = t1;
                            const int sa = (wr == 1) ? ai : 0, sw = (wr == 1) ? 0 : 1;
                            if ((wr == 1 || ai == 1) && fr < 2) {
                                const f32x4 h0 = halo[(((((sa * 2 + sw) * 2 + 0) * 4 + wc) * 2 + bj) * 4 + fq) * 2 + n], h1 = halo[(((((sa * 2 + sw) * 2 + 1) * 4 + wc) * 2 + bj) * 4 + fq) * 2 + n];
                                t1 = h1; t2 = (fr == 0) ? h0 : h1;
                            }
                        }
#pragma unroll
                        for (int i = 0; i < 4; ++i) {
                            const float ax = a[i];
                            float v = __builtin_fmaf(W2[bj][i], ax, Bb[bj][i]);
                            v = __builtin_fmaf(pg8_dpp<0x111, true>(ax), W1[bj][i], v);
                            v = __builtin_fmaf(pg8_dpp<0x112, true>(ax), W0[bj][i], v);
                            v = __builtin_fmaf(t1[i], W1m[bj][i], v);
                            v = __builtin_fmaf(t2[i], W0m[bj][i], v);
                            c[bj][i] = v;
                        }
                    }
                    float hm[4];
#pragma unroll
                    for (int i = 0; i < 4; ++i) { const float g = c[0][i]; hm[i] = g * __builtin_amdgcn_rcpf(1.f + __builtin_amdgcn_exp2f(-1.4426950408889634f * g)) * c[1][i]; }
                    u32x2v_t w; w.x = cvt_pk_bf16(hm[0], hm[1]); w.y = cvt_pk_bf16(hm[2], hm[3]);
                    *(u32x2v_t*)(HM + (size_t)(u.pm * BM + ai * HALF + wr * 64 + m * 16 + fr) * 2816 + jcol + 4 * n) = w;
                }
        }
    }
};
template <class Epi, class Sched, bool ALIGN_EPI = false, bool SP2 = false>
__device__ __forceinline__ void gemm_phase(PG8_LAS unsigned char* lds, const Gemm g, const Sched& S, const Epi& E, const int wave_s) {
    unsigned ones_l = ~0u; asm volatile("" : "+s"(ones_l)); int tid_l = wave_s * 64 + (int)__builtin_amdgcn_mbcnt_hi(ones_l, __builtin_amdgcn_mbcnt_lo(ones_l, 0u)); asm volatile("" : "+v"(tid_l));
    const int tid = tid_l, wid = __builtin_amdgcn_readfirstlane(tid >> 6), lane = tid & 63, wr = wid >> 2, wc = wid & 3, fr = lane & 15, fq = lane >> 4;
    const int K = g.K, nt = K / BK;
    unsigned voffA[2], voffB[2];
#pragma unroll
    for (int i = 0; i < 2; ++i) { int R, C; stage_rc(tid * 16 + i * 8192, R, C); const int Rb = Epi::PERM ? ((R & ~31) + perm32(R & 31)) : R;
        voffA[i] = (unsigned)(R * K + C) * 2u; voffB[i] = (unsigned)(Rb * K + C) * 2u; }
    const size_t kstep = (size_t)(BK * 2);
    const size_t hstep = (size_t)HALF * K * 2;
    const size_t tstep = 2 * hstep;
    const unsigned ldsw = (unsigned)wid * 1024u;
    const int aoff = lds_byte(wr * 64 + fr, fq * 8), boff = lds_byte(wc * 32 + fr, fq * 8);
#define PG8_SA(b, h) (((b) * 2 + (h)) * HTB)
#define PG8_SB(b, h) ((4 + (b) * 2 + (h)) * HTB)
#define PG8_STAGE(bufoff, gbase, voff) do { _Pragma("unroll") for (int _i = 0; _i < 2; ++_i) \
        __builtin_amdgcn_global_load_lds((const unsigned*)((const char*)(gbase) + (voff)[_i]), (PG8_LAS unsigned*)(lds + (bufoff) + ldsw + _i * 8192), 16, 0, 0); } while (0)
#define PG8_LDA(dst, b, h) do { _Pragma("unroll") for (int m = 0; m < 4; ++m) _Pragma("unroll") for (int k = 0; k < 2; ++k) dst[m][k] = *(const PG8_LAS bf16x8*)(lds + PG8_SA(b, h) + aoff + m * 2048 + k * 1024); } while (0)
#define PG8_LDB(dst, b, h) do { _Pragma("unroll") for (int n = 0; n < 2; ++n) _Pragma("unroll") for (int k = 0; k < 2; ++k) dst[n][k] = *(const PG8_LAS bf16x8*)(lds + PG8_SB(b, h) + boff + n * 2048 + k * 1024); } while (0)
#define PG8_MMA(ai, bj, At, Bt) do { __builtin_amdgcn_s_setprio(1); _Pragma("unroll") for (int m = 0; m < 4; ++m) _Pragma("unroll") for (int n = 0; n < 2; ++n) _Pragma("unroll") for (int k = 0; k < 2; ++k) \
        acc[ai][bj][m][n] = __builtin_amdgcn_mfma_f32_16x16x32_bf16(Bt[n][k], At[m][k], acc[ai][bj][m][n], 0, 0, 0); __builtin_amdgcn_s_setprio(0); } while (0)
#define PG8_WAIT_V(n) asm volatile("s_waitcnt vmcnt(" #n ")" ::: "memory")
#define PG8_WAIT_L(n) asm volatile("s_waitcnt lgkmcnt(" #n ")" ::: "memory")
#define PG8_BAR __builtin_amdgcn_s_barrier()
#define PG8_SCHED __builtin_amdgcn_sched_barrier(0)
    Unit cur, nxt; int ui = 0;
    if (!S.next(0, cur)) return;
    f32x4 acc[2][2][4][2];
#pragma unroll
    for (int a = 0; a < 2; ++a)
#pragma unroll
        for (int b = 0; b < 2; ++b)
#pragma unroll
            for (int m = 0; m < 4; ++m)
#pragma unroll
                for (int n = 0; n < 2; ++n) acc[a][b][m][n] = (f32x4){0.f, 0.f, 0.f, 0.f};
    bf16x8 At[4][2], B0[2][2], B1[2][2];
    const char* cA = (const char*)g.A + (size_t)cur.pm * tstep; const char* cB = (const char*)g.Bt + (size_t)cur.pn * tstep;
    S.a_ready(cur);
    if constexpr (SP2) {
        PG8_STAGE(PG8_SB(0, 0), cB, voffB); PG8_STAGE(PG8_SB(0, 1), cB + hstep, voffB); PG8_STAGE(PG8_SA(0, 0), cA, voffA); PG8_STAGE(PG8_SA(0, 1), cA + hstep, voffA);
        if (wr == 1) PG8_BAR;
        PG8_WAIT_V(2); PG8_BAR;
        PG8_STAGE(PG8_SB(1, 0), cB + kstep, voffB); PG8_STAGE(PG8_SA(1, 0), cA + kstep, voffA); PG8_STAGE(PG8_SB(1, 1), cB + hstep + kstep, voffB);
        PG8_WAIT_V(6); PG8_BAR;
    } else {
        PG8_STAGE(PG8_SB(0, 0), cB, voffB); PG8_STAGE(PG8_SA(0, 0), cA, voffA); PG8_STAGE(PG8_SB(0, 1), cB + hstep, voffB); PG8_STAGE(PG8_SA(0, 1), cA + hstep, voffA);
        if (wr == 1) PG8_BAR;
        PG8_WAIT_V(4); PG8_BAR;
        PG8_STAGE(PG8_SB(1, 0), cB + kstep, voffB); PG8_STAGE(PG8_SA(1, 0), cA + kstep, voffA); PG8_STAGE(PG8_SB(1, 1), cB + hstep + kstep, voffB);
        PG8_WAIT_V(6); PG8_BAR;
    }
    for (;;) {
        const bool has_next = S.next(ui + 1, nxt);
        const char* nA = has_next ? (const char*)g.A + (size_t)nxt.pm * tstep : cA; const char* nB = has_next ? (const char*)g.Bt + (size_t)nxt.pn * tstep : cB;
        for (int t = 0; t < nt; t += 2) {
            const bool last = (t == nt - 2);
            const char* a1 = cA + (size_t)(t + 1) * kstep;
            const char* a2 = last ? nA : cA + (size_t)(t + 2) * kstep; const char* b2 = last ? nB : cB + (size_t)(t + 2) * kstep;
            const char* a3 = a2 + kstep; const char* b3 = b2 + kstep;
            if (last && has_next) S.a_ready(nxt);
            if constexpr (SP2) {
            PG8_LDB(B0, 0, 0); PG8_LDB(B1, 0, 1); PG8_SCHED; PG8_LDA(At, 0, 0); PG8_STAGE(PG8_SA(1, 1), a1 + hstep, voffA);
            PG8_WAIT_V(8); PG8_WAIT_L(0); PG8_BAR; PG8_MMA(0, 0, At, B0); PG8_MMA(0, 1, At, B1); PG8_BAR; PG8_SCHED;
            PG8_LDA(At, 0, 1); PG8_STAGE(PG8_SB(0, 0), b2, voffB); PG8_STAGE(PG8_SB(0, 1), b2 + hstep, voffB); PG8_STAGE(PG8_SA(0, 0), a2, voffA);
            PG8_WAIT_V(8); PG8_WAIT_L(0); PG8_BAR; PG8_MMA(1, 0, At, B0); PG8_MMA(1, 1, At, B1); PG8_BAR; PG8_SCHED;
            PG8_LDB(B0, 1, 0); PG8_LDB(B1, 1, 1); PG8_SCHED; PG8_LDA(At, 1, 0); PG8_STAGE(PG8_SA(0, 1), a2 + hstep, voffA);
            PG8_WAIT_V(8); PG8_WAIT_L(0); PG8_BAR; PG8_MMA(0, 0, At, B0); PG8_MMA(0, 1, At, B1); PG8_BAR; PG8_SCHED;
            PG8_LDA(At, 1, 1); PG8_STAGE(PG8_SB(1, 0), b3, voffB); PG8_STAGE(PG8_SB(1, 1), b3 + hstep, voffB); PG8_STAGE(PG8_SA(1, 0), a3, voffA);
            PG8_WAIT_V(8); PG8_WAIT_L(0); PG8_BAR; PG8_MMA(1, 0, At, B0); PG8_MMA(1, 1, At, B1); PG8_BAR; PG8_SCHED;
            } else {
            PG8_LDB(B0, 0, 0); PG8_SCHED; PG8_LDA(At, 0, 0); PG8_STAGE(PG8_SA(1, 1), a1 + hstep, voffA);
            PG8_WAIT_L(8); PG8_BAR; PG8_WAIT_L(0); PG8_MMA(0, 0, At, B0); PG8_BAR; PG8_SCHED;
            PG8_LDB(B1, 0, 1); PG8_STAGE(PG8_SB(0, 0), b2, voffB);
            PG8_BAR; PG8_WAIT_L(0); PG8_MMA(0, 1, At, B1); PG8_BAR;
            PG8_LDA(At, 0, 1); PG8_STAGE(PG8_SA(0, 0), a2, voffA);
            PG8_BAR; PG8_WAIT_L(0); PG8_MMA(1, 0, At, B0); PG8_BAR; PG8_SCHED;
            PG8_STAGE(PG8_SB(0, 1), b2 + hstep, voffB);
            PG8_WAIT_V(6); PG8_BAR; PG8_MMA(1, 1, At, B1); PG8_BAR;
            PG8_LDB(B0, 1, 0); PG8_SCHED; PG8_LDA(At, 1, 0); PG8_STAGE(PG8_SA(0, 1), a2 + hstep, voffA);
            PG8_WAIT_L(8); PG8_BAR; PG8_WAIT_L(0); PG8_MMA(0, 0, At, B0); PG8_BAR; PG8_SCHED;
            PG8_LDB(B1, 1, 1); PG8_STAGE(PG8_SB(1, 0), b3, voffB);
            PG8_BAR; PG8_WAIT_L(0); PG8_MMA(0, 1, At, B1); PG8_BAR;
            PG8_LDA(At, 1, 1); PG8_STAGE(PG8_SA(1, 0), a3, voffA);
            PG8_BAR; PG8_WAIT_L(0); PG8_MMA(1, 0, At, B0); PG8_BAR; PG8_SCHED;
            PG8_STAGE(PG8_SB(1, 1), b3 + hstep, voffB);
            PG8_WAIT_V(6); PG8_BAR; PG8_MMA(1, 1, At, B1); PG8_BAR;
            }
        }
        if constexpr (ALIGN_EPI) { if (wr == 0) PG8_BAR; }
        if constexpr (!Epi::AFTER_DRAIN) { E(acc, cur, wr, wc, fr, fq); S.done(cur); }
        if (!has_next) break;
#pragma unroll
        for (int a = 0; a < 2; ++a)
#pragma unroll
            for (int b = 0; b < 2; ++b)
#pragma unroll
                for (int m = 0; m < 4; ++m)
#pragma unroll
                    for (int n = 0; n < 2; ++n) acc[a][b][m][n] = (f32x4){0.f, 0.f, 0.f, 0.f};
        cur = nxt; cA = nA; cB = nB; ++ui;
        if constexpr (ALIGN_EPI) { if (wr == 1) PG8_BAR; }
    }
    PG8_WAIT_V(0);
    if constexpr (!ALIGN_EPI) { if (wr == 0) PG8_BAR; }
    PG8_BAR;
    if constexpr (Epi::AFTER_DRAIN) { E.fused(acc, cur, wr, wc, fr, fq, lds, wid, lane); S.done(cur); }
#undef PG8_SA
#undef PG8_SB
#undef PG8_STAGE
#undef PG8_LDA
#undef PG8_LDB
#undef PG8_MMA
#undef PG8_WAIT_V
#undef PG8_WAIT_L
#undef PG8_BAR
#undef PG8_SCHED
}
}
constexpr int SEQ = 4096, NB = 8, DM = 1024, NH = 16, HD = 64, MTOK = NB * SEQ, DFF = 2816, NFF2 = 2 * DFF, DEPTH = 4;
constexpr int NQK_A = 2048, NQK_B = 2816;
constexpr int MHALF = MTOK / 2;
constexpr int NTHREADS = 512, NWAVES = 8;
constexpr float LOG2E = 1.4426950408889634f;
constexpr size_t MiB = 1u << 20;
constexpr size_t WS_CTL = 0, CTL_BYTES = 64 * 1024;
constexpr size_t WS_ROPE = 1 * MiB;
constexpr size_t WS_SSQ = 128 * 1024;
constexpr size_t WS_W = 2 * MiB, W_LAYER = 26 * MiB, WL_QK = 0, WL_V = 5632 * 1024, WL_O = WL_V + 2 * MiB, WL_IN = WL_O + 2 * MiB, WL_D = WL_IN + 11 * MiB;
constexpr size_t WS_XN = 106 * MiB, WS_OB = 170 * MiB, WS_SCR = WS_XN;
constexpr size_t WS_QO = 234 * MiB, WS_K = 298 * MiB, WS_VT = 362 * MiB, WS_QI = 426 * MiB, WS_KI = 458 * MiB, WS_WI = 462 * MiB, WS_MASK = 463 * MiB;
constexpr size_t WS_HM = 234 * MiB, WS_EF = 410 * MiB, WS_EL = 416 * MiB, WS_END = 498 * MiB;
static_assert(WL_D + (size_t)DM * DFF * 2 <= W_LAYER, "weights per layer");
static_assert(WS_W + DEPTH * W_LAYER <= WS_XN && WS_MASK + 16 * MiB <= WS_END && WS_HM + (size_t)MTOK * DFF * 2 <= WS_EF && WS_EF + (size_t)256 * NFF2 * 4 <= WS_EL && WS_EL + (size_t)256 * NFF2 * 4 <= WS_END, "ws map");

#define LAS __attribute__((address_space(3)))
typedef unsigned short bf16;
typedef short bf16x8 __attribute__((ext_vector_type(8)));
typedef float f32x4 __attribute__((ext_vector_type(4)));
typedef float f32x16 __attribute__((ext_vector_type(16)));
typedef unsigned u32x4 __attribute__((ext_vector_type(4)));
typedef unsigned u32x2 __attribute__((ext_vector_type(2)));
typedef float f32x2_t __attribute__((ext_vector_type(2))); typedef __bf16 bf16x2_t __attribute__((ext_vector_type(2)));
__device__ __forceinline__ unsigned cvtpk(float lo, float hi) { f32x2_t v = {lo, hi}; bf16x2_t b = __builtin_convertvector(v, bf16x2_t); return __builtin_bit_cast(unsigned, b); }
__device__ __forceinline__ float bf2f(unsigned short h) { return __uint_as_float((unsigned)h << 16); }
__device__ __forceinline__ float wave_sum(float v) {
#pragma unroll
    for (int o = 1; o < 64; o <<= 1) v += __shfl_xor(v, o);
    return v;
}
__device__ __forceinline__ unsigned wave_sum_u32(unsigned v) {
    v += (unsigned)__builtin_amdgcn_update_dpp(0, (int)v, 0x111, 0xf, 0xf, true);
    v += (unsigned)__builtin_amdgcn_update_dpp(0, (int)v, 0x112, 0xf, 0xf, true);
    v += (unsigned)__builtin_amdgcn_update_dpp(0, (int)v, 0x114, 0xf, 0xf, true);
    v += (unsigned)__builtin_amdgcn_update_dpp(0, (int)v, 0x118, 0xf, 0xf, true);
    v += (unsigned)__builtin_amdgcn_update_dpp(0, (int)v, 0x142, 0xa, 0xf, true);
    v += (unsigned)__builtin_amdgcn_update_dpp(0, (int)v, 0x143, 0xc, 0xf, true);
    return (unsigned)__builtin_amdgcn_readlane((int)v, 63);
}
__device__ __forceinline__ int lane_id() { unsigned ones = ~0u; asm volatile("" : "+s"(ones)); return (int)__builtin_amdgcn_mbcnt_hi(ones, __builtin_amdgcn_mbcnt_lo(ones, 0u)); }
__device__ __forceinline__ int pi_row(int i) { return (i & ~12) | ((i & 4) << 1) | ((i & 8) >> 1); }

struct Params {
    const float* x; const float* norm1_g; const float* norm2_g;
    const float* a_w_qkv; const float* a_q_norm; const float* a_k_norm; const float* a_rel_bias; const float* a_w_o;
    const float* b_w_in; const float* b_q_norm; const float* b_k_norm; const float* b_w_o;
    const float* c_w_qkv; const float* c_w_o;
    const float* ffn_w_in; const float* ffn_conv_w; const float* ffn_conv_b; const float* ffn_w_down;
    float* out; unsigned char* ws;
};

__device__ __forceinline__ void transpose_item(const float* W, int K, int ldw, int src_col0, int nvalid, bf16* WT, int dst_row0, int perm, const float* gk, LAS float* scr, int item, int lane) {
    const int kblks = K / 64, nb = item / kblks, kb = item % kblks, k0 = 64 * kb, n0 = 32 * nb;
    const int nn = n0 + (lane & 31); const bool ok = nn < nvalid;
    float wv[32];
#pragma unroll
    for (int i = 0; i < 32; ++i) { const int kk = 2 * i + (lane >> 5); wv[i] = ok ? W[(size_t)(k0 + kk) * ldw + src_col0 + nn] : 0.f; }
    if (gk) {
#pragma unroll
        for (int i = 0; i < 32; ++i) wv[i] *= gk[k0 + 2 * i + (lane >> 5)];
    }
#pragma unroll
    for (int i = 0; i < 32; ++i) { const int kk = 2 * i + (lane >> 5); scr[kk * 33 + (lane & 31)] = wv[i]; }
    asm volatile("s_waitcnt lgkmcnt(0)" ::: "memory");
    int L = dst_row0 + n0;
    if (perm == 1) { const int l = L & 255; L = (L & ~255) | (((l >> 5) & 1) * 128 + (l >> 6) * 32); }
    else if (perm == 2) { const int hb = L >= DFF ? 1 : 0, c = L - hb * DFF; L = (c >> 7) * 256 + hb * 128 + (c & 127); }
    const int c = lane & 7;
#pragma unroll
    for (int j = 0; j < 4; ++j) { const int n = (lane >> 3) + 8 * j; const LAS float* s = scr + (8 * c) * 33 + n;
        u32x4 o; o.x = cvtpk(s[0 * 33], s[1 * 33]); o.y = cvtpk(s[2 * 33], s[3 * 33]); o.z = cvtpk(s[4 * 33], s[5 * 33]); o.w = cvtpk(s[6 * 33], s[7 * 33]);
        *(u32x4*)(WT + (size_t)(L + n) * K + k0 + 8 * c) = o; }
    asm volatile("s_waitcnt lgkmcnt(0)" ::: "memory");
}
__device__ __forceinline__ void rms_row_to_bf16(const float* xrow, const float* g, bf16* orow, int lane) {
    const f32x4* xr = (const f32x4*)xrow + lane; const f32x4* gr = (const f32x4*)g + lane;
    f32x4 v[4]; float s = 0.f;
#pragma unroll
    for (int j = 0; j < 4; ++j) { v[j] = xr[64 * j]; s += (v[j].x * v[j].x + v[j].y * v[j].y) + (v[j].z * v[j].z + v[j].w * v[j].w); }
    const float rstd = rsqrtf(wave_sum(s) * (1.f / DM) + 1e-6f);
    u32x2* o8 = (u32x2*)orow + lane;
#pragma unroll
    for (int j = 0; j < 4; ++j) { const f32x4 gg = gr[64 * j]; u32x2 w; w.x = cvtpk(v[j].x * rstd * gg.x, v[j].y * rstd * gg.y); w.y = cvtpk(v[j].z * rstd * gg.z, v[j].w * rstd * gg.w); o8[64 * j] = w; }
}
__device__ __forceinline__ void xb_row(const float* xrow, bf16* orow, float* ssq4, int lane) {
    const f32x4* xr = (const f32x4*)xrow + lane;
    f32x4 v[4]; float s = 0.f;
#pragma unroll
    for (int j = 0; j < 4; ++j) { v[j] = xr[64 * j]; s += (v[j].x * v[j].x + v[j].y * v[j].y) + (v[j].z * v[j].z + v[j].w * v[j].w); }
    s = wave_sum(s);
    u32x2* o8 = (u32x2*)orow + lane;
#pragma unroll
    for (int j = 0; j < 4; ++j) { u32x2 w; w.x = cvtpk(v[j].x, v[j].y); w.y = cvtpk(v[j].z, v[j].w); o8[64 * j] = w; }
    if (lane == 0) *(f32x4*)ssq4 = (f32x4){s, 0.f, 0.f, 0.f};
}
__device__ __forceinline__ void norm_phase(const float* X, const float* g, bf16* XN, int gw, int ngw, int lane) {
    for (int m = gw; m < MTOK; m += ngw) rms_row_to_bf16(X + (size_t)m * DM, g, XN + (size_t)m * DM, lane);
}

#define MFMA32(a, b, c) __builtin_amdgcn_mfma_f32_32x32x16_bf16((a), (b), (c), 0, 0, 0)
__device__ __forceinline__ void qk_tile(f32x16& p0, f32x16& p1, const bf16* Kh  , size_t key0, int kpitch, const bf16x8 (&qr)[4], int r32, int hi) {
    const bf16* kp = Kh + (key0 + pi_row(r32)) * (size_t)kpitch + hi * 8;
    p0 = (f32x16){}; p1 = (f32x16){};
#pragma unroll
    for (int d0 = 0; d0 < 4; ++d0) {
        const bf16x8 k0 = *(const bf16x8*)(kp + d0 * 16), k1 = *(const bf16x8*)(kp + (size_t)32 * kpitch + d0 * 16);
        p0 = MFMA32(k0, qr[d0], p0); p1 = MFMA32(k1, qr[d0], p1);
    }
}
__device__ __forceinline__ void pv_tile(f32x16& o0, f32x16& o1, const bf16* Vth  , size_t key0, const f32x16& p0, const f32x16& p1, int r32, int hi) {
    const bf16* vp = Vth + (size_t)r32 * MTOK + key0 + hi * 8;
#pragma unroll
    for (int half = 0; half < 2; ++half)
#pragma unroll
        for (int s = 0; s < 2; ++s) {
            const f32x16& p = half ? p1 : p0;
            u32x4 w; w.x = cvtpk(p[8 * s + 0], p[8 * s + 1]); w.y = cvtpk(p[8 * s + 2], p[8 * s + 3]); w.z = cvtpk(p[8 * s + 4], p[8 * s + 5]); w.w = cvtpk(p[8 * s + 6], p[8 * s + 7]);
            const bf16x8 pf = __builtin_bit_cast(bf16x8, w);
            const bf16x8 v0 = *(const bf16x8*)(vp + half * 32 + s * 16), v1 = *(const bf16x8*)(vp + (size_t)32 * MTOK + half * 32 + s * 16);
            o0 = MFMA32(v0, pf, o0); o1 = MFMA32(v1, pf, o1);
        }
}
__device__ __forceinline__ void load_q(bf16x8 (&qr)[4], const bf16* Q, size_t qrow, int h, int hi) {
#pragma unroll
    for (int d0 = 0; d0 < 4; ++d0) qr[d0] = *(const bf16x8*)(Q + qrow * DM + h * HD + d0 * 16 + hi * 8);
}
__device__ __forceinline__ void store_o(bf16* O, size_t qrow, int h, const f32x16& o0, const f32x16& o1, float rl, int hi) {
    bf16* op = O + qrow * DM + h * HD + 4 * hi;
#pragma unroll
    for (int dh = 0; dh < 2; ++dh)
#pragma unroll
        for (int g = 0; g < 4; ++g) { const f32x16& o = dh ? o1 : o0; u32x2 w; w.x = cvtpk(o[4 * g] * rl, o[4 * g + 1] * rl); w.y = cvtpk(o[4 * g + 2] * rl, o[4 * g + 3] * rl);
            *(u32x2*)(op + 32 * dh + 8 * g) = w; }
}
#define MAX3(a, b, c) __builtin_fmaxf(__builtin_fmaxf((a), (b)), (c))
__device__ __forceinline__ void softmax_step(f32x16& p0, f32x16& p1, float& m, float& l, f32x16& o0, f32x16& o1) {
    float a = MAX3(p0[0], p0[1], p0[2]), b = MAX3(p1[0], p1[1], p1[2]);
#pragma unroll
    for (int r = 3; r < 15; r += 2) { a = MAX3(a, p0[r], p0[r + 1]); b = MAX3(b, p1[r], p1[r + 1]); }
    float mx = MAX3(a, b, p0[15]); mx = fmaxf(mx, p1[15]);
    mx = fmaxf(mx, __shfl_xor(mx, 32));
    const float mn = fmaxf(m, mx);
    if (!__all(mn == m)) {
        const float alpha = __builtin_amdgcn_exp2f(m - mn); m = mn; l *= alpha;
#pragma unroll
        for (int r = 0; r < 16; ++r) { o0[r] *= alpha; o1[r] *= alpha; }
    }
    float s = 0.f;
#pragma unroll
    for (int r = 0; r < 16; ++r) { p0[r] = __builtin_amdgcn_exp2f(p0[r] - mn); p1[r] = __builtin_amdgcn_exp2f(p1[r] - mn); s += p0[r] + p1[r]; }
    l += s;
}
__device__ __forceinline__ void attn_unit_of(int u, int& bh, int& qb) { bh = u >> 7; qb = u & 127; if ((u >> 11) & 1) qb = 127 - qb; }

__device__ __forceinline__ void attnA_phase(const bf16* Q, const bf16* K, const bf16* Vt, bf16* O, const float* rel_bias  , LAS float* biasL, int vw, int nvw, int tid) {
    for (int i = tid; i < 16 * 513; i += NTHREADS) biasL[(i / 513) * 516 + (i % 513)] = rel_bias[i] * LOG2E;
    __syncthreads();
    const int lane = tid & 63, r32 = lane & 31, hi = lane >> 5;
    for (int u = vw; u < NB * NH * 128; u += nvw) {
        int bh, qb; attn_unit_of(u, bh, qb); const int b = bh >> 4, h = bh & 15, c = qb >> 1, qh = qb & 1;
        const size_t qrow = (size_t)b * SEQ + qb * 32 + r32;
        bf16x8 qr[4]; load_q(qr, Q, qrow, h, hi);
        f32x16 o0 = (f32x16){}, o1 = (f32x16){}; float m = -1e30f, l = 0.f;
        const LAS float* bl = biasL + h * 516;
        for (int kt = (c < 8 ? 8 - c : 0); kt <= 8; ++kt) {
            const size_t key0 = (size_t)b * SEQ + (size_t)(c - 8 + kt) * 64;
            f32x16 p0, p1; qk_tile(p0, p1, K + h * HD, key0, DM, qr, r32, hi);
            if (kt >= 4) {
                const int base = (8 - kt) * 64 + qh * 32 + r32 - 8 * hi;
#pragma unroll
                for (int r = 0; r < 16; ++r) { const int d0 = base - (16 * (r >> 3) + (r & 7)); const int d1 = d0 - 32;
                    p0[r] += bl[(d0 < 256 ? d0 : 256) + 256]; p1[r] += bl[(d1 < 256 ? d1 : 256) + 256]; }
            } else { const float bc = bl[512];
#pragma unroll
                for (int r = 0; r < 16; ++r) { p0[r] += bc; p1[r] += bc; } }
            softmax_step(p0, p1, m, l, o0, o1);
            pv_tile(o0, o1, Vt + (size_t)h * HD * MTOK, key0, p0, p1, r32, hi);
        }
        l += __shfl_xor(l, 32);
        store_o(O, qrow, h, o0, o1, 1.0f / l, hi);
    }
}
__device__ __forceinline__ void attnC_phase(const bf16* Q, const bf16* K, const bf16* Vt, bf16* O, int vw, int nvw, int tid) {
    const int lane = tid & 63, r32 = lane & 31, hi = lane >> 5;
    for (int u = vw; u < NB * NH * 128; u += nvw) {
        int bh, qb; attn_unit_of(u, bh, qb); const int b = bh >> 4, h = bh & 15;
        const size_t qrow = (size_t)b * SEQ + qb * 32 + r32; const int t = qb * 32 + r32;
        bf16x8 qr[4]; load_q(qr, Q, qrow, h, hi);
        f32x16 o0 = (f32x16){}, o1 = (f32x16){}; float R = 0.f;
        for (int kt = qb >> 1; kt >= 0; --kt) {
            const size_t key0 = (size_t)b * SEQ + (size_t)kt * 64;
            f32x16 p0, p1; qk_tile(p0, p1, K + h * HD, key0, DM, qr, r32, hi);
            const int kb = kt * 64 + 8 * hi;
            float lk[32], lb[32];
#pragma unroll
            for (int e = 0; e < 32; ++e) { const int r = e & 15, half = e >> 4; const float z = half ? p1[r] : p0[r];
                const int key = kb + 32 * half + 16 * (r >> 3) + (r & 7);
                const float sp = fmaxf(z, 0.f) + __builtin_amdgcn_logf(1.f + __builtin_amdgcn_exp2f(-fabsf(z)));
                const bool valid = key < t;
                lk[e] = valid ? -sp : 0.f; lb[e] = valid ? (z - sp) : -INFINITY; }
            float G[4], ex[32];
#pragma unroll
            for (int gi = 0; gi < 4; ++gi) { float run = 0.f;
#pragma unroll
                for (int i = 7; i >= 0; --i) { ex[gi * 8 + i] = run; run += lk[gi * 8 + i]; }
                G[gi] = run; }
            float Gp[4];
#pragma unroll
            for (int gi = 0; gi < 4; ++gi) Gp[gi] = __shfl_xor(G[gi], 32);
            float suf[4]; float run = 0.f;
#pragma unroll
            for (int gi = 3; gi >= 0; --gi) { suf[gi] = run + (hi == 0 ? Gp[gi] : 0.f); run += G[gi] + Gp[gi]; }
#pragma unroll
            for (int e = 0; e < 32; ++e) { const float a = __builtin_amdgcn_exp2f(lb[e] + R + suf[e >> 3] + ex[e]); if (e < 16) p0[e] = a; else p1[e - 16] = a; }
            R += run;
            pv_tile(o0, o1, Vt + (size_t)h * HD * MTOK, key0, p0, p1, r32, hi);
            if (__all(R < -300.f)) break;
        }
        store_o(O, qrow, h, o0, o1, 1.0f, hi);
    }
}
constexpr int TP = 144;
constexpr int TILE_B = 64 * TP, KVBUF_B = 2 * TILE_B;
constexpr int PAIR_B = 2 * KVBUF_B;
struct KVStage { u32x4 k, v; };
__device__ __forceinline__ void kv_issue(KVStage& st, const bf16* Kh, const bf16* Vth, size_t key0, int tid) {
    const int row = tid >> 3, ch = tid & 7;
    st.k = *(const u32x4*)(Kh + (key0 + row) * DM + ch * 8);
    st.v = *(const u32x4*)(Vth + (size_t)row * MTOK + key0 + ch * 8);
}
__device__ __forceinline__ void kv_write(const KVStage& st, LAS unsigned char* buf, int tid) {
    const int row = tid >> 3, ch = tid & 7;
    *(LAS u32x4*)(buf + row * TP + ch * 16) = st.k;
    *(LAS u32x4*)(buf + TILE_B + row * TP + ch * 16) = st.v;
}
template <bool INIT = true> __device__ __forceinline__ void qk_lds(f32x16& p0, f32x16& p1, const LAS unsigned char* buf, const bf16x8 (&qr)[4], int r32, int hi) {
    const LAS unsigned char* kp = buf + pi_row(r32) * TP + hi * 16;
    if (INIT) { p0 = (f32x16){}; p1 = (f32x16){}; }
#pragma unroll
    for (int d0 = 0; d0 < 4; ++d0) {
        const bf16x8 k0 = *(const LAS bf16x8*)(kp + d0 * 32), k1 = *(const LAS bf16x8*)(kp + 32 * TP + d0 * 32);
        p0 = MFMA32(k0, qr[d0], p0); p1 = MFMA32(k1, qr[d0], p1);
    }
}
__device__ __forceinline__ void pv_lds(f32x16& o0, f32x16& o1, const LAS unsigned char* buf, const f32x16& p0, const f32x16& p1, int r32, int hi) {
    const LAS unsigned char* vp = buf + TILE_B + r32 * TP + hi * 16;
#pragma unroll
    for (int half = 0; half < 2; ++half)
#pragma unroll
        for (int s = 0; s < 2; ++s) {
            const f32x16& p = half ? p1 : p0;
            u32x4 w; w.x = cvtpk(p[8 * s + 0], p[8 * s + 1]); w.y = cvtpk(p[8 * s + 2], p[8 * s + 3]); w.z = cvtpk(p[8 * s + 4], p[8 * s + 5]); w.w = cvtpk(p[8 * s + 6], p[8 * s + 7]);
            const bf16x8 pf = __builtin_bit_cast(bf16x8, w);
            const bf16x8 v0 = *(const LAS bf16x8*)(vp + half * 64 + s * 32), v1 = *(const LAS bf16x8*)(vp + 32 * TP + half * 64 + s * 32);
            o0 = MFMA32(v0, pf, o0); o1 = MFMA32(v1, pf, o1);
        }
}
#define WG_BARRIER_L() do { asm volatile("s_waitcnt lgkmcnt(0)" ::: "memory"); __builtin_amdgcn_s_barrier(); asm volatile("" ::: "memory"); } while (0)
#define WG_BARRIER() do { asm volatile("s_waitcnt vmcnt(0) lgkmcnt(0)" ::: "memory"); __builtin_amdgcn_s_barrier(); asm volatile("" ::: "memory"); } while (0)
__device__ __forceinline__ void blk_unit_of(int u, int& bh, int& ub) { bh = u >> 4; ub = u & 15; if ((u >> 8) & 1) ub = 15 - ub; }

template <bool FIXED> __device__ __forceinline__ void attnA_blk(const bf16* Q, const bf16* K, const bf16* Vt, bf16* O, const float* rel_bias, float ref, LAS unsigned char* lds, int vcu, int G, int tid) {
    LAS float* biasL = (LAS float*)(lds + 2 * PAIR_B);
    for (int i = tid; i < 16 * 513; i += NTHREADS) biasL[(i / 513) * 516 + (i % 513)] = rel_bias[i] * LOG2E - (FIXED ? ref : 0.f);
    __syncthreads();
    const int lane = tid & 63, r32 = lane & 31, hi = lane >> 5, wid = __builtin_amdgcn_readfirstlane(tid >> 6);
#pragma unroll 1
    for (int u = vcu; u < NB * NH * 16; u += G) {
        int bh, ub; blk_unit_of(u, bh, ub); const int b = bh >> 4, h = bh & 15, qb = ub * 8 + wid, c = qb >> 1, qh = qb & 1;
        const size_t qrow = (size_t)b * SEQ + qb * 32 + r32;
        bf16x8 qr[4]; load_q(qr, Q, qrow, h, hi);
        f32x16 o0 = (f32x16){}, o1 = (f32x16){}; float m = -1e30f, l = 0.f;
        const LAS float* bl = biasL + h * 516;
        const bf16* Kh = K + h * HD; const bf16* Vth = Vt + (size_t)h * HD * MTOK;
        const int c0 = ub * 4, t_lo = c0 >= 8 ? c0 - 8 : 0, t_hi = c0 + 3;
        const size_t kbase = (size_t)b * SEQ; const int ntl = t_hi - t_lo + 1;
        KVStage sa, sb;
        kv_issue(sa, Kh, Vth, kbase + (size_t)t_lo * 64, tid); kv_issue(sb, Kh, Vth, kbase + (size_t)(t_lo + 1) * 64, tid);
        kv_write(sa, lds, tid); kv_write(sb, lds + KVBUF_B, tid); WG_BARRIER();
#define ATT_PAIR(IT) do { const int it_ = (IT); LAS unsigned char* pb = lds + ((it_ >> 1) & 1) * PAIR_B; \
            if (it_ + 2 < ntl) { kv_issue(sa, Kh, Vth, kbase + (size_t)(t_lo + it_ + 2) * 64, tid); kv_issue(sb, Kh, Vth, kbase + (size_t)(t_lo + it_ + 3) * 64, tid); } \
            { const int t = t_lo + it_; LAS unsigned char* buf = pb; ATT_COMPUTE } \
            { const int t = t_lo + it_ + 1; LAS unsigned char* buf = pb + KVBUF_B; ATT_COMPUTE } \
            if (it_ + 2 < ntl) { LAS unsigned char* nb = lds + (((it_ >> 1) + 1) & 1) * PAIR_B; kv_write(sa, nb, tid); kv_write(sb, nb + KVBUF_B, tid); } \
            WG_BARRIER(); } while (0)
#define ATT_COMPUTE             if (t >= c - 8 && t <= c) { \
                const int kt = t - c + 8; \
                f32x16 p0, p1; \
                if (kt > 4) { \
                    const LAS float* bp = bl + ((8 - kt) * 64 + qh * 32 + r32 - 8 * hi + 256); \
_Pragma("unroll") \
                    for (int r = 0; r < 16; ++r) { p0[r] = bp[-(16 * (r >> 3) + (r & 7))]; p1[r] = bp[-(16 * (r >> 3) + (r & 7)) - 32]; } \
                } else if (kt == 4) { \
                    const int base = 4 * 64 + qh * 32 + r32 - 8 * hi; \
_Pragma("unroll") \
                    for (int r = 0; r < 16; ++r) { const int d0 = base - (16 * (r >> 3) + (r & 7)); const int d1 = d0 - 32; \
                        p0[r] = bl[(d0 < 256 ? d0 : 256) + 256]; p1[r] = bl[(d1 < 256 ? d1 : 256) + 256]; } \
                } else { const float bc = bl[512]; \
_Pragma("unroll") \
                    for (int r = 0; r < 16; ++r) { p0[r] = bc; p1[r] = bc; } } \
                qk_lds<false>(p0, p1, buf, qr, r32, hi); \
                if (FIXED) { float sacc = 0.f; \
_Pragma("unroll") \
                    for (int r = 0; r < 16; ++r) { p0[r] = __builtin_amdgcn_exp2f(p0[r]); p1[r] = __builtin_amdgcn_exp2f(p1[r]); sacc += p0[r] + p1[r]; } \
                    l += sacc; \
                } else softmax_step(p0, p1, m, l, o0, o1); \
                pv_lds(o0, o1, buf, p0, p1, r32, hi); \
            }
#pragma unroll 1
        for (int it = 0; it < ntl; it += 2) ATT_PAIR(it);
#undef ATT_COMPUTE
        l += __shfl_xor(l, 32);
        store_o(O, qrow, h, o0, o1, 1.0f / l, hi);
    }
}
template <bool FIXED> __device__ __forceinline__ void attnB_blk(const bf16* Q, const bf16* K, const bf16* Vt, bf16* O, const unsigned long long* MASK, float ref, LAS unsigned char* lds, int vcu, int G, int tid) {
    const int lane = tid & 63, r32 = lane & 31, hi = lane >> 5, wid = __builtin_amdgcn_readfirstlane(tid >> 6);
#pragma unroll 1
    for (int u = vcu; u < NB * NH * 16; u += G) {
        int bh, ub; blk_unit_of(u, bh, ub); const int b = bh >> 4, h = bh & 15, qb = ub * 8 + wid;
        const size_t qrow = (size_t)b * SEQ + qb * 32 + r32;
        bf16x8 qr[4]; load_q(qr, Q, qrow, h, hi);
        f32x16 o0 = (f32x16){}, o1 = (f32x16){}; float m = -1e30f, l = 0.f;
        const unsigned long long* mrow = MASK + qrow * 64;
        const int ntile = (qb >> 1) + 1, t_hi = ub * 4 + 3;
        const bf16* Kh = K + h * HD; const bf16* Vth = Vt + (size_t)h * HD * MTOK;
        const size_t kbase = (size_t)b * SEQ; const int ntl = t_hi + 1, t_lo = 0;
        KVStage sa, sb;
        kv_issue(sa, Kh, Vth, kbase, tid); kv_issue(sb, Kh, Vth, kbase + 64, tid);
        unsigned long long mw_next = mrow[0];
        kv_write(sa, lds, tid); kv_write(sb, lds + KVBUF_B, tid); WG_BARRIER();
#define ATT_COMPUTE const unsigned long long mw = mw_next; if (t + 1 < ntile) mw_next = mrow[t + 1]; \
            if (t < ntile) { \
 \
                const int n0 = (int)~((unsigned)mw >> (8 * hi)), n1 = (int)~((unsigned)(mw >> 32) >> (8 * hi)); \
                f32x16 p0, p1; \
_Pragma("unroll") \
                for (int r = 0; r < 16; ++r) { const int bit = 16 * (r >> 3) + (r & 7); \
                    const float i0 = __int_as_float(__builtin_amdgcn_sbfe(n0, bit, 1) & (int)0xFF800000), i1 = __int_as_float(__builtin_amdgcn_sbfe(n1, bit, 1) & (int)0xFF800000); \
                    p0[r] = FIXED ? i0 - ref : i0; p1[r] = FIXED ? i1 - ref : i1; } \
                qk_lds<false>(p0, p1, buf, qr, r32, hi); \
                if (FIXED) { float sacc = 0.f; \
_Pragma("unroll") \
                    for (int r = 0; r < 16; ++r) { p0[r] = __builtin_amdgcn_exp2f(p0[r]); p1[r] = __builtin_amdgcn_exp2f(p1[r]); sacc += p0[r] + p1[r]; } \
                    l += sacc; \
                } else softmax_step(p0, p1, m, l, o0, o1); \
                pv_lds(o0, o1, buf, p0, p1, r32, hi); \
            }
#pragma unroll 1
        for (int it = 0; it < ntl; it += 2) ATT_PAIR(it);
#undef ATT_COMPUTE
        l += __shfl_xor(l, 32);
        store_o(O, qrow, h, o0, o1, 1.0f / l, hi);
    }
}
__device__ __forceinline__ void attnC_blk(const bf16* Q, const bf16* K, const bf16* Vt, bf16* O, LAS unsigned char* lds, int vcu, int G, int tid) {
    const int lane = tid & 63, r32 = lane & 31, hi = lane >> 5, wid = __builtin_amdgcn_readfirstlane(tid >> 6);
    LAS unsigned* flags = (LAS unsigned*)(lds + 2 * KVBUF_B);
#pragma unroll 1
    for (int u = vcu; u < NB * NH * 16; u += G) {
        int bh, ub; blk_unit_of(u, bh, ub); const int b = bh >> 4, h = bh & 15, qb = ub * 8 + wid;
        const size_t qrow = (size_t)b * SEQ + qb * 32 + r32; const int tq = qb * 32 + r32;
        bf16x8 qr[4]; load_q(qr, Q, qrow, h, hi);
        f32x16 o0 = (f32x16){}, o1 = (f32x16){}; float R = 0.f; bool done = false;
        const int t_hi = ub * 4 + 3, t_me = qb >> 1;
        const bf16* Kh = K + h * HD; const bf16* Vth = Vt + (size_t)h * HD * MTOK;
        KVStage st; kv_issue(st, Kh, Vth, (size_t)b * SEQ + (size_t)t_hi * 64, tid); kv_write(st, lds, tid); WG_BARRIER();
#pragma unroll 1
        for (int t = t_hi, it = 0; t >= 0; --t, ++it) {
            LAS unsigned char* buf = lds + (it & 1) * KVBUF_B;
            if (t > 0) kv_issue(st, Kh, Vth, (size_t)b * SEQ + (size_t)(t - 1) * 64, tid);
            if (t <= t_me && !done) {
                f32x16 p0, p1; qk_lds(p0, p1, buf, qr, r32, hi);
                const int kb = t * 64 + 8 * hi;
                float lk[32], lb[32];
#pragma unroll
                for (int e = 0; e < 32; ++e) { const int r = e & 15, half = e >> 4; const float z = half ? p1[r] : p0[r];
                    const int key = kb + 32 * half + 16 * (r >> 3) + (r & 7);
                    const float sp = fmaxf(z, 0.f) + __builtin_amdgcn_logf(1.f + __builtin_amdgcn_exp2f(-fabsf(z)));
                    const bool valid = key < tq;
                    lk[e] = valid ? -sp : 0.f; lb[e] = valid ? (z - sp) : -INFINITY; }
                float Gs[4], ex[32];
#pragma unroll
                for (int gi = 0; gi < 4; ++gi) { float run = 0.f;
#pragma unroll
                    for (int i = 7; i >= 0; --i) { ex[gi * 8 + i] = run; run += lk[gi * 8 + i]; }
                    Gs[gi] = run; }
                float Gp[4];
#pragma unroll
                for (int gi = 0; gi < 4; ++gi) Gp[gi] = __shfl_xor(Gs[gi], 32);
                float suf[4]; float run = 0.f;
#pragma unroll
                for (int gi = 3; gi >= 0; --gi) { suf[gi] = run + (hi == 0 ? Gp[gi] : 0.f); run += Gs[gi] + Gp[gi]; }
#pragma unroll
                for (int e = 0; e < 32; ++e) { const float a = __builtin_amdgcn_exp2f(lb[e] + R + suf[e >> 3] + ex[e]); if (e < 16) p0[e] = a; else p1[e - 16] = a; }
                R += run;
                pv_lds(o0, o1, buf, p0, p1, r32, hi);
                done = __all(R < -300.f);
            }
            if (lane == 0) flags[(it & 1) * 8 + wid] = (done || t == 0) ? 0u : 1u;
            if (t > 0) kv_write(st, lds + ((it + 1) & 1) * KVBUF_B, tid);
            WG_BARRIER();
            unsigned any = 0u;
#pragma unroll
            for (int w = 0; w < 8; ++w) any |= flags[(it & 1) * 8 + w];
            if (any == 0u) break;
        }
        store_o(O, qrow, h, o0, o1, 1.0f, hi);
        WG_BARRIER();
    }
}
#define XB_TMO      128
#define XB_XCNT(j)  (256  + 64 * (j))
#define XB_XSUB(j)  (1280 + 64 * (j))
#define XB_XGEN(j)  (2304 + 64 * (j))
#define XB_TOP      3328
#define XB_TOPGEN   3392
#define XCD_BAR_WORDS 3456
#define XB_SPIN_CAP (1u << 18)

__device__ __forceinline__ unsigned xb_ld(unsigned* p)              { return __hip_atomic_load(p, __ATOMIC_RELAXED, __HIP_MEMORY_SCOPE_AGENT); }
__device__ __forceinline__ unsigned xb_add(unsigned* p, unsigned v) { return __hip_atomic_fetch_add(p, v, __ATOMIC_RELAXED, __HIP_MEMORY_SCOPE_AGENT); }
__device__ __forceinline__ unsigned xb_xcc_id() { return (unsigned)__builtin_amdgcn_s_getreg((3 << 11) | 20) & 0xFu; }
#define XB_SPIN(cond, bar) do { unsigned _sp = 0; while (cond) { __builtin_amdgcn_s_sleep(1); \
    if ((++_sp & 255u) == 0u) { if (xb_ld(&(bar)[XB_TMO])) break; if (_sp > XB_SPIN_CAP) { atomicAdd(&(bar)[XB_TMO], 1u); break; } } } } while (0)

struct XcdBarrier {
    unsigned* bar; unsigned x;
    volatile LAS unsigned* st;
};

__device__ __forceinline__ XcdBarrier xcd_barrier_post(unsigned* bar, volatile LAS unsigned* st) {
    XcdBarrier b; b.bar = bar; b.x = xb_xcc_id(); b.st = st;
    if (threadIdx.x == 0) (void)xb_add(&bar[XB_XCNT(b.x)], 1u);
    return b;
}
__device__ __forceinline__ void xcd_barrier_complete(unsigned* bar, unsigned x, unsigned& nloc, unsigned& nx) {
    const unsigned G = gridDim.x * gridDim.y * gridDim.z;
    unsigned sum, cnt, mine, sp = 0u;
    for (;;) {
        sum = 0u; cnt = 0u; mine = 0u;
#pragma unroll
        for (unsigned j = 0; j < 16; ++j) { const unsigned c = xb_ld(&bar[XB_XCNT(j)]); sum += c; cnt += (c > 0u) ? 1u : 0u; mine = (j == x) ? c : mine; }
        if (sum == G) break;
        __builtin_amdgcn_s_sleep(1);
        if ((++sp & 255u) == 0u) { if (xb_ld(&bar[XB_TMO])) break; if (sp > XB_SPIN_CAP) { atomicAdd(&bar[XB_TMO], 1u); break; } }
    }
    nloc = mine > 0u ? mine : 1u; nx = cnt > 0u ? cnt : 1u;
}

__device__ __forceinline__ void xcd_barrier(const XcdBarrier& b, int g_wave_id) {
    asm volatile("s_waitcnt vmcnt(0)" ::: "memory");
    __syncthreads();
    if (g_wave_id == 0 && lane_id() == 0) {
        unsigned* bar = b.bar;
        __builtin_amdgcn_s_waitcnt(0);
        unsigned nloc = b.st[0], nx = b.st[1];
        if (nloc == 0u) { xcd_barrier_complete(bar, b.x, nloc, nx); b.st[0] = nloc; b.st[1] = nx; }
        const unsigned old = xb_add(&bar[XB_XSUB(b.x)], 1u);
        const unsigned gen = old / nloc;
        if (old + 1u == (gen + 1u) * nloc) {
            __builtin_amdgcn_fence(__ATOMIC_RELEASE, "agent");
            asm volatile("s_waitcnt vmcnt(0)" ::: "memory");
            const unsigned og = xb_add(&bar[XB_TOP], 1u);
            const unsigned tg = og / nx;
            if (og + 1u == (tg + 1u) * nx) xb_add(&bar[XB_TOPGEN], 1u);
            else XB_SPIN(xb_ld(&bar[XB_TOPGEN]) == tg, bar);
            __builtin_amdgcn_fence(__ATOMIC_ACQUIRE, "agent");
            xb_add(&bar[XB_XGEN(b.x)], 1u);
            asm volatile("s_waitcnt vmcnt(0)" ::: "memory");
        } else {
            XB_SPIN(xb_ld(&bar[XB_XGEN(b.x)]) == gen, bar);
            __builtin_amdgcn_fence(__ATOMIC_ACQUIRE, "agent");
            asm volatile("s_waitcnt vmcnt(0)" ::: "memory");
        }
    }
    __syncthreads();
}
constexpr int QI_PITCH = 520;
__device__ __forceinline__ void b1_phase(const bf16* QI, const bf16* KI, const float* WI, float* SCRb  , unsigned long long* MASK,
                                         LAS unsigned char* lds, int vcu, int G, int tid) {
    const int lane = tid & 63, r32 = lane & 31, hi = lane >> 5, wid = __builtin_amdgcn_readfirstlane(tid >> 6);
    LAS bf16* qs = (LAS bf16*)lds;
#pragma unroll 1
    for (int u0 = vcu, rnd = 0; u0 < NB * 128; u0 += G, ++rnd) {
        const int b = u0 >> 7; int qb = u0 & 127; if (rnd & 1) qb = 127 - qb;
        const size_t tok0 = (size_t)b * SEQ + qb * 32;
        const int ntile = (qb >> 1) + 1, limit = ntile * 64;
        for (int i = tid; i < 32 * 64; i += NTHREADS) { const int q = i >> 6, c = i & 63; *(LAS u32x4*)(qs + q * QI_PITCH + c * 8) = *(const u32x4*)(QI + (tok0 + q) * 512 + c * 8); }
        LAS float* wl = (LAS float*)(lds + 32 * QI_PITCH * 2);
        if (tid < 256) wl[tid] = WI[tok0 * 8 + tid];
        __syncthreads();
#ifndef B1_SCORE_REP
#define B1_SCORE_REP 1
#endif
#ifndef B1_TOPK_REP
#define B1_TOPK_REP 1
#endif
#ifndef B1_NO_SCORE
        for (int rep_ = 0; rep_ < B1_SCORE_REP; ++rep_)
#pragma unroll 1
        for (int kt = wid; kt < ntile; kt += NWAVES) {
            const size_t key0 = (size_t)b * SEQ + (size_t)kt * 64;
            const bf16* kp = KI + (key0 + pi_row(r32)) * 64 + hi * 8;
            bf16x8 kf0[4], kf1[4];
#pragma unroll
            for (int d0 = 0; d0 < 4; ++d0) { kf0[d0] = *(const bf16x8*)(kp + d0 * 16); kf1[d0] = *(const bf16x8*)(kp + 32 * 64 + d0 * 16); }
            f32x16 s0 = (f32x16){}, s1 = (f32x16){};
            int qoff = r32 * QI_PITCH + hi * 8; asm volatile("" : "+v"(qoff));
#pragma unroll 1
            for (int hh = 0; hh < 8; ++hh) {
                f32x16 a0 = (f32x16){}, a1 = (f32x16){};
                const float wh = wl[r32 * 8 + hh];
#pragma unroll
                for (int d0 = 0; d0 < 4; ++d0) { const bf16x8 qf = *(const LAS bf16x8*)(qs + qoff + hh * 64 + d0 * 16); a0 = MFMA32(kf0[d0], qf, a0); a1 = MFMA32(kf1[d0], qf, a1); }
#pragma unroll
                for (int r = 0; r < 16; ++r) { s0[r] = __builtin_fmaf(wh, __builtin_fmaxf(a0[r], 0.f), s0[r]); s1[r] = __builtin_fmaf(wh, __builtin_fmaxf(a1[r], 0.f), s1[r]); }
            }
            float* sp = SCRb + (size_t)r32 * 4096 + kt * 64 + 8 * hi;
#pragma unroll
            for (int half = 0; half < 2; ++half)
#pragma unroll
                for (int s = 0; s < 2; ++s) { const f32x16& p = half ? s1 : s0;
                    *(f32x4*)(sp + 32 * half + 16 * s) = (f32x4){p[8 * s], p[8 * s + 1], p[8 * s + 2], p[8 * s + 3]};
                    *(f32x4*)(sp + 32 * half + 16 * s + 4) = (f32x4){p[8 * s + 4], p[8 * s + 5], p[8 * s + 6], p[8 * s + 7]}; }
        }
#endif
        asm volatile("s_waitcnt vmcnt(0)" ::: "memory");
        __syncthreads();
#ifndef B1_NO_TOPK
#pragma unroll 1
        for (int qq = 0; qq < 4 * B1_TOPK_REP; ++qq) {
            const int q = wid * 4 + (qq & 3);
            const float* srow = SCRb + (size_t)q * 4096 + lane;
            unsigned uu[64];
#pragma unroll
            for (int j = 0; j < 64; ++j) { unsigned key = 0u; if (j < ntile) { const float f = srow[j * 64] + 0.0f; const unsigned bts = __float_as_uint(f); key = bts ^ ((bts >> 31) ? 0xFFFFFFFFu : 0x80000000u); } uu[j] = key; }
            unsigned T = 1u;
            if (limit > 256) {
                unsigned prefix = 0u;
#pragma unroll 1
                for (int bit = 31; bit >= 0; --bit) {
                    const unsigned cand = prefix | (1u << bit); unsigned less = 0u;
#pragma unroll
                    for (int j = 0; j < 64; ++j) less += (uu[j] < cand) ? 1u : 0u;
                    const int cnt = 4096 - (int)wave_sum_u32(less);
                    if (cnt >= 256) prefix = cand;
                    if (cnt == 256) break;
                }
                T = prefix;
            }
            int ngt = 0;
#pragma unroll
            for (int j = 0; j < 64; ++j) ngt += __popcll(__ballot(uu[j] > T));
            const int need = (limit > 256) ? (256 - ngt) : 4096;
            int c = 0; unsigned long long myword = 0ull;
#pragma unroll
            for (int j = 0; j < 64; ++j) {
                const bool eq = (uu[j] == T); const unsigned long long eqm = __ballot(eq);
                const int below = __builtin_amdgcn_mbcnt_hi((unsigned)(eqm >> 32), __builtin_amdgcn_mbcnt_lo((unsigned)eqm, 0u));
                const bool sel = (uu[j] > T) || (eq && (c + below < need));
                const unsigned long long word = __ballot(sel);
                c += __popcll(eqm);
                if (lane == j) myword = word;
            }
            if (lane < ntile) MASK[(tok0 + q) * 64 + lane] = myword;
        }
#endif
        __syncthreads();
    }
}
__device__ __forceinline__ void attnB_phase(const bf16* Q, const bf16* K, const bf16* Vt, bf16* O, const unsigned long long* MASK, int vw, int nvw, int tid) {
    const int lane = tid & 63, r32 = lane & 31, hi = lane >> 5;
    for (int u = vw; u < NB * NH * 128; u += nvw) {
        int bh, qb; attn_unit_of(u, bh, qb); const int b = bh >> 4, h = bh & 15;
        const size_t qrow = (size_t)b * SEQ + qb * 32 + r32;
        bf16x8 qr[4]; load_q(qr, Q, qrow, h, hi);
        f32x16 o0 = (f32x16){}, o1 = (f32x16){}; float m = -1e30f, l = 0.f;
        const unsigned long long* mrow = MASK + qrow * 64;
        const int ntile = (qb >> 1) + 1;
        for (int kt = 0; kt < ntile; ++kt) {
            const size_t key0 = (size_t)b * SEQ + (size_t)kt * 64;
            const unsigned long long mw = mrow[kt];
            f32x16 p0, p1; qk_tile(p0, p1, K + h * HD, key0, DM, qr, r32, hi);
            const unsigned m0 = (unsigned)mw >> (8 * hi), m1 = (unsigned)(mw >> 32) >> (8 * hi);
#pragma unroll
            for (int r = 0; r < 16; ++r) { const int bit = 16 * (r >> 3) + (r & 7);
                p0[r] = ((m0 >> bit) & 1u) ? p0[r] : -INFINITY; p1[r] = ((m1 >> bit) & 1u) ? p1[r] : -INFINITY; }
            softmax_step(p0, p1, m, l, o0, o1);
            pv_tile(o0, o1, Vt + (size_t)h * HD * MTOK, key0, p0, p1, r32, hi);
        }
        l += __shfl_xor(l, 32);
        store_o(O, qrow, h, o0, o1, 1.0f / l, hi);
    }
}
__device__ __forceinline__ void conv_phase(const bf16* A, bf16* HM, const float* cw  , const float* cb  , int gtid, int ngt) {
    constexpr int CG = DFF / 8, RUN = 32, NRUN = MHALF / RUN;
    for (int it = gtid; it < CG * NRUN; it += ngt) {
        const int cgp = it % CG, run = it / CG, c0 = cgp * 8, r0 = run * RUN;
        float wg[3][8], wu[3][8], bg[8], bu[8];
#pragma unroll
        for (int i = 0; i < 8; ++i) { bg[i] = cb[c0 + i]; bu[i] = cb[DFF + c0 + i];
#pragma unroll
            for (int k = 0; k < 3; ++k) { wg[k][i] = cw[k * NFF2 + c0 + i]; wu[k][i] = cw[k * NFF2 + DFF + c0 + i]; } }
        float g1[8], g2[8], u1[8], u2[8];
        const bool seqstart = (r0 & (SEQ - 1)) == 0;
#pragma unroll
        for (int i = 0; i < 8; ++i) { g1[i] = g2[i] = u1[i] = u2[i] = 0.f; }
        if (!seqstart) {
            const u32x4 a1 = *(const u32x4*)(A + (size_t)(r0 - 1) * NFF2 + c0), a2 = *(const u32x4*)(A + (size_t)(r0 - 2) * NFF2 + c0);
            const u32x4 b1 = *(const u32x4*)(A + (size_t)(r0 - 1) * NFF2 + DFF + c0), b2 = *(const u32x4*)(A + (size_t)(r0 - 2) * NFF2 + DFF + c0);
#pragma unroll
            for (int i = 0; i < 4; ++i) { g1[2 * i] = __uint_as_float(a1[i] << 16); g1[2 * i + 1] = __uint_as_float(a1[i] & 0xFFFF0000u); g2[2 * i] = __uint_as_float(a2[i] << 16); g2[2 * i + 1] = __uint_as_float(a2[i] & 0xFFFF0000u);
                u1[2 * i] = __uint_as_float(b1[i] << 16); u1[2 * i + 1] = __uint_as_float(b1[i] & 0xFFFF0000u); u2[2 * i] = __uint_as_float(b2[i] << 16); u2[2 * i + 1] = __uint_as_float(b2[i] & 0xFFFF0000u); }
        }
        for (int r = r0; r < r0 + RUN; ++r) {
            const u32x4 a0 = *(const u32x4*)(A + (size_t)r * NFF2 + c0), b0 = *(const u32x4*)(A + (size_t)r * NFF2 + DFF + c0);
            float g0[8], u0[8], hm[8];
#pragma unroll
            for (int i = 0; i < 4; ++i) { g0[2 * i] = __uint_as_float(a0[i] << 16); g0[2 * i + 1] = __uint_as_float(a0[i] & 0xFFFF0000u); u0[2 * i] = __uint_as_float(b0[i] << 16); u0[2 * i + 1] = __uint_as_float(b0[i] & 0xFFFF0000u); }
#pragma unroll
            for (int i = 0; i < 8; ++i) { const float cgv = bg[i] + wg[0][i] * g2[i] + wg[1][i] * g1[i] + wg[2][i] * g0[i]; const float cuv = bu[i] + wu[0][i] * u2[i] + wu[1][i] * u1[i] + wu[2][i] * u0[i];
                hm[i] = cgv / (1.f + __expf(-cgv)) * cuv; g2[i] = g1[i]; g1[i] = g0[i]; u2[i] = u1[i]; u1[i] = u0[i]; }
            u32x4 o; o.x = cvtpk(hm[0], hm[1]); o.y = cvtpk(hm[2], hm[3]); o.z = cvtpk(hm[4], hm[5]); o.w = cvtpk(hm[6], hm[7]);
            *(u32x4*)(HM + (size_t)r * DFF + c0) = o;
        }
    }
}

__device__ __forceinline__ void ffn_fixup(const float* EF, const float* EL, const float* cw, const float* cb, bf16* HM, int gtid, int ngt) {
    for (int it = gtid; it < 128 * 2 * 704; it += ngt) {
        const int j = (it % 704) * 4, rr = (it / 704) & 1, pm = it / 1408;
        if ((pm & 15) == 0) continue;
        const int pg = (j >> 7) * 256 + (j & 127);
        f32x4 c[2];
#pragma unroll
        for (int bj = 0; bj < 2; ++bj) { const int pc = pg + 128 * bj, lc = j + DFF * bj;
            const f32x4 am2 = *(const f32x4*)(EL + ((size_t)(pm - 1) * 2 + 0) * NFF2 + pc), am1 = *(const f32x4*)(EL + ((size_t)(pm - 1) * 2 + 1) * NFF2 + pc);
            const f32x4 a0 = *(const f32x4*)(EF + ((size_t)pm * 2 + 0) * NFF2 + pc), a1 = *(const f32x4*)(EF + ((size_t)pm * 2 + 1) * NFF2 + pc);
            const f32x4 w0 = *(const f32x4*)(cw + lc), w1 = *(const f32x4*)(cw + NFF2 + lc), w2 = *(const f32x4*)(cw + 2 * NFF2 + lc), bb = *(const f32x4*)(cb + lc);
            c[bj] = rr == 0 ? (bb + w0 * am2 + w1 * am1 + w2 * a0) : (bb + w0 * am1 + w1 * a0 + w2 * a1); }
        float hm[4];
#pragma unroll
        for (int i = 0; i < 4; ++i) { const float g = c[0][i]; hm[i] = g * __builtin_amdgcn_rcpf(1.f + __builtin_amdgcn_exp2f(-LOG2E * g)) * c[1][i]; }
        u32x2 w; w.x = cvtpk(hm[0], hm[1]); w.y = cvtpk(hm[2], hm[3]);
        *(u32x2*)(HM + (size_t)(pm * 256 + rr) * DFF + j) = w;
    }
}

__device__ __forceinline__ void ffn_fixup_tile(const float* EF, const float* EL, const float* cw, const float* cb, bf16* HM, int pm, int tid) {
    if ((pm & 15) == 0) return;
    for (int it = tid; it < 2 * 704; it += NTHREADS) {
        const int j = (it % 704) * 4, rr = it / 704;
        const int pg = (j >> 7) * 256 + (j & 127);
        f32x4 c[2];
#pragma unroll
        for (int bj = 0; bj < 2; ++bj) { const int pc = pg + 128 * bj, lc = j + DFF * bj;
            const f32x4 am2 = *(const f32x4*)(EL + ((size_t)(pm - 1) * 2 + 0) * NFF2 + pc), am1 = *(const f32x4*)(EL + ((size_t)(pm - 1) * 2 + 1) * NFF2 + pc);
            const f32x4 a0 = *(const f32x4*)(EF + ((size_t)pm * 2 + 0) * NFF2 + pc), a1 = *(const f32x4*)(EF + ((size_t)pm * 2 + 1) * NFF2 + pc);
            const f32x4 w0 = *(const f32x4*)(cw + lc), w1 = *(const f32x4*)(cw + NFF2 + lc), w2 = *(const f32x4*)(cw + 2 * NFF2 + lc), bb = *(const f32x4*)(cb + lc);
            c[bj] = rr == 0 ? (bb + w0 * am2 + w1 * am1 + w2 * a0) : (bb + w0 * am1 + w1 * a0 + w2 * a1); }
        float hm[4];
#pragma unroll
        for (int i = 0; i < 4; ++i) { const float g = c[0][i]; hm[i] = g * __builtin_amdgcn_rcpf(1.f + __builtin_amdgcn_exp2f(-LOG2E * g)) * c[1][i]; }
        u32x2 w; w.x = cvtpk(hm[0], hm[1]); w.y = cvtpk(hm[2], hm[3]);
        *(u32x2*)(HM + (size_t)(pm * 256 + rr) * DFF + j) = w;
    }
}
constexpr int LDS_BYTES = 147456;
constexpr int ITEMS_PER_LAYER = 1024 + 384 + 512 + 512 + 2816 + 1408;
#ifdef FAKE_SYNC
#define GRID_SYNC() __syncthreads()
#else
#define GRID_SYNC() xcd_barrier(bar, wave)
#endif
#ifndef PROBE
#define PROBE 0
#endif
#define PROBE_REP(bit) (((PROBE) >> (bit)) & 1 ? 2 : 1)

__device__ __forceinline__ unsigned char* ws_launder(unsigned char* w) { asm volatile("" : "+s"(w)); return w; }
__global__ void __launch_bounds__(NTHREADS, 2) fwd_kernel(Params p) {
    extern __shared__ __attribute__((aligned(16))) unsigned char lds_raw[];
    LAS unsigned char* lds = (LAS unsigned char*)lds_raw;
    cg::grid_group grid = cg::this_grid();
    const int tid = threadIdx.x, lane = tid & 63, wave = __builtin_amdgcn_readfirstlane(tid >> 6);
    const int G = gridDim.x, bx = blockIdx.x, vcu = (G % 8 == 0) ? (bx % 8) * (G / 8) + bx / 8 : bx;
    const int gw = vcu * NWAVES + wave, ngw = G * NWAVES, gtid = vcu * NTHREADS + tid, ngt = G * NTHREADS;
    unsigned char* ws = p.ws;
    if (tid < 4) ((LAS unsigned*)(lds + 131072))[tid] = 0u;
    __syncthreads();
    const XcdBarrier bar = xcd_barrier_post((unsigned*)(ws + WS_CTL), (volatile LAS unsigned*)(lds + 131072));
#define FRESH_TID(v) int v = wave * 64 + lane_id(); asm volatile("" : "+v"(v))
#define WSL(T, off) ((T*)(ws_launder(ws) + (off)))
#define ROPE WSL(f32x2_t, WS_ROPE)
#define XN WSL(bf16, WS_XN)
#define QO WSL(bf16, WS_QO)
#define KB WSL(bf16, WS_K)
#define VT WSL(bf16, WS_VT)
#define QI WSL(bf16, WS_QI)
#define KI WSL(bf16, WS_KI)
#define WI WSL(float, WS_WI)
#define MASK WSL(unsigned long long, WS_MASK)
#define SSQ WSL(float, WS_SSQ)
#define OB WSL(bf16, WS_OB)
#define DUMMY1 p.out
#define DUMMY2 p.out
#define EF WSL(float, WS_EF)
#define EL WSL(float, WS_EL)
#define HM WSL(bf16, WS_HM)
#define SCR p.out
    LAS float* PART = (LAS float*)(lds + 131072 + 1024);
    {
        LAS float* scr = (LAS float*)(lds + wave * 16384);
        for (int it = gw; it < DEPTH * ITEMS_PER_LAYER; it += ngw) {
            const int l = it / ITEMS_PER_LAYER; int r = it % ITEMS_PER_LAYER; const int kind = l % 3, li = l / 3;
            unsigned char* wl = ws + WS_W + (size_t)l * W_LAYER;
            const float* wqkv = kind == 0 ? p.a_w_qkv + (size_t)li * DM * 3072 : (kind == 1 ? p.b_w_in : p.c_w_qkv);
            const int ldq = kind == 1 ? 3656 : 3072;
            const float* g1 = p.norm1_g + (size_t)l * DM; const float* g2 = p.norm2_g + (size_t)l * DM;
            const float* wo = kind == 0 ? p.a_w_o + (size_t)li * DM * DM : (kind == 1 ? p.b_w_o : p.c_w_o);
            if (r < 1024) { transpose_item(wqkv, DM, ldq, 0, 2048, (bf16*)(wl + WL_QK), 0, 1, g1, scr, r, lane); continue; } r -= 1024;
            if (r < 384) { if (kind == 1) transpose_item(wqkv, DM, ldq, 3072, 584, (bf16*)(wl + WL_QK), 2048, 1, g1, scr, r, lane); continue; } r -= 384;
            if (r < 512) { transpose_item(wqkv, DM, ldq, 2048, 1024, (bf16*)(wl + WL_V), 0, 0, g1, scr, r, lane); continue; } r -= 512;
            if (r < 512) { transpose_item(wo, DM, DM, 0, 1024, (bf16*)(wl + WL_O), 0, 0, nullptr, scr, r, lane); continue; } r -= 512;
            if (r < 2816) { transpose_item(p.ffn_w_in + (size_t)l * DM * NFF2, DM, NFF2, 0, NFF2, (bf16*)(wl + WL_IN), 0, 2, g2, scr, r, lane); continue; } r -= 2816;
            transpose_item(p.ffn_w_down + (size_t)l * DFF * DM, DFF, DM, 0, DM, (bf16*)(wl + WL_D), 0, 0, nullptr, scr, r, lane);
        }
        for (int i = gtid; i < SEQ * 32; i += ngt) {
            const int pos = i >> 5, x = i & 31;
            const float inv = exp2f(-(float)x * (13.287712379549449f / 32.0f));
            const float ang = (float)pos * inv;
            const double rev = (double)ang * 0.15915494309189535; const float fr = (float)(rev - floor(rev));
            ROPE[i] = (f32x2_t){__builtin_amdgcn_cosf(fr), __builtin_amdgcn_sinf(fr)};
        }
        for (int m = gw; m < MTOK; m += ngw) xb_row(p.x + (size_t)m * DM, XN + (size_t)m * DM, SSQ + (size_t)m * 4, lane);
    }
    grid.sync();

    for (int l = 0; l < DEPTH; ++l) {
        const int kind = l % 3, li = l / 3;
        unsigned char* wl = ws + WS_W + (size_t)l * W_LAYER;
        const bf16* WQK = (const bf16*)(wl + WL_QK); const bf16* WV = (const bf16*)(wl + WL_V); const bf16* WO = (const bf16*)(wl + WL_O);
        const bf16* WIN = (const bf16*)(wl + WL_IN); const bf16* WD = (const bf16*)(wl + WL_D);
        for (int rep_ = 0; rep_ < PROBE_REP(0); ++rep_) {
        {
            pg8::Gemm g{XN, WQK, MTOK, kind == 1 ? NQK_B : NQK_A, DM}; pg8::StaticOrder S; S.init(MTOK, g.N, G, bx);
            pg8::EpiQKV E{kind, QO, KB, QI, KI, WI, kind == 1 ? p.b_q_norm : p.a_q_norm + li * HD, kind == 1 ? p.b_k_norm : p.a_k_norm + li * HD, (const pg8::f32x2v*)ROPE, 0.125f * LOG2E, 0.35355339059327373f * 0.125f, SSQ};
#ifndef NO_QKV
            pg8::gemm_phase<pg8::EpiQKV, pg8::StaticOrder, true, true>(lds, g, S, E, wave);
#endif
        }
        {
            pg8::Gemm g{WV, XN, DM, MTOK, DM}; pg8::StaticOrder S; S.init(DM, MTOK, G, bx);
            pg8::EpiVt E{VT, MTOK, SSQ};
            pg8::gemm_phase<pg8::EpiVt, pg8::StaticOrder, true, true>(lds, g, S, E, wave);
        }
        }
        GRID_SYNC();
#ifndef NO_A
        for (int rep_ = 0; rep_ < PROBE_REP(1); ++rep_)
        if (kind == 0) { FRESH_TID(t_); const float* gq_ = p.a_q_norm + li * HD; const float* gk_ = p.a_k_norm + li * HD; const float* rb_ = p.a_rel_bias + (size_t)li * NH * 513;
            float mq = 0.f, mk = 0.f, bmax = -1e30f, bmin = 1e30f;
            for (int i = 0; i < HD; ++i) { mq = fmaxf(mq, fabsf(gq_[i])); mk = fmaxf(mk, fabsf(gk_[i])); }
            for (int i = (t_ & 63); i < NH * 513; i += 64) { const float v = rb_[i] * LOG2E; bmax = fmaxf(bmax, v); bmin = fminf(bmin, v); }
#pragma unroll
            for (int o = 1; o < 64; o <<= 1) { bmax = fmaxf(bmax, __shfl_xor(bmax, o)); bmin = fminf(bmin, __shfl_xor(bmin, o)); }
            const float qk2 = 8.2f * mq * mk * LOG2E, ref = qk2 + bmax;
            if (__builtin_amdgcn_readfirstlane(ref - (bmin - qk2) <= 100.f ? 1 : 0)) attnA_blk<true>(QO, KB, VT, OB, rb_, ref, lds, vcu, G, t_);
            else attnA_blk<false>(QO, KB, VT, OB, rb_, 0.f, lds, vcu, G, t_); }
#endif
        if (kind == 1) {
#ifndef NO_B1
            for (int rep_ = 0; rep_ < PROBE_REP(2); ++rep_)
            { FRESH_TID(t_); b1_phase(QI, KI, WI, SCR + (size_t)bx * 32 * 4096, MASK, lds, vcu, G, t_); }
#endif
            GRID_SYNC();
#ifndef NO_B2
            for (int rep_ = 0; rep_ < PROBE_REP(3); ++rep_)
            { FRESH_TID(t_); float mq = 0.f, mk = 0.f;
              for (int i = 0; i < HD; ++i) { mq = fmaxf(mq, fabsf(p.b_q_norm[i])); mk = fmaxf(mk, fabsf(p.b_k_norm[i])); }
              const float ref = 8.2f * mq * mk * LOG2E;
              if (__builtin_amdgcn_readfirstlane(ref <= 50.f ? 1 : 0)) attnB_blk<true>(QO, KB, VT, OB, MASK, ref, lds, vcu, G, t_);
              else attnB_blk<false>(QO, KB, VT, OB, MASK, 0.f, lds, vcu, G, t_); }
#endif
        }
#ifndef NO_C
        for (int rep_ = 0; rep_ < PROBE_REP(4); ++rep_)
        if (kind == 2) { FRESH_TID(t_); attnC_blk(QO, KB, VT, OB, lds, vcu, G, t_); }
#endif
        GRID_SYNC();
        {
            pg8::Gemm g{OB, WO, MTOK, DM, DM}; pg8::StaticOrder S; S.init(MTOK, DM, G, bx);
            if (PROBE_REP(5) == 2) { pg8::EpiRes E0{l == 0 ? p.x : nullptr, XN, DUMMY1, DM, nullptr, SSQ, PART}; pg8::gemm_phase<pg8::EpiRes, pg8::StaticOrder, true, true>(lds, g, S, E0, wave); }
            pg8::EpiRes E{l == 0 ? p.x : nullptr, XN, nullptr, DM, XN, SSQ, PART};
            pg8::gemm_phase<pg8::EpiRes, pg8::StaticOrder, true, true>(lds, g, S, E, wave);
        }
        GRID_SYNC();
        {
            pg8::Gemm g{XN, WIN, MTOK, NFF2, DM}; pg8::StaticOrder S; S.init(MTOK, NFF2, G, bx);
            pg8::EpiFFN E{HM, p.ffn_conv_w + (size_t)l * 3 * NFF2, p.ffn_conv_b + (size_t)l * NFF2, EF, EL, (LAS pg8::f32x4*)(lds + 131072 + 1024), SSQ};
            for (int rep_ = 0; rep_ < PROBE_REP(7); ++rep_)
            pg8::gemm_phase<pg8::EpiFFN, pg8::StaticOrder, true, true>(lds, g, S, E, wave);
        }
        GRID_SYNC();
        {
            pg8::Gemm g{HM, WD, MTOK, DM, DFF}; pg8::StaticOrder S; S.init(MTOK, DM, G, bx);
            { FRESH_TID(t_); int lastpm = -1;
#pragma unroll 1
              for (int L = bx; L < 512; L += G) {
                  const int w_ = (L & 7) * 64 + (L >> 3), pm_ = (w_ >> 5) * 8 + (w_ & 7);
                  if (pm_ != lastpm) ffn_fixup_tile(EF, EL, p.ffn_conv_w + (size_t)l * 3 * NFF2, p.ffn_conv_b + (size_t)l * NFF2, HM, pm_, t_);
                  lastpm = pm_; }
              asm volatile("s_waitcnt vmcnt(0)" ::: "memory"); __syncthreads(); }
            if (PROBE_REP(9) == 2) { pg8::EpiRes E0{nullptr, XN, DUMMY2, DM, nullptr, SSQ, PART}; pg8::gemm_phase<pg8::EpiRes, pg8::StaticOrder, true, true>(lds, g, S, E0, wave); }
            pg8::EpiRes E{nullptr, XN, l + 1 == DEPTH ? p.out : nullptr, DM, l + 1 == DEPTH ? nullptr : XN, SSQ, PART};
            pg8::gemm_phase<pg8::EpiRes, pg8::StaticOrder, true, true>(lds, g, S, E, wave);
        }
        GRID_SYNC();
    }
}

extern "C" void kernel_launch(void* const* d_in, const int* in_sizes, int n_in, void* d_out, int out_size, void* d_ws, size_t ws_size, hipStream_t stream) {
    static int grid = 0;
    if (grid == 0) {
        if (n_in != 18 || out_size != MTOK * DM || ws_size < WS_END) { fprintf(stderr, "kernel_launch: unexpected shapes (n_in %d out %d ws %zu)\n", n_in, out_size, ws_size); grid = -1; return; }
        int dev = 0, cus = 0, per_cu = 0;
        hipGetDevice(&dev); hipDeviceGetAttribute(&cus, hipDeviceAttributeMultiprocessorCount, dev);
        hipFuncSetAttribute((const void*)fwd_kernel, hipFuncAttributeMaxDynamicSharedMemorySize, LDS_BYTES);
        hipOccupancyMaxActiveBlocksPerMultiprocessor(&per_cu, (const void*)fwd_kernel, NTHREADS, LDS_BYTES);
        if (per_cu < 1) { fprintf(stderr, "kernel_launch: occupancy query says %d blocks per CU\n", per_cu); per_cu = 1; }
        (void)hipGetLastError();
        grid = cus;
    }
    if (grid < 0) return;
    Params p{};
    const float** f = (const float**)&p;
    for (int i = 0; i < 18; ++i) f[i] = (const float*)d_in[i];
    p.out = (float*)d_out; p.ws = (unsigned char*)d_ws;
    if (hipMemsetAsync((char*)d_ws + WS_CTL, 0, CTL_BYTES, stream) != hipSuccess) { fprintf(stderr, "memset failed\n"); return; }
    void* args[] = {&p};
    hipError_t e = hipLaunchCooperativeKernel((const void*)fwd_kernel, dim3(grid), dim3(NTHREADS), args, LDS_BYTES, stream);
    if (e != hipSuccess) fprintf(stderr, "cooperative launch failed: %s (grid %d)\n", hipGetErrorString(e), grid);
}
```

```cpp
#include <hip/hip_runtime.h>
#include <hip/hip_cooperative_groups.h>
#include <cstdio>
#include <cstdint>
namespace cg = cooperative_groups;
namespace pg8 {
#define PG8_LAS __attribute__((address_space(3)))
typedef unsigned short bf16_t;
typedef short bf16x8 __attribute__((ext_vector_type(8)));
typedef float f32x4 __attribute__((ext_vector_type(4)));
typedef unsigned u32x4 __attribute__((ext_vector_type(4)));
constexpr int BM = 256, BK = 64, HALF = 128, HTB = HALF * BK * 2  , STAGE_BYTES = 8 * HTB, NXCD = 8, WGM = 8;

__host__ __device__ __forceinline__ int lds_byte(int r, int c) { const int st = (r >> 4) * 2 + (c >> 5), rr = r & 15, cc = c & 31, ob = rr * 64 + cc * 2; return st * 1024 + (ob ^ (((ob >> 9) & 1) << 5)); }
__host__ __device__ __forceinline__ void stage_rc(int b, int& R, int& C) { const int st = b / 1024, sb = b % 1024, swz = sb ^ (((sb >> 9) & 1) << 5); R = (st >> 1) * 16 + swz / 64; C = (st & 1) * 32 + (swz % 64) / 2; }
__host__ __device__ __forceinline__ int perm32(int rho) { const int n = rho >> 4, i = rho & 15; return 8 * (i >> 2) + 4 * n + (i & 3); }

struct Unit { int pm, pn; };
struct Gemm { const bf16_t* A; const bf16_t* Bt; int M, N, K; };

struct StaticOrder {
    int nM, nN, nwg, G, c;
    __host__ __device__ void init(int M, int N, int G_, int c_) { nM = M / BM; nN = N / BM; nwg = nM * nN; G = G_; c = c_; }
    __host__ __device__ bool next(int i, Unit& u) const {
        const long L = (long)i * G + c; if (L >= nwg) return false;
        int wgid = (int)L; { const int q = nwg / NXCD, r = nwg % NXCD, xcd = wgid % NXCD, off = wgid / NXCD; wgid = (xcd < r ? xcd * (q + 1) : r * (q + 1) + (xcd - r) * q) + off; }
        const int nig = WGM * nN, gid = wgid / nig, fm = gid * WGM, gsz = (nM - fm) < WGM ? (nM - fm) : WGM;
        u.pm = fm + ((wgid % nig) % gsz); u.pn = (wgid % nig) / gsz; return true;
    }
    __device__ __forceinline__ void a_ready(const Unit&) const {}
    __device__ __forceinline__ void done(const Unit&) const {}
};

__device__ __forceinline__ unsigned cvt_pk_bf16(float lo, float hi) { unsigned r; asm volatile("v_cvt_pk_bf16_f32 %0, %1, %2" : "=v"(r) : "v"(lo), "v"(hi)); return r; }
typedef float f32x2 __attribute__((ext_vector_type(2)));
typedef float f32x2v __attribute__((ext_vector_type(2)));
typedef unsigned u32x2v_t __attribute__((ext_vector_type(2)));
struct EpiBf16Plain {
    static constexpr bool PERM = true, AFTER_DRAIN = false;
    bf16_t* O; int ldc;
    __device__ __forceinline__ void operator()(const f32x4 (&acc)[2][2][4][2], const Unit& u, int wr, int wc, int fr, int fq) const {
        const int row0 = u.pm * BM + wr * 64 + fr; const int col0 = u.pn * BM + wc * 32 + 8 * fq;
#pragma unroll
        for (int ai = 0; ai < 2; ++ai)
#pragma unroll
            for (int m = 0; m < 4; ++m) { bf16_t* rowp = O + (size_t)(row0 + ai * HALF + m * 16) * ldc + col0;
#pragma unroll
                for (int bj = 0; bj < 2; ++bj) { const f32x4 v0 = acc[ai][bj][m][0], v1 = acc[ai][bj][m][1];
                    u32x4 w; w.x = cvt_pk_bf16(v0[0], v0[1]); w.y = cvt_pk_bf16(v0[2], v0[3]); w.z = cvt_pk_bf16(v1[0], v1[1]); w.w = cvt_pk_bf16(v1[2], v1[3]);
                    *(u32x4*)(rowp + bj * HALF) = w; } }
    }
};
__device__ __forceinline__ float rstd_of(const float* SSQ, size_t row) { const f32x4 s4 = *(const f32x4*)(SSQ + row * 4); return rsqrtf(((s4[0] + s4[1]) + (s4[2] + s4[3])) * (1.0f / 1024.0f) + 1e-6f); }
struct EpiRes {
    static constexpr bool PERM = true, AFTER_DRAIN = false;
    const float* base32; const bf16_t* base16; float* out32; int ldc; bf16_t* XB; float* SSQ; PG8_LAS float* part;
    __device__ __forceinline__ void operator()(const f32x4 (&acc)[2][2][4][2], const Unit& u, int wr, int wc, int fr_in, int fq_in) const {
        int fr = fr_in, fq = fq_in; asm volatile("" : "+v"(fr), "+v"(fq));
        const int col0 = u.pn * BM + wc * 32 + 8 * fq;
        u32x4 pre[2][4][2];
        if (!base32) {
#pragma unroll
            for (int ai = 0; ai < 2; ++ai)
#pragma unroll
                for (int m = 0; m < 4; ++m)
#pragma unroll
                    for (int bj = 0; bj < 2; ++bj) pre[ai][m][bj] = *(const u32x4*)(base16 + (size_t)(u.pm * BM + ai * HALF + wr * 64 + m * 16 + fr) * ldc + col0 + bj * HALF);
        }
#pragma unroll
        for (int ai = 0; ai < 2; ++ai)
#pragma unroll
            for (int m = 0; m < 4; ++m) { const int rl = ai * HALF + wr * 64 + m * 16 + fr; const size_t off = (size_t)(u.pm * BM + rl) * ldc + col0;
                float ss = 0.f;
#pragma unroll
                for (int bj = 0; bj < 2; ++bj) {
                    f32x4 b0, b1;
                    if (base32) { b0 = *(const f32x4*)(base32 + off + bj * HALF); b1 = *(const f32x4*)(base32 + off + bj * HALF + 4); }
                    else { const u32x4 r = pre[ai][m][bj];
                        b0 = (f32x4){__uint_as_float(r.x << 16), __uint_as_float(r.x & 0xFFFF0000u), __uint_as_float(r.y << 16), __uint_as_float(r.y & 0xFFFF0000u)};
                        b1 = (f32x4){__uint_as_float(r.z << 16), __uint_as_float(r.z & 0xFFFF0000u), __uint_as_float(r.w << 16), __uint_as_float(r.w & 0xFFFF0000u)}; }
                    const f32x4 v0 = b0 + acc[ai][bj][m][0], v1 = b1 + acc[ai][bj][m][1];
                    if (out32) { *(f32x4*)(out32 + off + bj * HALF) = v0; *(f32x4*)(out32 + off + bj * HALF + 4) = v1; }
                    if (XB) { u32x4 w; w.x = cvt_pk_bf16(v0[0], v0[1]); w.y = cvt_pk_bf16(v0[2], v0[3]); w.z = cvt_pk_bf16(v1[0], v1[1]); w.w = cvt_pk_bf16(v1[2], v1[3]); *(u32x4*)(XB + off + bj * HALF) = w;
                        const f32x4 q0 = (f32x4){__uint_as_float(w.x << 16), __uint_as_float(w.x & 0xFFFF0000u), __uint_as_float(w.y << 16), __uint_as_float(w.y & 0xFFFF0000u)};
                        const f32x4 q1 = (f32x4){__uint_as_float(w.z << 16), __uint_as_float(w.z & 0xFFFF0000u), __uint_as_float(w.w << 16), __uint_as_float(w.w & 0xFFFF0000u)};
                        ss += ((q0[0] * q0[0] + q0[1] * q0[1]) + (q0[2] * q0[2] + q0[3] * q0[3])) + ((q1[0] * q1[0] + q1[1] * q1[1]) + (q1[2] * q1[2] + q1[3] * q1[3])); } }
                ss += __shfl_xor(ss, 16); ss += __shfl_xor(ss, 32);
                if (fq == 0) part[rl * 4 + wc] = ss;
                if (base32 && (m & 1)) asm volatile("" ::: "memory"); }
        asm volatile("s_waitcnt lgkmcnt(0)" ::: "memory"); __builtin_amdgcn_s_barrier(); asm volatile("" ::: "memory");
        const int t = (wr * 4 + wc) * 64 + fq * 16 + fr;
        if (t < 256 && XB) { const f32x4 p4 = *(const PG8_LAS f32x4*)(part + t * 4); SSQ[(size_t)(u.pm * BM + t) * 4 + u.pn] = (p4[0] + p4[1]) + (p4[2] + p4[3]); }
    }
};
struct EpiVt {
    static constexpr bool PERM = true, AFTER_DRAIN = false;
    bf16_t* O; int ldc; const float* SSQ;
    __device__ __forceinline__ void operator()(const f32x4 (&acc)[2][2][4][2], const Unit& u, int wr, int wc, int fr_in, int fq_in) const {
        int fr = fr_in, fq = fq_in; asm volatile("" : "+v"(fr), "+v"(fq));
        const int row0 = u.pm * BM + wr * 64 + fr; const int col0 = u.pn * BM + wc * 32 + 8 * fq;
        float rs[2][8];
#pragma unroll
        for (int bj = 0; bj < 2; ++bj)
#pragma unroll
            for (int c = 0; c < 8; ++c) rs[bj][c] = rstd_of(SSQ, (size_t)(col0 + bj * HALF + c));
#pragma unroll
        for (int ai = 0; ai < 2; ++ai)
#pragma unroll
            for (int m = 0; m < 4; ++m) { bf16_t* rowp = O + (size_t)(row0 + ai * HALF + m * 16) * ldc + col0;
#pragma unroll
                for (int bj = 0; bj < 2; ++bj) { const f32x4 v0 = acc[ai][bj][m][0], v1 = acc[ai][bj][m][1];
                    u32x4 w; w.x = cvt_pk_bf16(v0[0] * rs[bj][0], v0[1] * rs[bj][1]); w.y = cvt_pk_bf16(v0[2] * rs[bj][2], v0[3] * rs[bj][3]); w.z = cvt_pk_bf16(v1[0] * rs[bj][4], v1[1] * rs[bj][5]); w.w = cvt_pk_bf16(v1[2] * rs[bj][6], v1[3] * rs[bj][7]);
                    *(u32x4*)(rowp + bj * HALF) = w; } }
    }
};
struct EpiQKV {
    static constexpr bool PERM = true, AFTER_DRAIN = false;
    int kind;
    bf16_t *Q, *K, *QI, *KI; float* WI;
    const float *gq, *gk; const f32x2v* rope; float qscale, wscale; const float* SSQ;
    __device__ __forceinline__ void operator()(const f32x4 (&acc)[2][2][4][2], const Unit& u, int wr, int wc, int fr_in, int fq_in) const {
        int fr = fr_in, fq = fq_in; asm volatile("" : "+v"(fr), "+v"(fq));
        const int hs = u.pn * 4 + wc;
        bf16_t* dst; int ld, col; bool donorm = false, dorope = false; const float* gain = gq; float sc = 1.f;
        if (hs < 16) { dst = Q; ld = 1024; col = hs * 64; donorm = (kind != 2); dorope = (kind == 1); gain = gq; sc = qscale; }
        else if (hs < 32) { dst = K; ld = 1024; col = (hs - 16) * 64; donorm = (kind != 2); dorope = (kind == 1); gain = gk; }
        else if (hs < 40) { dst = QI; ld = 512; col = (hs - 32) * 64; dorope = true; }
        else if (hs == 40) { dst = KI; ld = 64; col = 0; dorope = true; }
        else if (hs == 41) {
            if (fq == 0) {
#pragma unroll
                for (int ai = 0; ai < 2; ++ai)
#pragma unroll
                    for (int m = 0; m < 4; ++m) { const int row = u.pm * BM + ai * HALF + wr * 64 + m * 16 + fr;
                        const float rsw = rstd_of(SSQ, (size_t)row) * wscale; *(f32x4*)(WI + (size_t)row * 8) = acc[ai][0][m][0] * rsw; *(f32x4*)(WI + (size_t)row * 8 + 4) = acc[ai][0][m][1] * rsw; }
            }
            return;
        } else return;
        float g[2][2][4];
#pragma unroll
        for (int bj = 0; bj < 2; ++bj)
#pragma unroll
            for (int n = 0; n < 2; ++n)
#pragma unroll
                for (int i = 0; i < 4; ++i) g[bj][n][i] = donorm ? gain[32 * bj + 8 * fq + 4 * n + i] * sc : sc;
        f32x4 sq[2][4];
#pragma unroll
        for (int ai = 0; ai < 2; ++ai)
#pragma unroll
            for (int m = 0; m < 4; ++m) sq[ai][m] = *(const f32x4*)(SSQ + (size_t)(u.pm * BM + ai * HALF + wr * 64 + m * 16 + fr) * 4);
#pragma unroll
        for (int ai = 0; ai < 2; ++ai) {
#pragma unroll
          for (int mp = 0; mp < 4; ++mp) {
            f32x4 rp4[4][4];
            if (dorope) {
#pragma unroll
                for (int m = mp; m < mp + 1; ++m) { const f32x4* rp = (const f32x4*)(rope + (size_t)((u.pm * BM + ai * HALF + wr * 64 + m * 16 + fr) & 4095) * 32 + 8 * fq);
#pragma unroll
                    for (int k = 0; k < 4; ++k) rp4[m][k] = rp[k]; }
            }
#pragma unroll
            for (int m = mp; m < mp + 1; ++m) {
                const int row = u.pm * BM + ai * HALF + wr * 64 + m * 16 + fr;
                f32x4 v[2][2];
                const float rs0 = rsqrtf(((sq[ai][m][0] + sq[ai][m][1]) + (sq[ai][m][2] + sq[ai][m][3])) * (1.0f / 1024.0f) + 1e-6f);
#pragma unroll
                for (int bj = 0; bj < 2; ++bj)
#pragma unroll
                    for (int n = 0; n < 2; ++n) v[bj][n] = acc[ai][bj][m][n] * rs0;
                float r = 1.f;
                if (donorm) {
                    float ss = 0.f;
#pragma unroll
                    for (int bj = 0; bj < 2; ++bj)
#pragma unroll
                        for (int n = 0; n < 2; ++n) { const f32x4 x = v[bj][n]; ss += (x[0] * x[0] + x[1] * x[1]) + (x[2] * x[2] + x[3] * x[3]); }
                    ss += __shfl_xor(ss, 16); ss += __shfl_xor(ss, 32);
                    r = rsqrtf(ss * (1.0f / 64.0f) + 1e-6f);
                }
#pragma unroll
                for (int bj = 0; bj < 2; ++bj)
#pragma unroll
                    for (int n = 0; n < 2; ++n)
#pragma unroll
                        for (int i = 0; i < 4; ++i) v[bj][n][i] = v[bj][n][i] * r * g[bj][n][i];
                if (dorope) {
#pragma unroll
                    for (int n = 0; n < 2; ++n) { const f32x4 cs0 = rp4[m][2 * n], cs1 = rp4[m][2 * n + 1];
                        const float c_[4] = {cs0[0], cs0[2], cs1[0], cs1[2]}, s_[4] = {cs0[1], cs0[3], cs1[1], cs1[3]};
#pragma unroll
                        for (int i = 0; i < 4; ++i) { const float x1 = v[0][n][i], x2 = v[1][n][i]; v[0][n][i] = x1 * c_[i] - x2 * s_[i]; v[1][n][i] = x2 * c_[i] + x1 * s_[i]; } }
                }
                bf16_t* rowp = dst + (size_t)row * ld + col + 8 * fq;
#pragma unroll
                for (int bj = 0; bj < 2; ++bj) { u32x4 w; w.x = cvt_pk_bf16(v[bj][0][0], v[bj][0][1]); w.y = cvt_pk_bf16(v[bj][0][2], v[bj][0][3]); w.z = cvt_pk_bf16(v[bj][1][0], v[bj][1][1]); w.w = cvt_pk_bf16(v[bj][1][2], v[bj][1][3]);
                    *(u32x4*)(rowp + 32 * bj) = w; }
            }
            asm volatile("" ::: "memory");
          }
        }
    }
};
template <int CTRL, bool BC> __device__ __forceinline__ float pg8_dpp(float x) { return __int_as_float(__builtin_amdgcn_update_dpp(0, __float_as_int(x), CTRL, 0xf, 0xf, BC)); }
struct EpiFFN {
    static constexpr bool PERM = true, AFTER_DRAIN = false;
    bf16_t* HM; const float* cw; const float* cb; float* EF; float* EL; PG8_LAS f32x4* halo; const float* SSQ;
    __device__ __forceinline__ void operator()(const f32x4 (&acc_)[2][2][4][2], const Unit& u, int wr, int wc, int fr_in, int fq_in) const {
        int fr = fr_in, fq = fq_in; asm volatile("" : "+v"(fr), "+v"(fq));
        f32x4 (&acc)[2][2][4][2] = const_cast<f32x4 (&)[2][2][4][2]>(acc_);
        f32x4 Wn[2][4];
        { const int jc0 = u.pn * 128 + wc * 32 + 8 * fq;
#pragma unroll
          for (int bj = 0; bj < 2; ++bj) { const float* wp = cw + bj * 2816 + jc0;
              Wn[bj][0] = *(const f32x4*)(wp); Wn[bj][1] = *(const f32x4*)(wp + 5632); Wn[bj][2] = *(const f32x4*)(wp + 2 * 5632); Wn[bj][3] = *(const f32x4*)(cb + bj * 2816 + jc0); } }
#pragma unroll
        for (int ai = 0; ai < 2; ++ai)
#pragma unroll
            for (int m = 0; m < 4; ++m) { const float rs0 = rstd_of(SSQ, (size_t)(u.pm * BM + ai * HALF + wr * 64 + m * 16 + fr));
#pragma unroll
                for (int bj = 0; bj < 2; ++bj)
#pragma unroll
                    for (int n = 0; n < 2; ++n) acc[ai][bj][m][n] = acc[ai][bj][m][n] * rs0; }
        const int pcol = u.pn * 256 + wc * 32 + 8 * fq, jcol = u.pn * 128 + wc * 32 + 8 * fq;
        if (fr >= 14) {
            const int rr = fr - 14;
#pragma unroll
            for (int ai = 0; ai < 2; ++ai)
#pragma unroll
                for (int bj = 0; bj < 2; ++bj)
#pragma unroll
                    for (int n = 0; n < 2; ++n) halo[(((((ai * 2 + wr) * 2 + rr) * 4 + wc) * 2 + bj) * 4 + fq) * 2 + n] = acc[ai][bj][3][n];
            if (wr == 1) { float* e = EL + ((size_t)u.pm * 2 + rr) * 5632 + pcol;
#pragma unroll
                for (int bj = 0; bj < 2; ++bj)
#pragma unroll
                    for (int n = 0; n < 2; ++n) *(f32x4*)(e + bj * 128 + n * 4) = acc[1][bj][3][n]; }
        }
        if (wr == 0 && fr < 2) { float* e = EF + ((size_t)u.pm * 2 + fr) * 5632 + pcol;
#pragma unroll
            for (int bj = 0; bj < 2; ++bj)
#pragma unroll
                for (int n = 0; n < 2; ++n) *(f32x4*)(e + bj * 128 + n * 4) = acc[0][bj][0][n]; }
        asm volatile("s_waitcnt lgkmcnt(0)" ::: "memory"); __builtin_amdgcn_s_barrier(); asm volatile("" ::: "memory");
#pragma unroll
        for (int n = 0; n < 2; ++n) {
            f32x4 W0[2], W1[2], W2[2], Bb[2], W0m[2], W1m[2];
#pragma unroll
            for (int bj = 0; bj < 2; ++bj) { const float* wp = cw + bj * 2816 + jcol + 4 * n;
                if (n == 0) { W0[bj] = Wn[bj][0]; W1[bj] = Wn[bj][1]; W2[bj] = Wn[bj][2]; Bb[bj] = Wn[bj][3]; }
                else { W0[bj] = *(const f32x4*)(wp); W1[bj] = *(const f32x4*)(wp + 5632); W2[bj] = *(const f32x4*)(wp + 2 * 5632); Bb[bj] = *(const f32x4*)(cb + bj * 2816 + jcol + 4 * n); }
                W1m[bj] = fr == 0 ? W1[bj] : (f32x4){0.f, 0.f, 0.f, 0.f}; W0m[bj] = fr < 2 ? W0[bj] : (f32x4){0.f, 0.f, 0.f, 0.f}; }
#pragma unroll
            for (int ai = 0; ai < 2; ++ai)
#pragma unroll
                for (int m = 0; m < 4; ++m) {
                    f32x4 c[2];
#pragma unroll
                    for (int bj = 0; bj < 2; ++bj) {
                        const f32x4 a = acc[ai][bj][m][n];
                        f32x4 t1, t2;
                        if (m > 0) { const f32x4 ap = acc[ai][bj][m - 1][n];
#pragma unroll
                            for (int i = 0; i < 4; ++i) { const float apx = ap[i]; t1[i] = pg8_dpp<0x121, false>(apx); t2[i] = pg8_dpp<0x122, false>(apx); }
                        } else {
                            t1 = (f32x4){0.f, 0.f, 0.f, 0.f}; t2 = t1;
                            const int sa = (wr == 1) ? ai : 0, sw = (wr == 1) ? 0 : 1;
                            if ((wr == 1 || ai == 1) && fr < 2) {
                                const f32x4 h0 = halo[(((((sa * 2 + sw) * 2 + 0) * 4 + wc) * 2 + bj) * 4 + fq) * 2 + n], h1 = halo[(((((sa * 2 + sw) * 2 + 1) * 4 + wc) * 2 + bj) * 4 + fq) * 2 + n];
                                t1 = h1; t2 = (fr == 0) ? h0 : h1;
                            }
                        }
#pragma unroll
                        for (int i = 0; i < 4; ++i) {
                            const float ax = a[i];
                            float v = __builtin_fmaf(W2[bj][i], ax, Bb[bj][i]);
                            v = __builtin_fmaf(pg8_dpp<0x111, true>(ax), W1[bj][i], v);
                            v = __builtin_fmaf(pg8_dpp<0x112, true>(ax), W0[bj][i], v);
                            v = __builtin_fmaf(t1[i], W1m[bj][i], v);
                            v = __builtin_fmaf(t2[i], W0m[bj][i], v);
                            c[bj][i] = v;
                        }
                    }
                    float hm[4];
#pragma unroll
                    for (int i = 0; i < 4; ++i) { const float g = c[0][i]; hm[i] = g * __builtin_amdgcn_rcpf(1.f + __builtin_amdgcn_exp2f(-1.4426950408889634f * g)) * c[1][i]; }
                    u32x2v_t w; w.x = cvt_pk_bf16(hm[0], hm[1]); w.y = cvt_pk_bf16(hm[2], hm[3]);
                    *(u32x2v_t*)(HM + (size_t)(u.pm * BM + ai * HALF + wr * 64 + m * 16 + fr) * 2816 + jcol + 4 * n) = w;
                }
        }
    }
};
template <class Epi, class Sched, bool ALIGN_EPI = false, bool SP2 = false>
__device__ __forceinline__ void gemm_phase(PG8_LAS unsigned char* lds, const Gemm g, const Sched& S, const Epi& E, const int wave_s) {
    unsigned ones_l = ~0u; asm volatile("" : "+s"(ones_l)); int tid_l = wave_s * 64 + (int)__builtin_amdgcn_mbcnt_hi(ones_l, __builtin_amdgcn_mbcnt_lo(ones_l, 0u)); asm volatile("" : "+v"(tid_l));
    const int tid = tid_l, wid = __builtin_amdgcn_readfirstlane(tid >> 6), lane = tid & 63, wr = wid >> 2, wc = wid & 3, fr = lane & 15, fq = lane >> 4;
    const int K = g.K, nt = K / BK;
    unsigned voffA[2], voffB[2];
#pragma unroll
    for (int i = 0; i < 2; ++i) { int R, C; stage_rc(tid * 16 + i * 8192, R, C); const int Rb = Epi::PERM ? ((R & ~31) + perm32(R & 31)) : R;
        voffA[i] = (unsigned)(R * K + C) * 2u; voffB[i] = (unsigned)(Rb * K + C) * 2u; }
    const size_t kstep = (size_t)(BK * 2);
    const size_t hstep = (size_t)HALF * K * 2;
    const size_t tstep = 2 * hstep;
    const unsigned ldsw = (unsigned)wid * 1024u;
    const int aoff = lds_byte(wr * 64 + fr, fq * 8), boff = lds_byte(wc * 32 + fr, fq * 8);
#define PG8_SA(b, h) (((b) * 2 + (h)) * HTB)
#define PG8_SB(b, h) ((4 + (b) * 2 + (h)) * HTB)
#define PG8_STAGE(bufoff, gbase, voff) do { _Pragma("unroll") for (int _i = 0; _i < 2; ++_i) \
        __builtin_amdgcn_global_load_lds((const unsigned*)((const char*)(gbase) + (voff)[_i]), (PG8_LAS unsigned*)(lds + (bufoff) + ldsw + _i * 8192), 16, 0, 0); } while (0)
#define PG8_LDA(dst, b, h) do { _Pragma("unroll") for (int m = 0; m < 4; ++m) _Pragma("unroll") for (int k = 0; k < 2; ++k) dst[m][k] = *(const PG8_LAS bf16x8*)(lds + PG8_SA(b, h) + aoff + m * 2048 + k * 1024); } while (0)
#define PG8_LDB(dst, b, h) do { _Pragma("unroll") for (int n = 0; n < 2; ++n) _Pragma("unroll") for (int k = 0; k < 2; ++k) dst[n][k] = *(const PG8_LAS bf16x8*)(lds + PG8_SB(b, h) + boff + n * 2048 + k * 1024); } while (0)
#define PG8_MMA(ai, bj, At, Bt) do { __builtin_amdgcn_s_setprio(1); _Pragma("unroll") for (int m = 0; m < 4; ++m) _Pragma("unroll") for (int n = 0; n < 2; ++n) _Pragma("unroll") for (int k = 0; k < 2; ++k) \
        acc[ai][bj][m][n] = __builtin_amdgcn_mfma_f32_16x16x32_bf16(Bt[n][k], At[m][k], acc[ai][bj][m][n], 0, 0, 0); __builtin_amdgcn_s_setprio(0); } while (0)
#define PG8_WAIT_V(n) asm volatile("s_waitcnt vmcnt(" #n ")" ::: "memory")
#define PG8_WAIT_L(n) asm volatile("s_waitcnt lgkmcnt(" #n ")" ::: "memory")
#define PG8_BAR __builtin_amdgcn_s_barrier()
#define PG8_SCHED __builtin_amdgcn_sched_barrier(0)
    Unit cur, nxt; int ui = 0;
    if (!S.next(0, cur)) return;
    f32x4 acc[2][2][4][2];
#pragma unroll
    for (int a = 0; a < 2; ++a)
#pragma unroll
        for (int b = 0; b < 2; ++b)
#pragma unroll
            for (int m = 0; m < 4; ++m)
#pragma unroll
                for (int n = 0; n < 2; ++n) acc[a][b][m][n] = (f32x4){0.f, 0.f, 0.f, 0.f};
    bf16x8 At[4][2], B0[2][2], B1[2][2];
    const char* cA = (const char*)g.A + (size_t)cur.pm * tstep; const char* cB = (const char*)g.Bt + (size_t)cur.pn * tstep;
    S.a_ready(cur);
    if constexpr (SP2) {
        PG8_STAGE(PG8_SB(0, 0), cB, voffB); PG8_STAGE(PG8_SB(0, 1), cB + hstep, voffB); PG8_STAGE(PG8_SA(0, 0), cA, voffA); PG8_STAGE(PG8_SA(0, 1), cA + hstep, voffA);
        if (wr == 1) PG8_BAR;
        PG8_WAIT_V(2); PG8_BAR;
        PG8_STAGE(PG8_SB(1, 0), cB + kstep, voffB); PG8_STAGE(PG8_SA(1, 0), cA + kstep, voffA); PG8_STAGE(PG8_SB(1, 1), cB + hstep + kstep, voffB);
        PG8_WAIT_V(6); PG8_BAR;
    } else {
        PG8_STAGE(PG8_SB(0, 0), cB, voffB); PG8_STAGE(PG8_SA(0, 0), cA, voffA); PG8_STAGE(PG8_SB(0, 1), cB + hstep, voffB); PG8_STAGE(PG8_SA(0, 1), cA + hstep, voffA);
        if (wr == 1) PG8_BAR;
        PG8_WAIT_V(4); PG8_BAR;
        PG8_STAGE(PG8_SB(1, 0), cB + kstep, voffB); PG8_STAGE(PG8_SA(1, 0), cA + kstep, voffA); PG8_STAGE(PG8_SB(1, 1), cB + hstep + kstep, voffB);
        PG8_WAIT_V(6); PG8_BAR;
    }
    for (;;) {
        const bool has_next = S.next(ui + 1, nxt);
        const char* nA = has_next ? (const char*)g.A + (size_t)nxt.pm * tstep : cA; const char* nB = has_next ? (const char*)g.Bt + (size_t)nxt.pn * tstep : cB;
        for (int t = 0; t < nt; t += 2) {
            const bool last = (t == nt - 2);
            const char* a1 = cA + (size_t)(t + 1) * kstep;
            const char* a2 = last ? nA : cA + (size_t)(t + 2) * kstep; const char* b2 = last ? nB : cB + (size_t)(t + 2) * kstep;
            const char* a3 = a2 + kstep; const char* b3 = b2 + kstep;
            if (last && has_next) S.a_ready(nxt);
            if constexpr (SP2) {
            PG8_LDB(B0, 0, 0); PG8_LDB(B1, 0, 1); PG8_SCHED; PG8_LDA(At, 0, 0); PG8_STAGE(PG8_SA(1, 1), a1 + hstep, voffA);
            PG8_WAIT_V(8); PG8_WAIT_L(0); PG8_BAR; PG8_MMA(0, 0, At, B0); PG8_MMA(0, 1, At, B1); PG8_BAR; PG8_SCHED;
            PG8_LDA(At, 0, 1); PG8_STAGE(PG8_SB(0, 0), b2, voffB); PG8_STAGE(PG8_SB(0, 1), b2 + hstep, voffB); PG8_STAGE(PG8_SA(0, 0), a2, voffA);
            PG8_WAIT_V(8); PG8_WAIT_L(0); PG8_BAR; PG8_MMA(1, 0, At, B0); PG8_MMA(1, 1, At, B1); PG8_BAR; PG8_SCHED;
            PG8_LDB(B0, 1, 0); PG8_LDB(B1, 1, 1); PG8_SCHED; PG8_LDA(At, 1, 0); PG8_STAGE(PG8_SA(0, 1), a2 + hstep, voffA);
            PG8_WAIT_V(8); PG8_WAIT_L(0); PG8_BAR; PG8_MMA(0, 0, At, B0); PG8_MMA(0, 1, At, B1); PG8_BAR; PG8_SCHED;
            PG8_LDA(At, 1, 1); PG8_STAGE(PG8_SB(1, 0), b3, voffB); PG8_STAGE(PG8_SB(1, 1), b3 + hstep, voffB); PG8_STAGE(PG8_SA(1, 0), a3, voffA);
            PG8_WAIT_V(8); PG8_WAIT_L(0); PG8_BAR; PG8_MMA(1, 0, At, B0); PG8_MMA(1, 1, At, B1); PG8_BAR; PG8_SCHED;
            } else {
            PG8_LDB(B0, 0, 0); PG8_SCHED; PG8_LDA(At, 0, 0); PG8_STAGE(PG8_SA(1, 1), a1 + hstep, voffA);
            PG8_WAIT_L(8); PG8_BAR; PG8_WAIT_L(0); PG8_MMA(0, 0, At, B0); PG8_BAR; PG8_SCHED;
            PG8_LDB(B1, 0, 1); PG8_STAGE(PG8_SB(0, 0), b2, voffB);
            PG8_BAR; PG8_WAIT_L(0); PG8_MMA(0, 1, At, B1); PG8_BAR;
            PG8_LDA(At, 0, 1); PG8_STAGE(PG8_SA(0, 0), a2, voffA);
            PG8_BAR; PG8_WAIT_L(0); PG8_MMA(1, 0, At, B0); PG8_BAR; PG8_SCHED;
            PG8_STAGE(PG8_SB(0, 1), b2 + hstep, voffB);
            PG8_WAIT_V(6); PG8_BAR; PG8_MMA(1, 1, At, B1); PG8_BAR;
            PG8_LDB(B0, 1, 0); PG8_SCHED; PG8_LDA(At, 1, 0); PG8_STAGE(PG8_SA(0, 1), a2 + hstep, voffA);
            PG8_WAIT_L(8); PG8_BAR; PG8_WAIT_L(0); PG8_MMA(0, 0, At, B0); PG8_BAR; PG8_SCHED;
            PG8_LDB(B1, 1, 1); PG8_STAGE(PG8_SB(1, 0), b3, voffB);
            PG8_BAR; PG8_WAIT_L(0); PG8_MMA(0, 1, At, B1); PG8_BAR;
            PG8_LDA(At, 1, 1); PG8_STAGE(PG8_SA(1, 0), a3, voffA);
            PG8_BAR; PG8_WAIT_L(0); PG8_MMA(1, 0, At, B0); PG8_BAR; PG8_SCHED;
            PG8_STAGE(PG8_SB(1, 1), b3 + hstep, voffB);
            PG8_WAIT_V(6); PG8_BAR; PG8_MMA(1, 1, At, B1); PG8_BAR;
            }
        }
        if constexpr (ALIGN_EPI) { if (wr == 0) PG8_BAR; }
        if constexpr (!Epi::AFTER_DRAIN) { E(acc, cur, wr, wc, fr, fq); S.done(cur); }
        if (!has_next) break;
#pragma unroll
        for (int a = 0; a < 2; ++a)
#pragma unroll
            for (int b = 0; b < 2; ++b)
#pragma unroll
                for (int m = 0; m < 4; ++m)
#pragma unroll
                    for (int n = 0; n < 2; ++n) acc[a][b][m][n] = (f32x4){0.f, 0.f, 0.f, 0.f};
        cur = nxt; cA = nA; cB = nB; ++ui;
        if constexpr (ALIGN_EPI) { if (wr == 1) PG8_BAR; }
    }
    PG8_WAIT_V(0);
    if constexpr (!ALIGN_EPI) { if (wr == 0) PG8_BAR; }
    PG8_BAR;
    if constexpr (Epi::AFTER_DRAIN) { E.fused(acc, cur, wr, wc, fr, fq, lds, wid, lane); S.done(cur); }
#undef PG8_SA
#undef PG8_SB
#undef PG8_STAGE
#undef PG8_LDA
#undef PG8_LDB
#undef PG8_MMA
#undef PG8_WAIT_V
#undef PG8_WAIT_L
#undef PG8_BAR
#undef PG8_SCHED
}
}
constexpr int SEQ = 4096, NB = 8, DM = 1024, NH = 16, HD = 64, MTOK = NB * SEQ, DFF = 2816, NFF2 = 2 * DFF, DEPTH = 4;
constexpr int NQK_A = 2048, NQK_B = 2816;
constexpr int MHALF = MTOK / 2;
constexpr int NTHREADS = 512, NWAVES = 8;
constexpr float LOG2E = 1.4426950408889634f;
constexpr size_t MiB = 1u << 20;
constexpr size_t WS_CTL = 0, CTL_BYTES = 64 * 1024;
constexpr size_t WS_ROPE = 1 * MiB;
constexpr size_t WS_SSQ = 128 * 1024;
constexpr size_t WS_W = 2 * MiB, W_LAYER = 26 * MiB, WL_QK = 0, WL_V = 5632 * 1024, WL_O = WL_V + 2 * MiB, WL_IN = WL_O + 2 * MiB, WL_D = WL_IN + 11 * MiB;
constexpr size_t WS_XN = 106 * MiB, WS_OB = 170 * MiB, WS_SCR = WS_XN;
constexpr size_t WS_QO = 234 * MiB, WS_K = 298 * MiB, WS_VT = 362 * MiB, WS_QI = 426 * MiB, WS_KI = 458 * MiB, WS_WI = 462 * MiB, WS_MASK = 463 * MiB;
constexpr size_t WS_HM = 234 * MiB, WS_EF = 410 * MiB, WS_EL = 416 * MiB, WS_END = 498 * MiB;
static_assert(WL_D + (size_t)DM * DFF * 2 <= W_LAYER, "weights per layer");
static_assert(WS_W + DEPTH * W_LAYER <= WS_XN && WS_MASK + 16 * MiB <= WS_END && WS_HM + (size_t)MTOK * DFF * 2 <= WS_EF && WS_EF + (size_t)256 * NFF2 * 4 <= WS_EL && WS_EL + (size_t)256 * NFF2 * 4 <= WS_END, "ws map");

#define LAS __attribute__((address_space(3)))
typedef unsigned short bf16;
typedef short bf16x8 __attribute__((ext_vector_type(8)));
typedef float f32x4 __attribute__((ext_vector_type(4)));
typedef float f32x16 __attribute__((ext_vector_type(16)));
typedef unsigned u32x4 __attribute__((ext_vector_type(4)));
typedef unsigned u32x2 __attribute__((ext_vector_type(2)));
typedef float f32x2_t __attribute__((ext_vector_type(2))); typedef __bf16 bf16x2_t __attribute__((ext_vector_type(2)));
__device__ __forceinline__ unsigned cvtpk(float lo, float hi) { f32x2_t v = {lo, hi}; bf16x2_t b = __builtin_convertvector(v, bf16x2_t); return __builtin_bit_cast(unsigned, b); }
__device__ __forceinline__ float bf2f(unsigned short h) { return __uint_as_float((unsigned)h << 16); }
__device__ __forceinline__ float wave_sum(float v) {
#pragma unroll
    for (int o = 1; o < 64; o <<= 1) v += __shfl_xor(v, o);
    return v;
}
__device__ __forceinline__ unsigned wave_sum_u32(unsigned v) {
    v += (unsigned)__builtin_amdgcn_update_dpp(0, (int)v, 0x111, 0xf, 0xf, true);
    v += (unsigned)__builtin_amdgcn_update_dpp(0, (int)v, 0x112, 0xf, 0xf, true);
    v += (unsigned)__builtin_amdgcn_update_dpp(0, (int)v, 0x114, 0xf, 0xf, true);
    v += (unsigned)__builtin_amdgcn_update_dpp(0, (int)v, 0x118, 0xf, 0xf, true);
    v += (unsigned)__builtin_amdgcn_update_dpp(0, (int)v, 0x142, 0xa, 0xf, true);
    v += (unsigned)__builtin_amdgcn_update_dpp(0, (int)v, 0x143, 0xc, 0xf, true);
    return (unsigned)__builtin_amdgcn_readlane((int)v, 63);
}
__device__ __forceinline__ int lane_id() { unsigned ones = ~0u; asm volatile("" : "+s"(ones)); return (int)__builtin_amdgcn_mbcnt_hi(ones, __builtin_amdgcn_mbcnt_lo(ones, 0u)); }
__device__ __forceinline__ int pi_row(int i) { return (i & ~12) | ((i & 4) << 1) | ((i & 8) >> 1); }

struct Params {
    const float* x; const float* norm1_g; const float* norm2_g;
    const float* a_w_qkv; const float* a_q_norm; const float* a_k_norm; const float* a_rel_bias; const float* a_w_o;
    const float* b_w_in; const float* b_q_norm; const float* b_k_norm; const float* b_w_o;
    const float* c_w_qkv; const float* c_w_o;
    const float* ffn_w_in; const float* ffn_conv_w; const float* ffn_conv_b; const float* ffn_w_down;
    float* out; unsigned char* ws;
};

__device__ __forceinline__ void transpose_item(const float* W, int K, int ldw, int src_col0, int nvalid, bf16* WT, int dst_row0, int perm, const float* gk, LAS float* scr, int item, int lane) {
    const int kblks = K / 64, nb = item / kblks, kb = item % kblks, k0 = 64 * kb, n0 = 32 * nb;
    const int nn = n0 + (lane & 31); const bool ok = nn < nvalid;
    float wv[32];
#pragma unroll
    for (int i = 0; i < 32; ++i) { const int kk = 2 * i + (lane >> 5); wv[i] = ok ? W[(size_t)(k0 + kk) * ldw + src_col0 + nn] : 0.f; }
    if (gk) {
#pragma unroll
        for (int i = 0; i < 32; ++i) wv[i] *= gk[k0 + 2 * i + (lane >> 5)];
    }
#pragma unroll
    for (int i = 0; i < 32; ++i) { const int kk = 2 * i + (lane >> 5); scr[kk * 33 + (lane & 31)] = wv[i]; }
    asm volatile("s_waitcnt lgkmcnt(0)" ::: "memory");
    int L = dst_row0 + n0;
    if (perm == 1) { const int l = L & 255; L = (L & ~255) | (((l >> 5) & 1) * 128 + (l >> 6) * 32); }
    else if (perm == 2) { const int hb = L >= DFF ? 1 : 0, c = L - hb * DFF; L = (c >> 7) * 256 + hb * 128 + (c & 127); }
    const int c = lane & 7;
#pragma unroll
    for (int j = 0; j < 4; ++j) { const int n = (lane >> 3) + 8 * j; const LAS float* s = scr + (8 * c) * 33 + n;
        u32x4 o; o.x = cvtpk(s[0 * 33], s[1 * 33]); o.y = cvtpk(s[2 * 33], s[3 * 33]); o.z = cvtpk(s[4 * 33], s[5 * 33]); o.w = cvtpk(s[6 * 33], s[7 * 33]);
        *(u32x4*)(WT + (size_t)(L + n) * K + k0 + 8 * c) = o; }
    asm volatile("s_waitcnt lgkmcnt(0)" ::: "memory");
}
__device__ __forceinline__ void rms_row_to_bf16(const float* xrow, const float* g, bf16* orow, int lane) {
    const f32x4* xr = (const f32x4*)xrow + lane; const f32x4* gr = (const f32x4*)g + lane;
    f32x4 v[4]; float s = 0.f;
#pragma unroll
    for (int j = 0; j < 4; ++j) { v[j] = xr[64 * j]; s += (v[j].x * v[j].x + v[j].y * v[j].y) + (v[j].z * v[j].z + v[j].w * v[j].w); }
    const float rstd = rsqrtf(wave_sum(s) * (1.f / DM) + 1e-6f);
    u32x2* o8 = (u32x2*)orow + lane;
#pragma unroll
    for (int j = 0; j < 4; ++j) { const f32x4 gg = gr[64 * j]; u32x2 w; w.x = cvtpk(v[j].x * rstd * gg.x, v[j].y * rstd * gg.y); w.y = cvtpk(v[j].z * rstd * gg.z, v[j].w * rstd * gg.w); o8[64 * j] = w; }
}
__device__ __forceinline__ void xb_row(const float* xrow, bf16* orow, float* ssq4, int lane) {
    const f32x4* xr = (const f32x4*)xrow + lane;
    f32x4 v[4]; float s = 0.f;
#pragma unroll
    for (int j = 0; j < 4; ++j) { v[j] = xr[64 * j]; s += (v[j].x * v[j].x + v[j].y * v[j].y) + (v[j].z * v[j].z + v[j].w * v[j].w); }
    s = wave_sum(s);
    u32x2* o8 = (u32x2*)orow + lane;
#pragma unroll
    for (int j = 0; j < 4; ++j) { u32x2 w; w.x = cvtpk(v[j].x, v[j].y); w.y = cvtpk(v[j].z, v[j].w); o8[64 * j] = w; }
    if (lane == 0) *(f32x4*)ssq4 = (f32x4){s, 0.f, 0.f, 0.f};
}
__device__ __forceinline__ void norm_phase(const float* X, const float* g, bf16* XN, int gw, int ngw, int lane) {
    for (int m = gw; m < MTOK; m += ngw) rms_row_to_bf16(X + (size_t)m * DM, g, XN + (size_t)m * DM, lane);
}

#define MFMA32(a, b, c) __builtin_amdgcn_mfma_f32_32x32x16_bf16((a), (b), (c), 0, 0, 0)
__device__ __forceinline__ void qk_tile(f32x16& p0, f32x16& p1, const bf16* Kh  , size_t key0, int kpitch, const bf16x8 (&qr)[4], int r32, int hi) {
    const bf16* kp = Kh + (key0 + pi_row(r32)) * (size_t)kpitch + hi * 8;
    p0 = (f32x16){}; p1 = (f32x16){};
#pragma unroll
    for (int d0 = 0; d0 < 4; ++d0) {
        const bf16x8 k0 = *(const bf16x8*)(kp + d0 * 16), k1 = *(const bf16x8*)(kp + (size_t)32 * kpitch + d0 * 16);
        p0 = MFMA32(k0, qr[d0], p0); p1 = MFMA32(k1, qr[d0], p1);
    }
}
__device__ __forceinline__ void pv_tile(f32x16& o0, f32x16& o1, const bf16* Vth  , size_t key0, const f32x16& p0, const f32x16& p1, int r32, int hi) {
    const bf16* vp = Vth + (size_t)r32 * MTOK + key0 + hi * 8;
#pragma unroll
    for (int half = 0; half < 2; ++half)
#pragma unroll
        for (int s = 0; s < 2; ++s) {
            const f32x16& p = half ? p1 : p0;
            u32x4 w; w.x = cvtpk(p[8 * s + 0], p[8 * s + 1]); w.y = cvtpk(p[8 * s + 2], p[8 * s + 3]); w.z = cvtpk(p[8 * s + 4], p[8 * s + 5]); w.w = cvtpk(p[8 * s + 6], p[8 * s + 7]);
            const bf16x8 pf = __builtin_bit_cast(bf16x8, w);
            const bf16x8 v0 = *(const bf16x8*)(vp + half * 32 + s * 16), v1 = *(const bf16x8*)(vp + (size_t)32 * MTOK + half * 32 + s * 16);
            o0 = MFMA32(v0, pf, o0); o1 = MFMA32(v1, pf, o1);
        }
}
__device__ __forceinline__ void load_q(bf16x8 (&qr)[4], const bf16* Q, size_t qrow, int h, int hi) {
#pragma unroll
    for (int d0 = 0; d0 < 4; ++d0) qr[d0] = *(const bf16x8*)(Q + qrow * DM + h * HD + d0 * 16 + hi * 8);
}
__device__ __forceinline__ void store_o(bf16* O, size_t qrow, int h, const f32x16& o0, const f32x16& o1, float rl, int hi) {
    bf16* op = O + qrow * DM + h * HD + 4 * hi;
#pragma unroll
    for (int dh = 0; dh < 2; ++dh)
#pragma unroll
        for (int g = 0; g < 4; ++g) { const f32x16& o = dh ? o1 : o0; u32x2 w; w.x = cvtpk(o[4 * g] * rl, o[4 * g + 1] * rl); w.y = cvtpk(o[4 * g + 2] * rl, o[4 * g + 3] * rl);
            *(u32x2*)(op + 32 * dh + 8 * g) = w; }
}
#define MAX3(a, b, c) __builtin_fmaxf(__builtin_fmaxf((a), (b)), (c))
__device__ __forceinline__ void softmax_step(f32x16& p0, f32x16& p1, float& m, float& l, f32x16& o0, f32x16& o1) {
    float a = MAX3(p0[0], p0[1], p0[2]), b = MAX3(p1[0], p1[1], p1[2]);
#pragma unroll
    for (int r = 3; r < 15; r += 2) { a = MAX3(a, p0[r], p0[r + 1]); b = MAX3(b, p1[r], p1[r + 1]); }
    float mx = MAX3(a, b, p0[15]); mx = fmaxf(mx, p1[15]);
    mx = fmaxf(mx, __shfl_xor(mx, 32));
    const float mn = fmaxf(m, mx);
    if (!__all(mn == m)) {
        const float alpha = __builtin_amdgcn_exp2f(m - mn); m = mn; l *= alpha;
#pragma unroll
        for (int r = 0; r < 16; ++r) { o0[r] *= alpha; o1[r] *= alpha; }
    }
    float s = 0.f;
#pragma unroll
    for (int r = 0; r < 16; ++r) { p0[r] = __builtin_amdgcn_exp2f(p0[r] - mn); p1[r] = __builtin_amdgcn_exp2f(p1[r] - mn); s += p0[r] + p1[r]; }
    l += s;
}
__device__ __forceinline__ void attn_unit_of(int u, int& bh, int& qb) { bh = u >> 7; qb = u & 127; if ((u >> 11) & 1) qb = 127 - qb; }

__device__ __forceinline__ void attnA_phase(const bf16* Q, const bf16* K, const bf16* Vt, bf16* O, const float* rel_bias  , LAS float* biasL, int vw, int nvw, int tid) {
    for (int i = tid; i < 16 * 513; i += NTHREADS) biasL[(i / 513) * 516 + (i % 513)] = rel_bias[i] * LOG2E;
    __syncthreads();
    const int lane = tid & 63, r32 = lane & 31, hi = lane >> 5;
    for (int u = vw; u < NB * NH * 128; u += nvw) {
        int bh, qb; attn_unit_of(u, bh, qb); const int b = bh >> 4, h = bh & 15, c = qb >> 1, qh = qb & 1;
        const size_t qrow = (size_t)b * SEQ + qb * 32 + r32;
        bf16x8 qr[4]; load_q(qr, Q, qrow, h, hi);
        f32x16 o0 = (f32x16){}, o1 = (f32x16){}; float m = -1e30f, l = 0.f;
        const LAS float* bl = biasL + h * 516;
        for (int kt = (c < 8 ? 8 - c : 0); kt <= 8; ++kt) {
            const size_t key0 = (size_t)b * SEQ + (size_t)(c - 8 + kt) * 64;
            f32x16 p0, p1; qk_tile(p0, p1, K + h * HD, key0, DM, qr, r32, hi);
            if (kt >= 4) {
                const int base = (8 - kt) * 64 + qh * 32 + r32 - 8 * hi;
#pragma unroll
                for (int r = 0; r < 16; ++r) { const int d0 = base - (16 * (r >> 3) + (r & 7)); const int d1 = d0 - 32;
                    p0[r] += bl[(d0 < 256 ? d0 : 256) + 256]; p1[r] += bl[(d1 < 256 ? d1 : 256) + 256]; }
            } else { const float bc = bl[512];
#pragma unroll
                for (int r = 0; r < 16; ++r) { p0[r] += bc; p1[r] += bc; } }
            softmax_step(p0, p1, m, l, o0, o1);
            pv_tile(o0, o1, Vt + (size_t)h * HD * MTOK, key0, p0, p1, r32, hi);
        }
        l += __shfl_xor(l, 32);
        store_o(O, qrow, h, o0, o1, 1.0f / l, hi);
    }
}
__device__ __forceinline__ void attnC_phase(const bf16* Q, const bf16* K, const bf16* Vt, bf16* O, int vw, int nvw, int tid) {
    const int lane = tid & 63, r32 = lane & 31, hi = lane >> 5;
    for (int u = vw; u < NB * NH * 128; u += nvw) {
        int bh, qb; attn_unit_of(u, bh, qb); const int b = bh >> 4, h = bh & 15;
        const size_t qrow = (size_t)b * SEQ + qb * 32 + r32; const int t = qb * 32 + r32;
        bf16x8 qr[4]; load_q(qr, Q, qrow, h, hi);
        f32x16 o0 = (f32x16){}, o1 = (f32x16){}; float R = 0.f;
        for (int kt = qb >> 1; kt >= 0; --kt) {
            const size_t key0 = (size_t)b * SEQ + (size_t)kt * 64;
            f32x16 p0, p1; qk_tile(p0, p1, K + h * HD, key0, DM, qr, r32, hi);
            const int kb = kt * 64 + 8 * hi;
            float lk[32], lb[32];
#pragma unroll
            for (int e = 0; e < 32; ++e) { const int r = e & 15, half = e >> 4; const float z = half ? p1[r] : p0[r];
                const int key = kb + 32 * half + 16 * (r >> 3) + (r & 7);
                const float sp = fmaxf(z, 0.f) + __builtin_amdgcn_logf(1.f + __builtin_amdgcn_exp2f(-fabsf(z)));
                const bool valid = key < t;
                lk[e] = valid ? -sp : 0.f; lb[e] = valid ? (z - sp) : -INFINITY; }
            float G[4], ex[32];
#pragma unroll
            for (int gi = 0; gi < 4; ++gi) { float run = 0.f;
#pragma unroll
                for (int i = 7; i >= 0; --i) { ex[gi * 8 + i] = run; run += lk[gi * 8 + i]; }
                G[gi] = run; }
            float Gp[4];
#pragma unroll
            for (int gi = 0; gi < 4; ++gi) Gp[gi] = __shfl_xor(G[gi], 32);
            float suf[4]; float run = 0.f;
#pragma unroll
            for (int gi = 3; gi >= 0; --gi) { suf[gi] = run + (hi == 0 ? Gp[gi] : 0.f); run += G[gi] + Gp[gi]; }
#pragma unroll
            for (int e = 0; e < 32; ++e) { const float a = __builtin_amdgcn_exp2f(lb[e] + R + suf[e >> 3] + ex[e]); if (e < 16) p0[e] = a; else p1[e - 16] = a; }
            R += run;
            pv_tile(o0, o1, Vt + (size_t)h * HD * MTOK, key0, p0, p1, r32, hi);
            if (__all(R < -300.f)) break;
        }
        store_o(O, qrow, h, o0, o1, 1.0f, hi);
    }
}
constexpr int TP = 144;
constexpr int TILE_B = 64 * TP, KVBUF_B = 2 * TILE_B;
constexpr int PAIR_B = 2 * KVBUF_B;
struct KVStage { u32x4 k, v; };
__device__ __forceinline__ void kv_issue(KVStage& st, const bf16* Kh, const bf16* Vth, size_t key0, int tid) {
    const int row = tid >> 3, ch = tid & 7;
    st.k = *(const u32x4*)(Kh + (key0 + row) * DM + ch * 8);
    st.v = *(const u32x4*)(Vth + (size_t)row * MTOK + key0 + ch * 8);
}
__device__ __forceinline__ void kv_write(const KVStage& st, LAS unsigned char* buf, int tid) {
    const int row = tid >> 3, ch = tid & 7;
    *(LAS u32x4*)(buf + row * TP + ch * 16) = st.k;
    *(LAS u32x4*)(buf + TILE_B + row * TP + ch * 16) = st.v;
}
template <bool INIT = true> __device__ __forceinline__ void qk_lds(f32x16& p0, f32x16& p1, const LAS unsigned char* buf, const bf16x8 (&qr)[4], int r32, int hi) {
    const LAS unsigned char* kp = buf + pi_row(r32) * TP + hi * 16;
    if (INIT) { p0 = (f32x16){}; p1 = (f32x16){}; }
#pragma unroll
    for (int d0 = 0; d0 < 4; ++d0) {
        const bf16x8 k0 = *(const LAS bf16x8*)(kp + d0 * 32), k1 = *(const LAS bf16x8*)(kp + 32 * TP + d0 * 32);
        p0 = MFMA32(k0, qr[d0], p0); p1 = MFMA32(k1, qr[d0], p1);
    }
}
__device__ __forceinline__ void pv_lds(f32x16& o0, f32x16& o1, const LAS unsigned char* buf, const f32x16& p0, const f32x16& p1, int r32, int hi) {
    const LAS unsigned char* vp = buf + TILE_B + r32 * TP + hi * 16;
#pragma unroll
    for (int half = 0; half < 2; ++half)
#pragma unroll
        for (int s = 0; s < 2; ++s) {
            const f32x16& p = half ? p1 : p0;
            u32x4 w; w.x = cvtpk(p[8 * s + 0], p[8 * s + 1]); w.y = cvtpk(p[8 * s + 2], p[8 * s + 3]); w.z = cvtpk(p[8 * s + 4], p[8 * s + 5]); w.w = cvtpk(p[8 * s + 6], p[8 * s + 7]);
            const bf16x8 pf = __builtin_bit_cast(bf16x8, w);
            const bf16x8 v0 = *(const LAS bf16x8*)(vp + half * 64 + s * 32), v1 = *(const LAS bf16x8*)(vp + 32 * TP + half * 64 + s * 32);
            o0 = MFMA32(v0, pf, o0); o1 = MFMA32(v1, pf, o1);
        }
}
#define WG_BARRIER_L() do { asm volatile("s_waitcnt lgkmcnt(0)" ::: "memory"); __builtin_amdgcn_s_barrier(); asm volatile("" ::: "memory"); } while (0)
#define WG_BARRIER() do { asm volatile("s_waitcnt vmcnt(0) lgkmcnt(0)" ::: "memory"); __builtin_amdgcn_s_barrier(); asm volatile("" ::: "memory"); } while (0)
__device__ __forceinline__ void blk_unit_of(int u, int& bh, int& ub) { bh = u >> 4; ub = u & 15; if ((u >> 8) & 1) ub = 15 - ub; }

template <bool FIXED> __device__ __forceinline__ void attnA_blk(const bf16* Q, const bf16* K, const bf16* Vt, bf16* O, const float* rel_bias, float ref, LAS unsigned char* lds, int vcu, int G, int tid) {
    LAS float* biasL = (LAS float*)(lds + 2 * PAIR_B);
    for (int i = tid; i < 16 * 513; i += NTHREADS) biasL[(i / 513) * 516 + (i % 513)] = rel_bias[i] * LOG2E - (FIXED ? ref : 0.f);
    __syncthreads();
    const int lane = tid & 63, r32 = lane & 31, hi = lane >> 5, wid = __builtin_amdgcn_readfirstlane(tid >> 6);
#pragma unroll 1
    for (int u = vcu; u < NB * NH * 16; u += G) {
        int bh, ub; blk_unit_of(u, bh, ub); const int b = bh >> 4, h = bh & 15, qb = ub * 8 + wid, c = qb >> 1, qh = qb & 1;
        const size_t qrow = (size_t)b * SEQ + qb * 32 + r32;
        bf16x8 qr[4]; load_q(qr, Q, qrow, h, hi);
        f32x16 o0 = (f32x16){}, o1 = (f32x16){}; float m = -1e30f, l = 0.f;
        const LAS float* bl = biasL + h * 516;
        const bf16* Kh = K + h * HD; const bf16* Vth = Vt + (size_t)h * HD * MTOK;
        const int c0 = ub * 4, t_lo = c0 >= 8 ? c0 - 8 : 0, t_hi = c0 + 3;
        const size_t kbase = (size_t)b * SEQ; const int ntl = t_hi - t_lo + 1;
        KVStage sa, sb;
        kv_issue(sa, Kh, Vth, kbase + (size_t)t_lo * 64, tid); kv_issue(sb, Kh, Vth, kbase + (size_t)(t_lo + 1) * 64, tid);
        kv_write(sa, lds, tid); kv_write(sb, lds + KVBUF_B, tid); WG_BARRIER();
#define ATT_PAIR(IT) do { const int it_ = (IT); LAS unsigned char* pb = lds + ((it_ >> 1) & 1) * PAIR_B; \
            if (it_ + 2 < ntl) { kv_issue(sa, Kh, Vth, kbase + (size_t)(t_lo + it_ + 2) * 64, tid); kv_issue(sb, Kh, Vth, kbase + (size_t)(t_lo + it_ + 3) * 64, tid); } \
            { const int t = t_lo + it_; LAS unsigned char* buf = pb; ATT_COMPUTE } \
            { const int t = t_lo + it_ + 1; LAS unsigned char* buf = pb + KVBUF_B; ATT_COMPUTE } \
            if (it_ + 2 < ntl) { LAS unsigned char* nb = lds + (((it_ >> 1) + 1) & 1) * PAIR_B; kv_write(sa, nb, tid); kv_write(sb, nb + KVBUF_B, tid); } \
            WG_BARRIER(); } while (0)
#define ATT_COMPUTE             if (t >= c - 8 && t <= c) { \
                const int kt = t - c + 8; \
                f32x16 p0, p1; \
                if (kt > 4) { \
                    const LAS float* bp = bl + ((8 - kt) * 64 + qh * 32 + r32 - 8 * hi + 256); \
_Pragma("unroll") \
                    for (int r = 0; r < 16; ++r) { p0[r] = bp[-(16 * (r >> 3) + (r & 7))]; p1[r] = bp[-(16 * (r >> 3) + (r & 7)) - 32]; } \
                } else if (kt == 4) { \
                    const int base = 4 * 64 + qh * 32 + r32 - 8 * hi; \
_Pragma("unroll") \
                    for (int r = 0; r < 16; ++r) { const int d0 = base - (16 * (r >> 3) + (r & 7)); const int d1 = d0 - 32; \
                        p0[r] = bl[(d0 < 256 ? d0 : 256) + 256]; p1[r] = bl[(d1 < 256 ? d1 : 256) + 256]; } \
                } else { const float bc = bl[512]; \
_Pragma("unroll") \
                    for (int r = 0; r < 16; ++r) { p0[r] = bc; p1[r] = bc; } } \
                qk_lds<false>(p0, p1, buf, qr, r32, hi); \
                if (FIXED) { float sacc = 0.f; \
_Pragma("unroll") \
                    for (int r = 0; r < 16; ++r) { p0[r] = __builtin_amdgcn_exp2f(p0[r]); p1[r] = __builtin_amdgcn_exp2f(p1[r]); sacc += p0[r] + p1[r]; } \
                    l += sacc; \
                } else softmax_step(p0, p1, m, l, o0, o1); \
                pv_lds(o0, o1, buf, p0, p1, r32, hi); \
            }
#pragma unroll 1
        for (int it = 0; it < ntl; it += 2) ATT_PAIR(it);
#undef ATT_COMPUTE
        l += __shfl_xor(l, 32);
        store_o(O, qrow, h, o0, o1, 1.0f / l, hi);
    }
}
template <bool FIXED> __device__ __forceinline__ void attnB_blk(const bf16* Q, const bf16* K, const bf16* Vt, bf16* O, const unsigned long long* MASK, float ref, LAS unsigned char* lds, int vcu, int G, int tid) {
    const int lane = tid & 63, r32 = lane & 31, hi = lane >> 5, wid = __builtin_amdgcn_readfirstlane(tid >> 6);
#pragma unroll 1
    for (int u = vcu; u < NB * NH * 16; u += G) {
        int bh, ub; blk_unit_of(u, bh, ub); const int b = bh >> 4, h = bh & 15, qb = ub * 8 + wid;
        const size_t qrow = (size_t)b * SEQ + qb * 32 + r32;
        bf16x8 qr[4]; load_q(qr, Q, qrow, h, hi);
        f32x16 o0 = (f32x16){}, o1 = (f32x16){}; float m = -1e30f, l = 0.f;
        const unsigned long long* mrow = MASK + qrow * 64;
        const int ntile = (qb >> 1) + 1, t_hi = ub * 4 + 3;
        const bf16* Kh = K + h * HD; const bf16* Vth = Vt + (size_t)h * HD * MTOK;
        const size_t kbase = (size_t)b * SEQ; const int ntl = t_hi + 1, t_lo = 0;
        KVStage sa, sb;
        kv_issue(sa, Kh, Vth, kbase, tid); kv_issue(sb, Kh, Vth, kbase + 64, tid);
        unsigned long long mw_next = mrow[0];
        kv_write(sa, lds, tid); kv_write(sb, lds + KVBUF_B, tid); WG_BARRIER();
#define ATT_COMPUTE const unsigned long long mw = mw_next; if (t + 1 < ntile) mw_next = mrow[t + 1]; \
            if (t < ntile) { \
 \
                const int n0 = (int)~((unsigned)mw >> (8 * hi)), n1 = (int)~((unsigned)(mw >> 32) >> (8 * hi)); \
                f32x16 p0, p1; \
_Pragma("unroll") \
                for (int r = 0; r < 16; ++r) { const int bit = 16 * (r >> 3) + (r & 7); \
                    const float i0 = __int_as_float(__builtin_amdgcn_sbfe(n0, bit, 1) & (int)0xFF800000), i1 = __int_as_float(__builtin_amdgcn_sbfe(n1, bit, 1) & (int)0xFF800000); \
                    p0[r] = FIXED ? i0 - ref : i0; p1[r] = FIXED ? i1 - ref : i1; } \
                qk_lds<false>(p0, p1, buf, qr, r32, hi); \
                if (FIXED) { float sacc = 0.f; \
_Pragma("unroll") \
                    for (int r = 0; r < 16; ++r) { p0[r] = __builtin_amdgcn_exp2f(p0[r]); p1[r] = __builtin_amdgcn_exp2f(p1[r]); sacc += p0[r] + p1[r]; } \
                    l += sacc; \
                } else softmax_step(p0, p1, m, l, o0, o1); \
                pv_lds(o0, o1, buf, p0, p1, r32, hi); \
            }
#pragma unroll 1
        for (int it = 0; it < ntl; it += 2) ATT_PAIR(it);
#undef ATT_COMPUTE
        l += __shfl_xor(l, 32);
        store_o(O, qrow, h, o0, o1, 1.0f / l, hi);
    }
}
__device__ __forceinline__ void attnC_blk(const bf16* Q, const bf16* K, const bf16* Vt, bf16* O, LAS unsigned char* lds, int vcu, int G, int tid) {
    const int lane = tid & 63, r32 = lane & 31, hi = lane >> 5, wid = __builtin_amdgcn_readfirstlane(tid >> 6);
    LAS unsigned* flags = (LAS unsigned*)(lds + 2 * KVBUF_B);
#pragma unroll 1
    for (int u = vcu; u < NB * NH * 16; u += G) {
        int bh, ub; blk_unit_of(u, bh, ub); const int b = bh >> 4, h = bh & 15, qb = ub * 8 + wid;
        const size_t qrow = (size_t)b * SEQ + qb * 32 + r32; const int tq = qb * 32 + r32;
        bf16x8 qr[4]; load_q(qr, Q, qrow, h, hi);
        f32x16 o0 = (f32x16){}, o1 = (f32x16){}; float R = 0.f; bool done = false;
        const int t_hi = ub * 4 + 3, t_me = qb >> 1;
        const bf16* Kh = K + h * HD; const bf16* Vth = Vt + (size_t)h * HD * MTOK;
        KVStage st; kv_issue(st, Kh, Vth, (size_t)b * SEQ + (size_t)t_hi * 64, tid); kv_write(st, lds, tid); WG_BARRIER();
#pragma unroll 1
        for (int t = t_hi, it = 0; t >= 0; --t, ++it) {
            LAS unsigned char* buf = lds + (it & 1) * KVBUF_B;
            if (t > 0) kv_issue(st, Kh, Vth, (size_t)b * SEQ + (size_t)(t - 1) * 64, tid);
            if (t <= t_me && !done) {
                f32x16 p0, p1; qk_lds(p0, p1, buf, qr, r32, hi);
                const int kb = t * 64 + 8 * hi;
                const bool diag = (t == t_me);
                float lk[32], lb[32];
#pragma unroll
                for (int e = 0; e < 32; ++e) { const int r = e & 15, half = e >> 4; const float z = half ? p1[r] : p0[r];
                    const float sp = __builtin_amdgcn_logf(1.f + __builtin_amdgcn_exp2f(fminf(z, 80.f)));
                    lk[e] = -sp; lb[e] = z - sp; }
                if (diag) {
#pragma unroll
                    for (int e = 0; e < 32; ++e) { const int r = e & 15, half = e >> 4; const int key = kb + 32 * half + 16 * (r >> 3) + (r & 7);
                        const bool valid = key < tq; lk[e] = valid ? lk[e] : 0.f; lb[e] = valid ? lb[e] : -INFINITY; }
                }
                float Gs[4], ex[32];
#pragma unroll
                for (int gi = 0; gi < 4; ++gi) { float run = 0.f;
#pragma unroll
                    for (int i = 7; i >= 0; --i) { ex[gi * 8 + i] = run; run += lk[gi * 8 + i]; }
                    Gs[gi] = run; }
                float Gp[4];
#pragma unroll
                for (int gi = 0; gi < 4; ++gi) Gp[gi] = __shfl_xor(Gs[gi], 32);
                float suf[4]; float run = 0.f;
#pragma unroll
                for (int gi = 3; gi >= 0; --gi) { suf[gi] = R + run + (hi == 0 ? Gp[gi] : 0.f); run += Gs[gi] + Gp[gi]; }
#pragma unroll
                for (int e = 0; e < 32; ++e) { const float a = __builtin_amdgcn_exp2f(lb[e] + (suf[e >> 3] + ex[e])); if (e < 16) p0[e] = a; else p1[e - 16] = a; }
                R += run;
                pv_lds(o0, o1, buf, p0, p1, r32, hi);
                done = __all(R < -300.f);
            }
            if (lane == 0) flags[(it & 1) * 8 + wid] = (done || t == 0) ? 0u : 1u;
            if (t > 0) kv_write(st, lds + ((it + 1) & 1) * KVBUF_B, tid);
            WG_BARRIER();
            unsigned any = 0u;
#pragma unroll
            for (int w = 0; w < 8; ++w) any |= flags[(it & 1) * 8 + w];
            if (any == 0u) break;
        }
        store_o(O, qrow, h, o0, o1, 1.0f, hi);
        WG_BARRIER();
    }
}
#define XB_TMO      128
#define XB_XCNT(j)  (256  + 64 * (j))
#define XB_XSUB(j)  (1280 + 64 * (j))
#define XB_XGEN(j)  (2304 + 64 * (j))
#define XB_TOP      3328
#define XB_TOPGEN   3392
#define XCD_BAR_WORDS 3456
#define XB_SPIN_CAP (1u << 18)

__device__ __forceinline__ unsigned xb_ld(unsigned* p)              { return __hip_atomic_load(p, __ATOMIC_RELAXED, __HIP_MEMORY_SCOPE_AGENT); }
__device__ __forceinline__ unsigned xb_add(unsigned* p, unsigned v) { return __hip_atomic_fetch_add(p, v, __ATOMIC_RELAXED, __HIP_MEMORY_SCOPE_AGENT); }
__device__ __forceinline__ unsigned xb_xcc_id() { return (unsigned)__builtin_amdgcn_s_getreg((3 << 11) | 20) & 0xFu; }
#define XB_SPIN(cond, bar) do { unsigned _sp = 0; while (cond) { __builtin_amdgcn_s_sleep(1); \
    if ((++_sp & 255u) == 0u) { if (xb_ld(&(bar)[XB_TMO])) break; if (_sp > XB_SPIN_CAP) { atomicAdd(&(bar)[XB_TMO], 1u); break; } } } } while (0)

struct XcdBarrier {
    unsigned* bar; unsigned x;
    volatile LAS unsigned* st;
};

__device__ __forceinline__ XcdBarrier xcd_barrier_post(unsigned* bar, volatile LAS unsigned* st) {
    XcdBarrier b; b.bar = bar; b.x = xb_xcc_id(); b.st = st;
    if (threadIdx.x == 0) (void)xb_add(&bar[XB_XCNT(b.x)], 1u);
    return b;
}
__device__ __forceinline__ void xcd_barrier_complete(unsigned* bar, unsigned x, unsigned& nloc, unsigned& nx) {
    const unsigned G = gridDim.x * gridDim.y * gridDim.z;
    unsigned sum, cnt, mine, sp = 0u;
    for (;;) {
        sum = 0u; cnt = 0u; mine = 0u;
#pragma unroll
        for (unsigned j = 0; j < 16; ++j) { const unsigned c = xb_ld(&bar[XB_XCNT(j)]); sum += c; cnt += (c > 0u) ? 1u : 0u; mine = (j == x) ? c : mine; }
        if (sum == G) break;
        __builtin_amdgcn_s_sleep(1);
        if ((++sp & 255u) == 0u) { if (xb_ld(&bar[XB_TMO])) break; if (sp > XB_SPIN_CAP) { atomicAdd(&bar[XB_TMO], 1u); break; } }
    }
    nloc = mine > 0u ? mine : 1u; nx = cnt > 0u ? cnt : 1u;
}

__device__ __forceinline__ void xcd_barrier(const XcdBarrier& b, int g_wave_id) {
    asm volatile("s_waitcnt vmcnt(0)" ::: "memory");
    __syncthreads();
    if (g_wave_id == 0 && lane_id() == 0) {
        unsigned* bar = b.bar;
        __builtin_amdgcn_s_waitcnt(0);
        unsigned nloc = b.st[0], nx = b.st[1];
        if (nloc == 0u) { xcd_barrier_complete(bar, b.x, nloc, nx); b.st[0] = nloc; b.st[1] = nx; }
        const unsigned old = xb_add(&bar[XB_XSUB(b.x)], 1u);
        const unsigned gen = old / nloc;
        if (old + 1u == (gen + 1u) * nloc) {
            __builtin_amdgcn_fence(__ATOMIC_RELEASE, "agent");
            asm volatile("s_waitcnt vmcnt(0)" ::: "memory");
            const unsigned og = xb_add(&bar[XB_TOP], 1u);
            const unsigned tg = og / nx;
            if (og + 1u == (tg + 1u) * nx) xb_add(&bar[XB_TOPGEN], 1u);
            else XB_SPIN(xb_ld(&bar[XB_TOPGEN]) == tg, bar);
            __builtin_amdgcn_fence(__ATOMIC_ACQUIRE, "agent");
            xb_add(&bar[XB_XGEN(b.x)], 1u);
            asm volatile("s_waitcnt vmcnt(0)" ::: "memory");
        } else {
            XB_SPIN(xb_ld(&bar[XB_XGEN(b.x)]) == gen, bar);
            __builtin_amdgcn_fence(__ATOMIC_ACQUIRE, "agent");
            asm volatile("s_waitcnt vmcnt(0)" ::: "memory");
        }
    }
    __syncthreads();
}
constexpr int QI_PITCH = 520;
__device__ __forceinline__ void b1_phase(const bf16* QI, const bf16* KI, const float* WI, float* SCRb  , unsigned long long* MASK,
                                         LAS unsigned char* lds, int vcu, int G, int tid) {
    const int lane = tid & 63, r32 = lane & 31, hi = lane >> 5, wid = __builtin_amdgcn_readfirstlane(tid >> 6);
    LAS bf16* qs = (LAS bf16*)lds;
#pragma unroll 1
    for (int u0 = vcu, rnd = 0; u0 < NB * 128; u0 += G, ++rnd) {
        const int b = u0 >> 7; int qb = u0 & 127; if (rnd & 1) qb = 127 - qb;
        const size_t tok0 = (size_t)b * SEQ + qb * 32;
        const int ntile = (qb >> 1) + 1, limit = ntile * 64;
        for (int i = tid; i < 32 * 64; i += NTHREADS) { const int q = i >> 6, c = i & 63; *(LAS u32x4*)(qs + q * QI_PITCH + c * 8) = *(const u32x4*)(QI + (tok0 + q) * 512 + c * 8); }
        LAS float* wl = (LAS float*)(lds + 32 * QI_PITCH * 2);
        if (tid < 256) wl[tid] = WI[tok0 * 8 + tid];
        __syncthreads();
#ifndef B1_SCORE_REP
#define B1_SCORE_REP 1
#endif
#ifndef B1_TOPK_REP
#define B1_TOPK_REP 1
#endif
#ifndef B1_NO_SCORE
        for (int rep_ = 0; rep_ < B1_SCORE_REP; ++rep_)
#pragma unroll 1
        for (int kt = wid; kt < ntile; kt += NWAVES) {
            const size_t key0 = (size_t)b * SEQ + (size_t)kt * 64;
            const bf16* kp = KI + (key0 + pi_row(r32)) * 64 + hi * 8;
            bf16x8 kf0[4], kf1[4];
#pragma unroll
            for (int d0 = 0; d0 < 4; ++d0) { kf0[d0] = *(const bf16x8*)(kp + d0 * 16); kf1[d0] = *(const bf16x8*)(kp + 32 * 64 + d0 * 16); }
            f32x16 s0 = (f32x16){}, s1 = (f32x16){};
            int qoff = r32 * QI_PITCH + hi * 8; asm volatile("" : "+v"(qoff));
#pragma unroll 1
            for (int hh = 0; hh < 8; ++hh) {
                f32x16 a0 = (f32x16){}, a1 = (f32x16){};
                const float wh = wl[r32 * 8 + hh];
#pragma unroll
                for (int d0 = 0; d0 < 4; ++d0) { const bf16x8 qf = *(const LAS bf16x8*)(qs + qoff + hh * 64 + d0 * 16); a0 = MFMA32(kf0[d0], qf, a0); a1 = MFMA32(kf1[d0], qf, a1); }
#pragma unroll
                for (int r = 0; r < 16; ++r) { s0[r] = __builtin_fmaf(wh, __builtin_fmaxf(a0[r], 0.f), s0[r]); s1[r] = __builtin_fmaf(wh, __builtin_fmaxf(a1[r], 0.f), s1[r]); }
            }
            float* sp = SCRb + (size_t)r32 * 4096 + kt * 64 + 8 * hi;
#pragma unroll
            for (int half = 0; half < 2; ++half)
#pragma unroll
                for (int s = 0; s < 2; ++s) { const f32x16& p = half ? s1 : s0;
                    *(f32x4*)(sp + 32 * half + 16 * s) = (f32x4){p[8 * s], p[8 * s + 1], p[8 * s + 2], p[8 * s + 3]};
                    *(f32x4*)(sp + 32 * half + 16 * s + 4) = (f32x4){p[8 * s + 4], p[8 * s + 5], p[8 * s + 6], p[8 * s + 7]}; }
        }
#endif
        asm volatile("s_waitcnt vmcnt(0)" ::: "memory");
        __syncthreads();
#ifndef B1_NO_TOPK
#pragma unroll 1
        for (int qq = 0; qq < 4 * B1_TOPK_REP; ++qq) {
            const int q = wid * 4 + (qq & 3);
            const float* srow = SCRb + (size_t)q * 4096 + lane;
            unsigned uu[64];
#pragma unroll
            for (int j = 0; j < 64; ++j) { unsigned key = 0u; if (j < ntile) { const float f = srow[j * 64] + 0.0f; const unsigned bts = __float_as_uint(f); key = bts ^ ((bts >> 31) ? 0xFFFFFFFFu : 0x80000000u); } uu[j] = key; }
            unsigned T = 1u;
            if (limit > 256) {
                unsigned prefix = 0u;
#pragma unroll 1
                for (int bit = 31; bit >= 0; --bit) {
                    const unsigned cand = prefix | (1u << bit); unsigned less = 0u;
#pragma unroll
                    for (int j = 0; j < 64; ++j) less += (uu[j] < cand) ? 1u : 0u;
                    const int cnt = 4096 - (int)wave_sum_u32(less);
                    if (cnt >= 256) prefix = cand;
                    if (cnt == 256) break;
                }
                T = prefix;
            }
            int ngt = 0;
#pragma unroll
            for (int j = 0; j < 64; ++j) ngt += __popcll(__ballot(uu[j] > T));
            const int need = (limit > 256) ? (256 - ngt) : 4096;
            int c = 0; unsigned long long myword = 0ull;
#pragma unroll
            for (int j = 0; j < 64; ++j) {
                const bool eq = (uu[j] == T); const unsigned long long eqm = __ballot(eq);
                const int below = __builtin_amdgcn_mbcnt_hi((unsigned)(eqm >> 32), __builtin_amdgcn_mbcnt_lo((unsigned)eqm, 0u));
                const bool sel = (uu[j] > T) || (eq && (c + below < need));
                const unsigned long long word = __ballot(sel);
                c += __popcll(eqm);
                if (lane == j) myword = word;
            }
            if (lane < ntile) MASK[(tok0 + q) * 64 + lane] = myword;
        }
#endif
        __syncthreads();
    }
}
__device__ __forceinline__ void attnB_phase(const bf16* Q, const bf16* K, const bf16* Vt, bf16* O, const unsigned long long* MASK, int vw, int nvw, int tid) {
    const int lane = tid & 63, r32 = lane & 31, hi = lane >> 5;
    for (int u = vw; u < NB * NH * 128; u += nvw) {
        int bh, qb; attn_unit_of(u, bh, qb); const int b = bh >> 4, h = bh & 15;
        const size_t qrow = (size_t)b * SEQ + qb * 32 + r32;
        bf16x8 qr[4]; load_q(qr, Q, qrow, h, hi);
        f32x16 o0 = (f32x16){}, o1 = (f32x16){}; float m = -1e30f, l = 0.f;
        const unsigned long long* mrow = MASK + qrow * 64;
        const int ntile = (qb >> 1) + 1;
        for (int kt = 0; kt < ntile; ++kt) {
            const size_t key0 = (size_t)b * SEQ + (size_t)kt * 64;
            const unsigned long long mw = mrow[kt];
            f32x16 p0, p1; qk_tile(p0, p1, K + h * HD, key0, DM, qr, r32, hi);
            const unsigned m0 = (unsigned)mw >> (8 * hi), m1 = (unsigned)(mw >> 32) >> (8 * hi);
#pragma unroll
            for (int r = 0; r < 16; ++r) { const int bit = 16 * (r >> 3) + (r & 7);
                p0[r] = ((m0 >> bit) & 1u) ? p0[r] : -INFINITY; p1[r] = ((m1 >> bit) & 1u) ? p1[r] : -INFINITY; }
            softmax_step(p0, p1, m, l, o0, o1);
            pv_tile(o0, o1, Vt + (size_t)h * HD * MTOK, key0, p0, p1, r32, hi);
        }
        l += __shfl_xor(l, 32);
        store_o(O, qrow, h, o0, o1, 1.0f / l, hi);
    }
}
__device__ __forceinline__ void conv_phase(const bf16* A, bf16* HM, const float* cw  , const float* cb  , int gtid, int ngt) {
    constexpr int CG = DFF / 8, RUN = 32, NRUN = MHALF / RUN;
    for (int it = gtid; it < CG * NRUN; it += ngt) {
        const int cgp = it % CG, run = it / CG, c0 = cgp * 8, r0 = run * RUN;
        float wg[3][8], wu[3][8], bg[8], bu[8];
#pragma unroll
        for (int i = 0; i < 8; ++i) { bg[i] = cb[c0 + i]; bu[i] = cb[DFF + c0 + i];
#pragma unroll
            for (int k = 0; k < 3; ++k) { wg[k][i] = cw[k * NFF2 + c0 + i]; wu[k][i] = cw[k * NFF2 + DFF + c0 + i]; } }
        float g1[8], g2[8], u1[8], u2[8];
        const bool seqstart = (r0 & (SEQ - 1)) == 0;
#pragma unroll
        for (int i = 0; i < 8; ++i) { g1[i] = g2[i] = u1[i] = u2[i] = 0.f; }
        if (!seqstart) {
            const u32x4 a1 = *(const u32x4*)(A + (size_t)(r0 - 1) * NFF2 + c0), a2 = *(const u32x4*)(A + (size_t)(r0 - 2) * NFF2 + c0);
            const u32x4 b1 = *(const u32x4*)(A + (size_t)(r0 - 1) * NFF2 + DFF + c0), b2 = *(const u32x4*)(A + (size_t)(r0 - 2) * NFF2 + DFF + c0);
#pragma unroll
            for (int i = 0; i < 4; ++i) { g1[2 * i] = __uint_as_float(a1[i] << 16); g1[2 * i + 1] = __uint_as_float(a1[i] & 0xFFFF0000u); g2[2 * i] = __uint_as_float(a2[i] << 16); g2[2 * i + 1] = __uint_as_float(a2[i] & 0xFFFF0000u);
                u1[2 * i] = __uint_as_float(b1[i] << 16); u1[2 * i + 1] = __uint_as_float(b1[i] & 0xFFFF0000u); u2[2 * i] = __uint_as_float(b2[i] << 16); u2[2 * i + 1] = __uint_as_float(b2[i] & 0xFFFF0000u); }
        }
        for (int r = r0; r < r0 + RUN; ++r) {
            const u32x4 a0 = *(const u32x4*)(A + (size_t)r * NFF2 + c0), b0 = *(const u32x4*)(A + (size_t)r * NFF2 + DFF + c0);
            float g0[8], u0[8], hm[8];
#pragma unroll
            for (int i = 0; i < 4; ++i) { g0[2 * i] = __uint_as_float(a0[i] << 16); g0[2 * i + 1] = __uint_as_float(a0[i] & 0xFFFF0000u); u0[2 * i] = __uint_as_float(b0[i] << 16); u0[2 * i + 1] = __uint_as_float(b0[i] & 0xFFFF0000u); }
#pragma unroll
            for (int i = 0; i < 8; ++i) { const float cgv = bg[i] + wg[0][i] * g2[i] + wg[1][i] * g1[i] + wg[2][i] * g0[i]; const float cuv = bu[i] + wu[0][i] * u2[i] + wu[1][i] * u1[i] + wu[2][i] * u0[i];
                hm[i] = cgv / (1.f + __expf(-cgv)) * cuv; g2[i] = g1[i]; g1[i] = g0[i]; u2[i] = u1[i]; u1[i] = u0[i]; }
            u32x4 o; o.x = cvtpk(hm[0], hm[1]); o.y = cvtpk(hm[2], hm[3]); o.z = cvtpk(hm[4], hm[5]); o.w = cvtpk(hm[6], hm[7]);
            *(u32x4*)(HM + (size_t)r * DFF + c0) = o;
        }
    }
}

__device__ __forceinline__ void ffn_fixup(const float* EF, const float* EL, const float* cw, const float* cb, bf16* HM, int gtid, int ngt) {
    for (int it = gtid; it < 128 * 2 * 704; it += ngt) {
        const int j = (it % 704) * 4, rr = (it / 704) & 1, pm = it / 1408;
        if ((pm & 15) == 0) continue;
        const int pg = (j >> 7) * 256 + (j & 127);
        f32x4 c[2];
#pragma unroll
        for (int bj = 0; bj < 2; ++bj) { const int pc = pg + 128 * bj, lc = j + DFF * bj;
            const f32x4 am2 = *(const f32x4*)(EL + ((size_t)(pm - 1) * 2 + 0) * NFF2 + pc), am1 = *(const f32x4*)(EL + ((size_t)(pm - 1) * 2 + 1) * NFF2 + pc);
            const f32x4 a0 = *(const f32x4*)(EF + ((size_t)pm * 2 + 0) * NFF2 + pc), a1 = *(const f32x4*)(EF + ((size_t)pm * 2 + 1) * NFF2 + pc);
            const f32x4 w0 = *(const f32x4*)(cw + lc), w1 = *(const f32x4*)(cw + NFF2 + lc), w2 = *(const f32x4*)(cw + 2 * NFF2 + lc), bb = *(const f32x4*)(cb + lc);
            c[bj] = rr == 0 ? (bb + w0 * am2 + w1 * am1 + w2 * a0) : (bb + w0 * am1 + w1 * a0 + w2 * a1); }
        float hm[4];
#pragma unroll
        for (int i = 0; i < 4; ++i) { const float g = c[0][i]; hm[i] = g * __builtin_amdgcn_rcpf(1.f + __builtin_amdgcn_exp2f(-LOG2E * g)) * c[1][i]; }
        u32x2 w; w.x = cvtpk(hm[0], hm[1]); w.y = cvtpk(hm[2], hm[3]);
        *(u32x2*)(HM + (size_t)(pm * 256 + rr) * DFF + j) = w;
    }
}

__device__ __forceinline__ void ffn_fixup_tile(const float* EF, const float* EL, const float* cw, const float* cb, bf16* HM, int pm, int tid) {
    if ((pm & 15) == 0) return;
    for (int it = tid; it < 2 * 704; it += NTHREADS) {
        const int j = (it % 704) * 4, rr = it / 704;
        const int pg = (j >> 7) * 256 + (j & 127);
        f32x4 c[2];
#pragma unroll
        for (int bj = 0; bj < 2; ++bj) { const int pc = pg + 128 * bj, lc = j + DFF * bj;
            const f32x4 am2 = *(const f32x4*)(EL + ((size_t)(pm - 1) * 2 + 0) * NFF2 + pc), am1 = *(const f32x4*)(EL + ((size_t)(pm - 1) * 2 + 1) * NFF2 + pc);
            const f32x4 a0 = *(const f32x4*)(EF + ((size_t)pm * 2 + 0) * NFF2 + pc), a1 = *(const f32x4*)(EF + ((size_t)pm * 2 + 1) * NFF2 + pc);
            const f32x4 w0 = *(const f32x4*)(cw + lc), w1 = *(const f32x4*)(cw + NFF2 + lc), w2 = *(const f32x4*)(cw + 2 * NFF2 + lc), bb = *(const f32x4*)(cb + lc);
            c[bj] = rr == 0 ? (bb + w0 * am2 + w1 * am1 + w2 * a0) : (bb + w0 * am1 + w1 * a0 + w2 * a1); }
        float hm[4];
#pragma unroll
        for (int i = 0; i < 4; ++i) { const float g = c[0][i]; hm[i] = g * __builtin_amdgcn_rcpf(1.f + __builtin_amdgcn_exp2f(-LOG2E * g)) * c[1][i]; }
        u32x2 w; w.x = cvtpk(hm[0], hm[1]); w.y = cvtpk(hm[2], hm[3]);
        *(u32x2*)(HM + (size_t)(pm * 256 + rr) * DFF + j) = w;
    }
}
constexpr int LDS_BYTES = 147456;
constexpr int ITEMS_PER_LAYER = 1024 + 384 + 512 + 512 + 2816 + 1408;
#ifdef FAKE_SYNC
#define GRID_SYNC() __syncthreads()
#else
#define GRID_SYNC() xcd_barrier(bar, wave)
#endif
#ifndef PROBE
#define PROBE 0
#endif
#define PROBE_REP(bit) (((PROBE) >> (bit)) & 1 ? 2 : 1)

__device__ __forceinline__ unsigned char* ws_launder(unsigned char* w) { asm volatile("" : "+s"(w)); return w; }
__global__ void __launch_bounds__(NTHREADS, 2) fwd_kernel(Params p) {
    extern __shared__ __attribute__((aligned(16))) unsigned char lds_raw[];
    LAS unsigned char* lds = (LAS unsigned char*)lds_raw;
    cg::grid_group grid = cg::this_grid();
    const int tid = threadIdx.x, lane = tid & 63, wave = __builtin_amdgcn_readfirstlane(tid >> 6);
    const int G = gridDim.x, bx = blockIdx.x, vcu = (G % 8 == 0) ? (bx % 8) * (G / 8) + bx / 8 : bx;
    const int gw = vcu * NWAVES + wave, ngw = G * NWAVES, gtid = vcu * NTHREADS + tid, ngt = G * NTHREADS;
    unsigned char* ws = p.ws;
    if (tid < 4) ((LAS unsigned*)(lds + 131072))[tid] = 0u;
    __syncthreads();
    const XcdBarrier bar = xcd_barrier_post((unsigned*)(ws + WS_CTL), (volatile LAS unsigned*)(lds + 131072));
#define FRESH_TID(v) int v = wave * 64 + lane_id(); asm volatile("" : "+v"(v))
#define WSL(T, off) ((T*)(ws_launder(ws) + (off)))
#define ROPE WSL(f32x2_t, WS_ROPE)
#define XN WSL(bf16, WS_XN)
#define QO WSL(bf16, WS_QO)
#define KB WSL(bf16, WS_K)
#define VT WSL(bf16, WS_VT)
#define QI WSL(bf16, WS_QI)
#define KI WSL(bf16, WS_KI)
#define WI WSL(float, WS_WI)
#define MASK WSL(unsigned long long, WS_MASK)
#define SSQ WSL(float, WS_SSQ)
#define OB WSL(bf16, WS_OB)
#define DUMMY1 p.out
#define DUMMY2 p.out
#define EF WSL(float, WS_EF)
#define EL WSL(float, WS_EL)
#define HM WSL(bf16, WS_HM)
#define SCR p.out
    LAS float* PART = (LAS float*)(lds + 131072 + 1024);
    {
        LAS float* scr = (LAS float*)(lds + wave * 16384);
        for (int it = gw; it < DEPTH * ITEMS_PER_LAYER; it += ngw) {
            const int l = it / ITEMS_PER_LAYER; int r = it % ITEMS_PER_LAYER; const int kind = l % 3, li = l / 3;
            unsigned char* wl = ws + WS_W + (size_t)l * W_LAYER;
            const float* wqkv = kind == 0 ? p.a_w_qkv + (size_t)li * DM * 3072 : (kind == 1 ? p.b_w_in : p.c_w_qkv);
            const int ldq = kind == 1 ? 3656 : 3072;
            const float* g1 = p.norm1_g + (size_t)l * DM; const float* g2 = p.norm2_g + (size_t)l * DM;
            const float* wo = kind == 0 ? p.a_w_o + (size_t)li * DM * DM : (kind == 1 ? p.b_w_o : p.c_w_o);
            if (r < 1024) { transpose_item(wqkv, DM, ldq, 0, 2048, (bf16*)(wl + WL_QK), 0, 1, g1, scr, r, lane); continue; } r -= 1024;
            if (r < 384) { if (kind == 1) transpose_item(wqkv, DM, ldq, 3072, 584, (bf16*)(wl + WL_QK), 2048, 1, g1, scr, r, lane); continue; } r -= 384;
            if (r < 512) { transpose_item(wqkv, DM, ldq, 2048, 1024, (bf16*)(wl + WL_V), 0, 0, g1, scr, r, lane); continue; } r -= 512;
            if (r < 512) { transpose_item(wo, DM, DM, 0, 1024, (bf16*)(wl + WL_O), 0, 0, nullptr, scr, r, lane); continue; } r -= 512;
            if (r < 2816) { transpose_item(p.ffn_w_in + (size_t)l * DM * NFF2, DM, NFF2, 0, NFF2, (bf16*)(wl + WL_IN), 0, 2, g2, scr, r, lane); continue; } r -= 2816;
            transpose_item(p.ffn_w_down + (size_t)l * DFF * DM, DFF, DM, 0, DM, (bf16*)(wl + WL_D), 0, 0, nullptr, scr, r, lane);
        }
        for (int i = gtid; i < SEQ * 32; i += ngt) {
            const int pos = i >> 5, x = i & 31;
            const float inv = exp2f(-(float)x * (13.287712379549449f / 32.0f));
            const float ang = (float)pos * inv;
            const double rev = (double)ang * 0.15915494309189535; const float fr = (float)(rev - floor(rev));
            ROPE[i] = (f32x2_t){__builtin_amdgcn_cosf(fr), __builtin_amdgcn_sinf(fr)};
        }
        for (int m = gw; m < MTOK; m += ngw) xb_row(p.x + (size_t)m * DM, XN + (size_t)m * DM, SSQ + (size_t)m * 4, lane);
    }
    grid.sync();

    for (int l = 0; l < DEPTH; ++l) {
        const int kind = l % 3, li = l / 3;
        unsigned char* wl = ws + WS_W + (size_t)l * W_LAYER;
        const bf16* WQK = (const bf16*)(wl + WL_QK); const bf16* WV = (const bf16*)(wl + WL_V); const bf16* WO = (const bf16*)(wl + WL_O);
        const bf16* WIN = (const bf16*)(wl + WL_IN); const bf16* WD = (const bf16*)(wl + WL_D);
        for (int rep_ = 0; rep_ < PROBE_REP(0); ++rep_) {
        {
            pg8::Gemm g{XN, WQK, MTOK, kind == 1 ? NQK_B : NQK_A, DM}; pg8::StaticOrder S; S.init(MTOK, g.N, G, bx);
            pg8::EpiQKV E{kind, QO, KB, QI, KI, WI, kind == 1 ? p.b_q_norm : p.a_q_norm + li * HD, kind == 1 ? p.b_k_norm : p.a_k_norm + li * HD, (const pg8::f32x2v*)ROPE, 0.125f * LOG2E, 0.35355339059327373f * 0.125f, SSQ};
#ifndef NO_QKV
            pg8::gemm_phase<pg8::EpiQKV, pg8::StaticOrder, true, true>(lds, g, S, E, wave);
#endif
        }
        {
            pg8::Gemm g{WV, XN, DM, MTOK, DM}; pg8::StaticOrder S; S.init(DM, MTOK, G, bx);
            pg8::EpiVt E{VT, MTOK, SSQ};
            pg8::gemm_phase<pg8::EpiVt, pg8::StaticOrder, true, true>(lds, g, S, E, wave);
        }
        }
        GRID_SYNC();
#ifndef NO_A
        for (int rep_ = 0; rep_ < PROBE_REP(1); ++rep_)
        if (kind == 0) { FRESH_TID(t_); const float* gq_ = p.a_q_norm + li * HD; const float* gk_ = p.a_k_norm + li * HD; const float* rb_ = p.a_rel_bias + (size_t)li * NH * 513;
            float mq = 0.f, mk = 0.f, bmax = -1e30f, bmin = 1e30f;
            for (int i = 0; i < HD; ++i) { mq = fmaxf(mq, fabsf(gq_[i])); mk = fmaxf(mk, fabsf(gk_[i])); }
            for (int i = (t_ & 63); i < NH * 513; i += 64) { const float v = rb_[i] * LOG2E; bmax = fmaxf(bmax, v); bmin = fminf(bmin, v); }
#pragma unroll
            for (int o = 1; o < 64; o <<= 1) { bmax = fmaxf(bmax, __shfl_xor(bmax, o)); bmin = fminf(bmin, __shfl_xor(bmin, o)); }
            const float qk2 = 8.2f * mq * mk * LOG2E, ref = qk2 + bmax;
            if (__builtin_amdgcn_readfirstlane(ref - (bmin - qk2) <= 100.f ? 1 : 0)) attnA_blk<true>(QO, KB, VT, OB, rb_, ref, lds, vcu, G, t_);
            else attnA_blk<false>(QO, KB, VT, OB, rb_, 0.f, lds, vcu, G, t_); }
#endif
        if (kind == 1) {
#ifndef NO_B1
            for (int rep_ = 0; rep_ < PROBE_REP(2); ++rep_)
            { FRESH_TID(t_); b1_phase(QI, KI, WI, SCR + (size_t)bx * 32 * 4096, MASK, lds, vcu, G, t_); }
#endif
            GRID_SYNC();
#ifndef NO_B2
            for (int rep_ = 0; rep_ < PROBE_REP(3); ++rep_)
            { FRESH_TID(t_); float mq = 0.f, mk = 0.f;
              for (int i = 0; i < HD; ++i) { mq = fmaxf(mq, fabsf(p.b_q_norm[i])); mk = fmaxf(mk, fabsf(p.b_k_norm[i])); }
              const float ref = 8.2f * mq * mk * LOG2E;
              if (__builtin_amdgcn_readfirstlane(ref <= 50.f ? 1 : 0)) attnB_blk<true>(QO, KB, VT, OB, MASK, ref, lds, vcu, G, t_);
              else attnB_blk<false>(QO, KB, VT, OB, MASK, 0.f, lds, vcu, G, t_); }
#endif
        }
#ifndef NO_C
        for (int rep_ = 0; rep_ < PROBE_REP(4); ++rep_)
        if (kind == 2) { FRESH_TID(t_); attnC_blk(QO, KB, VT, OB, lds, vcu, G, t_); }
#endif
        GRID_SYNC();
        {
            pg8::Gemm g{OB, WO, MTOK, DM, DM}; pg8::StaticOrder S; S.init(MTOK, DM, G, bx);
            if (PROBE_REP(5) == 2) { pg8::EpiRes E0{l == 0 ? p.x : nullptr, XN, DUMMY1, DM, nullptr, SSQ, PART}; pg8::gemm_phase<pg8::EpiRes, pg8::StaticOrder, true, true>(lds, g, S, E0, wave); }
            pg8::EpiRes E{l == 0 ? p.x : nullptr, XN, nullptr, DM, XN, SSQ, PART};
            pg8::gemm_phase<pg8::EpiRes, pg8::StaticOrder, true, true>(lds, g, S, E, wave);
        }
        GRID_SYNC();
        {
            pg8::Gemm g{XN, WIN, MTOK, NFF2, DM}; pg8::StaticOrder S; S.init(MTOK, NFF2, G, bx);
            pg8::EpiFFN E{HM, p.ffn_conv_w + (size_t)l * 3 * NFF2, p.ffn_conv_b + (size_t)l * NFF2, EF, EL, (LAS pg8::f32x4*)(lds + 131072 + 1024), SSQ};
            for (int rep_ = 0; rep_ < PROBE_REP(7); ++rep_)
            pg8::gemm_phase<pg8::EpiFFN, pg8::StaticOrder, true, true>(lds, g, S, E, wave);
        }
        GRID_SYNC();
        {
            pg8::Gemm g{HM, WD, MTOK, DM, DFF}; pg8::StaticOrder S; S.init(MTOK, DM, G, bx);
            { FRESH_TID(t_); int lastpm = -1;
#pragma unroll 1
              for (int L = bx; L < 512; L += G) {
                  const int w_ = (L & 7) * 64 + (L >> 3), pm_ = (w_ >> 5) * 8 + (w_ & 7);
                  if (pm_ != lastpm) ffn_fixup_tile(EF, EL, p.ffn_conv_w + (size_t)l * 3 * NFF2, p.ffn_conv_b + (size_t)l * NFF2, HM, pm_, t_);
                  lastpm = pm_; }
              asm volatile("s_waitcnt vmcnt(0)" ::: "memory"); __syncthreads(); }
            if (PROBE_REP(9) == 2) { pg8::EpiRes E0{nullptr, XN, DUMMY2, DM, nullptr, SSQ, PART}; pg8::gemm_phase<pg8::EpiRes, pg8::StaticOrder, true, true>(lds, g, S, E0, wave); }
            pg8::EpiRes E{nullptr, XN, l + 1 == DEPTH ? p.out : nullptr, DM, l + 1 == DEPTH ? nullptr : XN, SSQ, PART};
            pg8::gemm_phase<pg8::EpiRes, pg8::StaticOrder, true, true>(lds, g, S, E, wave);
        }
        GRID_SYNC();
    }
}

extern "C" void kernel_launch(void* const* d_in, const int* in_sizes, int n_in, void* d_out, int out_size, void* d_ws, size_t ws_size, hipStream_t stream) {
    static int grid = 0;
    if (grid == 0) {
        if (n_in != 18 || out_size != MTOK * DM || ws_size < WS_END) { fprintf(stderr, "kernel_launch: unexpected shapes (n_in %d out %d ws %zu)\n", n_in, out_size, ws_size); grid = -1; return; }
        int dev = 0, cus = 0, per_cu = 0;
        hipGetDevice(&dev); hipDeviceGetAttribute(&cus, hipDeviceAttributeMultiprocessorCount, dev);
        hipFuncSetAttribute((const void*)fwd_kernel, hipFuncAttributeMaxDynamicSharedMemorySize, LDS_BYTES);
        hipOccupancyMaxActiveBlocksPerMultiprocessor(&per_cu, (const void*)fwd_kernel, NTHREADS, LDS_BYTES);
        if (per_cu < 1) { fprintf(stderr, "kernel_launch: occupancy query says %d blocks per CU\n", per_cu); per_cu = 1; }
        (void)hipGetLastError();
        grid = cus;
    }
    if (grid < 0) return;
    Params p{};
    const float** f = (const float**)&p;
    for (int i = 0; i < 18; ++i) f[i] = (const float*)d_in[i];
    p.out = (float*)d_out; p.ws = (unsigned char*)d_ws;
    if (hipMemsetAsync((char*)d_ws + WS_CTL, 0, CTL_BYTES, stream) != hipSuccess) { fprintf(stderr, "memset failed\n"); return; }
    void* args[] = {&p};
    hipError_t e = hipLaunchCooperativeKernel((const void*)fwd_kernel, dim3(grid), dim3(NTHREADS), args, LDS_BYTES, stream);
    if (e != hipSuccess) fprintf(stderr, "cooperative launch failed: %s (grid %d)\n", hipGetErrorString(e), grid);
}
```

```cpp
#include <hip/hip_runtime.h>
#include <hip/hip_cooperative_groups.h>
#include <cstdio>
#include <cstdint>
namespace cg = cooperative_groups;
namespace pg8 {
#define PG8_LAS __attribute__((address_space(3)))
typedef unsigned short bf16_t;
typedef short bf16x8 __attribute__((ext_vector_type(8)));
typedef float f32x4 __attribute__((ext_vector_type(4)));
typedef unsigned u32x4 __attribute__((ext_vector_type(4)));
constexpr int BM = 256, BK = 64, HALF = 128, HTB = HALF * BK * 2  , STAGE_BYTES = 8 * HTB, NXCD = 8, WGM = 8;

__host__ __device__ __forceinline__ int lds_byte(int r, int c) { const int st = (r >> 4) * 2 + (c >> 5), rr = r & 15, cc = c & 31, ob = rr * 64 + cc * 2; return st * 1024 + (ob ^ (((ob >> 9) & 1) << 5)); }
__host__ __device__ __forceinline__ void stage_rc(int b, int& R, int& C) { const int st = b / 1024, sb = b % 1024, swz = sb ^ (((sb >> 9) & 1) << 5); R = (st >> 1) * 16 + swz / 64; C = (st & 1) * 32 + (swz % 64) / 2; }
__host__ __device__ __forceinline__ int perm32(int rho) { const int n = rho >> 4, i = rho & 15; return 8 * (i >> 2) + 4 * n + (i & 3); }

struct Unit { int pm, pn; };
struct Gemm { const bf16_t* A; const bf16_t* Bt; int M, N, K; };

struct StaticOrder {
    int nM, nN, nwg, G, c;
    __host__ __device__ void init(int M, int N, int G_, int c_) { nM = M / BM; nN = N / BM; nwg = nM * nN; G = G_; c = c_; }
    __host__ __device__ bool next(int i, Unit& u) const {
        const long L = (long)i * G + c; if (L >= nwg) return false;
        int wgid = (int)L; { const int q = nwg / NXCD, r = nwg % NXCD, xcd = wgid % NXCD, off = wgid / NXCD; wgid = (xcd < r ? xcd * (q + 1) : r * (q + 1) + (xcd - r) * q) + off; }
        const int nig = WGM * nN, gid = wgid / nig, fm = gid * WGM, gsz = (nM - fm) < WGM ? (nM - fm) : WGM;
        u.pm = fm + ((wgid % nig) % gsz); u.pn = (wgid % nig) / gsz; return true;
    }
    __device__ __forceinline__ void a_ready(const Unit&) const {}
    __device__ __forceinline__ void done(const Unit&) const {}
};

__device__ __forceinline__ unsigned cvt_pk_bf16(float lo, float hi) { unsigned r; asm volatile("v_cvt_pk_bf16_f32 %0, %1, %2" : "=v"(r) : "v"(lo), "v"(hi)); return r; }
typedef float f32x2 __attribute__((ext_vector_type(2)));
typedef float f32x2v __attribute__((ext_vector_type(2)));
typedef unsigned u32x2v_t __attribute__((ext_vector_type(2)));
struct EpiBf16Plain {
    static constexpr bool PERM = true, AFTER_DRAIN = false;
    bf16_t* O; int ldc;
    __device__ __forceinline__ void operator()(const f32x4 (&acc)[2][2][4][2], const Unit& u, int wr, int wc, int fr, int fq) const {
        const int row0 = u.pm * BM + wr * 64 + fr; const int col0 = u.pn * BM + wc * 32 + 8 * fq;
#pragma unroll
        for (int ai = 0; ai < 2; ++ai)
#pragma unroll
            for (int m = 0; m < 4; ++m) { bf16_t* rowp = O + (size_t)(row0 + ai * HALF + m * 16) * ldc + col0;
#pragma unroll
                for (int bj = 0; bj < 2; ++bj) { const f32x4 v0 = acc[ai][bj][m][0], v1 = acc[ai][bj][m][1];
                    u32x4 w; w.x = cvt_pk_bf16(v0[0], v0[1]); w.y = cvt_pk_bf16(v0[2], v0[3]); w.z = cvt_pk_bf16(v1[0], v1[1]); w.w = cvt_pk_bf16(v1[2], v1[3]);
                    *(u32x4*)(rowp + bj * HALF) = w; } }
    }
};
__device__ __forceinline__ float rstd_of(const float* SSQ, size_t row) { const f32x4 s4 = *(const f32x4*)(SSQ + row * 4); return rsqrtf(((s4[0] + s4[1]) + (s4[2] + s4[3])) * (1.0f / 1024.0f) + 1e-6f); }
struct EpiRes {
    static constexpr bool PERM = true, AFTER_DRAIN = false;
    const float* base32; const bf16_t* base16; float* out32; int ldc; bf16_t* XB; float* SSQ; PG8_LAS float* part;
    __device__ __forceinline__ void operator()(const f32x4 (&acc)[2][2][4][2], const Unit& u, int wr, int wc, int fr_in, int fq_in) const {
        int fr = fr_in, fq = fq_in; asm volatile("" : "+v"(fr), "+v"(fq));
        const int col0 = u.pn * BM + wc * 32 + 8 * fq;
        u32x4 pre[2][4][2];
        if (!base32) {
#pragma unroll
            for (int ai = 0; ai < 2; ++ai)
#pragma unroll
                for (int m = 0; m < 4; ++m)
#pragma unroll
                    for (int bj = 0; bj < 2; ++bj) pre[ai][m][bj] = *(const u32x4*)(base16 + (size_t)(u.pm * BM + ai * HALF + wr * 64 + m * 16 + fr) * ldc + col0 + bj * HALF);
        }
#pragma unroll
        for (int ai = 0; ai < 2; ++ai)
#pragma unroll
            for (int m = 0; m < 4; ++m) { const int rl = ai * HALF + wr * 64 + m * 16 + fr; const size_t off = (size_t)(u.pm * BM + rl) * ldc + col0;
                float ss = 0.f;
#pragma unroll
                for (int bj = 0; bj < 2; ++bj) {
                    f32x4 b0, b1;
                    if (base32) { b0 = *(const f32x4*)(base32 + off + bj * HALF); b1 = *(const f32x4*)(base32 + off + bj * HALF + 4); }
                    else { const u32x4 r = pre[ai][m][bj];
                        b0 = (f32x4){__uint_as_float(r.x << 16), __uint_as_float(r.x & 0xFFFF0000u), __uint_as_float(r.y << 16), __uint_as_float(r.y & 0xFFFF0000u)};
                        b1 = (f32x4){__uint_as_float(r.z << 16), __uint_as_float(r.z & 0xFFFF0000u), __uint_as_float(r.w << 16), __uint_as_float(r.w & 0xFFFF0000u)}; }
                    const f32x4 v0 = b0 + acc[ai][bj][m][0], v1 = b1 + acc[ai][bj][m][1];
                    if (out32) { *(f32x4*)(out32 + off + bj * HALF) = v0; *(f32x4*)(out32 + off + bj * HALF + 4) = v1; }
                    if (XB) { u32x4 w; w.x = cvt_pk_bf16(v0[0], v0[1]); w.y = cvt_pk_bf16(v0[2], v0[3]); w.z = cvt_pk_bf16(v1[0], v1[1]); w.w = cvt_pk_bf16(v1[2], v1[3]); *(u32x4*)(XB + off + bj * HALF) = w;
                        const f32x4 q0 = (f32x4){__uint_as_float(w.x << 16), __uint_as_float(w.x & 0xFFFF0000u), __uint_as_float(w.y << 16), __uint_as_float(w.y & 0xFFFF0000u)};
                        const f32x4 q1 = (f32x4){__uint_as_float(w.z << 16), __uint_as_float(w.z & 0xFFFF0000u), __uint_as_float(w.w << 16), __uint_as_float(w.w & 0xFFFF0000u)};
                        ss += ((q0[0] * q0[0] + q0[1] * q0[1]) + (q0[2] * q0[2] + q0[3] * q0[3])) + ((q1[0] * q1[0] + q1[1] * q1[1]) + (q1[2] * q1[2] + q1[3] * q1[3])); } }
                ss += __shfl_xor(ss, 16); ss += __shfl_xor(ss, 32);
                if (fq == 0) part[rl * 4 + wc] = ss;
                if (base32 && (m & 1)) asm volatile("" ::: "memory"); }
        asm volatile("s_waitcnt lgkmcnt(0)" ::: "memory"); __builtin_amdgcn_s_barrier(); asm volatile("" ::: "memory");
        const int t = (wr * 4 + wc) * 64 + fq * 16 + fr;
        if (t < 256 && XB) { const f32x4 p4 = *(const PG8_LAS f32x4*)(part + t * 4); SSQ[(size_t)(u.pm * BM + t) * 4 + u.pn] = (p4[0] + p4[1]) + (p4[2] + p4[3]); }
    }
};
struct EpiVt {
    static constexpr bool PERM = true, AFTER_DRAIN = false;
    bf16_t* O; int ldc; const float* SSQ;
    __device__ __forceinline__ void operator()(const f32x4 (&acc)[2][2][4][2], const Unit& u, int wr, int wc, int fr_in, int fq_in) const {
        int fr = fr_in, fq = fq_in; asm volatile("" : "+v"(fr), "+v"(fq));
        const int row0 = u.pm * BM + wr * 64 + fr; const int col0 = u.pn * BM + wc * 32 + 8 * fq;
        float rs[2][8];
#pragma unroll
        for (int bj = 0; bj < 2; ++bj)
#pragma unroll
            for (int c = 0; c < 8; ++c) rs[bj][c] = rstd_of(SSQ, (size_t)(col0 + bj * HALF + c));
#pragma unroll
        for (int ai = 0; ai < 2; ++ai)
#pragma unroll
            for (int m = 0; m < 4; ++m) { bf16_t* rowp = O + (size_t)(row0 + ai * HALF + m * 16) * ldc + col0;
#pragma unroll
                for (int bj = 0; bj < 2; ++bj) { const f32x4 v0 = acc[ai][bj][m][0], v1 = acc[ai][bj][m][1];
                    u32x4 w; w.x = cvt_pk_bf16(v0[0] * rs[bj][0], v0[1] * rs[bj][1]); w.y = cvt_pk_bf16(v0[2] * rs[bj][2], v0[3] * rs[bj][3]); w.z = cvt_pk_bf16(v1[0] * rs[bj][4], v1[1] * rs[bj][5]); w.w = cvt_pk_bf16(v1[2] * rs[bj][6], v1[3] * rs[bj][7]);
                    *(u32x4*)(rowp + bj * HALF) = w; } }
    }
};
struct EpiQKV {
    static constexpr bool PERM = true, AFTER_DRAIN = false;
    int kind;
    bf16_t *Q, *K, *QI, *KI; float* WI;
    const float *gq, *gk; const f32x2v* rope; float qscale, wscale; const float* SSQ;
    __device__ __forceinline__ void operator()(const f32x4 (&acc)[2][2][4][2], const Unit& u, int wr, int wc, int fr_in, int fq_in) const {
        int fr = fr_in, fq = fq_in; asm volatile("" : "+v"(fr), "+v"(fq));
        const int hs = u.pn * 4 + wc;
        bf16_t* dst; int ld, col; bool donorm = false, dorope = false; const float* gain = gq; float sc = 1.f;
        if (hs < 16) { dst = Q; ld = 1024; col = hs * 64; donorm = (kind != 2); dorope = (kind == 1); gain = gq; sc = qscale; }
        else if (hs < 32) { dst = K; ld = 1024; col = (hs - 16) * 64; donorm = (kind != 2); dorope = (kind == 1); gain = gk; }
        else if (hs < 40) { dst = QI; ld = 512; col = (hs - 32) * 64; dorope = true; }
        else if (hs == 40) { dst = KI; ld = 64; col = 0; dorope = true; }
        else if (hs == 41) {
            if (fq == 0) {
#pragma unroll
                for (int ai = 0; ai < 2; ++ai)
#pragma unroll
                    for (int m = 0; m < 4; ++m) { const int row = u.pm * BM + ai * HALF + wr * 64 + m * 16 + fr;
                        const float rsw = rstd_of(SSQ, (size_t)row) * wscale; *(f32x4*)(WI + (size_t)row * 8) = acc[ai][0][m][0] * rsw; *(f32x4*)(WI + (size_t)row * 8 + 4) = acc[ai][0][m][1] * rsw; }
            }
            return;
        } else return;
        float g[2][2][4];
#pragma unroll
        for (int bj = 0; bj < 2; ++bj)
#pragma unroll
            for (int n = 0; n < 2; ++n)
#pragma unroll
                for (int i = 0; i < 4; ++i) g[bj][n][i] = donorm ? gain[32 * bj + 8 * fq + 4 * n + i] * sc : sc;
        f32x4 sq[2][4];
#pragma unroll
        for (int ai = 0; ai < 2; ++ai)
#pragma unroll
            for (int m = 0; m < 4; ++m) sq[ai][m] = *(const f32x4*)(SSQ + (size_t)(u.pm * BM + ai * HALF + wr * 64 + m * 16 + fr) * 4);
#pragma unroll
        for (int ai = 0; ai < 2; ++ai) {
#pragma unroll
          for (int mp = 0; mp < 4; ++mp) {
            f32x4 rp4[4][4];
            if (dorope) {
#pragma unroll
                for (int m = mp; m < mp + 1; ++m) { const f32x4* rp = (const f32x4*)(rope + (size_t)((u.pm * BM + ai * HALF + wr * 64 + m * 16 + fr) & 4095) * 32 + 8 * fq);
#pragma unroll
                    for (int k = 0; k < 4; ++k) rp4[m][k] = rp[k]; }
            }
#pragma unroll
            for (int m = mp; m < mp + 1; ++m) {
                const int row = u.pm * BM + ai * HALF + wr * 64 + m * 16 + fr;
                f32x4 v[2][2];
                const float rs0 = rsqrtf(((sq[ai][m][0] + sq[ai][m][1]) + (sq[ai][m][2] + sq[ai][m][3])) * (1.0f / 1024.0f) + 1e-6f);
#pragma unroll
                for (int bj = 0; bj < 2; ++bj)
#pragma unroll
                    for (int n = 0; n < 2; ++n) v[bj][n] = acc[ai][bj][m][n] * rs0;
                float r = 1.f;
                if (donorm) {
                    float ss = 0.f;
#pragma unroll
                    for (int bj = 0; bj < 2; ++bj)
#pragma unroll
                        for (int n = 0; n < 2; ++n) { const f32x4 x = v[bj][n]; ss += (x[0] * x[0] + x[1] * x[1]) + (x[2] * x[2] + x[3] * x[3]); }
                    ss += __shfl_xor(ss, 16); ss += __shfl_xor(ss, 32);
                    r = rsqrtf(ss * (1.0f / 64.0f) + 1e-6f);
                }
#pragma unroll
                for (int bj = 0; bj < 2; ++bj)
#pragma unroll
                    for (int n = 0; n < 2; ++n)
#pragma unroll
                        for (int i = 0; i < 4; ++i) v[bj][n][i] = v[bj][n][i] * r * g[bj][n][i];
                if (dorope) {
#pragma unroll
                    for (int n = 0; n < 2; ++n) { const f32x4 cs0 = rp4[m][2 * n], cs1 = rp4[m][2 * n + 1];
                        const float c_[4] = {cs0[0], cs0[2], cs1[0], cs1[2]}, s_[4] = {cs0[1], cs0[3], cs1[1], cs1[3]};
#pragma unroll
                        for (int i = 0; i < 4; ++i) { const float x1 = v[0][n][i], x2 = v[1][n][i]; v[0][n][i] = x1 * c_[i] - x2 * s_[i]; v[1][n][i] = x2 * c_[i] + x1 * s_[i]; } }
                }
                bf16_t* rowp = dst + (size_t)row * ld + col + 8 * fq;
#pragma unroll
                for (int bj = 0; bj < 2; ++bj) { u32x4 w; w.x = cvt_pk_bf16(v[bj][0][0], v[bj][0][1]); w.y = cvt_pk_bf16(v[bj][0][2], v[bj][0][3]); w.z = cvt_pk_bf16(v[bj][1][0], v[bj][1][1]); w.w = cvt_pk_bf16(v[bj][1][2], v[bj][1][3]);
                    *(u32x4*)(rowp + 32 * bj) = w; }
            }
            asm volatile("" ::: "memory");
          }
        }
    }
};
template <int CTRL, bool BC> __device__ __forceinline__ float pg8_dpp(float x) { return __int_as_float(__builtin_amdgcn_update_dpp(0, __float_as_int(x), CTRL, 0xf, 0xf, BC)); }
struct EpiFFN {
    static constexpr bool PERM = true, AFTER_DRAIN = false;
    bf16_t* HM; const float* cw; const float* cb; float* EF; float* EL; PG8_LAS f32x4* halo; const float* SSQ;
    __device__ __forceinline__ void operator()(const f32x4 (&acc_)[2][2][4][2], const Unit& u, int wr, int wc, int fr_in, int fq_in) const {
        int fr = fr_in, fq = fq_in; asm volatile("" : "+v"(fr), "+v"(fq));
        f32x4 (&acc)[2][2][4][2] = const_cast<f32x4 (&)[2][2][4][2]>(acc_);
        f32x4 Wn[2][4];
        { const int jc0 = u.pn * 128 + wc * 32 + 8 * fq;
#pragma unroll
          for (int bj = 0; bj < 2; ++bj) { const float* wp = cw + bj * 2816 + jc0;
              Wn[bj][0] = *(const f32x4*)(wp); Wn[bj][1] = *(const f32x4*)(wp + 5632); Wn[bj][2] = *(const f32x4*)(wp + 2 * 5632); Wn[bj][3] = *(const f32x4*)(cb + bj * 2816 + jc0); } }
#pragma unroll
        for (int ai = 0; ai < 2; ++ai)
#pragma unroll
            for (int m = 0; m < 4; ++m) { const float rs0 = rstd_of(SSQ, (size_t)(u.pm * BM + ai * HALF + wr * 64 + m * 16 + fr));
#pragma unroll
                for (int bj = 0; bj < 2; ++bj)
#pragma unroll
                    for (int n = 0; n < 2; ++n) acc[ai][bj][m][n] = acc[ai][bj][m][n] * rs0; }
        const int pcol = u.pn * 256 + wc * 32 + 8 * fq, jcol = u.pn * 128 + wc * 32 + 8 * fq;
        if (fr >= 14) {
            const int rr = fr - 14;
#pragma unroll
            for (int ai = 0; ai < 2; ++ai)
#pragma unroll
                for (int bj = 0; bj < 2; ++bj)
#pragma unroll
                    for (int n = 0; n < 2; ++n) halo[(((((ai * 2 + wr) * 2 + rr) * 4 + wc) * 2 + bj) * 4 + fq) * 2 + n] = acc[ai][bj][3][n];
            if (wr == 1) { float* e = EL + ((size_t)u.pm * 2 + rr) * 5632 + pcol;
#pragma unroll
                for (int bj = 0; bj < 2; ++bj)
#pragma unroll
                    for (int n = 0; n < 2; ++n) *(f32x4*)(e + bj * 128 + n * 4) = acc[1][bj][3][n]; }
        }
        if (wr == 0 && fr < 2) { float* e = EF + ((size_t)u.pm * 2 + fr) * 5632 + pcol;
#pragma unroll
            for (int bj = 0; bj < 2; ++bj)
#pragma unroll
                for (int n = 0; n < 2; ++n) *(f32x4*)(e + bj * 128 + n * 4) = acc[0][bj][0][n]; }
        asm volatile("s_waitcnt lgkmcnt(0)" ::: "memory"); __builtin_amdgcn_s_barrier(); asm volatile("" ::: "memory");
#pragma unroll
        for (int n = 0; n < 2; ++n) {
            f32x4 W0[2], W1[2], W2[2], Bb[2], W0m[2], W1m[2];
#pragma unroll
            for (int bj = 0; bj < 2; ++bj) { const float* wp = cw + bj * 2816 + jcol + 4 * n;
                if (n == 0) { W0[bj] = Wn[bj][0]; W1[bj] = Wn[bj][1]; W2[bj] = Wn[bj][2]; Bb[bj] = Wn[bj][3]; }
                else { W0[bj] = *(const f32x4*)(wp); W1[bj] = *(const f32x4*)(wp + 5632); W2[bj] = *(const f32x4*)(wp + 2 * 5632); Bb[bj] = *(const f32x4*)(cb + bj * 2816 + jcol + 4 * n); }
                W1m[bj] = fr == 0 ? W1[bj] : (f32x4){0.f, 0.f, 0.f, 0.f}; W0m[bj] = fr < 2 ? W0[bj] : (f32x4){0.f, 0.f, 0.f, 0.f}; }
#pragma unroll
            for (int ai = 0; ai < 2; ++ai)
#pragma unroll
                for (int m = 0; m < 4; ++m) {
                    f32x4 c[2];
#pragma unroll
                    for (int bj = 0; bj < 2; ++bj) {
                        const f32x4 a = acc[ai][bj][m][n];
                        f32x4 t1, t2;
                        if (m > 0) { const f32x4 ap = acc[ai][bj][m - 1][n];
#pragma unroll
                            for (int i = 0; i < 4; ++i) { const float apx = ap[i]; t1[i] = pg8_dpp<0x121, false>(apx); t2[i] = pg8_dpp<0x122, false>(apx); }
                        } else {
                            t1 = (f32x4){0.f, 0.f, 0.f, 0.f}; t2 = t1;
                            const int sa = (wr == 1) ? ai : 0, sw = (wr == 1) ? 0 : 1;
                            if ((wr == 1 || ai == 1) && fr < 2) {
                                const f32x4 h0 = halo[(((((sa * 2 + sw) * 2 + 0) * 4 + wc) * 2 + bj) * 4 + fq) * 2 + n], h1 = halo[(((((sa * 2 + sw) * 2 + 1) * 4 + wc) * 2 + bj) * 4 + fq) * 2 + n];
                                t1 = h1; t2 = (fr == 0) ? h0 : h1;
                            }
                        }
#pragma unroll
                        for (int i = 0; i < 4; ++i) {
                            const float ax = a[i];
                            float v = __builtin_fmaf(W2[bj][i], ax, Bb[bj][i]);
                            v = __builtin_fmaf(pg8_dpp<0x111, true>(ax), W1[bj][i], v);
                            v = __builtin_fmaf(pg8_dpp<0x112, true>(ax), W0[bj][i], v);
                            v = __builtin_fmaf(t1[i], W1m[bj][i], v);
                            v = __builtin_fmaf(t2[i], W0m[bj][i], v);
                            c[bj][i] = v;
                        }
                    }
                    float hm[4];
#pragma unroll
                    for (int i = 0; i < 4; ++i) { const float g = c[0][i]; hm[i] = g * __builtin_amdgcn_rcpf(1.f + __builtin_amdgcn_exp2f(-1.4426950408889634f * g)) * c[1][i]; }
                    u32x2v_t w; w.x = cvt_pk_bf16(hm[0], hm[1]); w.y = cvt_pk_bf16(hm[2], hm[3]);
                    *(u32x2v_t*)(HM + (size_t)(u.pm * BM + ai * HALF + wr * 64 + m * 16 + fr) * 2816 + jcol + 4 * n) = w;
                }
        }
    }
};
template <class Epi, class Sched, bool ALIGN_EPI = false, bool SP2 = false>
__device__ __forceinline__ void gemm_phase(PG8_LAS unsigned char* lds, const Gemm g, const Sched& S, const Epi& E, const int wave_s) {
    unsigned ones_l = ~0u; asm volatile("" : "+s"(ones_l)); int tid_l = wave_s * 64 + (int)__builtin_amdgcn_mbcnt_hi(ones_l, __builtin_amdgcn_mbcnt_lo(ones_l, 0u)); asm volatile("" : "+v"(tid_l));
    const int tid = tid_l, wid = __builtin_amdgcn_readfirstlane(tid >> 6), lane = tid & 63, wr = wid >> 2, wc = wid & 3, fr = lane & 15, fq = lane >> 4;
    const int K = g.K, nt = K / BK;
    unsigned voffA[2], voffB[2];
#pragma unroll
    for (int i = 0; i < 2; ++i) { int R, C; stage_rc(tid * 16 + i * 8192, R, C); const int Rb = Epi::PERM ? ((R & ~31) + perm32(R & 31)) : R;
        voffA[i] = (unsigned)(R * K + C) * 2u; voffB[i] = (unsigned)(Rb * K + C) * 2u; }
    const size_t kstep = (size_t)(BK * 2);
    const size_t hstep = (size_t)HALF * K * 2;
    const size_t tstep = 2 * hstep;
    const unsigned ldsw = (unsigned)wid * 1024u;
    const int aoff = lds_byte(wr * 64 + fr, fq * 8), boff = lds_byte(wc * 32 + fr, fq * 8);
#define PG8_SA(b, h) (((b) * 2 + (h)) * HTB)
#define PG8_SB(b, h) ((4 + (b) * 2 + (h)) * HTB)
#define PG8_STAGE(bufoff, gbase, voff) do { _Pragma("unroll") for (int _i = 0; _i < 2; ++_i) \
        __builtin_amdgcn_global_load_lds((const unsigned*)((const char*)(gbase) + (voff)[_i]), (PG8_LAS unsigned*)(lds + (bufoff) + ldsw + _i * 8192), 16, 0, 0); } while (0)
#define PG8_LDA(dst, b, h) do { _Pragma("unroll") for (int m = 0; m < 4; ++m) _Pragma("unroll") for (int k = 0; k < 2; ++k) dst[m][k] = *(const PG8_LAS bf16x8*)(lds + PG8_SA(b, h) + aoff + m * 2048 + k * 1024); } while (0)
#define PG8_LDB(dst, b, h) do { _Pragma("unroll") for (int n = 0; n < 2; ++n) _Pragma("unroll") for (int k = 0; k < 2; ++k) dst[n][k] = *(const PG8_LAS bf16x8*)(lds + PG8_SB(b, h) + boff + n * 2048 + k * 1024); } while (0)
#define PG8_MMA(ai, bj, At, Bt) do { __builtin_amdgcn_s_setprio(1); _Pragma("unroll") for (int m = 0; m < 4; ++m) _Pragma("unroll") for (int n = 0; n < 2; ++n) _Pragma("unroll") for (int k = 0; k < 2; ++k) \
        acc[ai][bj][m][n] = __builtin_amdgcn_mfma_f32_16x16x32_bf16(Bt[n][k], At[m][k], acc[ai][bj][m][n], 0, 0, 0); __builtin_amdgcn_s_setprio(0); } while (0)
#define PG8_WAIT_V(n) asm volatile("s_waitcnt vmcnt(" #n ")" ::: "memory")
#define PG8_WAIT_L(n) asm volatile("s_waitcnt lgkmcnt(" #n ")" ::: "memory")
#define PG8_BAR __builtin_amdgcn_s_barrier()
#define PG8_SCHED __builtin_amdgcn_sched_barrier(0)
    Unit cur, nxt; int ui = 0;
    if (!S.next(0, cur)) return;
    f32x4 acc[2][2][4][2];
#pragma unroll
    for (int a = 0; a < 2; ++a)
#pragma unroll
        for (int b = 0; b < 2; ++b)
#pragma unroll
            for (int m = 0; m < 4; ++m)
#pragma unroll
                for (int n = 0; n < 2; ++n) acc[a][b][m][n] = (f32x4){0.f, 0.f, 0.f, 0.f};
    bf16x8 At[4][2], B0[2][2], B1[2][2];
    const char* cA = (const char*)g.A + (size_t)cur.pm * tstep; const char* cB = (const char*)g.Bt + (size_t)cur.pn * tstep;
    S.a_ready(cur);
    if constexpr (SP2) {
        PG8_STAGE(PG8_SB(0, 0), cB, voffB); PG8_STAGE(PG8_SB(0, 1), cB + hstep, voffB); PG8_STAGE(PG8_SA(0, 0), cA, voffA); PG8_STAGE(PG8_SA(0, 1), cA + hstep, voffA);
        if (wr == 1) PG8_BAR;
        PG8_WAIT_V(2); PG8_BAR;
        PG8_STAGE(PG8_SB(1, 0), cB + kstep, voffB); PG8_STAGE(PG8_SA(1, 0), cA + kstep, voffA); PG8_STAGE(PG8_SB(1, 1), cB + hstep + kstep, voffB);
        PG8_WAIT_V(6); PG8_BAR;
    } else {
        PG8_STAGE(PG8_SB(0, 0), cB, voffB); PG8_STAGE(PG8_SA(0, 0), cA, voffA); PG8_STAGE(PG8_SB(0, 1), cB + hstep, voffB); PG8_STAGE(PG8_SA(0, 1), cA + hstep, voffA);
        if (wr == 1) PG8_BAR;
        PG8_WAIT_V(4); PG8_BAR;
        PG8_STAGE(PG8_SB(1, 0), cB + kstep, voffB); PG8_STAGE(PG8_SA(1, 0), cA + kstep, voffA); PG8_STAGE(PG8_SB(1, 1), cB + hstep + kstep, voffB);
        PG8_WAIT_V(6); PG8_BAR;
    }
    for (;;) {
        const bool has_next = S.next(ui + 1, nxt);
        const char* nA = has_next ? (const char*)g.A + (size_t)nxt.pm * tstep : cA; const char* nB = has_next ? (const char*)g.Bt + (size_t)nxt.pn * tstep : cB;
        for (int t = 0; t < nt; t += 2) {
            const bool last = (t == nt - 2);
            const char* a1 = cA + (size_t)(t + 1) * kstep;
            const char* a2 = last ? nA : cA + (size_t)(t + 2) * kstep; const char* b2 = last ? nB : cB + (size_t)(t + 2) * kstep;
            const char* a3 = a2 + kstep; const char* b3 = b2 + kstep;
            if (last && has_next) S.a_ready(nxt);
            if constexpr (SP2) {
            PG8_LDB(B0, 0, 0); PG8_LDB(B1, 0, 1); PG8_SCHED; PG8_LDA(At, 0, 0); PG8_STAGE(PG8_SA(1, 1), a1 + hstep, voffA);
            PG8_WAIT_V(8); PG8_WAIT_L(0); PG8_BAR; PG8_MMA(0, 0, At, B0); PG8_MMA(0, 1, At, B1); PG8_BAR; PG8_SCHED;
            PG8_LDA(At, 0, 1); PG8_STAGE(PG8_SB(0, 0), b2, voffB); PG8_STAGE(PG8_SB(0, 1), b2 + hstep, voffB); PG8_STAGE(PG8_SA(0, 0), a2, voffA);
            PG8_WAIT_V(8); PG8_WAIT_L(0); PG8_BAR; PG8_MMA(1, 0, At, B0); PG8_MMA(1, 1, At, B1); PG8_BAR; PG8_SCHED;
            PG8_LDB(B0, 1, 0); PG8_LDB(B1, 1, 1); PG8_SCHED; PG8_LDA(At, 1, 0); PG8_STAGE(PG8_SA(0, 1), a2 + hstep, voffA);
            PG8_WAIT_V(8); PG8_WAIT_L(0); PG8_BAR; PG8_MMA(0, 0, At, B0); PG8_MMA(0, 1, At, B1); PG8_BAR; PG8_SCHED;
            PG8_LDA(At, 1, 1); PG8_STAGE(PG8_SB(1, 0), b3, voffB); PG8_STAGE(PG8_SB(1, 1), b3 + hstep, voffB); PG8_STAGE(PG8_SA(1, 0), a3, voffA);
            PG8_WAIT_V(8); PG8_WAIT_L(0); PG8_BAR; PG8_MMA(1, 0, At, B0); PG8_MMA(1, 1, At, B1); PG8_BAR; PG8_SCHED;
            } else {
            PG8_LDB(B0, 0, 0); PG8_SCHED; PG8_LDA(At, 0, 0); PG8_STAGE(PG8_SA(1, 1), a1 + hstep, voffA);
            PG8_WAIT_L(8); PG8_BAR; PG8_WAIT_L(0); PG8_MMA(0, 0, At, B0); PG8_BAR; PG8_SCHED;
            PG8_LDB(B1, 0, 1); PG8_STAGE(PG8_SB(0, 0), b2, voffB);
            PG8_BAR; PG8_WAIT_L(0); PG8_MMA(0, 1, At, B1); PG8_BAR;
            PG8_LDA(At, 0, 1); PG8_STAGE(PG8_SA(0, 0), a2, voffA);
            PG8_BAR; PG8_WAIT_L(0); PG8_MMA(1, 0, At, B0); PG8_BAR; PG8_SCHED;
            PG8_STAGE(PG8_SB(0, 1), b2 + hstep, voffB);
            PG8_WAIT_V(6); PG8_BAR; PG8_MMA(1, 1, At, B1); PG8_BAR;
            PG8_LDB(B0, 1, 0); PG8_SCHED; PG8_LDA(At, 1, 0); PG8_STAGE(PG8_SA(0, 1), a2 + hstep, voffA);
            PG8_WAIT_L(8); PG8_BAR; PG8_WAIT_L(0); PG8_MMA(0, 0, At, B0); PG8_BAR; PG8_SCHED;
            PG8_LDB(B1, 1, 1); PG8_STAGE(PG8_SB(1, 0), b3, voffB);
            PG8_BAR; PG8_WAIT_L(0); PG8_MMA(0, 1, At, B1); PG8_BAR;
            PG8_LDA(At, 1, 1); PG8_STAGE(PG8_SA(1, 0), a3, voffA);
            PG8_BAR; PG8_WAIT_L(0); PG8_MMA(1, 0, At, B0); PG8_BAR; PG8_SCHED;
            PG8_STAGE(PG8_SB(1, 1), b3 + hstep, voffB);
            PG8_WAIT_V(6); PG8_BAR; PG8_MMA(1, 1, At, B1); PG8_BAR;
            }
        }
        if constexpr (ALIGN_EPI) { if (wr == 0) PG8_BAR; }
        if constexpr (!Epi::AFTER_DRAIN) { E(acc, cur, wr, wc, fr, fq); S.done(cur); }
        if (!has_next) break;
#pragma unroll
        for (int a = 0; a < 2; ++a)
#pragma unroll
            for (int b = 0; b < 2; ++b)
#pragma unroll
                for (int m = 0; m < 4; ++m)
#pragma unroll
                    for (int n = 0; n < 2; ++n) acc[a][b][m][n] = (f32x4){0.f, 0.f, 0.f, 0.f};
        cur = nxt; cA = nA; cB = nB; ++ui;
        if constexpr (ALIGN_EPI) { if (wr == 1) PG8_BAR; }
    }
    PG8_WAIT_V(0);
    if constexpr (!ALIGN_EPI) { if (wr == 0) PG8_BAR; }
    PG8_BAR;
    if constexpr (Epi::AFTER_DRAIN) { E.fused(acc, cur, wr, wc, fr, fq, lds, wid, lane); S.done(cur); }
#undef PG8_SA
#undef PG8_SB
#undef PG8_STAGE
#undef PG8_LDA
#undef PG8_LDB
#undef PG8_MMA
#undef PG8_WAIT_V
#undef PG8_WAIT_L
#undef PG8_BAR
#undef PG8_SCHED
}
}
constexpr int SEQ = 4096, NB = 8, DM = 1024, NH = 16, HD = 64, MTOK = NB * SEQ, DFF = 2816, NFF2 = 2 * DFF, DEPTH = 4;
constexpr int NQK_A = 2048, NQK_B = 2816;
constexpr int MHALF = MTOK / 2;
constexpr int VTP = MTOK + 2048 + 128;
constexpr int NTHREADS = 512, NWAVES = 8;
constexpr float LOG2E = 1.4426950408889634f;
constexpr size_t MiB = 1u << 20;
constexpr size_t WS_CTL = 0, CTL_BYTES = 64 * 1024;
constexpr size_t WS_ROPE = 1 * MiB;
constexpr size_t WS_SSQ = 128 * 1024;
constexpr size_t WS_W = 2 * MiB, W_LAYER = 26 * MiB, WL_QK = 0, WL_V = 5632 * 1024, WL_O = WL_V + 2 * MiB, WL_IN = WL_O + 2 * MiB, WL_D = WL_IN + 11 * MiB;
constexpr size_t WS_XN = 106 * MiB, WS_OB = 170 * MiB, WS_SCR = WS_XN;
constexpr size_t WS_QO = 234 * MiB, WS_K = 298 * MiB, WS_VT = 362 * MiB, WS_QI = 431 * MiB, WS_KI = 463 * MiB, WS_WI = 467 * MiB, WS_MASK = 468 * MiB;
constexpr size_t WS_HM = 234 * MiB, WS_EF = 410 * MiB, WS_EL = 416 * MiB, WS_END = 498 * MiB;
static_assert(WL_D + (size_t)DM * DFF * 2 <= W_LAYER, "weights per layer");
static_assert(WS_VT + (size_t)DM * VTP * 2 <= WS_QI && WS_W + DEPTH * W_LAYER <= WS_XN && WS_MASK + 16 * MiB <= WS_END && WS_HM + (size_t)MTOK * DFF * 2 <= WS_EF && WS_EF + (size_t)256 * NFF2 * 4 <= WS_EL && WS_EL + (size_t)256 * NFF2 * 4 <= WS_END, "ws map");

#define LAS __attribute__((address_space(3)))
typedef unsigned short bf16;
typedef short bf16x8 __attribute__((ext_vector_type(8)));
typedef float f32x4 __attribute__((ext_vector_type(4)));
typedef float f32x16 __attribute__((ext_vector_type(16)));
typedef unsigned u32x4 __attribute__((ext_vector_type(4)));
typedef unsigned u32x2 __attribute__((ext_vector_type(2)));
typedef float f32x2_t __attribute__((ext_vector_type(2))); typedef __bf16 bf16x2_t __attribute__((ext_vector_type(2)));
__device__ __forceinline__ unsigned cvtpk(float lo, float hi) { f32x2_t v = {lo, hi}; bf16x2_t b = __builtin_convertvector(v, bf16x2_t); return __builtin_bit_cast(unsigned, b); }
__device__ __forceinline__ float bf2f(unsigned short h) { return __uint_as_float((unsigned)h << 16); }
__device__ __forceinline__ float wave_sum(float v) {
#pragma unroll
    for (int o = 1; o < 64; o <<= 1) v += __shfl_xor(v, o);
    return v;
}
__device__ __forceinline__ unsigned wave_sum_u32(unsigned v) {
    v += (unsigned)__builtin_amdgcn_update_dpp(0, (int)v, 0x111, 0xf, 0xf, true);
    v += (unsigned)__builtin_amdgcn_update_dpp(0, (int)v, 0x112, 0xf, 0xf, true);
    v += (unsigned)__builtin_amdgcn_update_dpp(0, (int)v, 0x114, 0xf, 0xf, true);
    v += (unsigned)__builtin_amdgcn_update_dpp(0, (int)v, 0x118, 0xf, 0xf, true);
    v += (unsigned)__builtin_amdgcn_update_dpp(0, (int)v, 0x142, 0xa, 0xf, true);
    v += (unsigned)__builtin_amdgcn_update_dpp(0, (int)v, 0x143, 0xc, 0xf, true);
    return (unsigned)__builtin_amdgcn_readlane((int)v, 63);
}
__device__ __forceinline__ int lane_id() { unsigned ones = ~0u; asm volatile("" : "+s"(ones)); return (int)__builtin_amdgcn_mbcnt_hi(ones, __builtin_amdgcn_mbcnt_lo(ones, 0u)); }
__device__ __forceinline__ int pi_row(int i) { return (i & ~12) | ((i & 4) << 1) | ((i & 8) >> 1); }

struct Params {
    const float* x; const float* norm1_g; const float* norm2_g;
    const float* a_w_qkv; const float* a_q_norm; const float* a_k_norm; const float* a_rel_bias; const float* a_w_o;
    const float* b_w_in; const float* b_q_norm; const float* b_k_norm; const float* b_w_o;
    const float* c_w_qkv; const float* c_w_o;
    const float* ffn_w_in; const float* ffn_conv_w; const float* ffn_conv_b; const float* ffn_w_down;
    float* out; unsigned char* ws;
};

__device__ __forceinline__ void transpose_item(const float* W, int K, int ldw, int src_col0, int nvalid, bf16* WT, int dst_row0, int perm, const float* gk, LAS float* scr, int item, int lane) {
    const int kblks = K / 64, nb = item / kblks, kb = item % kblks, k0 = 64 * kb, n0 = 32 * nb;
    const int nn = n0 + (lane & 31); const bool ok = nn < nvalid;
    float wv[32];
#pragma unroll
    for (int i = 0; i < 32; ++i) { const int kk = 2 * i + (lane >> 5); wv[i] = ok ? W[(size_t)(k0 + kk) * ldw + src_col0 + nn] : 0.f; }
    if (gk) {
#pragma unroll
        for (int i = 0; i < 32; ++i) wv[i] *= gk[k0 + 2 * i + (lane >> 5)];
    }
#pragma unroll
    for (int i = 0; i < 32; ++i) { const int kk = 2 * i + (lane >> 5); scr[kk * 33 + (lane & 31)] = wv[i]; }
    asm volatile("s_waitcnt lgkmcnt(0)" ::: "memory");
    int L = dst_row0 + n0;
    if (perm == 1) { const int l = L & 255; L = (L & ~255) | (((l >> 5) & 1) * 128 + (l >> 6) * 32); }
    else if (perm == 2) { const int hb = L >= DFF ? 1 : 0, c = L - hb * DFF; L = (c >> 7) * 256 + hb * 128 + (c & 127); }
    const int c = lane & 7;
#pragma unroll
    for (int j = 0; j < 4; ++j) { const int n = (lane >> 3) + 8 * j; const LAS float* s = scr + (8 * c) * 33 + n;
        u32x4 o; o.x = cvtpk(s[0 * 33], s[1 * 33]); o.y = cvtpk(s[2 * 33], s[3 * 33]); o.z = cvtpk(s[4 * 33], s[5 * 33]); o.w = cvtpk(s[6 * 33], s[7 * 33]);
        *(u32x4*)(WT + (size_t)(L + n) * K + k0 + 8 * c) = o; }
    asm volatile("s_waitcnt lgkmcnt(0)" ::: "memory");
}
__device__ __forceinline__ void rms_row_to_bf16(const float* xrow, const float* g, bf16* orow, int lane) {
    const f32x4* xr = (const f32x4*)xrow + lane; const f32x4* gr = (const f32x4*)g + lane;
    f32x4 v[4]; float s = 0.f;
#pragma unroll
    for (int j = 0; j < 4; ++j) { v[j] = xr[64 * j]; s += (v[j].x * v[j].x + v[j].y * v[j].y) + (v[j].z * v[j].z + v[j].w * v[j].w); }
    const float rstd = rsqrtf(wave_sum(s) * (1.f / DM) + 1e-6f);
    u32x2* o8 = (u32x2*)orow + lane;
#pragma unroll
    for (int j = 0; j < 4; ++j) { const f32x4 gg = gr[64 * j]; u32x2 w; w.x = cvtpk(v[j].x * rstd * gg.x, v[j].y * rstd * gg.y); w.y = cvtpk(v[j].z * rstd * gg.z, v[j].w * rstd * gg.w); o8[64 * j] = w; }
}
__device__ __forceinline__ void xb_row(const float* xrow, bf16* orow, float* ssq4, int lane) {
    const f32x4* xr = (const f32x4*)xrow + lane;
    f32x4 v[4]; float s = 0.f;
#pragma unroll
    for (int j = 0; j < 4; ++j) { v[j] = xr[64 * j]; s += (v[j].x * v[j].x + v[j].y * v[j].y) + (v[j].z * v[j].z + v[j].w * v[j].w); }
    s = wave_sum(s);
    u32x2* o8 = (u32x2*)orow + lane;
#pragma unroll
    for (int j = 0; j < 4; ++j) { u32x2 w; w.x = cvtpk(v[j].x, v[j].y); w.y = cvtpk(v[j].z, v[j].w); o8[64 * j] = w; }
    if (lane == 0) *(f32x4*)ssq4 = (f32x4){s, 0.f, 0.f, 0.f};
}
__device__ __forceinline__ void norm_phase(const float* X, const float* g, bf16* XN, int gw, int ngw, int lane) {
    for (int m = gw; m < MTOK; m += ngw) rms_row_to_bf16(X + (size_t)m * DM, g, XN + (size_t)m * DM, lane);
}

#define MFMA32(a, b, c) __builtin_amdgcn_mfma_f32_32x32x16_bf16((a), (b), (c), 0, 0, 0)
__device__ __forceinline__ void qk_tile(f32x16& p0, f32x16& p1, const bf16* Kh  , size_t key0, int kpitch, const bf16x8 (&qr)[4], int r32, int hi) {
    const bf16* kp = Kh + (key0 + pi_row(r32)) * (size_t)kpitch + hi * 8;
    p0 = (f32x16){}; p1 = (f32x16){};
#pragma unroll
    for (int d0 = 0; d0 < 4; ++d0) {
        const bf16x8 k0 = *(const bf16x8*)(kp + d0 * 16), k1 = *(const bf16x8*)(kp + (size_t)32 * kpitch + d0 * 16);
        p0 = MFMA32(k0, qr[d0], p0); p1 = MFMA32(k1, qr[d0], p1);
    }
}
__device__ __forceinline__ void pv_tile(f32x16& o0, f32x16& o1, const bf16* Vth  , size_t key0, const f32x16& p0, const f32x16& p1, int r32, int hi) {
    const bf16* vp = Vth + (size_t)r32 * MTOK + key0 + hi * 8;
#pragma unroll
    for (int half = 0; half < 2; ++half)
#pragma unroll
        for (int s = 0; s < 2; ++s) {
            const f32x16& p = half ? p1 : p0;
            u32x4 w; w.x = cvtpk(p[8 * s + 0], p[8 * s + 1]); w.y = cvtpk(p[8 * s + 2], p[8 * s + 3]); w.z = cvtpk(p[8 * s + 4], p[8 * s + 5]); w.w = cvtpk(p[8 * s + 6], p[8 * s + 7]);
            const bf16x8 pf = __builtin_bit_cast(bf16x8, w);
            const bf16x8 v0 = *(const bf16x8*)(vp + half * 32 + s * 16), v1 = *(const bf16x8*)(vp + (size_t)32 * MTOK + half * 32 + s * 16);
            o0 = MFMA32(v0, pf, o0); o1 = MFMA32(v1, pf, o1);
        }
}
__device__ __forceinline__ void load_q(bf16x8 (&qr)[4], const bf16* Q, size_t qrow, int h, int hi) {
#pragma unroll
    for (int d0 = 0; d0 < 4; ++d0) qr[d0] = *(const bf16x8*)(Q + qrow * DM + h * HD + d0 * 16 + hi * 8);
}
__device__ __forceinline__ void store_o(bf16* O, size_t qrow, int h, const f32x16& o0, const f32x16& o1, float rl, int hi) {
    bf16* op = O + qrow * DM + h * HD + 4 * hi;
#pragma unroll
    for (int dh = 0; dh < 2; ++dh)
#pragma unroll
        for (int g = 0; g < 4; ++g) { const f32x16& o = dh ? o1 : o0; u32x2 w; w.x = cvtpk(o[4 * g] * rl, o[4 * g + 1] * rl); w.y = cvtpk(o[4 * g + 2] * rl, o[4 * g + 3] * rl);
            *(u32x2*)(op + 32 * dh + 8 * g) = w; }
}
#define MAX3(a, b, c) __builtin_fmaxf(__builtin_fmaxf((a), (b)), (c))
__device__ __forceinline__ void softmax_step(f32x16& p0, f32x16& p1, float& m, float& l, f32x16& o0, f32x16& o1) {
    float a = MAX3(p0[0], p0[1], p0[2]), b = MAX3(p1[0], p1[1], p1[2]);
#pragma unroll
    for (int r = 3; r < 15; r += 2) { a = MAX3(a, p0[r], p0[r + 1]); b = MAX3(b, p1[r], p1[r + 1]); }
    float mx = MAX3(a, b, p0[15]); mx = fmaxf(mx, p1[15]);
    mx = fmaxf(mx, __shfl_xor(mx, 32));
    const float mn = fmaxf(m, mx);
    if (!__all(mn == m)) {
        const float alpha = __builtin_amdgcn_exp2f(m - mn); m = mn; l *= alpha;
#pragma unroll
        for (int r = 0; r < 16; ++r) { o0[r] *= alpha; o1[r] *= alpha; }
    }
    float s = 0.f;
#pragma unroll
    for (int r = 0; r < 16; ++r) { p0[r] = __builtin_amdgcn_exp2f(p0[r] - mn); p1[r] = __builtin_amdgcn_exp2f(p1[r] - mn); s += p0[r] + p1[r]; }
    l += s;
}
__device__ __forceinline__ void attn_unit_of(int u, int& bh, int& qb) { bh = u >> 7; qb = u & 127; if ((u >> 11) & 1) qb = 127 - qb; }

__device__ __forceinline__ void attnA_phase(const bf16* Q, const bf16* K, const bf16* Vt, bf16* O, const float* rel_bias  , LAS float* biasL, int vw, int nvw, int tid) {
    for (int i = tid; i < 16 * 513; i += NTHREADS) biasL[(i / 513) * 516 + (i % 513)] = rel_bias[i] * LOG2E;
    __syncthreads();
    const int lane = tid & 63, r32 = lane & 31, hi = lane >> 5;
    for (int u = vw; u < NB * NH * 128; u += nvw) {
        int bh, qb; attn_unit_of(u, bh, qb); const int b = bh >> 4, h = bh & 15, c = qb >> 1, qh = qb & 1;
        const size_t qrow = (size_t)b * SEQ + qb * 32 + r32;
        bf16x8 qr[4]; load_q(qr, Q, qrow, h, hi);
        f32x16 o0 = (f32x16){}, o1 = (f32x16){}; float m = -1e30f, l = 0.f;
        const LAS float* bl = biasL + h * 516;
        for (int kt = (c < 8 ? 8 - c : 0); kt <= 8; ++kt) {
            const size_t key0 = (size_t)b * SEQ + (size_t)(c - 8 + kt) * 64;
            f32x16 p0, p1; qk_tile(p0, p1, K + h * HD, key0, DM, qr, r32, hi);
            if (kt >= 4) {
                const int base = (8 - kt) * 64 + qh * 32 + r32 - 8 * hi;
#pragma unroll
                for (int r = 0; r < 16; ++r) { const int d0 = base - (16 * (r >> 3) + (r & 7)); const int d1 = d0 - 32;
                    p0[r] += bl[(d0 < 256 ? d0 : 256) + 256]; p1[r] += bl[(d1 < 256 ? d1 : 256) + 256]; }
            } else { const float bc = bl[512];
#pragma unroll
                for (int r = 0; r < 16; ++r) { p0[r] += bc; p1[r] += bc; } }
            softmax_step(p0, p1, m, l, o0, o1);
            pv_tile(o0, o1, Vt + (size_t)h * HD * MTOK, key0, p0, p1, r32, hi);
        }
        l += __shfl_xor(l, 32);
        store_o(O, qrow, h, o0, o1, 1.0f / l, hi);
    }
}
__device__ __forceinline__ void attnC_phase(const bf16* Q, const bf16* K, const bf16* Vt, bf16* O, int vw, int nvw, int tid) {
    const int lane = tid & 63, r32 = lane & 31, hi = lane >> 5;
    for (int u = vw; u < NB * NH * 128; u += nvw) {
        int bh, qb; attn_unit_of(u, bh, qb); const int b = bh >> 4, h = bh & 15;
        const size_t qrow = (size_t)b * SEQ + qb * 32 + r32; const int t = qb * 32 + r32;
        bf16x8 qr[4]; load_q(qr, Q, qrow, h, hi);
        f32x16 o0 = (f32x16){}, o1 = (f32x16){}; float R = 0.f;
        for (int kt = qb >> 1; kt >= 0; --kt) {
            const size_t key0 = (size_t)b * SEQ + (size_t)kt * 64;
            f32x16 p0, p1; qk_tile(p0, p1, K + h * HD, key0, DM, qr, r32, hi);
            const int kb = kt * 64 + 8 * hi;
            float lk[32], lb[32];
#pragma unroll
            for (int e = 0; e < 32; ++e) { const int r = e & 15, half = e >> 4; const float z = half ? p1[r] : p0[r];
                const int key = kb + 32 * half + 16 * (r >> 3) + (r & 7);
                const float sp = fmaxf(z, 0.f) + __builtin_amdgcn_logf(1.f + __builtin_amdgcn_exp2f(-fabsf(z)));
                const bool valid = key < t;
                lk[e] = valid ? -sp : 0.f; lb[e] = valid ? (z - sp) : -INFINITY; }
            float G[4], ex[32];
#pragma unroll
            for (int gi = 0; gi < 4; ++gi) { float run = 0.f;
#pragma unroll
                for (int i = 7; i >= 0; --i) { ex[gi * 8 + i] = run; run += lk[gi * 8 + i]; }
                G[gi] = run; }
            float Gp[4];
#pragma unroll
            for (int gi = 0; gi < 4; ++gi) Gp[gi] = __shfl_xor(G[gi], 32);
            float suf[4]; float run = 0.f;
#pragma unroll
            for (int gi = 3; gi >= 0; --gi) { suf[gi] = run + (hi == 0 ? Gp[gi] : 0.f); run += G[gi] + Gp[gi]; }
#pragma unroll
            for (int e = 0; e < 32; ++e) { const float a = __builtin_amdgcn_exp2f(lb[e] + R + suf[e >> 3] + ex[e]); if (e < 16) p0[e] = a; else p1[e - 16] = a; }
            R += run;
            pv_tile(o0, o1, Vt + (size_t)h * HD * MTOK, key0, p0, p1, r32, hi);
            if (__all(R < -300.f)) break;
        }
        store_o(O, qrow, h, o0, o1, 1.0f, hi);
    }
}
constexpr int TP = 144;
constexpr int TILE_B = 64 * TP, KVBUF_B = 2 * TILE_B;
constexpr int PAIR_B = 2 * KVBUF_B;
struct KVStage { u32x4 k, v; };
__device__ __forceinline__ void kv_issue(KVStage& st, const bf16* Kh, const bf16* Vth, size_t key0, int tid) {
    const int row = tid >> 3, ch = tid & 7;
    st.k = *(const u32x4*)(Kh + (key0 + row) * DM + ch * 8);
    st.v = *(const u32x4*)(Vth + (size_t)row * VTP + key0 + ch * 8);
}
__device__ __forceinline__ void kv_write(const KVStage& st, LAS unsigned char* buf, int tid) {
    const int row = tid >> 3, ch = tid & 7;
    *(LAS u32x4*)(buf + row * TP + ch * 16) = st.k;
    *(LAS u32x4*)(buf + TILE_B + row * TP + ch * 16) = st.v;
}
template <bool INIT = true> __device__ __forceinline__ void qk_lds(f32x16& p0, f32x16& p1, const LAS unsigned char* buf, const bf16x8 (&qr)[4], int r32, int hi) {
    const LAS unsigned char* kp = buf + pi_row(r32) * TP + hi * 16;
    if (INIT) { p0 = (f32x16){}; p1 = (f32x16){}; }
#pragma unroll
    for (int d0 = 0; d0 < 4; ++d0) {
        const bf16x8 k0 = *(const LAS bf16x8*)(kp + d0 * 32), k1 = *(const LAS bf16x8*)(kp + 32 * TP + d0 * 32);
        p0 = MFMA32(k0, qr[d0], p0); p1 = MFMA32(k1, qr[d0], p1);
    }
}
__device__ __forceinline__ void pv_lds(f32x16& o0, f32x16& o1, const LAS unsigned char* buf, const f32x16& p0, const f32x16& p1, int r32, int hi) {
    const LAS unsigned char* vp = buf + TILE_B + r32 * TP + hi * 16;
#pragma unroll
    for (int half = 0; half < 2; ++half)
#pragma unroll
        for (int s = 0; s < 2; ++s) {
            const f32x16& p = half ? p1 : p0;
            u32x4 w; w.x = cvtpk(p[8 * s + 0], p[8 * s + 1]); w.y = cvtpk(p[8 * s + 2], p[8 * s + 3]); w.z = cvtpk(p[8 * s + 4], p[8 * s + 5]); w.w = cvtpk(p[8 * s + 6], p[8 * s + 7]);
            const bf16x8 pf = __builtin_bit_cast(bf16x8, w);
            const bf16x8 v0 = *(const LAS bf16x8*)(vp + half * 64 + s * 32), v1 = *(const LAS bf16x8*)(vp + 32 * TP + half * 64 + s * 32);
            o0 = MFMA32(v0, pf, o0); o1 = MFMA32(v1, pf, o1);
        }
}
#define WG_BARRIER_L() do { asm volatile("s_waitcnt lgkmcnt(0)" ::: "memory"); __builtin_amdgcn_s_barrier(); asm volatile("" ::: "memory"); } while (0)
#define WG_BARRIER() do { asm volatile("s_waitcnt vmcnt(0) lgkmcnt(0)" ::: "memory"); __builtin_amdgcn_s_barrier(); asm volatile("" ::: "memory"); } while (0)
__device__ __forceinline__ void blk_unit_of(int u, int& bh, int& ub) { bh = u >> 4; ub = u & 15; if ((u >> 8) & 1) ub = 15 - ub; }

template <bool FIXED> __device__ __forceinline__ void attnA_blk(const bf16* Q, const bf16* K, const bf16* Vt, bf16* O, const float* rel_bias, float ref, LAS unsigned char* lds, int vcu, int G, int tid) {
    LAS float* biasL = (LAS float*)(lds + 2 * PAIR_B);
    for (int i = tid; i < 16 * 513; i += NTHREADS) biasL[(i / 513) * 516 + (i % 513)] = rel_bias[i] * LOG2E - (FIXED ? ref : 0.f);
    __syncthreads();
    const int lane = tid & 63, r32 = lane & 31, hi = lane >> 5, wid = __builtin_amdgcn_readfirstlane(tid >> 6);
#pragma unroll 1
    for (int u = vcu; u < NB * NH * 16; u += G) {
        int bh, ub; blk_unit_of(u, bh, ub); const int b = bh >> 4, h = bh & 15, qb = ub * 8 + wid, c = qb >> 1, qh = qb & 1;
        const size_t qrow = (size_t)b * SEQ + qb * 32 + r32;
        bf16x8 qr[4]; load_q(qr, Q, qrow, h, hi);
        f32x16 o0 = (f32x16){}, o1 = (f32x16){}; float m = -1e30f, l = 0.f;
        const LAS float* bl = biasL + h * 516;
        const bf16* Kh = K + h * HD; const bf16* Vth = Vt + (size_t)h * HD * VTP;
        const int c0 = ub * 4, t_lo = c0 >= 8 ? c0 - 8 : 0, t_hi = c0 + 3;
        const size_t kbase = (size_t)b * SEQ; const int ntl = t_hi - t_lo + 1;
        KVStage sa, sb;
        kv_issue(sa, Kh, Vth, kbase + (size_t)t_lo * 64, tid); kv_issue(sb, Kh, Vth, kbase + (size_t)(t_lo + 1) * 64, tid);
        kv_write(sa, lds, tid); kv_write(sb, lds + KVBUF_B, tid); WG_BARRIER();
#define ATT_PAIR(IT) do { const int it_ = (IT); LAS unsigned char* pb = lds + ((it_ >> 1) & 1) * PAIR_B; \
            if (it_ + 2 < ntl) { kv_issue(sa, Kh, Vth, kbase + (size_t)(t_lo + it_ + 2) * 64, tid); kv_issue(sb, Kh, Vth, kbase + (size_t)(t_lo + it_ + 3) * 64, tid); } \
            { const int t = t_lo + it_; LAS unsigned char* buf = pb; ATT_COMPUTE } \
            { const int t = t_lo + it_ + 1; LAS unsigned char* buf = pb + KVBUF_B; ATT_COMPUTE } \
            if (it_ + 2 < ntl) { LAS unsigned char* nb = lds + (((it_ >> 1) + 1) & 1) * PAIR_B; kv_write(sa, nb, tid); kv_write(sb, nb + KVBUF_B, tid); } \
            WG_BARRIER(); } while (0)
#define ATT_COMPUTE             if (t >= c - 8 && t <= c) { \
                const int kt = t - c + 8; \
                f32x16 p0, p1; \
                if (kt > 4) { \
                    const LAS float* bp = bl + ((8 - kt) * 64 + qh * 32 + r32 - 8 * hi + 256); \
_Pragma("unroll") \
                    for (int r = 0; r < 16; ++r) { p0[r] = bp[-(16 * (r >> 3) + (r & 7))]; p1[r] = bp[-(16 * (r >> 3) + (r & 7)) - 32]; } \
                } else if (kt == 4) { \
                    const int base = 4 * 64 + qh * 32 + r32 - 8 * hi; \
_Pragma("unroll") \
                    for (int r = 0; r < 16; ++r) { const int d0 = base - (16 * (r >> 3) + (r & 7)); const int d1 = d0 - 32; \
                        p0[r] = bl[(d0 < 256 ? d0 : 256) + 256]; p1[r] = bl[(d1 < 256 ? d1 : 256) + 256]; } \
                } else { const float bc = bl[512]; \
_Pragma("unroll") \
                    for (int r = 0; r < 16; ++r) { p0[r] = bc; p1[r] = bc; } } \
                qk_lds<false>(p0, p1, buf, qr, r32, hi); \
                if (FIXED) { float sacc = 0.f; \
_Pragma("unroll") \
                    for (int r = 0; r < 16; ++r) { p0[r] = __builtin_amdgcn_exp2f(p0[r]); p1[r] = __builtin_amdgcn_exp2f(p1[r]); sacc += p0[r] + p1[r]; } \
                    l += sacc; \
                } else softmax_step(p0, p1, m, l, o0, o1); \
                pv_lds(o0, o1, buf, p0, p1, r32, hi); \
            }
#pragma unroll 1
        for (int it = 0; it < ntl; it += 2) ATT_PAIR(it);
#undef ATT_COMPUTE
        l += __shfl_xor(l, 32);
        store_o(O, qrow, h, o0, o1, 1.0f / l, hi);
    }
}
__device__ __forceinline__ void b_mask_init(f32x16& p0, f32x16& p1, unsigned long long mw, int hi, float ref) {
    const int n0 = (int)~((unsigned)mw >> (8 * hi)), n1 = (int)~((unsigned)(mw >> 32) >> (8 * hi));
#pragma unroll
    for (int r = 0; r < 16; ++r) { const int bit = 16 * (r >> 3) + (r & 7);
        p0[r] = __int_as_float(__builtin_amdgcn_sbfe(n0, bit, 1) & (int)0xFF800000) - ref; p1[r] = __int_as_float(__builtin_amdgcn_sbfe(n1, bit, 1) & (int)0xFF800000) - ref; }
}
__device__ __forceinline__ float exp_tile(f32x16& p0, f32x16& p1) {
    float sacc = 0.f;
#pragma unroll
    for (int r = 0; r < 16; ++r) { p0[r] = __builtin_amdgcn_exp2f(p0[r]); p1[r] = __builtin_amdgcn_exp2f(p1[r]);
#ifdef PB2_EXPX
        p0[r] = __builtin_amdgcn_exp2f(__builtin_amdgcn_logf(p0[r])); p1[r] = __builtin_amdgcn_exp2f(__builtin_amdgcn_logf(p1[r]));
#endif
        sacc += p0[r] + p1[r]; }
    return sacc;
}
template <bool FIXED> __device__ __forceinline__ void attnB_blk(const bf16* Q, const bf16* K, const bf16* Vt, bf16* O, const unsigned long long* MASK, float ref, LAS unsigned char* lds, int vcu, int G, int tid) {
    const int lane = tid & 63, r32 = lane & 31, hi = lane >> 5, wid = __builtin_amdgcn_readfirstlane(tid >> 6);
#pragma unroll 1
    for (int u = vcu; u < NB * NH * 16; u += G) {
        int bh, ub; blk_unit_of(u, bh, ub); const int b = bh >> 4, h = bh & 15, qb = ub * 8 + wid;
        const size_t qrow = (size_t)b * SEQ + qb * 32 + r32;
        bf16x8 qr[4]; load_q(qr, Q, qrow, h, hi);
        f32x16 o0 = (f32x16){}, o1 = (f32x16){}; float m = -1e30f, l = 0.f;
        const u32x4* mrow2 = (const u32x4*)(MASK + qrow * 64);
        const int ntile = (qb >> 1) + 1, t_hi = ub * 4 + 3;
        const bf16* Kh = K + h * HD; const bf16* Vth = Vt + (size_t)h * HD * VTP;
        const size_t kbase = (size_t)b * SEQ; const int ntl = t_hi + 1;
#ifndef PB2_LOOPX
#define PB2_LOOPX 1
#endif
        for (int rep2 = 0; rep2 < PB2_LOOPX; ++rep2) {
        KVStage sa, sb;
        kv_issue(sa, Kh, Vth, kbase, tid); kv_issue(sb, Kh, Vth, kbase + 64, tid);
        u32x4 mnext = mrow2[0];
        kv_write(sa, lds, tid); kv_write(sb, lds + KVBUF_B, tid); WG_BARRIER();
#pragma unroll 1
        for (int it = 0; it < ntl; it += 2) {
            LAS unsigned char* pb = lds + ((it >> 1) & 1) * PAIR_B;
            u32x4 mcur = mnext; asm volatile("" : "+v"(mcur));
            if (it + 2 < ntl) { kv_issue(sa, Kh, Vth, kbase + (size_t)(it + 2) * 64, tid); kv_issue(sb, Kh, Vth, kbase + (size_t)(it + 3) * 64, tid); }
            if (it + 2 < ntile) mnext = mrow2[(it >> 1) + 1];
            const unsigned long long ma = (it < ntile) ? ((unsigned long long)mcur.y << 32 | mcur.x) : 0ull, mb = (it + 1 < ntile) ? ((unsigned long long)mcur.w << 32 | mcur.z) : 0ull;
#pragma unroll
            for (int k = 0; k < 2; ++k) {
                if (it + k < ntile) {
                    LAS unsigned char* buf = pb + k * KVBUF_B;
                    f32x16 p0, p1; b_mask_init(p0, p1, k ? mb : ma, hi, FIXED ? ref : 0.f);
                    qk_lds<false>(p0, p1, buf, qr, r32, hi);
                    if (FIXED) l += exp_tile(p0, p1); else softmax_step(p0, p1, m, l, o0, o1);
                    pv_lds(o0, o1, buf, p0, p1, r32, hi);
                }
            }
            if (it + 2 < ntl) { LAS unsigned char* nb = lds + (((it >> 1) + 1) & 1) * PAIR_B; kv_write(sa, nb, tid); kv_write(sb, nb + KVBUF_B, tid);
#ifdef PB2_STAGEX
                kv_issue(sa, Kh, Vth, kbase + (size_t)(it + 2) * 64, tid); kv_issue(sb, Kh, Vth, kbase + (size_t)(it + 3) * 64, tid); kv_write(sa, nb, tid); kv_write(sb, nb + KVBUF_B, tid);
#endif
            }
            WG_BARRIER();
#ifdef PB2_BARX
            WG_BARRIER(); WG_BARRIER();
#endif
        }
        }
        l += __shfl_xor(l, 32);
        store_o(O, qrow, h, o0, o1, 1.0f / l, hi);
    }
}
__device__ __forceinline__ void attnC_blk(const bf16* Q, const bf16* K, const bf16* Vt, bf16* O, LAS unsigned char* lds, int vcu, int G, int tid) {
    const int lane = tid & 63, r32 = lane & 31, hi = lane >> 5, wid = __builtin_amdgcn_readfirstlane(tid >> 6);
    LAS unsigned* flags = (LAS unsigned*)(lds + 2 * KVBUF_B);
#pragma unroll 1
    for (int u = vcu; u < NB * NH * 16; u += G) {
        int bh, ub; blk_unit_of(u, bh, ub); const int b = bh >> 4, h = bh & 15, qb = ub * 8 + wid;
        const size_t qrow = (size_t)b * SEQ + qb * 32 + r32; const int tq = qb * 32 + r32;
        bf16x8 qr[4]; load_q(qr, Q, qrow, h, hi);
        f32x16 o0 = (f32x16){}, o1 = (f32x16){}; float R = 0.f; bool done = false;
        const int t_hi = ub * 4 + 3, t_me = qb >> 1;
        const bf16* Kh = K + h * HD; const bf16* Vth = Vt + (size_t)h * HD * VTP;
        KVStage st; kv_issue(st, Kh, Vth, (size_t)b * SEQ + (size_t)t_hi * 64, tid); kv_write(st, lds, tid); WG_BARRIER();
#pragma unroll 1
        for (int t = t_hi, it = 0; t >= 0; --t, ++it) {
            LAS unsigned char* buf = lds + (it & 1) * KVBUF_B;
            if (t > 0) kv_issue(st, Kh, Vth, (size_t)b * SEQ + (size_t)(t - 1) * 64, tid);
            if (t <= t_me && !done) {
                f32x16 p0, p1; qk_lds(p0, p1, buf, qr, r32, hi);
                const int kb = t * 64 + 8 * hi;
                const bool diag = (t == t_me);
                float lk[32], lb[32];
#pragma unroll
                for (int e = 0; e < 32; ++e) { const int r = e & 15, half = e >> 4; const float z = half ? p1[r] : p0[r];
                    const float sp = __builtin_amdgcn_logf(1.f + __builtin_amdgcn_exp2f(fminf(z, 80.f)));
                    lk[e] = -sp; lb[e] = z - sp; }
                if (diag) {
#pragma unroll
                    for (int e = 0; e < 32; ++e) { const int r = e & 15, half = e >> 4; const int key = kb + 32 * half + 16 * (r >> 3) + (r & 7);
                        const bool valid = key < tq; lk[e] = valid ? lk[e] : 0.f; lb[e] = valid ? lb[e] : -INFINITY; }
                }
                float Gs[4], ex[32];
#pragma unroll
                for (int gi = 0; gi < 4; ++gi) { float run = 0.f;
#pragma unroll
                    for (int i = 7; i >= 0; --i) { ex[gi * 8 + i] = run; run += lk[gi * 8 + i]; }
                    Gs[gi] = run; }
                float Gp[4];
#pragma unroll
                for (int gi = 0; gi < 4; ++gi) Gp[gi] = __shfl_xor(Gs[gi], 32);
                float suf[4]; float run = 0.f;
#pragma unroll
                for (int gi = 3; gi >= 0; --gi) { suf[gi] = R + run + (hi == 0 ? Gp[gi] : 0.f); run += Gs[gi] + Gp[gi]; }
#pragma unroll
                for (int e = 0; e < 32; ++e) { const float a = __builtin_amdgcn_exp2f(lb[e] + (suf[e >> 3] + ex[e])); if (e < 16) p0[e] = a; else p1[e - 16] = a; }
                R += run;
                pv_lds(o0, o1, buf, p0, p1, r32, hi);
                done = __all(R < -300.f);
            }
            if (lane == 0) flags[(it & 1) * 8 + wid] = (done || t == 0) ? 0u : 1u;
            if (t > 0) kv_write(st, lds + ((it + 1) & 1) * KVBUF_B, tid);
            WG_BARRIER();
            unsigned any = 0u;
#pragma unroll
            for (int w = 0; w < 8; ++w) any |= flags[(it & 1) * 8 + w];
            if (any == 0u) break;
        }
        store_o(O, qrow, h, o0, o1, 1.0f, hi);
        WG_BARRIER();
    }
}
#define XB_TMO      128
#define XB_XCNT(j)  (256  + 64 * (j))
#define XB_XSUB(j)  (1280 + 64 * (j))
#define XB_XGEN(j)  (2304 + 64 * (j))
#define XB_TOP      3328
#define XB_TOPGEN   3392
#define XCD_BAR_WORDS 3456
#define XB_SPIN_CAP (1u << 18)

__device__ __forceinline__ unsigned xb_ld(unsigned* p)              { return __hip_atomic_load(p, __ATOMIC_RELAXED, __HIP_MEMORY_SCOPE_AGENT); }
__device__ __forceinline__ unsigned xb_add(unsigned* p, unsigned v) { return __hip_atomic_fetch_add(p, v, __ATOMIC_RELAXED, __HIP_MEMORY_SCOPE_AGENT); }
__device__ __forceinline__ unsigned xb_xcc_id() { return (unsigned)__builtin_amdgcn_s_getreg((3 << 11) | 20) & 0xFu; }
#define XB_SPIN(cond, bar) do { unsigned _sp = 0; while (cond) { __builtin_amdgcn_s_sleep(1); \
    if ((++_sp & 255u) == 0u) { if (xb_ld(&(bar)[XB_TMO])) break; if (_sp > XB_SPIN_CAP) { atomicAdd(&(bar)[XB_TMO], 1u); break; } } } } while (0)

struct XcdBarrier {
    unsigned* bar; unsigned x;
    volatile LAS unsigned* st;
};

__device__ __forceinline__ XcdBarrier xcd_barrier_post(unsigned* bar, volatile LAS unsigned* st) {
    XcdBarrier b; b.bar = bar; b.x = xb_xcc_id(); b.st = st;
    if (threadIdx.x == 0) (void)xb_add(&bar[XB_XCNT(b.x)], 1u);
    return b;
}
__device__ __forceinline__ void xcd_barrier_complete(unsigned* bar, unsigned x, unsigned& nloc, unsigned& nx) {
    const unsigned G = gridDim.x * gridDim.y * gridDim.z;
    unsigned sum, cnt, mine, sp = 0u;
    for (;;) {
        sum = 0u; cnt = 0u; mine = 0u;
#pragma unroll
        for (unsigned j = 0; j < 16; ++j) { const unsigned c = xb_ld(&bar[XB_XCNT(j)]); sum += c; cnt += (c > 0u) ? 1u : 0u; mine = (j == x) ? c : mine; }
        if (sum == G) break;
        __builtin_amdgcn_s_sleep(1);
        if ((++sp & 255u) == 0u) { if (xb_ld(&bar[XB_TMO])) break; if (sp > XB_SPIN_CAP) { atomicAdd(&bar[XB_TMO], 1u); break; } }
    }
    nloc = mine > 0u ? mine : 1u; nx = cnt > 0u ? cnt : 1u;
}

__device__ __forceinline__ void xcd_barrier(const XcdBarrier& b, int g_wave_id) {
    asm volatile("s_waitcnt vmcnt(0)" ::: "memory");
    __syncthreads();
    if (g_wave_id == 0 && lane_id() == 0) {
        unsigned* bar = b.bar;
        __builtin_amdgcn_s_waitcnt(0);
        unsigned nloc = b.st[0], nx = b.st[1];
        if (nloc == 0u) { xcd_barrier_complete(bar, b.x, nloc, nx); b.st[0] = nloc; b.st[1] = nx; }
        const unsigned old = xb_add(&bar[XB_XSUB(b.x)], 1u);
        const unsigned gen = old / nloc;
        if (old + 1u == (gen + 1u) * nloc) {
            __builtin_amdgcn_fence(__ATOMIC_RELEASE, "agent");
            asm volatile("s_waitcnt vmcnt(0)" ::: "memory");
            const unsigned og = xb_add(&bar[XB_TOP], 1u);
            const unsigned tg = og / nx;
            if (og + 1u == (tg + 1u) * nx) xb_add(&bar[XB_TOPGEN], 1u);
            else XB_SPIN(xb_ld(&bar[XB_TOPGEN]) == tg, bar);
            __builtin_amdgcn_fence(__ATOMIC_ACQUIRE, "agent");
            xb_add(&bar[XB_XGEN(b.x)], 1u);
            asm volatile("s_waitcnt vmcnt(0)" ::: "memory");
        } else {
            XB_SPIN(xb_ld(&bar[XB_XGEN(b.x)]) == gen, bar);
            __builtin_amdgcn_fence(__ATOMIC_ACQUIRE, "agent");
            asm volatile("s_waitcnt vmcnt(0)" ::: "memory");
        }
    }
    __syncthreads();
}
constexpr int QI_PITCH = 520;
__device__ __forceinline__ void b1_phase(const bf16* QI, const bf16* KI, const float* WI, float* SCRb  , unsigned long long* MASK,
                                         LAS unsigned char* lds, int vcu, int G, int tid) {
    const int lane = tid & 63, r32 = lane & 31, hi = lane >> 5, wid = __builtin_amdgcn_readfirstlane(tid >> 6);
    LAS bf16* qs = (LAS bf16*)lds;
#pragma unroll 1
    for (int u0 = vcu, rnd = 0; u0 < NB * 128; u0 += G, ++rnd) {
        const int b = u0 >> 7; int qb = u0 & 127; if (rnd & 1) qb = 127 - qb;
        const size_t tok0 = (size_t)b * SEQ + qb * 32;
        const int ntile = (qb >> 1) + 1, limit = ntile * 64;
        for (int i = tid; i < 32 * 64; i += NTHREADS) { const int q = i >> 6, c = i & 63; *(LAS u32x4*)(qs + q * QI_PITCH + c * 8) = *(const u32x4*)(QI + (tok0 + q) * 512 + c * 8); }
        LAS float* wl = (LAS float*)(lds + 32 * QI_PITCH * 2);
        if (tid < 256) wl[tid] = WI[tok0 * 8 + tid];
        __syncthreads();
#ifndef B1_SCORE_REP
#define B1_SCORE_REP 1
#endif
#ifndef B1_TOPK_REP
#define B1_TOPK_REP 1
#endif
#ifndef B1_NO_SCORE
        for (int rep_ = 0; rep_ < B1_SCORE_REP; ++rep_)
#pragma unroll 1
        for (int kt = wid; kt < ntile; kt += NWAVES) {
            const size_t key0 = (size_t)b * SEQ + (size_t)kt * 64;
            const bf16* kp = KI + (key0 + pi_row(r32)) * 64 + hi * 8;
            bf16x8 kf0[4], kf1[4];
#pragma unroll
            for (int d0 = 0; d0 < 4; ++d0) { kf0[d0] = *(const bf16x8*)(kp + d0 * 16); kf1[d0] = *(const bf16x8*)(kp + 32 * 64 + d0 * 16); }
            f32x16 s0 = (f32x16){}, s1 = (f32x16){};
            int qoff = r32 * QI_PITCH + hi * 8; asm volatile("" : "+v"(qoff));
#pragma unroll 1
            for (int hh = 0; hh < 8; ++hh) {
                f32x16 a0 = (f32x16){}, a1 = (f32x16){};
                const float wh = wl[r32 * 8 + hh];
#pragma unroll
                for (int d0 = 0; d0 < 4; ++d0) { const bf16x8 qf = *(const LAS bf16x8*)(qs + qoff + hh * 64 + d0 * 16); a0 = MFMA32(kf0[d0], qf, a0); a1 = MFMA32(kf1[d0], qf, a1); }
#pragma unroll
                for (int r = 0; r < 16; ++r) { s0[r] = __builtin_fmaf(wh, __builtin_fmaxf(a0[r], 0.f), s0[r]); s1[r] = __builtin_fmaf(wh, __builtin_fmaxf(a1[r], 0.f), s1[r]); }
            }
            float* sp = SCRb + (size_t)r32 * 4096 + kt * 64 + 8 * hi;
#pragma unroll
            for (int half = 0; half < 2; ++half)
#pragma unroll
                for (int s = 0; s < 2; ++s) { const f32x16& p = half ? s1 : s0;
                    *(f32x4*)(sp + 32 * half + 16 * s) = (f32x4){p[8 * s], p[8 * s + 1], p[8 * s + 2], p[8 * s + 3]};
                    *(f32x4*)(sp + 32 * half + 16 * s + 4) = (f32x4){p[8 * s + 4], p[8 * s + 5], p[8 * s + 6], p[8 * s + 7]}; }
        }
#endif
        asm volatile("s_waitcnt vmcnt(0)" ::: "memory");
        __syncthreads();
#ifndef B1_NO_TOPK
#pragma unroll 1
        for (int qq = 0; qq < 4 * B1_TOPK_REP; ++qq) {
            const int q = wid * 4 + (qq & 3);
            const float* srow = SCRb + (size_t)q * 4096 + lane;
            unsigned uu[64];
#pragma unroll
            for (int j = 0; j < 64; ++j) { unsigned key = 0u; if (j < ntile) { const float f = srow[j * 64] + 0.0f; const unsigned bts = __float_as_uint(f); key = bts ^ ((bts >> 31) ? 0xFFFFFFFFu : 0x80000000u); } uu[j] = key; }
            unsigned T = 1u;
            if (limit > 256) {
                unsigned prefix = 0u;
#pragma unroll 1
                for (int bit = 31; bit >= 0; --bit) {
                    const unsigned cand = prefix | (1u << bit); unsigned less = 0u;
#pragma unroll
                    for (int j = 0; j < 64; ++j) less += (uu[j] < cand) ? 1u : 0u;
                    const int cnt = 4096 - (int)wave_sum_u32(less);
                    if (cnt >= 256) prefix = cand;
                    if (cnt == 256) break;
                }
                T = prefix;
            }
            int ngt = 0;
#pragma unroll
            for (int j = 0; j < 64; ++j) ngt += __popcll(__ballot(uu[j] > T));
            const int need = (limit > 256) ? (256 - ngt) : 4096;
            int c = 0; unsigned long long myword = 0ull;
#pragma unroll
            for (int j = 0; j < 64; ++j) {
                const bool eq = (uu[j] == T); const unsigned long long eqm = __ballot(eq);
                const int below = __builtin_amdgcn_mbcnt_hi((unsigned)(eqm >> 32), __builtin_amdgcn_mbcnt_lo((unsigned)eqm, 0u));
                const bool sel = (uu[j] > T) || (eq && (c + below < need));
                const unsigned long long word = __ballot(sel);
                c += __popcll(eqm);
                if (lane == j) myword = word;
            }
            if (lane < ntile) MASK[(tok0 + q) * 64 + lane] = myword;
        }
#endif
        __syncthreads();
    }
}
__device__ __forceinline__ void attnB_phase(const bf16* Q, const bf16* K, const bf16* Vt, bf16* O, const unsigned long long* MASK, int vw, int nvw, int tid) {
    const int lane = tid & 63, r32 = lane & 31, hi = lane >> 5;
    for (int u = vw; u < NB * NH * 128; u += nvw) {
        int bh, qb; attn_unit_of(u, bh, qb); const int b = bh >> 4, h = bh & 15;
        const size_t qrow = (size_t)b * SEQ + qb * 32 + r32;
        bf16x8 qr[4]; load_q(qr, Q, qrow, h, hi);
        f32x16 o0 = (f32x16){}, o1 = (f32x16){}; float m = -1e30f, l = 0.f;
        const unsigned long long* mrow = MASK + qrow * 64;
        const int ntile = (qb >> 1) + 1;
        for (int kt = 0; kt < ntile; ++kt) {
            const size_t key0 = (size_t)b * SEQ + (size_t)kt * 64;
            const unsigned long long mw = mrow[kt];
            f32x16 p0, p1; qk_tile(p0, p1, K + h * HD, key0, DM, qr, r32, hi);
            const unsigned m0 = (unsigned)mw >> (8 * hi), m1 = (unsigned)(mw >> 32) >> (8 * hi);
#pragma unroll
            for (int r = 0; r < 16; ++r) { const int bit = 16 * (r >> 3) + (r & 7);
                p0[r] = ((m0 >> bit) & 1u) ? p0[r] : -INFINITY; p1[r] = ((m1 >> bit) & 1u) ? p1[r] : -INFINITY; }
            softmax_step(p0, p1, m, l, o0, o1);
            pv_tile(o0, o1, Vt + (size_t)h * HD * MTOK, key0, p0, p1, r32, hi);
        }
        l += __shfl_xor(l, 32);
        store_o(O, qrow, h, o0, o1, 1.0f / l, hi);
    }
}
__device__ __forceinline__ void conv_phase(const bf16* A, bf16* HM, const float* cw  , const float* cb  , int gtid, int ngt) {
    constexpr int CG = DFF / 8, RUN = 32, NRUN = MHALF / RUN;
    for (int it = gtid; it < CG * NRUN; it += ngt) {
        const int cgp = it % CG, run = it / CG, c0 = cgp * 8, r0 = run * RUN;
        float wg[3][8], wu[3][8], bg[8], bu[8];
#pragma unroll
        for (int i = 0; i < 8; ++i) { bg[i] = cb[c0 + i]; bu[i] = cb[DFF + c0 + i];
#pragma unroll
            for (int k = 0; k < 3; ++k) { wg[k][i] = cw[k * NFF2 + c0 + i]; wu[k][i] = cw[k * NFF2 + DFF + c0 + i]; } }
        float g1[8], g2[8], u1[8], u2[8];
        const bool seqstart = (r0 & (SEQ - 1)) == 0;
#pragma unroll
        for (int i = 0; i < 8; ++i) { g1[i] = g2[i] = u1[i] = u2[i] = 0.f; }
        if (!seqstart) {
            const u32x4 a1 = *(const u32x4*)(A + (size_t)(r0 - 1) * NFF2 + c0), a2 = *(const u32x4*)(A + (size_t)(r0 - 2) * NFF2 + c0);
            const u32x4 b1 = *(const u32x4*)(A + (size_t)(r0 - 1) * NFF2 + DFF + c0), b2 = *(const u32x4*)(A + (size_t)(r0 - 2) * NFF2 + DFF + c0);
#pragma unroll
            for (int i = 0; i < 4; ++i) { g1[2 * i] = __uint_as_float(a1[i] << 16); g1[2 * i + 1] = __uint_as_float(a1[i] & 0xFFFF0000u); g2[2 * i] = __uint_as_float(a2[i] << 16); g2[2 * i + 1] = __uint_as_float(a2[i] & 0xFFFF0000u);
                u1[2 * i] = __uint_as_float(b1[i] << 16); u1[2 * i + 1] = __uint_as_float(b1[i] & 0xFFFF0000u); u2[2 * i] = __uint_as_float(b2[i] << 16); u2[2 * i + 1] = __uint_as_float(b2[i] & 0xFFFF0000u); }
        }
        for (int r = r0; r < r0 + RUN; ++r) {
            const u32x4 a0 = *(const u32x4*)(A + (size_t)r * NFF2 + c0), b0 = *(const u32x4*)(A + (size_t)r * NFF2 + DFF + c0);
            float g0[8], u0[8], hm[8];
#pragma unroll
            for (int i = 0; i < 4; ++i) { g0[2 * i] = __uint_as_float(a0[i] << 16); g0[2 * i + 1] = __uint_as_float(a0[i] & 0xFFFF0000u); u0[2 * i] = __uint_as_float(b0[i] << 16); u0[2 * i + 1] = __uint_as_float(b0[i] & 0xFFFF0000u); }
#pragma unroll
            for (int i = 0; i < 8; ++i) { const float cgv = bg[i] + wg[0][i] * g2[i] + wg[1][i] * g1[i] + wg[2][i] * g0[i]; const float cuv = bu[i] + wu[0][i] * u2[i] + wu[1][i] * u1[i] + wu[2][i] * u0[i];
                hm[i] = cgv / (1.f + __expf(-cgv)) * cuv; g2[i] = g1[i]; g1[i] = g0[i]; u2[i] = u1[i]; u1[i] = u0[i]; }
            u32x4 o; o.x = cvtpk(hm[0], hm[1]); o.y = cvtpk(hm[2], hm[3]); o.z = cvtpk(hm[4], hm[5]); o.w = cvtpk(hm[6], hm[7]);
            *(u32x4*)(HM + (size_t)r * DFF + c0) = o;
        }
    }
}

__device__ __forceinline__ void ffn_fixup(const float* EF, const float* EL, const float* cw, const float* cb, bf16* HM, int gtid, int ngt) {
    for (int it = gtid; it < 128 * 2 * 704; it += ngt) {
        const int j = (it % 704) * 4, rr = (it / 704) & 1, pm = it / 1408;
        if ((pm & 15) == 0) continue;
        const int pg = (j >> 7) * 256 + (j & 127);
        f32x4 c[2];
#pragma unroll
        for (int bj = 0; bj < 2; ++bj) { const int pc = pg + 128 * bj, lc = j + DFF * bj;
            const f32x4 am2 = *(const f32x4*)(EL + ((size_t)(pm - 1) * 2 + 0) * NFF2 + pc), am1 = *(const f32x4*)(EL + ((size_t)(pm - 1) * 2 + 1) * NFF2 + pc);
            const f32x4 a0 = *(const f32x4*)(EF + ((size_t)pm * 2 + 0) * NFF2 + pc), a1 = *(const f32x4*)(EF + ((size_t)pm * 2 + 1) * NFF2 + pc);
            const f32x4 w0 = *(const f32x4*)(cw + lc), w1 = *(const f32x4*)(cw + NFF2 + lc), w2 = *(const f32x4*)(cw + 2 * NFF2 + lc), bb = *(const f32x4*)(cb + lc);
            c[bj] = rr == 0 ? (bb + w0 * am2 + w1 * am1 + w2 * a0) : (bb + w0 * am1 + w1 * a0 + w2 * a1); }
        float hm[4];
#pragma unroll
        for (int i = 0; i < 4; ++i) { const float g = c[0][i]; hm[i] = g * __builtin_amdgcn_rcpf(1.f + __builtin_amdgcn_exp2f(-LOG2E * g)) * c[1][i]; }
        u32x2 w; w.x = cvtpk(hm[0], hm[1]); w.y = cvtpk(hm[2], hm[3]);
        *(u32x2*)(HM + (size_t)(pm * 256 + rr) * DFF + j) = w;
    }
}

__device__ __forceinline__ void ffn_fixup_tile(const float* EF, const float* EL, const float* cw, const float* cb, bf16* HM, int pm, int tid) {
    if ((pm & 15) == 0) return;
    for (int it = tid; it < 2 * 704; it += NTHREADS) {
        const int j = (it % 704) * 4, rr = it / 704;
        const int pg = (j >> 7) * 256 + (j & 127);
        f32x4 c[2];
#pragma unroll
        for (int bj = 0; bj < 2; ++bj) { const int pc = pg + 128 * bj, lc = j + DFF * bj;
            const f32x4 am2 = *(const f32x4*)(EL + ((size_t)(pm - 1) * 2 + 0) * NFF2 + pc), am1 = *(const f32x4*)(EL + ((size_t)(pm - 1) * 2 + 1) * NFF2 + pc);
            const f32x4 a0 = *(const f32x4*)(EF + ((size_t)pm * 2 + 0) * NFF2 + pc), a1 = *(const f32x4*)(EF + ((size_t)pm * 2 + 1) * NFF2 + pc);
            const f32x4 w0 = *(const f32x4*)(cw + lc), w1 = *(const f32x4*)(cw + NFF2 + lc), w2 = *(const f32x4*)(cw + 2 * NFF2 + lc), bb = *(const f32x4*)(cb + lc);
            c[bj] = rr == 0 ? (bb + w0 * am2 + w1 * am1 + w2 * a0) : (bb + w0 * am1 + w1 * a0 + w2 * a1); }
        float hm[4];
#pragma unroll
        for (int i = 0; i < 4; ++i) { const float g = c[0][i]; hm[i] = g * __builtin_amdgcn_rcpf(1.f + __builtin_amdgcn_exp2f(-LOG2E * g)) * c[1][i]; }
        u32x2 w; w.x = cvtpk(hm[0], hm[1]); w.y = cvtpk(hm[2], hm[3]);
        *(u32x2*)(HM + (size_t)(pm * 256 + rr) * DFF + j) = w;
    }
}
constexpr int LDS_BYTES = 147456;
constexpr int ITEMS_PER_LAYER = 1024 + 384 + 512 + 512 + 2816 + 1408;
#ifdef FAKE_SYNC
#define GRID_SYNC() __syncthreads()
#else
#define GRID_SYNC() xcd_barrier(bar, wave)
#endif
#ifndef PROBE
#define PROBE 0
#endif
#define PROBE_REP(bit) (((PROBE) >> (bit)) & 1 ? 2 : 1)

__device__ __forceinline__ unsigned char* ws_launder(unsigned char* w) { asm volatile("" : "+s"(w)); return w; }
__global__ void __launch_bounds__(NTHREADS, 2) fwd_kernel(Params p) {
    extern __shared__ __attribute__((aligned(16))) unsigned char lds_raw[];
    LAS unsigned char* lds = (LAS unsigned char*)lds_raw;
    cg::grid_group grid = cg::this_grid();
    const int tid = threadIdx.x, lane = tid & 63, wave = __builtin_amdgcn_readfirstlane(tid >> 6);
    const int G = gridDim.x, bx = blockIdx.x, vcu = (G % 8 == 0) ? (bx % 8) * (G / 8) + bx / 8 : bx;
    const int gw = vcu * NWAVES + wave, ngw = G * NWAVES, gtid = vcu * NTHREADS + tid, ngt = G * NTHREADS;
    unsigned char* ws = p.ws;
    if (tid < 4) ((LAS unsigned*)(lds + 131072))[tid] = 0u;
    __syncthreads();
    const XcdBarrier bar = xcd_barrier_post((unsigned*)(ws + WS_CTL), (volatile LAS unsigned*)(lds + 131072));
#define FRESH_TID(v) int v = wave * 64 + lane_id(); asm volatile("" : "+v"(v))
#define WSL(T, off) ((T*)(ws_launder(ws) + (off)))
#define ROPE WSL(f32x2_t, WS_ROPE)
#define XN WSL(bf16, WS_XN)
#define QO WSL(bf16, WS_QO)
#define KB WSL(bf16, WS_K)
#define VT WSL(bf16, WS_VT)
#define QI WSL(bf16, WS_QI)
#define KI WSL(bf16, WS_KI)
#define WI WSL(float, WS_WI)
#define MASK WSL(unsigned long long, WS_MASK)
#define SSQ WSL(float, WS_SSQ)
#define OB WSL(bf16, WS_OB)
#define DUMMY1 p.out
#define DUMMY2 p.out
#define EF WSL(float, WS_EF)
#define EL WSL(float, WS_EL)
#define HM WSL(bf16, WS_HM)
#define SCR p.out
    LAS float* PART = (LAS float*)(lds + 131072 + 1024);
    {
        LAS float* scr = (LAS float*)(lds + wave * 16384);
        for (int it = gw; it < DEPTH * ITEMS_PER_LAYER; it += ngw) {
            const int l = it / ITEMS_PER_LAYER; int r = it % ITEMS_PER_LAYER; const int kind = l % 3, li = l / 3;
            unsigned char* wl = ws + WS_W + (size_t)l * W_LAYER;
            const float* wqkv = kind == 0 ? p.a_w_qkv + (size_t)li * DM * 3072 : (kind == 1 ? p.b_w_in : p.c_w_qkv);
            const int ldq = kind == 1 ? 3656 : 3072;
            const float* g1 = p.norm1_g + (size_t)l * DM; const float* g2 = p.norm2_g + (size_t)l * DM;
            const float* wo = kind == 0 ? p.a_w_o + (size_t)li * DM * DM : (kind == 1 ? p.b_w_o : p.c_w_o);
            if (r < 1024) { transpose_item(wqkv, DM, ldq, 0, 2048, (bf16*)(wl + WL_QK), 0, 1, g1, scr, r, lane); continue; } r -= 1024;
            if (r < 384) { if (kind == 1) transpose_item(wqkv, DM, ldq, 3072, 584, (bf16*)(wl + WL_QK), 2048, 1, g1, scr, r, lane); continue; } r -= 384;
            if (r < 512) { transpose_item(wqkv, DM, ldq, 2048, 1024, (bf16*)(wl + WL_V), 0, 0, g1, scr, r, lane); continue; } r -= 512;
            if (r < 512) { transpose_item(wo, DM, DM, 0, 1024, (bf16*)(wl + WL_O), 0, 0, nullptr, scr, r, lane); continue; } r -= 512;
            if (r < 2816) { transpose_item(p.ffn_w_in + (size_t)l * DM * NFF2, DM, NFF2, 0, NFF2, (bf16*)(wl + WL_IN), 0, 2, g2, scr, r, lane); continue; } r -= 2816;
            transpose_item(p.ffn_w_down + (size_t)l * DFF * DM, DFF, DM, 0, DM, (bf16*)(wl + WL_D), 0, 0, nullptr, scr, r, lane);
        }
        for (int i = gtid; i < SEQ * 32; i += ngt) {
            const int pos = i >> 5, x = i & 31;
            const float inv = exp2f(-(float)x * (13.287712379549449f / 32.0f));
            const float ang = (float)pos * inv;
            const double rev = (double)ang * 0.15915494309189535; const float fr = (float)(rev - floor(rev));
            ROPE[i] = (f32x2_t){__builtin_amdgcn_cosf(fr), __builtin_amdgcn_sinf(fr)};
        }
        for (int m = gw; m < MTOK; m += ngw) xb_row(p.x + (size_t)m * DM, XN + (size_t)m * DM, SSQ + (size_t)m * 4, lane);
    }
    grid.sync();

    for (int l = 0; l < DEPTH; ++l) {
        const int kind = l % 3, li = l / 3;
        unsigned char* wl = ws + WS_W + (size_t)l * W_LAYER;
        const bf16* WQK = (const bf16*)(wl + WL_QK); const bf16* WV = (const bf16*)(wl + WL_V); const bf16* WO = (const bf16*)(wl + WL_O);
        const bf16* WIN = (const bf16*)(wl + WL_IN); const bf16* WD = (const bf16*)(wl + WL_D);
        for (int rep_ = 0; rep_ < PROBE_REP(0); ++rep_) {
        {
            pg8::Gemm g{XN, WQK, MTOK, kind == 1 ? NQK_B : NQK_A, DM}; pg8::StaticOrder S; S.init(MTOK, g.N, G, bx);
            pg8::EpiQKV E{kind, QO, KB, QI, KI, WI, kind == 1 ? p.b_q_norm : p.a_q_norm + li * HD, kind == 1 ? p.b_k_norm : p.a_k_norm + li * HD, (const pg8::f32x2v*)ROPE, 0.125f * LOG2E, 0.35355339059327373f * 0.125f, SSQ};
#ifndef NO_QKV
            pg8::gemm_phase<pg8::EpiQKV, pg8::StaticOrder, true, true>(lds, g, S, E, wave);
#endif
        }
        {
            pg8::Gemm g{WV, XN, DM, MTOK, DM}; pg8::StaticOrder S; S.init(DM, MTOK, G, bx);
            pg8::EpiVt E{VT, VTP, SSQ};
            pg8::gemm_phase<pg8::EpiVt, pg8::StaticOrder, true, true>(lds, g, S, E, wave);
        }
        }
        GRID_SYNC();
#ifndef NO_A
        for (int rep_ = 0; rep_ < PROBE_REP(1); ++rep_)
        if (kind == 0) { FRESH_TID(t_); const float* gq_ = p.a_q_norm + li * HD; const float* gk_ = p.a_k_norm + li * HD; const float* rb_ = p.a_rel_bias + (size_t)li * NH * 513;
            float mq = 0.f, mk = 0.f, bmax = -1e30f, bmin = 1e30f;
            for (int i = 0; i < HD; ++i) { mq = fmaxf(mq, fabsf(gq_[i])); mk = fmaxf(mk, fabsf(gk_[i])); }
            for (int i = (t_ & 63); i < NH * 513; i += 64) { const float v = rb_[i] * LOG2E; bmax = fmaxf(bmax, v); bmin = fminf(bmin, v); }
#pragma unroll
            for (int o = 1; o < 64; o <<= 1) { bmax = fmaxf(bmax, __shfl_xor(bmax, o)); bmin = fminf(bmin, __shfl_xor(bmin, o)); }
            const float qk2 = 8.2f * mq * mk * LOG2E, ref = qk2 + bmax;
            if (__builtin_amdgcn_readfirstlane(ref - (bmin - qk2) <= 100.f ? 1 : 0)) attnA_blk<true>(QO, KB, VT, OB, rb_, ref, lds, vcu, G, t_);
            else attnA_blk<false>(QO, KB, VT, OB, rb_, 0.f, lds, vcu, G, t_); }
#endif
        if (kind == 1) {
#ifndef NO_B1
            for (int rep_ = 0; rep_ < PROBE_REP(2); ++rep_)
            { FRESH_TID(t_); b1_phase(QI, KI, WI, SCR + (size_t)bx * 32 * 4096, MASK, lds, vcu, G, t_); }
#endif
            GRID_SYNC();
#ifndef NO_B2
            for (int rep_ = 0; rep_ < PROBE_REP(3); ++rep_)
            { FRESH_TID(t_); float mq = 0.f, mk = 0.f;
              for (int i = 0; i < HD; ++i) { mq = fmaxf(mq, fabsf(p.b_q_norm[i])); mk = fmaxf(mk, fabsf(p.b_k_norm[i])); }
              const float ref = 8.2f * mq * mk * LOG2E;
              if (__builtin_amdgcn_readfirstlane(ref <= 50.f ? 1 : 0)) attnB_blk<true>(QO, KB, VT, OB, MASK, ref, lds, vcu, G, t_);
              else attnB_blk<false>(QO, KB, VT, OB, MASK, 0.f, lds, vcu, G, t_); }
#endif
        }
#ifndef NO_C
        for (int rep_ = 0; rep_ < PROBE_REP(4); ++rep_)
        if (kind == 2) { FRESH_TID(t_); attnC_blk(QO, KB, VT, OB, lds, vcu, G, t_); }
#endif
        GRID_SYNC();
        {
            pg8::Gemm g{OB, WO, MTOK, DM, DM}; pg8::StaticOrder S; S.init(MTOK, DM, G, bx);
            if (PROBE_REP(5) == 2) { pg8::EpiRes E0{l == 0 ? p.x : nullptr, XN, DUMMY1, DM, nullptr, SSQ, PART}; pg8::gemm_phase<pg8::EpiRes, pg8::StaticOrder, true, true>(lds, g, S, E0, wave); }
            pg8::EpiRes E{l == 0 ? p.x : nullptr, XN, nullptr, DM, XN, SSQ, PART};
            pg8::gemm_phase<pg8::EpiRes, pg8::StaticOrder, true, true>(lds, g, S, E, wave);
        }
        GRID_SYNC();
        {
            pg8::Gemm g{XN, WIN, MTOK, NFF2, DM}; pg8::StaticOrder S; S.init(MTOK, NFF2, G, bx);
            pg8::EpiFFN E{HM, p.ffn_conv_w + (size_t)l * 3 * NFF2, p.ffn_conv_b + (size_t)l * NFF2, EF, EL, (LAS pg8::f32x4*)(lds + 131072 + 1024), SSQ};
            for (int rep_ = 0; rep_ < PROBE_REP(7); ++rep_)
            pg8::gemm_phase<pg8::EpiFFN, pg8::StaticOrder, true, true>(lds, g, S, E, wave);
        }
        GRID_SYNC();
        {
            pg8::Gemm g{HM, WD, MTOK, DM, DFF}; pg8::StaticOrder S; S.init(MTOK, DM, G, bx);
            { FRESH_TID(t_); int lastpm = -1;
#pragma unroll 1
              for (int L = bx; L < 512; L += G) {
                  const int w_ = (L & 7) * 64 + (L >> 3), pm_ = (w_ >> 5) * 8 + (w_ & 7);
                  if (pm_ != lastpm) ffn_fixup_tile(EF, EL, p.ffn_conv_w + (size_t)l * 3 * NFF2, p.ffn_conv_b + (size_t)l * NFF2, HM, pm_, t_);
                  lastpm = pm_; }
              asm volatile("s_waitcnt vmcnt(0)" ::: "memory"); __syncthreads(); }
            if (PROBE_REP(9) == 2) { pg8::EpiRes E0{nullptr, XN, DUMMY2, DM, nullptr, SSQ, PART}; pg8::gemm_phase<pg8::EpiRes, pg8::StaticOrder, true, true>(lds, g, S, E0, wave); }
            pg8::EpiRes E{nullptr, XN, l + 1 == DEPTH ? p.out : nullptr, DM, l + 1 == DEPTH ? nullptr : XN, SSQ, PART};
            pg8::gemm_phase<pg8::EpiRes, pg8::StaticOrder, true, true>(lds, g, S, E, wave);
        }
        GRID_SYNC();
    }
}

extern "C" void kernel_launch(void* const* d_in, const int* in_sizes, int n_in, void* d_out, int out_size, void* d_ws, size_t ws_size, hipStream_t stream) {
    static int grid = 0;
    if (grid == 0) {
        if (n_in != 18 || out_size != MTOK * DM || ws_size < WS_END) { fprintf(stderr, "kernel_launch: unexpected shapes (n_in %d out %d ws %zu)\n", n_in, out_size, ws_size); grid = -1; return; }
        int dev = 0, cus = 0, per_cu = 0;
        hipGetDevice(&dev); hipDeviceGetAttribute(&cus, hipDeviceAttributeMultiprocessorCount, dev);
        hipFuncSetAttribute((const void*)fwd_kernel, hipFuncAttributeMaxDynamicSharedMemorySize, LDS_BYTES);
        hipOccupancyMaxActiveBlocksPerMultiprocessor(&per_cu, (const void*)fwd_kernel, NTHREADS, LDS_BYTES);
        if (per_cu < 1) { fprintf(stderr, "kernel_launch: occupancy query says %d blocks per CU\n", per_cu); per_cu = 1; }
        (void)hipGetLastError();
        grid = cus;
    }
    if (grid < 0) return;
    Params p{};
    const float** f = (const float**)&p;
    for (int i = 0; i < 18; ++i) f[i] = (const float*)d_in[i];
    p.out = (float*)d_out; p.ws = (unsigned char*)d_ws;
    if (hipMemsetAsync((char*)d_ws + WS_CTL, 0, CTL_BYTES, stream) != hipSuccess) { fprintf(stderr, "memset failed\n"); return; }
    void* args[] = {&p};
    hipError_t e = hipLaunchCooperativeKernel((const void*)fwd_kernel, dim3(grid), dim3(NTHREADS), args, LDS_BYTES, stream);
    if (e != hipSuccess) fprintf(stderr, "cooperative launch failed: %s (grid %d)\n", hipGetErrorString(e), grid);
}
```

```cpp
#include <hip/hip_runtime.h>
#include <hip/hip_cooperative_groups.h>
#include <cstdio>
#include <cstdint>
namespace cg = cooperative_groups;
namespace pg8 {
#define PG8_LAS __attribute__((address_space(3)))
typedef unsigned short bf16_t;
typedef short bf16x8 __attribute__((ext_vector_type(8)));
typedef float f32x4 __attribute__((ext_vector_type(4)));
typedef unsigned u32x4 __attribute__((ext_vector_type(4)));
constexpr int BM = 256, BK = 64, HALF = 128, HTB = HALF * BK * 2  , STAGE_BYTES = 8 * HTB, NXCD = 8, WGM = 8;

__host__ __device__ __forceinline__ int lds_byte(int r, int c) { const int st = (r >> 4) * 2 + (c >> 5), rr = r & 15, cc = c & 31, ob = rr * 64 + cc * 2; return st * 1024 + (ob ^ (((ob >> 9) & 1) << 5)); }
__host__ __device__ __forceinline__ void stage_rc(int b, int& R, int& C) { const int st = b / 1024, sb = b % 1024, swz = sb ^ (((sb >> 9) & 1) << 5); R = (st >> 1) * 16 + swz / 64; C = (st & 1) * 32 + (swz % 64) / 2; }
__host__ __device__ __forceinline__ int perm32(int rho) { const int n = rho >> 4, i = rho & 15; return 8 * (i >> 2) + 4 * n + (i & 3); }

struct Unit { int pm, pn; };
struct Gemm { const bf16_t* A; const bf16_t* Bt; int M, N, K; };

struct StaticOrder {
    int nM, nN, nwg, G, c;
    __host__ __device__ void init(int M, int N, int G_, int c_) { nM = M / BM; nN = N / BM; nwg = nM * nN; G = G_; c = c_; }
    __host__ __device__ bool next(int i, Unit& u) const {
        const long L = (long)i * G + c; if (L >= nwg) return false;
        int wgid = (int)L; { const int q = nwg / NXCD, r = nwg % NXCD, xcd = wgid % NXCD, off = wgid / NXCD; wgid = (xcd < r ? xcd * (q + 1) : r * (q + 1) + (xcd - r) * q) + off; }
        const int nig = WGM * nN, gid = wgid / nig, fm = gid * WGM, gsz = (nM - fm) < WGM ? (nM - fm) : WGM;
        u.pm = fm + ((wgid % nig) % gsz); u.pn = (wgid % nig) / gsz; return true;
    }
    __device__ __forceinline__ void a_ready(const Unit&) const {}
    __device__ __forceinline__ void done(const Unit&) const {}
};

__device__ __forceinline__ unsigned cvt_pk_bf16(float lo, float hi) { unsigned r; asm volatile("v_cvt_pk_bf16_f32 %0, %1, %2" : "=v"(r) : "v"(lo), "v"(hi)); return r; }
typedef float f32x2 __attribute__((ext_vector_type(2)));
typedef float f32x2v __attribute__((ext_vector_type(2)));
typedef unsigned u32x2v_t __attribute__((ext_vector_type(2)));
struct EpiBf16Plain {
    static constexpr bool PERM = true, AFTER_DRAIN = false;
    bf16_t* O; int ldc;
    __device__ __forceinline__ void operator()(const f32x4 (&acc)[2][2][4][2], const Unit& u, int wr, int wc, int fr, int fq) const {
        const int row0 = u.pm * BM + wr * 64 + fr; const int col0 = u.pn * BM + wc * 32 + 8 * fq;
#pragma unroll
        for (int ai = 0; ai < 2; ++ai)
#pragma unroll
            for (int m = 0; m < 4; ++m) { bf16_t* rowp = O + (size_t)(row0 + ai * HALF + m * 16) * ldc + col0;
#pragma unroll
                for (int bj = 0; bj < 2; ++bj) { const f32x4 v0 = acc[ai][bj][m][0], v1 = acc[ai][bj][m][1];
                    u32x4 w; w.x = cvt_pk_bf16(v0[0], v0[1]); w.y = cvt_pk_bf16(v0[2], v0[3]); w.z = cvt_pk_bf16(v1[0], v1[1]); w.w = cvt_pk_bf16(v1[2], v1[3]);
                    *(u32x4*)(rowp + bj * HALF) = w; } }
    }
};
__device__ __forceinline__ float rstd_of(const float* SSQ, size_t row) { const f32x4 s4 = *(const f32x4*)(SSQ + row * 4); return rsqrtf(((s4[0] + s4[1]) + (s4[2] + s4[3])) * (1.0f / 1024.0f) + 1e-6f); }
struct EpiRes {
    static constexpr bool PERM = true, AFTER_DRAIN = false;
    const float* base32; const bf16_t* base16; float* out32; int ldc; bf16_t* XB; float* SSQ; PG8_LAS float* part;
    __device__ __forceinline__ void operator()(const f32x4 (&acc)[2][2][4][2], const Unit& u, int wr, int wc, int fr_in, int fq_in) const {
        int fr = fr_in, fq = fq_in; asm volatile("" : "+v"(fr), "+v"(fq));
        const int col0 = u.pn * BM + wc * 32 + 8 * fq;
        u32x4 pre[2][4][2];
        if (!base32) {
#pragma unroll
            for (int ai = 0; ai < 2; ++ai)
#pragma unroll
                for (int m = 0; m < 4; ++m)
#pragma unroll
                    for (int bj = 0; bj < 2; ++bj) pre[ai][m][bj] = *(const u32x4*)(base16 + (size_t)(u.pm * BM + ai * HALF + wr * 64 + m * 16 + fr) * ldc + col0 + bj * HALF);
        }
#pragma unroll
        for (int ai = 0; ai < 2; ++ai)
#pragma unroll
            for (int m = 0; m < 4; ++m) { const int rl = ai * HALF + wr * 64 + m * 16 + fr; const size_t off = (size_t)(u.pm * BM + rl) * ldc + col0;
                float ss = 0.f;
#pragma unroll
                for (int bj = 0; bj < 2; ++bj) {
                    f32x4 b0, b1;
                    if (base32) { b0 = *(const f32x4*)(base32 + off + bj * HALF); b1 = *(const f32x4*)(base32 + off + bj * HALF + 4); }
                    else { const u32x4 r = pre[ai][m][bj];
                        b0 = (f32x4){__uint_as_float(r.x << 16), __uint_as_float(r.x & 0xFFFF0000u), __uint_as_float(r.y << 16), __uint_as_float(r.y & 0xFFFF0000u)};
                        b1 = (f32x4){__uint_as_float(r.z << 16), __uint_as_float(r.z & 0xFFFF0000u), __uint_as_float(r.w << 16), __uint_as_float(r.w & 0xFFFF0000u)}; }
                    const f32x4 v0 = b0 + acc[ai][bj][m][0], v1 = b1 + acc[ai][bj][m][1];
                    if (out32) { *(f32x4*)(out32 + off + bj * HALF) = v0; *(f32x4*)(out32 + off + bj * HALF + 4) = v1; }
                    if (XB) { u32x4 w; w.x = cvt_pk_bf16(v0[0], v0[1]); w.y = cvt_pk_bf16(v0[2], v0[3]); w.z = cvt_pk_bf16(v1[0], v1[1]); w.w = cvt_pk_bf16(v1[2], v1[3]); *(u32x4*)(XB + off + bj * HALF) = w;
                        const f32x4 q0 = (f32x4){__uint_as_float(w.x << 16), __uint_as_float(w.x & 0xFFFF0000u), __uint_as_float(w.y << 16), __uint_as_float(w.y & 0xFFFF0000u)};
                        const f32x4 q1 = (f32x4){__uint_as_float(w.z << 16), __uint_as_float(w.z & 0xFFFF0000u), __uint_as_float(w.w << 16), __uint_as_float(w.w & 0xFFFF0000u)};
                        ss += ((q0[0] * q0[0] + q0[1] * q0[1]) + (q0[2] * q0[2] + q0[3] * q0[3])) + ((q1[0] * q1[0] + q1[1] * q1[1]) + (q1[2] * q1[2] + q1[3] * q1[3])); } }
                ss += __shfl_xor(ss, 16); ss += __shfl_xor(ss, 32);
                if (fq == 0) part[rl * 4 + wc] = ss;
                if (base32 && (m & 1)) asm volatile("" ::: "memory"); }
        asm volatile("s_waitcnt lgkmcnt(0)" ::: "memory"); __builtin_amdgcn_s_barrier(); asm volatile("" ::: "memory");
        const int t = (wr * 4 + wc) * 64 + fq * 16 + fr;
        if (t < 256 && XB) { const f32x4 p4 = *(const PG8_LAS f32x4*)(part + t * 4); SSQ[(size_t)(u.pm * BM + t) * 4 + u.pn] = (p4[0] + p4[1]) + (p4[2] + p4[3]); }
    }
};
struct EpiVt {
    static constexpr bool PERM = true, AFTER_DRAIN = false;
    bf16_t* O; int ldc; const float* SSQ;
    __device__ __forceinline__ void operator()(const f32x4 (&acc)[2][2][4][2], const Unit& u, int wr, int wc, int fr_in, int fq_in) const {
        int fr = fr_in, fq = fq_in; asm volatile("" : "+v"(fr), "+v"(fq));
        const int row0 = u.pm * BM + wr * 64 + fr; const int col0 = u.pn * BM + wc * 32 + 8 * fq;
        float rs[2][8];
#pragma unroll
        for (int bj = 0; bj < 2; ++bj)
#pragma unroll
            for (int c = 0; c < 8; ++c) rs[bj][c] = rstd_of(SSQ, (size_t)(col0 + bj * HALF + c));
#pragma unroll
        for (int ai = 0; ai < 2; ++ai)
#pragma unroll
            for (int m = 0; m < 4; ++m) { bf16_t* rowp = O + (size_t)(row0 + ai * HALF + m * 16) * ldc + col0;
#pragma unroll
                for (int bj = 0; bj < 2; ++bj) { const f32x4 v0 = acc[ai][bj][m][0], v1 = acc[ai][bj][m][1];
                    u32x4 w; w.x = cvt_pk_bf16(v0[0] * rs[bj][0], v0[1] * rs[bj][1]); w.y = cvt_pk_bf16(v0[2] * rs[bj][2], v0[3] * rs[bj][3]); w.z = cvt_pk_bf16(v1[0] * rs[bj][4], v1[1] * rs[bj][5]); w.w = cvt_pk_bf16(v1[2] * rs[bj][6], v1[3] * rs[bj][7]);
                    *(u32x4*)(rowp + bj * HALF) = w; } }
    }
};
struct EpiQKV {
    static constexpr bool PERM = true, AFTER_DRAIN = false;
    int kind;
    bf16_t *Q, *K, *QI, *KI; float* WI;
    const float *gq, *gk; const f32x2v* rope; float qscale, wscale; const float* SSQ;
    __device__ __forceinline__ void operator()(const f32x4 (&acc)[2][2][4][2], const Unit& u, int wr, int wc, int fr_in, int fq_in) const {
        int fr = fr_in, fq = fq_in; asm volatile("" : "+v"(fr), "+v"(fq));
        const int hs = u.pn * 4 + wc;
        bf16_t* dst; int ld, col; bool donorm = false, dorope = false; const float* gain = gq; float sc = 1.f;
        if (hs < 16) { dst = Q; ld = 1024; col = hs * 64; donorm = (kind != 2); dorope = (kind == 1); gain = gq; sc = qscale; }
        else if (hs < 32) { dst = K; ld = 1024; col = (hs - 16) * 64; donorm = (kind != 2); dorope = (kind == 1); gain = gk; }
        else if (hs < 40) { dst = QI; ld = 512; col = (hs - 32) * 64; dorope = true; }
        else if (hs == 40) { dst = KI; ld = 64; col = 0; dorope = true; }
        else if (hs == 41) {
            if (fq == 0) {
#pragma unroll
                for (int ai = 0; ai < 2; ++ai)
#pragma unroll
                    for (int m = 0; m < 4; ++m) { const int row = u.pm * BM + ai * HALF + wr * 64 + m * 16 + fr;
                        const float rsw = rstd_of(SSQ, (size_t)row) * wscale; *(f32x4*)(WI + (size_t)row * 8) = acc[ai][0][m][0] * rsw; *(f32x4*)(WI + (size_t)row * 8 + 4) = acc[ai][0][m][1] * rsw; }
            }
            return;
        } else return;
        float g[2][2][4];
#pragma unroll
        for (int bj = 0; bj < 2; ++bj)
#pragma unroll
            for (int n = 0; n < 2; ++n)
#pragma unroll
                for (int i = 0; i < 4; ++i) g[bj][n][i] = donorm ? gain[32 * bj + 8 * fq + 4 * n + i] * sc : sc;
        f32x4 sq[2][4];
#pragma unroll
        for (int ai = 0; ai < 2; ++ai)
#pragma unroll
            for (int m = 0; m < 4; ++m) sq[ai][m] = *(const f32x4*)(SSQ + (size_t)(u.pm * BM + ai * HALF + wr * 64 + m * 16 + fr) * 4);
#pragma unroll
        for (int ai = 0; ai < 2; ++ai) {
#pragma unroll
          for (int mp = 0; mp < 4; ++mp) {
            f32x4 rp4[4][4];
            if (dorope) {
#pragma unroll
                for (int m = mp; m < mp + 1; ++m) { const f32x4* rp = (const f32x4*)(rope + (size_t)((u.pm * BM + ai * HALF + wr * 64 + m * 16 + fr) & 4095) * 32 + 8 * fq);
#pragma unroll
                    for (int k = 0; k < 4; ++k) rp4[m][k] = rp[k]; }
            }
#pragma unroll
            for (int m = mp; m < mp + 1; ++m) {
                const int row = u.pm * BM + ai * HALF + wr * 64 + m * 16 + fr;
                f32x4 v[2][2];
                const float rs0 = rsqrtf(((sq[ai][m][0] + sq[ai][m][1]) + (sq[ai][m][2] + sq[ai][m][3])) * (1.0f / 1024.0f) + 1e-6f);
#pragma unroll
                for (int bj = 0; bj < 2; ++bj)
#pragma unroll
                    for (int n = 0; n < 2; ++n) v[bj][n] = acc[ai][bj][m][n] * rs0;
                float r = 1.f;
                if (donorm) {
                    float ss = 0.f;
#pragma unroll
                    for (int bj = 0; bj < 2; ++bj)
#pragma unroll
                        for (int n = 0; n < 2; ++n) { const f32x4 x = v[bj][n]; ss += (x[0] * x[0] + x[1] * x[1]) + (x[2] * x[2] + x[3] * x[3]); }
                    ss += __shfl_xor(ss, 16); ss += __shfl_xor(ss, 32);
                    r = rsqrtf(ss * (1.0f / 64.0f) + 1e-6f);
                }
#pragma unroll
                for (int bj = 0; bj < 2; ++bj)
#pragma unroll
                    for (int n = 0; n < 2; ++n)
#pragma unroll
                        for (int i = 0; i < 4; ++i) v[bj][n][i] = v[bj][n][i] * r * g[bj][n][i];
                if (dorope) {
#pragma unroll
                    for (int n = 0; n < 2; ++n) { const f32x4 cs0 = rp4[m][2 * n], cs1 = rp4[m][2 * n + 1];
                        const float c_[4] = {cs0[0], cs0[2], cs1[0], cs1[2]}, s_[4] = {cs0[1], cs0[3], cs1[1], cs1[3]};
#pragma unroll
                        for (int i = 0; i < 4; ++i) { const float x1 = v[0][n][i], x2 = v[1][n][i]; v[0][n][i] = x1 * c_[i] - x2 * s_[i]; v[1][n][i] = x2 * c_[i] + x1 * s_[i]; } }
                }
                bf16_t* rowp = dst + (size_t)row * ld + col + 8 * fq;
#pragma unroll
                for (int bj = 0; bj < 2; ++bj) { u32x4 w; w.x = cvt_pk_bf16(v[bj][0][0], v[bj][0][1]); w.y = cvt_pk_bf16(v[bj][0][2], v[bj][0][3]); w.z = cvt_pk_bf16(v[bj][1][0], v[bj][1][1]); w.w = cvt_pk_bf16(v[bj][1][2], v[bj][1][3]);
                    *(u32x4*)(rowp + 32 * bj) = w; }
            }
            asm volatile("" ::: "memory");
          }
        }
    }
};
template <int CTRL, bool BC> __device__ __forceinline__ float pg8_dpp(float x) { return __int_as_float(__builtin_amdgcn_update_dpp(0, __float_as_int(x), CTRL, 0xf, 0xf, BC)); }
struct EpiFFN {
    static constexpr bool PERM = true, AFTER_DRAIN = false;
    bf16_t* HM; const float* cw; const float* cb; float* EF; float* EL; PG8_LAS f32x4* halo; const float* SSQ;
    __device__ __forceinline__ void operator()(const f32x4 (&acc_)[2][2][4][2], const Unit& u, int wr, int wc, int fr_in, int fq_in) const {
        int fr = fr_in, fq = fq_in; asm volatile("" : "+v"(fr), "+v"(fq));
        f32x4 (&acc)[2][2][4][2] = const_cast<f32x4 (&)[2][2][4][2]>(acc_);
        f32x4 Wn[2][4];
        { const int jc0 = u.pn * 128 + wc * 32 + 8 * fq;
#pragma unroll
          for (int bj = 0; bj < 2; ++bj) { const float* wp = cw + bj * 2816 + jc0;
              Wn[bj][0] = *(const f32x4*)(wp); Wn[bj][1] = *(const f32x4*)(wp + 5632); Wn[bj][2] = *(const f32x4*)(wp + 2 * 5632); Wn[bj][3] = *(const f32x4*)(cb + bj * 2816 + jc0); } }
#pragma unroll
        for (int ai = 0; ai < 2; ++ai)
#pragma unroll
            for (int m = 0; m < 4; ++m) { const float rs0 = rstd_of(SSQ, (size_t)(u.pm * BM + ai * HALF + wr * 64 + m * 16 + fr));
#pragma unroll
                for (int bj = 0; bj < 2; ++bj)
#pragma unroll
                    for (int n = 0; n < 2; ++n) acc[ai][bj][m][n] = acc[ai][bj][m][n] * rs0; }
        const int pcol = u.pn * 256 + wc * 32 + 8 * fq, jcol = u.pn * 128 + wc * 32 + 8 * fq;
        if (fr >= 14) {
            const int rr = fr - 14;
#pragma unroll
            for (int ai = 0; ai < 2; ++ai)
#pragma unroll
                for (int bj = 0; bj < 2; ++bj)
#pragma unroll
                    for (int n = 0; n < 2; ++n) halo[(((((ai * 2 + wr) * 2 + rr) * 4 + wc) * 2 + bj) * 4 + fq) * 2 + n] = acc[ai][bj][3][n];
            if (wr == 1) { float* e = EL + ((size_t)u.pm * 2 + rr) * 5632 + pcol;
#pragma unroll
                for (int bj = 0; bj < 2; ++bj)
#pragma unroll
                    for (int n = 0; n < 2; ++n) *(f32x4*)(e + bj * 128 + n * 4) = acc[1][bj][3][n]; }
        }
        if (wr == 0 && fr < 2) { float* e = EF + ((size_t)u.pm * 2 + fr) * 5632 + pcol;
#pragma unroll
            for (int bj = 0; bj < 2; ++bj)
#pragma unroll
                for (int n = 0; n < 2; ++n) *(f32x4*)(e + bj * 128 + n * 4) = acc[0][bj][0][n]; }
        asm volatile("s_waitcnt lgkmcnt(0)" ::: "memory"); __builtin_amdgcn_s_barrier(); asm volatile("" ::: "memory");
#pragma unroll
        for (int n = 0; n < 2; ++n) {
            f32x4 W0[2], W1[2], W2[2], Bb[2], W0m[2], W1m[2];
#pragma unroll
            for (int bj = 0; bj < 2; ++bj) { const float* wp = cw + bj * 2816 + jcol + 4 * n;
                if (n == 0) { W0[bj] = Wn[bj][0]; W1[bj] = Wn[bj][1]; W2[bj] = Wn[bj][2]; Bb[bj] = Wn[bj][3]; }
                else { W0[bj] = *(const f32x4*)(wp); W1[bj] = *(const f32x4*)(wp + 5632); W2[bj] = *(const f32x4*)(wp + 2 * 5632); Bb[bj] = *(const f32x4*)(cb + bj * 2816 + jcol + 4 * n); }
                W1m[bj] = fr == 0 ? W1[bj] : (f32x4){0.f, 0.f, 0.f, 0.f}; W0m[bj] = fr < 2 ? W0[bj] : (f32x4){0.f, 0.f, 0.f, 0.f}; }
#pragma unroll
            for (int ai = 0; ai < 2; ++ai)
#pragma unroll
                for (int m = 0; m < 4; ++m) {
                    f32x4 c[2];
#pragma unroll
                    for (int bj = 0; bj < 2; ++bj) {
                        const f32x4 a = acc[ai][bj][m][n];
                        f32x4 t1, t2;
                        if (m > 0) { const f32x4 ap = acc[ai][bj][m - 1][n];
#pragma unroll
                            for (int i = 0; i < 4; ++i) { const float apx = ap[i]; t1[i] = pg8_dpp<0x121, false>(apx); t2[i] = pg8_dpp<0x122, false>(apx); }
                        } else {
                            t1 = (f32x4){0.f, 0.f, 0.f, 0.f}; t2 = t1;
                            const int sa = (wr == 1) ? ai : 0, sw = (wr == 1) ? 0 : 1;
                            if ((wr == 1 || ai == 1) && fr < 2) {
                                const f32x4 h0 = halo[(((((sa * 2 + sw) * 2 + 0) * 4 + wc) * 2 + bj) * 4 + fq) * 2 + n], h1 = halo[(((((sa * 2 + sw) * 2 + 1) * 4 + wc) * 2 + bj) * 4 + fq) * 2 + n];
                                t1 = h1; t2 = (fr == 0) ? h0 : h1;
                            }
                        }
#pragma unroll
                        for (int i = 0; i < 4; ++i) {
                            const float ax = a[i];
                            float v = __builtin_fmaf(W2[bj][i], ax, Bb[bj][i]);
                            v = __builtin_fmaf(pg8_dpp<0x111, true>(ax), W1[bj][i], v);
                            v = __builtin_fmaf(pg8_dpp<0x112, true>(ax), W0[bj][i], v);
                            v = __builtin_fmaf(t1[i], W1m[bj][i], v);
                            v = __builtin_fmaf(t2[i], W0m[bj][i], v);
                            c[bj][i] = v;
                        }
                    }
                    float hm[4];
#pragma unroll
                    for (int i = 0; i < 4; ++i) { const float g = c[0][i]; hm[i] = g * __builtin_amdgcn_rcpf(1.f + __builtin_amdgcn_exp2f(-1.4426950408889634f * g)) * c[1][i]; }
                    u32x2v_t w; w.x = cvt_pk_bf16(hm[0], hm[1]); w.y = cvt_pk_bf16(hm[2], hm[3]);
                    *(u32x2v_t*)(HM + (size_t)(u.pm * BM + ai * HALF + wr * 64 + m * 16 + fr) * 2816 + jcol + 4 * n) = w;
                }
        }
    }
};
template <class Epi, class Sched, bool ALIGN_EPI = false, bool SP2 = false>
__device__ __forceinline__ void gemm_phase(PG8_LAS unsigned char* lds, const Gemm g, const Sched& S, const Epi& E, const int wave_s) {
    unsigned ones_l = ~0u; asm volatile("" : "+s"(ones_l)); int tid_l = wave_s * 64 + (int)__builtin_amdgcn_mbcnt_hi(ones_l, __builtin_amdgcn_mbcnt_lo(ones_l, 0u)); asm volatile("" : "+v"(tid_l));
    const int tid = tid_l, wid = __builtin_amdgcn_readfirstlane(tid >> 6), lane = tid & 63, wr = wid >> 2, wc = wid & 3, fr = lane & 15, fq = lane >> 4;
    const int K = g.K, nt = K / BK;
    unsigned voffA[2], voffB[2];
#pragma unroll
    for (int i = 0; i < 2; ++i) { int R, C; stage_rc(tid * 16 + i * 8192, R, C); const int Rb = Epi::PERM ? ((R & ~31) + perm32(R & 31)) : R;
        voffA[i] = (unsigned)(R * K + C) * 2u; voffB[i] = (unsigned)(Rb * K + C) * 2u; }
    const size_t kstep = (size_t)(BK * 2);
    const size_t hstep = (size_t)HALF * K * 2;
    const size_t tstep = 2 * hstep;
    const unsigned ldsw = (unsigned)wid * 1024u;
    const int aoff = lds_byte(wr * 64 + fr, fq * 8), boff = lds_byte(wc * 32 + fr, fq * 8);
#define PG8_SA(b, h) (((b) * 2 + (h)) * HTB)
#define PG8_SB(b, h) ((4 + (b) * 2 + (h)) * HTB)
#define PG8_STAGE(bufoff, gbase, voff) do { _Pragma("unroll") for (int _i = 0; _i < 2; ++_i) \
        __builtin_amdgcn_global_load_lds((const unsigned*)((const char*)(gbase) + (voff)[_i]), (PG8_LAS unsigned*)(lds + (bufoff) + ldsw + _i * 8192), 16, 0, 0); } while (0)
#define PG8_LDA(dst, b, h) do { _Pragma("unroll") for (int m = 0; m < 4; ++m) _Pragma("unroll") for (int k = 0; k < 2; ++k) dst[m][k] = *(const PG8_LAS bf16x8*)(lds + PG8_SA(b, h) + aoff + m * 2048 + k * 1024); } while (0)
#define PG8_LDB(dst, b, h) do { _Pragma("unroll") for (int n = 0; n < 2; ++n) _Pragma("unroll") for (int k = 0; k < 2; ++k) dst[n][k] = *(const PG8_LAS bf16x8*)(lds + PG8_SB(b, h) + boff + n * 2048 + k * 1024); } while (0)
#define PG8_MMA(ai, bj, At, Bt) do { __builtin_amdgcn_s_setprio(1); _Pragma("unroll") for (int m = 0; m < 4; ++m) _Pragma("unroll") for (int n = 0; n < 2; ++n) _Pragma("unroll") for (int k = 0; k < 2; ++k) \
        acc[ai][bj][m][n] = __builtin_amdgcn_mfma_f32_16x16x32_bf16(Bt[n][k], At[m][k], acc[ai][bj][m][n], 0, 0, 0); __builtin_amdgcn_s_setprio(0); } while (0)
#define PG8_WAIT_V(n) asm volatile("s_waitcnt vmcnt(" #n ")" ::: "memory")
#define PG8_WAIT_L(n) asm volatile("s_waitcnt lgkmcnt(" #n ")" ::: "memory")
#define PG8_BAR __builtin_amdgcn_s_barrier()
#define PG8_SCHED __builtin_amdgcn_sched_barrier(0)
    Unit cur, nxt; int ui = 0;
    if (!S.next(0, cur)) return;
    f32x4 acc[2][2][4][2];
#pragma unroll
    for (int a = 0; a < 2; ++a)
#pragma unroll
        for (int b = 0; b < 2; ++b)
#pragma unroll
            for (int m = 0; m < 4; ++m)
#pragma unroll
                for (int n = 0; n < 2; ++n) acc[a][b][m][n] = (f32x4){0.f, 0.f, 0.f, 0.f};
    bf16x8 At[4][2], B0[2][2], B1[2][2];
    const char* cA = (const char*)g.A + (size_t)cur.pm * tstep; const char* cB = (const char*)g.Bt + (size_t)cur.pn * tstep;
    S.a_ready(cur);
    if constexpr (SP2) {
        PG8_STAGE(PG8_SB(0, 0), cB, voffB); PG8_STAGE(PG8_SB(0, 1), cB + hstep, voffB); PG8_STAGE(PG8_SA(0, 0), cA, voffA); PG8_STAGE(PG8_SA(0, 1), cA + hstep, voffA);
        if (wr == 1) PG8_BAR;
        PG8_WAIT_V(2); PG8_BAR;
        PG8_STAGE(PG8_SB(1, 0), cB + kstep, voffB); PG8_STAGE(PG8_SA(1, 0), cA + kstep, voffA); PG8_STAGE(PG8_SB(1, 1), cB + hstep + kstep, voffB);
        PG8_WAIT_V(6); PG8_BAR;
    } else {
        PG8_STAGE(PG8_SB(0, 0), cB, voffB); PG8_STAGE(PG8_SA(0, 0), cA, voffA); PG8_STAGE(PG8_SB(0, 1), cB + hstep, voffB); PG8_STAGE(PG8_SA(0, 1), cA + hstep, voffA);
        if (wr == 1) PG8_BAR;
        PG8_WAIT_V(4); PG8_BAR;
        PG8_STAGE(PG8_SB(1, 0), cB + kstep, voffB); PG8_STAGE(PG8_SA(1, 0), cA + kstep, voffA); PG8_STAGE(PG8_SB(1, 1), cB + hstep + kstep, voffB);
        PG8_WAIT_V(6); PG8_BAR;
    }
    for (;;) {
        const bool has_next = S.next(ui + 1, nxt);
        const char* nA = has_next ? (const char*)g.A + (size_t)nxt.pm * tstep : cA; const char* nB = has_next ? (const char*)g.Bt + (size_t)nxt.pn * tstep : cB;
        for (int t = 0; t < nt; t += 2) {
            const bool last = (t == nt - 2);
            const char* a1 = cA + (size_t)(t + 1) * kstep;
            const char* a2 = last ? nA : cA + (size_t)(t + 2) * kstep; const char* b2 = last ? nB : cB + (size_t)(t + 2) * kstep;
            const char* a3 = a2 + kstep; const char* b3 = b2 + kstep;
            if (last && has_next) S.a_ready(nxt);
            if constexpr (SP2) {
            PG8_LDB(B0, 0, 0); PG8_LDB(B1, 0, 1); PG8_SCHED; PG8_LDA(At, 0, 0); PG8_STAGE(PG8_SA(1, 1), a1 + hstep, voffA);
            PG8_WAIT_V(8); PG8_WAIT_L(0); PG8_BAR; PG8_MMA(0, 0, At, B0); PG8_MMA(0, 1, At, B1); PG8_BAR; PG8_SCHED;
            PG8_LDA(At, 0, 1); PG8_STAGE(PG8_SB(0, 0), b2, voffB); PG8_STAGE(PG8_SB(0, 1), b2 + hstep, voffB); PG8_STAGE(PG8_SA(0, 0), a2, voffA);
            PG8_WAIT_V(8); PG8_WAIT_L(0); PG8_BAR; PG8_MMA(1, 0, At, B0); PG8_MMA(1, 1, At, B1); PG8_BAR; PG8_SCHED;
            PG8_LDB(B0, 1, 0); PG8_LDB(B1, 1, 1); PG8_SCHED; PG8_LDA(At, 1, 0); PG8_STAGE(PG8_SA(0, 1), a2 + hstep, voffA);
            PG8_WAIT_V(8); PG8_WAIT_L(0); PG8_BAR; PG8_MMA(0, 0, At, B0); PG8_MMA(0, 1, At, B1); PG8_BAR; PG8_SCHED;
            PG8_LDA(At, 1, 1); PG8_STAGE(PG8_SB(1, 0), b3, voffB); PG8_STAGE(PG8_SB(1, 1), b3 + hstep, voffB); PG8_STAGE(PG8_SA(1, 0), a3, voffA);
            PG8_WAIT_V(8); PG8_WAIT_L(0); PG8_BAR; PG8_MMA(1, 0, At, B0); PG8_MMA(1, 1, At, B1); PG8_BAR; PG8_SCHED;
            } else {
            PG8_LDB(B0, 0, 0); PG8_SCHED; PG8_LDA(At, 0, 0); PG8_STAGE(PG8_SA(1, 1), a1 + hstep, voffA);
            PG8_WAIT_L(8); PG8_BAR; PG8_WAIT_L(0); PG8_MMA(0, 0, At, B0); PG8_BAR; PG8_SCHED;
            PG8_LDB(B1, 0, 1); PG8_STAGE(PG8_SB(0, 0), b2, voffB);
            PG8_BAR; PG8_WAIT_L(0); PG8_MMA(0, 1, At, B1); PG8_BAR;
            PG8_LDA(At, 0, 1); PG8_STAGE(PG8_SA(0, 0), a2, voffA);
            PG8_BAR; PG8_WAIT_L(0); PG8_MMA(1, 0, At, B0); PG8_BAR; PG8_SCHED;
            PG8_STAGE(PG8_SB(0, 1), b2 + hstep, voffB);
            PG8_WAIT_V(6); PG8_BAR; PG8_MMA(1, 1, At, B1); PG8_BAR;
            PG8_LDB(B0, 1, 0); PG8_SCHED; PG8_LDA(At, 1, 0); PG8_STAGE(PG8_SA(0, 1), a2 + hstep, voffA);
            PG8_WAIT_L(8); PG8_BAR; PG8_WAIT_L(0); PG8_MMA(0, 0, At, B0); PG8_BAR; PG8_SCHED;
            PG8_LDB(B1, 1, 1); PG8_STAGE(PG8_SB(1, 0), b3, voffB);
            PG8_BAR; PG8_WAIT_L(0); PG8_MMA(0, 1, At, B1); PG8_BAR;
            PG8_LDA(At, 1, 1); PG8_STAGE(PG8_SA(1, 0), a3, voffA);
            PG8_BAR; PG8_WAIT_L(0); PG8_MMA(1, 0, At, B0); PG8_BAR; PG8_SCHED;
            PG8_STAGE(PG8_SB(1, 1), b3 + hstep, voffB);
            PG8_WAIT_V(6); PG8_BAR; PG8_MMA(1, 1, At, B1); PG8_BAR;
            }
        }
        if constexpr (ALIGN_EPI) { if (wr == 0) PG8_BAR; }
        if constexpr (!Epi::AFTER_DRAIN) { E(acc, cur, wr, wc, fr, fq); S.done(cur); }
        if (!has_next) break;
#pragma unroll
        for (int a = 0; a < 2; ++a)
#pragma unroll
            for (int b = 0; b < 2; ++b)
#pragma unroll
                for (int m = 0; m < 4; ++m)
#pragma unroll
                    for (int n = 0; n < 2; ++n) acc[a][b][m][n] = (f32x4){0.f, 0.f, 0.f, 0.f};
        cur = nxt; cA = nA; cB = nB; ++ui;
        if constexpr (ALIGN_EPI) { if (wr == 1) PG8_BAR; }
    }
    PG8_WAIT_V(0);
    if constexpr (!ALIGN_EPI) { if (wr == 0) PG8_BAR; }
    PG8_BAR;
    if constexpr (Epi::AFTER_DRAIN) { E.fused(acc, cur, wr, wc, fr, fq, lds, wid, lane); S.done(cur); }
#undef PG8_SA
#undef PG8_SB
#undef PG8_STAGE
#undef PG8_LDA
#undef PG8_LDB
#undef PG8_MMA
#undef PG8_WAIT_V
#undef PG8_WAIT_L
#undef PG8_BAR
#undef PG8_SCHED
}
}
constexpr int SEQ = 4096, NB = 8, DM = 1024, NH = 16, HD = 64, MTOK = NB * SEQ, DFF = 2816, NFF2 = 2 * DFF, DEPTH = 4;
constexpr int NQK_A = 2048, NQK_B = 2816;
constexpr int MHALF = MTOK / 2;
constexpr int VTP = MTOK + 2048 + 128;
constexpr int NTHREADS = 512, NWAVES = 8;
constexpr float LOG2E = 1.4426950408889634f;
constexpr size_t MiB = 1u << 20;
constexpr size_t WS_CTL = 0, CTL_BYTES = 64 * 1024;
constexpr size_t WS_ROPE = 1 * MiB;
constexpr size_t WS_SSQ = 128 * 1024;
constexpr size_t WS_W = 2 * MiB, W_LAYER = 26 * MiB, WL_QK = 0, WL_V = 5632 * 1024, WL_O = WL_V + 2 * MiB, WL_IN = WL_O + 2 * MiB, WL_D = WL_IN + 11 * MiB;
constexpr size_t WS_XN = 106 * MiB, WS_OB = 170 * MiB, WS_SCR = WS_XN;
constexpr size_t WS_QO = 234 * MiB, WS_K = 298 * MiB, WS_VT = 362 * MiB, WS_QI = 431 * MiB, WS_KI = 463 * MiB, WS_WI = 467 * MiB, WS_MASK = 468 * MiB;
constexpr size_t WS_HM = 234 * MiB, WS_EF = 410 * MiB, WS_EL = 416 * MiB, WS_END = 498 * MiB;
static_assert(WL_D + (size_t)DM * DFF * 2 <= W_LAYER, "weights per layer");
static_assert(WS_VT + (size_t)DM * VTP * 2 <= WS_QI && WS_W + DEPTH * W_LAYER <= WS_XN && WS_MASK + 16 * MiB <= WS_END && WS_HM + (size_t)MTOK * DFF * 2 <= WS_EF && WS_EF + (size_t)256 * NFF2 * 4 <= WS_EL && WS_EL + (size_t)256 * NFF2 * 4 <= WS_END, "ws map");

#define LAS __attribute__((address_space(3)))
typedef unsigned short bf16;
typedef short bf16x8 __attribute__((ext_vector_type(8)));
typedef float f32x4 __attribute__((ext_vector_type(4)));
typedef float f32x16 __attribute__((ext_vector_type(16)));
typedef unsigned u32x4 __attribute__((ext_vector_type(4)));
typedef unsigned u32x2 __attribute__((ext_vector_type(2)));
typedef float f32x2_t __attribute__((ext_vector_type(2))); typedef __bf16 bf16x2_t __attribute__((ext_vector_type(2)));
__device__ __forceinline__ unsigned cvtpk(float lo, float hi) { f32x2_t v = {lo, hi}; bf16x2_t b = __builtin_convertvector(v, bf16x2_t); return __builtin_bit_cast(unsigned, b); }
__device__ __forceinline__ float bf2f(unsigned short h) { return __uint_as_float((unsigned)h << 16); }
__device__ __forceinline__ float wave_sum(float v) {
#pragma unroll
    for (int o = 1; o < 64; o <<= 1) v += __shfl_xor(v, o);
    return v;
}
__device__ __forceinline__ unsigned wave_sum_u32(unsigned v) {
    v += (unsigned)__builtin_amdgcn_update_dpp(0, (int)v, 0x111, 0xf, 0xf, true);
    v += (unsigned)__builtin_amdgcn_update_dpp(0, (int)v, 0x112, 0xf, 0xf, true);
    v += (unsigned)__builtin_amdgcn_update_dpp(0, (int)v, 0x114, 0xf, 0xf, true);
    v += (unsigned)__builtin_amdgcn_update_dpp(0, (int)v, 0x118, 0xf, 0xf, true);
    v += (unsigned)__builtin_amdgcn_update_dpp(0, (int)v, 0x142, 0xa, 0xf, true);
    v += (unsigned)__builtin_amdgcn_update_dpp(0, (int)v, 0x143, 0xc, 0xf, true);
    return (unsigned)__builtin_amdgcn_readlane((int)v, 63);
}
__device__ __forceinline__ int lane_id() { unsigned ones = ~0u; asm volatile("" : "+s"(ones)); return (int)__builtin_amdgcn_mbcnt_hi(ones, __builtin_amdgcn_mbcnt_lo(ones, 0u)); }
__device__ __forceinline__ int pi_row(int i) { return (i & ~12) | ((i & 4) << 1) | ((i & 8) >> 1); }

struct Params {
    const float* x; const float* norm1_g; const float* norm2_g;
    const float* a_w_qkv; const float* a_q_norm; const float* a_k_norm; const float* a_rel_bias; const float* a_w_o;
    const float* b_w_in; const float* b_q_norm; const float* b_k_norm; const float* b_w_o;
    const float* c_w_qkv; const float* c_w_o;
    const float* ffn_w_in; const float* ffn_conv_w; const float* ffn_conv_b; const float* ffn_w_down;
    float* out; unsigned char* ws;
};

__device__ __forceinline__ void transpose_item(const float* W, int K, int ldw, int src_col0, int nvalid, bf16* WT, int dst_row0, int perm, const float* gk, LAS float* scr, int item, int lane) {
    const int kblks = K / 64, nb = item / kblks, kb = item % kblks, k0 = 64 * kb, n0 = 32 * nb;
    const int nn = n0 + (lane & 31); const bool ok = nn < nvalid;
    float wv[32];
#pragma unroll
    for (int i = 0; i < 32; ++i) { const int kk = 2 * i + (lane >> 5); wv[i] = ok ? W[(size_t)(k0 + kk) * ldw + src_col0 + nn] : 0.f; }
    if (gk) {
#pragma unroll
        for (int i = 0; i < 32; ++i) wv[i] *= gk[k0 + 2 * i + (lane >> 5)];
    }
#pragma unroll
    for (int i = 0; i < 32; ++i) { const int kk = 2 * i + (lane >> 5); scr[kk * 33 + (lane & 31)] = wv[i]; }
    asm volatile("s_waitcnt lgkmcnt(0)" ::: "memory");
    int L = dst_row0 + n0;
    if (perm == 1) { const int l = L & 255; L = (L & ~255) | (((l >> 5) & 1) * 128 + (l >> 6) * 32); }
    else if (perm == 2) { const int hb = L >= DFF ? 1 : 0, c = L - hb * DFF; L = (c >> 7) * 256 + hb * 128 + (c & 127); }
    const int c = lane & 7;
#pragma unroll
    for (int j = 0; j < 4; ++j) { const int n = (lane >> 3) + 8 * j; const LAS float* s = scr + (8 * c) * 33 + n;
        u32x4 o; o.x = cvtpk(s[0 * 33], s[1 * 33]); o.y = cvtpk(s[2 * 33], s[3 * 33]); o.z = cvtpk(s[4 * 33], s[5 * 33]); o.w = cvtpk(s[6 * 33], s[7 * 33]);
        *(u32x4*)(WT + (size_t)(L + n) * K + k0 + 8 * c) = o; }
    asm volatile("s_waitcnt lgkmcnt(0)" ::: "memory");
}
__device__ __forceinline__ void rms_row_to_bf16(const float* xrow, const float* g, bf16* orow, int lane) {
    const f32x4* xr = (const f32x4*)xrow + lane; const f32x4* gr = (const f32x4*)g + lane;
    f32x4 v[4]; float s = 0.f;
#pragma unroll
    for (int j = 0; j < 4; ++j) { v[j] = xr[64 * j]; s += (v[j].x * v[j].x + v[j].y * v[j].y) + (v[j].z * v[j].z + v[j].w * v[j].w); }
    const float rstd = rsqrtf(wave_sum(s) * (1.f / DM) + 1e-6f);
    u32x2* o8 = (u32x2*)orow + lane;
#pragma unroll
    for (int j = 0; j < 4; ++j) { const f32x4 gg = gr[64 * j]; u32x2 w; w.x = cvtpk(v[j].x * rstd * gg.x, v[j].y * rstd * gg.y); w.y = cvtpk(v[j].z * rstd * gg.z, v[j].w * rstd * gg.w); o8[64 * j] = w; }
}
__device__ __forceinline__ void xb_row(const float* xrow, bf16* orow, float* ssq4, int lane) {
    const f32x4* xr = (const f32x4*)xrow + lane;
    f32x4 v[4]; float s = 0.f;
#pragma unroll
    for (int j = 0; j < 4; ++j) { v[j] = xr[64 * j]; s += (v[j].x * v[j].x + v[j].y * v[j].y) + (v[j].z * v[j].z + v[j].w * v[j].w); }
    s = wave_sum(s);
    u32x2* o8 = (u32x2*)orow + lane;
#pragma unroll
    for (int j = 0; j < 4; ++j) { u32x2 w; w.x = cvtpk(v[j].x, v[j].y); w.y = cvtpk(v[j].z, v[j].w); o8[64 * j] = w; }
    if (lane == 0) *(f32x4*)ssq4 = (f32x4){s, 0.f, 0.f, 0.f};
}
__device__ __forceinline__ void norm_phase(const float* X, const float* g, bf16* XN, int gw, int ngw, int lane) {
    for (int m = gw; m < MTOK; m += ngw) rms_row_to_bf16(X + (size_t)m * DM, g, XN + (size_t)m * DM, lane);
}

#define MFMA32(a, b, c) __builtin_amdgcn_mfma_f32_32x32x16_bf16((a), (b), (c), 0, 0, 0)
__device__ __forceinline__ void qk_tile(f32x16& p0, f32x16& p1, const bf16* Kh  , size_t key0, int kpitch, const bf16x8 (&qr)[4], int r32, int hi) {
    const bf16* kp = Kh + (key0 + pi_row(r32)) * (size_t)kpitch + hi * 8;
    p0 = (f32x16){}; p1 = (f32x16){};
#pragma unroll
    for (int d0 = 0; d0 < 4; ++d0) {
        const bf16x8 k0 = *(const bf16x8*)(kp + d0 * 16), k1 = *(const bf16x8*)(kp + (size_t)32 * kpitch + d0 * 16);
        p0 = MFMA32(k0, qr[d0], p0); p1 = MFMA32(k1, qr[d0], p1);
    }
}
__device__ __forceinline__ void pv_tile(f32x16& o0, f32x16& o1, const bf16* Vth  , size_t key0, const f32x16& p0, const f32x16& p1, int r32, int hi) {
    const bf16* vp = Vth + (size_t)r32 * MTOK + key0 + hi * 8;
#pragma unroll
    for (int half = 0; half < 2; ++half)
#pragma unroll
        for (int s = 0; s < 2; ++s) {
            const f32x16& p = half ? p1 : p0;
            u32x4 w; w.x = cvtpk(p[8 * s + 0], p[8 * s + 1]); w.y = cvtpk(p[8 * s + 2], p[8 * s + 3]); w.z = cvtpk(p[8 * s + 4], p[8 * s + 5]); w.w = cvtpk(p[8 * s + 6], p[8 * s + 7]);
            const bf16x8 pf = __builtin_bit_cast(bf16x8, w);
            const bf16x8 v0 = *(const bf16x8*)(vp + half * 32 + s * 16), v1 = *(const bf16x8*)(vp + (size_t)32 * MTOK + half * 32 + s * 16);
            o0 = MFMA32(v0, pf, o0); o1 = MFMA32(v1, pf, o1);
        }
}
__device__ __forceinline__ void load_q(bf16x8 (&qr)[4], const bf16* Q, size_t qrow, int h, int hi) {
#pragma unroll
    for (int d0 = 0; d0 < 4; ++d0) qr[d0] = *(const bf16x8*)(Q + qrow * DM + h * HD + d0 * 16 + hi * 8);
}
__device__ __forceinline__ void store_o(bf16* O, size_t qrow, int h, const f32x16& o0, const f32x16& o1, float rl, int hi) {
    bf16* op = O + qrow * DM + h * HD + 4 * hi;
#pragma unroll
    for (int dh = 0; dh < 2; ++dh)
#pragma unroll
        for (int g = 0; g < 4; ++g) { const f32x16& o = dh ? o1 : o0; u32x2 w; w.x = cvtpk(o[4 * g] * rl, o[4 * g + 1] * rl); w.y = cvtpk(o[4 * g + 2] * rl, o[4 * g + 3] * rl);
            *(u32x2*)(op + 32 * dh + 8 * g) = w; }
}
#define MAX3(a, b, c) __builtin_fmaxf(__builtin_fmaxf((a), (b)), (c))
__device__ __forceinline__ void softmax_step(f32x16& p0, f32x16& p1, float& m, float& l, f32x16& o0, f32x16& o1) {
    float a = MAX3(p0[0], p0[1], p0[2]), b = MAX3(p1[0], p1[1], p1[2]);
#pragma unroll
    for (int r = 3; r < 15; r += 2) { a = MAX3(a, p0[r], p0[r + 1]); b = MAX3(b, p1[r], p1[r + 1]); }
    float mx = MAX3(a, b, p0[15]); mx = fmaxf(mx, p1[15]);
    mx = fmaxf(mx, __shfl_xor(mx, 32));
    const float mn = fmaxf(m, mx);
    if (!__all(mn == m)) {
        const float alpha = __builtin_amdgcn_exp2f(m - mn); m = mn; l *= alpha;
#pragma unroll
        for (int r = 0; r < 16; ++r) { o0[r] *= alpha; o1[r] *= alpha; }
    }
    float s = 0.f;
#pragma unroll
    for (int r = 0; r < 16; ++r) { p0[r] = __builtin_amdgcn_exp2f(p0[r] - mn); p1[r] = __builtin_amdgcn_exp2f(p1[r] - mn); s += p0[r] + p1[r]; }
    l += s;
}
__device__ __forceinline__ void attn_unit_of(int u, int& bh, int& qb) { bh = u >> 7; qb = u & 127; if ((u >> 11) & 1) qb = 127 - qb; }

__device__ __forceinline__ void attnA_phase(const bf16* Q, const bf16* K, const bf16* Vt, bf16* O, const float* rel_bias  , LAS float* biasL, int vw, int nvw, int tid) {
    for (int i = tid; i < 16 * 513; i += NTHREADS) biasL[(i / 513) * 516 + (i % 513)] = rel_bias[i] * LOG2E;
    __syncthreads();
    const int lane = tid & 63, r32 = lane & 31, hi = lane >> 5;
    for (int u = vw; u < NB * NH * 128; u += nvw) {
        int bh, qb; attn_unit_of(u, bh, qb); const int b = bh >> 4, h = bh & 15, c = qb >> 1, qh = qb & 1;
        const size_t qrow = (size_t)b * SEQ + qb * 32 + r32;
        bf16x8 qr[4]; load_q(qr, Q, qrow, h, hi);
        f32x16 o0 = (f32x16){}, o1 = (f32x16){}; float m = -1e30f, l = 0.f;
        const LAS float* bl = biasL + h * 516;
        for (int kt = (c < 8 ? 8 - c : 0); kt <= 8; ++kt) {
            const size_t key0 = (size_t)b * SEQ + (size_t)(c - 8 + kt) * 64;
            f32x16 p0, p1; qk_tile(p0, p1, K + h * HD, key0, DM, qr, r32, hi);
            if (kt >= 4) {
                const int base = (8 - kt) * 64 + qh * 32 + r32 - 8 * hi;
#pragma unroll
                for (int r = 0; r < 16; ++r) { const int d0 = base - (16 * (r >> 3) + (r & 7)); const int d1 = d0 - 32;
                    p0[r] += bl[(d0 < 256 ? d0 : 256) + 256]; p1[r] += bl[(d1 < 256 ? d1 : 256) + 256]; }
            } else { const float bc = bl[512];
#pragma unroll
                for (int r = 0; r < 16; ++r) { p0[r] += bc; p1[r] += bc; } }
            softmax_step(p0, p1, m, l, o0, o1);
            pv_tile(o0, o1, Vt + (size_t)h * HD * MTOK, key0, p0, p1, r32, hi);
        }
        l += __shfl_xor(l, 32);
        store_o(O, qrow, h, o0, o1, 1.0f / l, hi);
    }
}
__device__ __forceinline__ void attnC_phase(const bf16* Q, const bf16* K, const bf16* Vt, bf16* O, int vw, int nvw, int tid) {
    const int lane = tid & 63, r32 = lane & 31, hi = lane >> 5;
    for (int u = vw; u < NB * NH * 128; u += nvw) {
        int bh, qb; attn_unit_of(u, bh, qb); const int b = bh >> 4, h = bh & 15;
        const size_t qrow = (size_t)b * SEQ + qb * 32 + r32; const int t = qb * 32 + r32;
        bf16x8 qr[4]; load_q(qr, Q, qrow, h, hi);
        f32x16 o0 = (f32x16){}, o1 = (f32x16){}; float R = 0.f;
        for (int kt = qb >> 1; kt >= 0; --kt) {
            const size_t key0 = (size_t)b * SEQ + (size_t)kt * 64;
            f32x16 p0, p1; qk_tile(p0, p1, K + h * HD, key0, DM, qr, r32, hi);
            const int kb = kt * 64 + 8 * hi;
            float lk[32], lb[32];
#pragma unroll
            for (int e = 0; e < 32; ++e) { const int r = e & 15, half = e >> 4; const float z = half ? p1[r] : p0[r];
                const int key = kb + 32 * half + 16 * (r >> 3) + (r & 7);
                const float sp = fmaxf(z, 0.f) + __builtin_amdgcn_logf(1.f + __builtin_amdgcn_exp2f(-fabsf(z)));
                const bool valid = key < t;
                lk[e] = valid ? -sp : 0.f; lb[e] = valid ? (z - sp) : -INFINITY; }
            float G[4], ex[32];
#pragma unroll
            for (int gi = 0; gi < 4; ++gi) { float run = 0.f;
#pragma unroll
                for (int i = 7; i >= 0; --i) { ex[gi * 8 + i] = run; run += lk[gi * 8 + i]; }
                G[gi] = run; }
            float Gp[4];
#pragma unroll
            for (int gi = 0; gi < 4; ++gi) Gp[gi] = __shfl_xor(G[gi], 32);
            float suf[4]; float run = 0.f;
#pragma unroll
            for (int gi = 3; gi >= 0; --gi) { suf[gi] = run + (hi == 0 ? Gp[gi] : 0.f); run += G[gi] + Gp[gi]; }
#pragma unroll
            for (int e = 0; e < 32; ++e) { const float a = __builtin_amdgcn_exp2f(lb[e] + R + suf[e >> 3] + ex[e]); if (e < 16) p0[e] = a; else p1[e - 16] = a; }
            R += run;
            pv_tile(o0, o1, Vt + (size_t)h * HD * MTOK, key0, p0, p1, r32, hi);
            if (__all(R < -300.f)) break;
        }
        store_o(O, qrow, h, o0, o1, 1.0f, hi);
    }
}
constexpr int TP = 144;
constexpr int TILE_B = 64 * TP, KVBUF_B = 2 * TILE_B;
constexpr int PAIR_B = 2 * KVBUF_B;
struct KVStage { u32x4 k, v; };
__device__ __forceinline__ void kv_issue(KVStage& st, const bf16* Kh, const bf16* Vth, size_t key0, int tid) {
    const int row = tid >> 3, ch = tid & 7;
    st.k = *(const u32x4*)(Kh + (key0 + row) * DM + ch * 8);
    st.v = *(const u32x4*)(Vth + (size_t)row * VTP + key0 + ch * 8);
}
__device__ __forceinline__ void kv_write(const KVStage& st, LAS unsigned char* buf, int tid) {
    const int row = tid >> 3, ch = tid & 7;
    *(LAS u32x4*)(buf + row * TP + ch * 16) = st.k;
    *(LAS u32x4*)(buf + TILE_B + row * TP + ch * 16) = st.v;
}
template <bool INIT = true> __device__ __forceinline__ void qk_lds(f32x16& p0, f32x16& p1, const LAS unsigned char* buf, const bf16x8 (&qr)[4], int r32, int hi) {
    const LAS unsigned char* kp = buf + pi_row(r32) * TP + hi * 16;
    if (INIT) { p0 = (f32x16){}; p1 = (f32x16){}; }
#pragma unroll
    for (int d0 = 0; d0 < 4; ++d0) {
        const bf16x8 k0 = *(const LAS bf16x8*)(kp + d0 * 32), k1 = *(const LAS bf16x8*)(kp + 32 * TP + d0 * 32);
        p0 = MFMA32(k0, qr[d0], p0); p1 = MFMA32(k1, qr[d0], p1);
    }
}
__device__ __forceinline__ void pv_lds(f32x16& o0, f32x16& o1, const LAS unsigned char* buf, const f32x16& p0, const f32x16& p1, int r32, int hi) {
    const LAS unsigned char* vp = buf + TILE_B + r32 * TP + hi * 16;
#pragma unroll
    for (int half = 0; half < 2; ++half)
#pragma unroll
        for (int s = 0; s < 2; ++s) {
            const f32x16& p = half ? p1 : p0;
            u32x4 w; w.x = cvtpk(p[8 * s + 0], p[8 * s + 1]); w.y = cvtpk(p[8 * s + 2], p[8 * s + 3]); w.z = cvtpk(p[8 * s + 4], p[8 * s + 5]); w.w = cvtpk(p[8 * s + 6], p[8 * s + 7]);
            const bf16x8 pf = __builtin_bit_cast(bf16x8, w);
            const bf16x8 v0 = *(const LAS bf16x8*)(vp + half * 64 + s * 32), v1 = *(const LAS bf16x8*)(vp + 32 * TP + half * 64 + s * 32);
            o0 = MFMA32(v0, pf, o0); o1 = MFMA32(v1, pf, o1);
        }
}
#define WG_BARRIER_L() do { asm volatile("s_waitcnt lgkmcnt(0)" ::: "memory"); __builtin_amdgcn_s_barrier(); asm volatile("" ::: "memory"); } while (0)
#define WG_BARRIER() do { asm volatile("s_waitcnt vmcnt(0) lgkmcnt(0)" ::: "memory"); __builtin_amdgcn_s_barrier(); asm volatile("" ::: "memory"); } while (0)
__device__ __forceinline__ void blk_unit_of(int u, int& bh, int& ub) { bh = u >> 4; ub = u & 15; if ((u >> 8) & 1) ub = 15 - ub; }

template <bool FIXED> __device__ __forceinline__ void attnA_blk(const bf16* Q, const bf16* K, const bf16* Vt, bf16* O, const float* rel_bias, float ref, LAS unsigned char* lds, int vcu, int G, int tid) {
    LAS float* biasL = (LAS float*)(lds + 2 * PAIR_B);
    for (int i = tid; i < 16 * 513; i += NTHREADS) biasL[(i / 513) * 516 + (i % 513)] = rel_bias[i] * LOG2E - (FIXED ? ref : 0.f);
    __syncthreads();
    const int lane = tid & 63, r32 = lane & 31, hi = lane >> 5, wid = __builtin_amdgcn_readfirstlane(tid >> 6);
#pragma unroll 1
    for (int u = vcu; u < NB * NH * 16; u += G) {
        int bh, ub; blk_unit_of(u, bh, ub); const int b = bh >> 4, h = bh & 15, qb = ub * 8 + wid, c = qb >> 1, qh = qb & 1;
        const size_t qrow = (size_t)b * SEQ + qb * 32 + r32;
        bf16x8 qr[4]; load_q(qr, Q, qrow, h, hi);
        f32x16 o0 = (f32x16){}, o1 = (f32x16){}; float m = -1e30f, l = 0.f;
        const LAS float* bl = biasL + h * 516;
        const bf16* Kh = K + h * HD; const bf16* Vth = Vt + (size_t)h * HD * VTP;
        const int c0 = ub * 4, t_lo = c0 >= 8 ? c0 - 8 : 0, t_hi = c0 + 3;
        const size_t kbase = (size_t)b * SEQ; const int ntl = t_hi - t_lo + 1;
        KVStage sa, sb;
        kv_issue(sa, Kh, Vth, kbase + (size_t)t_lo * 64, tid); kv_issue(sb, Kh, Vth, kbase + (size_t)(t_lo + 1) * 64, tid);
        kv_write(sa, lds, tid); kv_write(sb, lds + KVBUF_B, tid); WG_BARRIER();
#define ATT_PAIR(IT) do { const int it_ = (IT); LAS unsigned char* pb = lds + ((it_ >> 1) & 1) * PAIR_B; \
            if (it_ + 2 < ntl) { kv_issue(sa, Kh, Vth, kbase + (size_t)(t_lo + it_ + 2) * 64, tid); kv_issue(sb, Kh, Vth, kbase + (size_t)(t_lo + it_ + 3) * 64, tid); } \
            { const int t = t_lo + it_; LAS unsigned char* buf = pb; ATT_COMPUTE } \
            { const int t = t_lo + it_ + 1; LAS unsigned char* buf = pb + KVBUF_B; ATT_COMPUTE } \
            if (it_ + 2 < ntl) { LAS unsigned char* nb = lds + (((it_ >> 1) + 1) & 1) * PAIR_B; kv_write(sa, nb, tid); kv_write(sb, nb + KVBUF_B, tid); } \
            WG_BARRIER(); } while (0)
#define ATT_COMPUTE             if (t >= c - 8 && t <= c) { \
                const int kt = t - c + 8; \
                f32x16 p0, p1; \
                if (kt > 4) { \
                    const LAS float* bp = bl + ((8 - kt) * 64 + qh * 32 + r32 - 8 * hi + 256); \
_Pragma("unroll") \
                    for (int r = 0; r < 16; ++r) { p0[r] = bp[-(16 * (r >> 3) + (r & 7))]; p1[r] = bp[-(16 * (r >> 3) + (r & 7)) - 32]; } \
                } else if (kt == 4) { \
                    const int base = 4 * 64 + qh * 32 + r32 - 8 * hi; \
_Pragma("unroll") \
                    for (int r = 0; r < 16; ++r) { const int d0 = base - (16 * (r >> 3) + (r & 7)); const int d1 = d0 - 32; \
                        p0[r] = bl[(d0 < 256 ? d0 : 256) + 256]; p1[r] = bl[(d1 < 256 ? d1 : 256) + 256]; } \
                } else { const float bc = bl[512]; \
_Pragma("unroll") \
                    for (int r = 0; r < 16; ++r) { p0[r] = bc; p1[r] = bc; } } \
                qk_lds<false>(p0, p1, buf, qr, r32, hi); \
                if (FIXED) { float sacc = 0.f; \
_Pragma("unroll") \
                    for (int r = 0; r < 16; ++r) { p0[r] = __builtin_amdgcn_exp2f(p0[r]); p1[r] = __builtin_amdgcn_exp2f(p1[r]); sacc += p0[r] + p1[r]; } \
                    l += sacc; \
                } else softmax_step(p0, p1, m, l, o0, o1); \
                pv_lds(o0, o1, buf, p0, p1, r32, hi); \
            }
#pragma unroll 1
        for (int it = 0; it < ntl; it += 2) ATT_PAIR(it);
#undef ATT_COMPUTE
        l += __shfl_xor(l, 32);
        store_o(O, qrow, h, o0, o1, 1.0f / l, hi);
    }
}
__device__ __forceinline__ void b_mask_init(f32x16& p0, f32x16& p1, unsigned long long mw, int hi, float ref) {
    const int n0 = (int)~((unsigned)mw >> (8 * hi)), n1 = (int)~((unsigned)(mw >> 32) >> (8 * hi));
#pragma unroll
    for (int r = 0; r < 16; ++r) { const int bit = 16 * (r >> 3) + (r & 7);
        p0[r] = __int_as_float(__builtin_amdgcn_sbfe(n0, bit, 1) & (int)0xFF800000) - ref; p1[r] = __int_as_float(__builtin_amdgcn_sbfe(n1, bit, 1) & (int)0xFF800000) - ref; }
}
__device__ __forceinline__ float exp_tile(f32x16& p0, f32x16& p1) {
    float sacc = 0.f;
#pragma unroll
    for (int r = 0; r < 16; ++r) { p0[r] = __builtin_amdgcn_exp2f(p0[r]); p1[r] = __builtin_amdgcn_exp2f(p1[r]);
#ifdef PB2_EXPX
        p0[r] = __builtin_amdgcn_exp2f(__builtin_amdgcn_logf(p0[r])); p1[r] = __builtin_amdgcn_exp2f(__builtin_amdgcn_logf(p1[r]));
#endif
        sacc += p0[r] + p1[r]; }
    return sacc;
}
template <bool FIXED> __device__ __forceinline__ void attnB_blk(const bf16* Q, const bf16* K, const bf16* Vt, bf16* O, const unsigned long long* MASK, float ref, LAS unsigned char* lds, int vcu, int G, int tid) {
    const int lane = tid & 63, r32 = lane & 31, hi = lane >> 5, wid = __builtin_amdgcn_readfirstlane(tid >> 6);
#pragma unroll 1
    for (int u = vcu; u < NB * NH * 16; u += G) {
        int bh, ub; blk_unit_of(u, bh, ub); const int b = bh >> 4, h = bh & 15, qb = ub * 8 + wid;
        const size_t qrow = (size_t)b * SEQ + qb * 32 + r32;
        bf16x8 qr[4]; load_q(qr, Q, qrow, h, hi);
        f32x16 o0 = (f32x16){}, o1 = (f32x16){}; float m = -1e30f, l = 0.f;
        const u32x4* mrow2 = (const u32x4*)(MASK + qrow * 64);
        const int ntile = (qb >> 1) + 1, t_hi = ub * 4 + 3;
        const bf16* Kh = K + h * HD; const bf16* Vth = Vt + (size_t)h * HD * VTP;
        const size_t kbase = (size_t)b * SEQ; const int ntl = t_hi + 1;
#ifndef PB2_LOOPX
#define PB2_LOOPX 1
#endif
        for (int rep2 = 0; rep2 < PB2_LOOPX; ++rep2) {
        KVStage sa, sb;
        kv_issue(sa, Kh, Vth, kbase, tid); kv_issue(sb, Kh, Vth, kbase + 64, tid);
        u32x4 mnext = mrow2[0];
        kv_write(sa, lds, tid); kv_write(sb, lds + KVBUF_B, tid); WG_BARRIER();
#pragma unroll 1
        for (int it = 0; it < ntl; it += 2) {
            LAS unsigned char* pb = lds + ((it >> 1) & 1) * PAIR_B;
            u32x4 mcur = mnext; asm volatile("" : "+v"(mcur));
            if (it + 2 < ntl) { kv_issue(sa, Kh, Vth, kbase + (size_t)(it + 2) * 64, tid); kv_issue(sb, Kh, Vth, kbase + (size_t)(it + 3) * 64, tid); }
            if (it + 2 < ntile) mnext = mrow2[(it >> 1) + 1];
            const unsigned long long ma = (it < ntile) ? ((unsigned long long)mcur.y << 32 | mcur.x) : 0ull, mb = (it + 1 < ntile) ? ((unsigned long long)mcur.w << 32 | mcur.z) : 0ull;
#pragma unroll
            for (int k = 0; k < 2; ++k) {
                if (it + k < ntile) {
                    LAS unsigned char* buf = pb + k * KVBUF_B;
                    f32x16 p0, p1; b_mask_init(p0, p1, k ? mb : ma, hi, FIXED ? ref : 0.f);
                    qk_lds<false>(p0, p1, buf, qr, r32, hi);
                    if (FIXED) l += exp_tile(p0, p1); else softmax_step(p0, p1, m, l, o0, o1);
                    pv_lds(o0, o1, buf, p0, p1, r32, hi);
                }
            }
            if (it + 2 < ntl) { LAS unsigned char* nb = lds + (((it >> 1) + 1) & 1) * PAIR_B; kv_write(sa, nb, tid); kv_write(sb, nb + KVBUF_B, tid);
#ifdef PB2_STAGEX
                kv_issue(sa, Kh, Vth, kbase + (size_t)(it + 2) * 64, tid); kv_issue(sb, Kh, Vth, kbase + (size_t)(it + 3) * 64, tid); kv_write(sa, nb, tid); kv_write(sb, nb + KVBUF_B, tid);
#endif
            }
            WG_BARRIER();
#ifdef PB2_BARX
            WG_BARRIER(); WG_BARRIER();
#endif
        }
        }
        l += __shfl_xor(l, 32);
        store_o(O, qrow, h, o0, o1, 1.0f / l, hi);
    }
}
__device__ __forceinline__ void attnC_blk(const bf16* Q, const bf16* K, const bf16* Vt, bf16* O, LAS unsigned char* lds, int vcu, int G, int tid) {
    const int lane = tid & 63, r32 = lane & 31, hi = lane >> 5, wid = __builtin_amdgcn_readfirstlane(tid >> 6);
    LAS unsigned* flags = (LAS unsigned*)(lds + 2 * KVBUF_B);
#pragma unroll 1
    for (int u = vcu; u < NB * NH * 16; u += G) {
        int bh, ub; blk_unit_of(u, bh, ub); const int b = bh >> 4, h = bh & 15, qb = ub * 8 + wid;
        const size_t qrow = (size_t)b * SEQ + qb * 32 + r32; const int tq = qb * 32 + r32;
        bf16x8 qr[4]; load_q(qr, Q, qrow, h, hi);
        f32x16 o0 = (f32x16){}, o1 = (f32x16){}; float R = 0.f; bool done = false;
        const int t_hi = ub * 4 + 3, t_me = qb >> 1;
        const bf16* Kh = K + h * HD; const bf16* Vth = Vt + (size_t)h * HD * VTP;
        KVStage st; kv_issue(st, Kh, Vth, (size_t)b * SEQ + (size_t)t_hi * 64, tid); kv_write(st, lds, tid); WG_BARRIER();
#pragma unroll 1
        for (int t = t_hi, it = 0; t >= 0; --t, ++it) {
            LAS unsigned char* buf = lds + (it & 1) * KVBUF_B;
            if (t > 0) kv_issue(st, Kh, Vth, (size_t)b * SEQ + (size_t)(t - 1) * 64, tid);
            if (t <= t_me && !done) {
                f32x16 p0, p1; qk_lds(p0, p1, buf, qr, r32, hi);
                const int kb = t * 64 + 8 * hi;
                const bool diag = (t == t_me);
                float lk[32], lb[32];
#pragma unroll
                for (int e = 0; e < 32; ++e) { const int r = e & 15, half = e >> 4; const float z = half ? p1[r] : p0[r];
                    const float sp = __builtin_amdgcn_logf(1.f + __builtin_amdgcn_exp2f(fminf(z, 80.f)));
                    lk[e] = -sp; lb[e] = z - sp; }
                if (diag) {
#pragma unroll
                    for (int e = 0; e < 32; ++e) { const int r = e & 15, half = e >> 4; const int key = kb + 32 * half + 16 * (r >> 3) + (r & 7);
                        const bool valid = key < tq; lk[e] = valid ? lk[e] : 0.f; lb[e] = valid ? lb[e] : -INFINITY; }
                }
                float Gs[4], ex[32];
#pragma unroll
                for (int gi = 0; gi < 4; ++gi) { float run = 0.f;
#pragma unroll
                    for (int i = 7; i >= 0; --i) { ex[gi * 8 + i] = run; run += lk[gi * 8 + i]; }
                    Gs[gi] = run; }
                float Gp[4];
#pragma unroll
                for (int gi = 0; gi < 4; ++gi) Gp[gi] = __shfl_xor(Gs[gi], 32);
                float suf[4]; float run = 0.f;
#pragma unroll
                for (int gi = 3; gi >= 0; --gi) { suf[gi] = R + run + (hi == 0 ? Gp[gi] : 0.f); run += Gs[gi] + Gp[gi]; }
#pragma unroll
                for (int e = 0; e < 32; ++e) { const float a = __builtin_amdgcn_exp2f(lb[e] + (suf[e >> 3] + ex[e])); if (e < 16) p0[e] = a; else p1[e - 16] = a; }
                R += run;
                pv_lds(o0, o1, buf, p0, p1, r32, hi);
                done = __all(R < -300.f);
            }
            if (lane == 0) flags[(it & 1) * 8 + wid] = (done || t == 0) ? 0u : 1u;
            if (t > 0) kv_write(st, lds + ((it + 1) & 1) * KVBUF_B, tid);
            WG_BARRIER();
            unsigned any = 0u;
#pragma unroll
            for (int w = 0; w < 8; ++w) any |= flags[(it & 1) * 8 + w];
            if (any == 0u) break;
        }
        store_o(O, qrow, h, o0, o1, 1.0f, hi);
        WG_BARRIER();
    }
}
#define XB_TMO      128
#define XB_XCNT(j)  (256  + 64 * (j))
#define XB_XSUB(j)  (1280 + 64 * (j))
#define XB_XGEN(j)  (2304 + 64 * (j))
#define XB_TOP      3328
#define XB_TOPGEN   3392
#define XCD_BAR_WORDS 3456
#define XB_SPIN_CAP (1u << 18)

__device__ __forceinline__ unsigned xb_ld(unsigned* p)              { return __hip_atomic_load(p, __ATOMIC_RELAXED, __HIP_MEMORY_SCOPE_AGENT); }
__device__ __forceinline__ unsigned xb_add(unsigned* p, unsigned v) { return __hip_atomic_fetch_add(p, v, __ATOMIC_RELAXED, __HIP_MEMORY_SCOPE_AGENT); }
__device__ __forceinline__ unsigned xb_xcc_id() { return (unsigned)__builtin_amdgcn_s_getreg((3 << 11) | 20) & 0xFu; }
#define XB_SPIN(cond, bar) do { unsigned _sp = 0; while (cond) { __builtin_amdgcn_s_sleep(1); \
    if ((++_sp & 255u) == 0u) { if (xb_ld(&(bar)[XB_TMO])) break; if (_sp > XB_SPIN_CAP) { atomicAdd(&(bar)[XB_TMO], 1u); break; } } } } while (0)

struct XcdBarrier {
    unsigned* bar; unsigned x;
    volatile LAS unsigned* st;
};

__device__ __forceinline__ XcdBarrier xcd_barrier_post(unsigned* bar, volatile LAS unsigned* st) {
    XcdBarrier b; b.bar = bar; b.x = xb_xcc_id(); b.st = st;
    if (threadIdx.x == 0) (void)xb_add(&bar[XB_XCNT(b.x)], 1u);
    return b;
}
__device__ __forceinline__ void xcd_barrier_complete(unsigned* bar, unsigned x, unsigned& nloc, unsigned& nx) {
    const unsigned G = gridDim.x * gridDim.y * gridDim.z;
    unsigned sum, cnt, mine, sp = 0u;
    for (;;) {
        sum = 0u; cnt = 0u; mine = 0u;
#pragma unroll
        for (unsigned j = 0; j < 16; ++j) { const unsigned c = xb_ld(&bar[XB_XCNT(j)]); sum += c; cnt += (c > 0u) ? 1u : 0u; mine = (j == x) ? c : mine; }
        if (sum == G) break;
        __builtin_amdgcn_s_sleep(1);
        if ((++sp & 255u) == 0u) { if (xb_ld(&bar[XB_TMO])) break; if (sp > XB_SPIN_CAP) { atomicAdd(&bar[XB_TMO], 1u); break; } }
    }
    nloc = mine > 0u ? mine : 1u; nx = cnt > 0u ? cnt : 1u;
}

__device__ __forceinline__ void xcd_barrier(const XcdBarrier& b, int g_wave_id) {
    asm volatile("s_waitcnt vmcnt(0)" ::: "memory");
    __syncthreads();
    if (g_wave_id == 0 && lane_id() == 0) {
        unsigned* bar = b.bar;
        __builtin_amdgcn_s_waitcnt(0);
        unsigned nloc = b.st[0], nx = b.st[1];
        if (nloc == 0u) { xcd_barrier_complete(bar, b.x, nloc, nx); b.st[0] = nloc; b.st[1] = nx; }
        const unsigned old = xb_add(&bar[XB_XSUB(b.x)], 1u);
        const unsigned gen = old / nloc;
        if (old + 1u == (gen + 1u) * nloc) {
            __builtin_amdgcn_fence(__ATOMIC_RELEASE, "agent");
            asm volatile("s_waitcnt vmcnt(0)" ::: "memory");
            const unsigned og = xb_add(&bar[XB_TOP], 1u);
            const unsigned tg = og / nx;
            if (og + 1u == (tg + 1u) * nx) xb_add(&bar[XB_TOPGEN], 1u);
            else XB_SPIN(xb_ld(&bar[XB_TOPGEN]) == tg, bar);
            __builtin_amdgcn_fence(__ATOMIC_ACQUIRE, "agent");
            xb_add(&bar[XB_XGEN(b.x)], 1u);
            asm volatile("s_waitcnt vmcnt(0)" ::: "memory");
        } else {
            XB_SPIN(xb_ld(&bar[XB_XGEN(b.x)]) == gen, bar);
            __builtin_amdgcn_fence(__ATOMIC_ACQUIRE, "agent");
            asm volatile("s_waitcnt vmcnt(0)" ::: "memory");
        }
    }
    __syncthreads();
}
constexpr int QI_PITCH = 520;
__device__ __forceinline__ void b1_phase(const bf16* QI, const bf16* KI, const float* WI, float* SCRb  , unsigned long long* MASK,
                                         LAS unsigned char* lds, int vcu, int G, int tid) {
    const int lane = tid & 63, r32 = lane & 31, hi = lane >> 5, wid = __builtin_amdgcn_readfirstlane(tid >> 6);
    LAS bf16* qs = (LAS bf16*)lds;
#pragma unroll 1
    for (int u0 = vcu, rnd = 0; u0 < NB * 128; u0 += G, ++rnd) {
        const int b = u0 >> 7; int qb = u0 & 127; if (rnd & 1) qb = 127 - qb;
        const size_t tok0 = (size_t)b * SEQ + qb * 32;
        const int ntile = (qb >> 1) + 1, limit = ntile * 64;
        for (int i = tid; i < 32 * 64; i += NTHREADS) { const int q = i >> 6, c = i & 63; *(LAS u32x4*)(qs + q * QI_PITCH + c * 8) = *(const u32x4*)(QI + (tok0 + q) * 512 + c * 8); }
        LAS float* wl = (LAS float*)(lds + 32 * QI_PITCH * 2);
        if (tid < 256) wl[tid] = WI[tok0 * 8 + tid];
        __syncthreads();
#ifndef B1_SCORE_REP
#define B1_SCORE_REP 1
#endif
#ifndef B1_TOPK_REP
#define B1_TOPK_REP 1
#endif
#ifndef B1_NO_SCORE
        for (int rep_ = 0; rep_ < B1_SCORE_REP; ++rep_)
#pragma unroll 1
        for (int kt = wid; kt < ntile; kt += NWAVES) {
            const size_t key0 = (size_t)b * SEQ + (size_t)kt * 64;
            const bf16* kp = KI + (key0 + pi_row(r32)) * 64 + hi * 8;
            bf16x8 kf0[4], kf1[4];
#pragma unroll
            for (int d0 = 0; d0 < 4; ++d0) { kf0[d0] = *(const bf16x8*)(kp + d0 * 16); kf1[d0] = *(const bf16x8*)(kp + 32 * 64 + d0 * 16); }
            f32x16 s0 = (f32x16){}, s1 = (f32x16){};
            int qoff = r32 * QI_PITCH + hi * 8; asm volatile("" : "+v"(qoff));
#pragma unroll 1
            for (int hh = 0; hh < 8; ++hh) {
                f32x16 a0 = (f32x16){}, a1 = (f32x16){};
                const float wh = wl[r32 * 8 + hh];
#pragma unroll
                for (int d0 = 0; d0 < 4; ++d0) { const bf16x8 qf = *(const LAS bf16x8*)(qs + qoff + hh * 64 + d0 * 16); a0 = MFMA32(kf0[d0], qf, a0); a1 = MFMA32(kf1[d0], qf, a1); }
#pragma unroll
                for (int r = 0; r < 16; ++r) { s0[r] = __builtin_fmaf(wh, __builtin_fmaxf(a0[r], 0.f), s0[r]); s1[r] = __builtin_fmaf(wh, __builtin_fmaxf(a1[r], 0.f), s1[r]); }
            }
            float* sp = SCRb + (size_t)r32 * 4096 + kt * 64 + 8 * hi;
#pragma unroll
            for (int half = 0; half < 2; ++half)
#pragma unroll
                for (int s = 0; s < 2; ++s) { const f32x16& p = half ? s1 : s0;
                    *(f32x4*)(sp + 32 * half + 16 * s) = (f32x4){p[8 * s], p[8 * s + 1], p[8 * s + 2], p[8 * s + 3]};
                    *(f32x4*)(sp + 32 * half + 16 * s + 4) = (f32x4){p[8 * s + 4], p[8 * s + 5], p[8 * s + 6], p[8 * s + 7]}; }
        }
#endif
        asm volatile("s_waitcnt vmcnt(0)" ::: "memory");
        __syncthreads();
#ifndef B1_NO_TOPK
#pragma unroll 1
        for (int qq = 0; qq < 4 * B1_TOPK_REP; ++qq) {
            const int q = wid * 4 + (qq & 3);
            const float* srow = SCRb + (size_t)q * 4096 + lane;
            unsigned uu[64];
#pragma unroll
            for (int j = 0; j < 64; ++j) { unsigned key = 0u; if (j < ntile) { const float f = srow[j * 64] + 0.0f; const unsigned bts = __float_as_uint(f); key = bts ^ ((bts >> 31) ? 0xFFFFFFFFu : 0x80000000u); } uu[j] = key; }
            unsigned T = 1u;
            if (limit > 256) {
                unsigned prefix = 0u;
#pragma unroll 1
                for (int bit = 31; bit >= 0; --bit) {
                    const unsigned cand = prefix | (1u << bit); unsigned less = 0u;
#pragma unroll
                    for (int j = 0; j < 64; ++j) less += (uu[j] < cand) ? 1u : 0u;
                    const int cnt = 4096 - (int)wave_sum_u32(less);
                    if (cnt >= 256) prefix = cand;
                    if (cnt == 256) break;
                }
                T = prefix;
            }
            int ngt = 0;
#pragma unroll
            for (int j = 0; j < 64; ++j) ngt += __popcll(__ballot(uu[j] > T));
            const int need = (limit > 256) ? (256 - ngt) : 4096;
            int c = 0; unsigned long long myword = 0ull;
#pragma unroll
            for (int j = 0; j < 64; ++j) {
                const bool eq = (uu[j] == T); const unsigned long long eqm = __ballot(eq);
                const int below = __builtin_amdgcn_mbcnt_hi((unsigned)(eqm >> 32), __builtin_amdgcn_mbcnt_lo((unsigned)eqm, 0u));
                const bool sel = (uu[j] > T) || (eq && (c + below < need));
                const unsigned long long word = __ballot(sel);
                c += __popcll(eqm);
                if (lane == j) myword = word;
            }
            if (lane < ntile) MASK[(tok0 + q) * 64 + lane] = myword;
        }
#endif
        __syncthreads();
    }
}
__device__ __forceinline__ void attnB_phase(const bf16* Q, const bf16* K, const bf16* Vt, bf16* O, const unsigned long long* MASK, int vw, int nvw, int tid) {
    const int lane = tid & 63, r32 = lane & 31, hi = lane >> 5;
    for (int u = vw; u < NB * NH * 128; u += nvw) {
        int bh, qb; attn_unit_of(u, bh, qb); const int b = bh >> 4, h = bh & 15;
        const size_t qrow = (size_t)b * SEQ + qb * 32 + r32;
        bf16x8 qr[4]; load_q(qr, Q, qrow, h, hi);
        f32x16 o0 = (f32x16){}, o1 = (f32x16){}; float m = -1e30f, l = 0.f;
        const unsigned long long* mrow = MASK + qrow * 64;
        const int ntile = (qb >> 1) + 1;
        for (int kt = 0; kt < ntile; ++kt) {
            const size_t key0 = (size_t)b * SEQ + (size_t)kt * 64;
            const unsigned long long mw = mrow[kt];
            f32x16 p0, p1; qk_tile(p0, p1, K + h * HD, key0, DM, qr, r32, hi);
            const unsigned m0 = (unsigned)mw >> (8 * hi), m1 = (unsigned)(mw >> 32) >> (8 * hi);
#pragma unroll
            for (int r = 0; r < 16; ++r) { const int bit = 16 * (r >> 3) + (r & 7);
                p0[r] = ((m0 >> bit) & 1u) ? p0[r] : -INFINITY; p1[r] = ((m1 >> bit) & 1u) ? p1[r] : -INFINITY; }
            softmax_step(p0, p1, m, l, o0, o1);
            pv_tile(o0, o1, Vt + (size_t)h * HD * MTOK, key0, p0, p1, r32, hi);
        }
        l += __shfl_xor(l, 32);
        store_o(O, qrow, h, o0, o1, 1.0f / l, hi);
    }
}
__device__ __forceinline__ void conv_phase(const bf16* A, bf16* HM, const float* cw  , const float* cb  , int gtid, int ngt) {
    constexpr int CG = DFF / 8, RUN = 32, NRUN = MHALF / RUN;
    for (int it = gtid; it < CG * NRUN; it += ngt) {
        const int cgp = it % CG, run = it / CG, c0 = cgp * 8, r0 = run * RUN;
        float wg[3][8], wu[3][8], bg[8], bu[8];
#pragma unroll
        for (int i = 0; i < 8; ++i) { bg[i] = cb[c0 + i]; bu[i] = cb[DFF + c0 + i];
#pragma unroll
            for (int k = 0; k < 3; ++k) { wg[k][i] = cw[k * NFF2 + c0 + i]; wu[k][i] = cw[k * NFF2 + DFF + c0 + i]; } }
        float g1[8], g2[8], u1[8], u2[8];
        const bool seqstart = (r0 & (SEQ - 1)) == 0;
#pragma unroll
        for (int i = 0; i < 8; ++i) { g1[i] = g2[i] = u1[i] = u2[i] = 0.f; }
        if (!seqstart) {
            const u32x4 a1 = *(const u32x4*)(A + (size_t)(r0 - 1) * NFF2 + c0), a2 = *(const u32x4*)(A + (size_t)(r0 - 2) * NFF2 + c0);
            const u32x4 b1 = *(const u32x4*)(A + (size_t)(r0 - 1) * NFF2 + DFF + c0), b2 = *(const u32x4*)(A + (size_t)(r0 - 2) * NFF2 + DFF + c0);
#pragma unroll
            for (int i = 0; i < 4; ++i) { g1[2 * i] = __uint_as_float(a1[i] << 16); g1[2 * i + 1] = __uint_as_float(a1[i] & 0xFFFF0000u); g2[2 * i] = __uint_as_float(a2[i] << 16); g2[2 * i + 1] = __uint_as_float(a2[i] & 0xFFFF0000u);
                u1[2 * i] = __uint_as_float(b1[i] << 16); u1[2 * i + 1] = __uint_as_float(b1[i] & 0xFFFF0000u); u2[2 * i] = __uint_as_float(b2[i] << 16); u2[2 * i + 1] = __uint_as_float(b2[i] & 0xFFFF0000u); }
        }
        for (int r = r0; r < r0 + RUN; ++r) {
            const u32x4 a0 = *(const u32x4*)(A + (size_t)r * NFF2 + c0), b0 = *(const u32x4*)(A + (size_t)r * NFF2 + DFF + c0);
            float g0[8], u0[8], hm[8];
#pragma unroll
            for (int i = 0; i < 4; ++i) { g0[2 * i] = __uint_as_float(a0[i] << 16); g0[2 * i + 1] = __uint_as_float(a0[i] & 0xFFFF0000u); u0[2 * i] = __uint_as_float(b0[i] << 16); u0[2 * i + 1] = __uint_as_float(b0[i] & 0xFFFF0000u); }
#pragma unroll
            for (int i = 0; i < 8; ++i) { const float cgv = bg[i] + wg[0][i] * g2[i] + wg[1][i] * g1[i] + wg[2][i] * g0[i]; const float cuv = bu[i] + wu[0][i] * u2[i] + wu[1][i] * u1[i] + wu[2][i] * u0[i];
                hm[i] = cgv / (1.f + __expf(-cgv)) * cuv; g2[i] = g1[i]; g1[i] = g0[i]; u2[i] = u1[i]; u1[i] = u0[i]; }
            u32x4 o; o.x = cvtpk(hm[0], hm[1]); o.y = cvtpk(hm[2], hm[3]); o.z = cvtpk(hm[4], hm[5]); o.w = cvtpk(hm[6], hm[7]);
            *(u32x4*)(HM + (size_t)r * DFF + c0) = o;
        }
    }
}

__device__ __forceinline__ void ffn_fixup(const float* EF, const float* EL, const float* cw, const float* cb, bf16* HM, int gtid, int ngt) {
    for (int it = gtid; it < 128 * 2 * 704; it += ngt) {
        const int j = (it % 704) * 4, rr = (it / 704) & 1, pm = it / 1408;
        if ((pm & 15) == 0) continue;
        const int pg = (j >> 7) * 256 + (j & 127);
        f32x4 c[2];
#pragma unroll
        for (int bj = 0; bj < 2; ++bj) { const int pc = pg + 128 * bj, lc = j + DFF * bj;
            const f32x4 am2 = *(const f32x4*)(EL + ((size_t)(pm - 1) * 2 + 0) * NFF2 + pc), am1 = *(const f32x4*)(EL + ((size_t)(pm - 1) * 2 + 1) * NFF2 + pc);
            const f32x4 a0 = *(const f32x4*)(EF + ((size_t)pm * 2 + 0) * NFF2 + pc), a1 = *(const f32x4*)(EF + ((size_t)pm * 2 + 1) * NFF2 + pc);
            const f32x4 w0 = *(const f32x4*)(cw + lc), w1 = *(const f32x4*)(cw + NFF2 + lc), w2 = *(const f32x4*)(cw + 2 * NFF2 + lc), bb = *(const f32x4*)(cb + lc);
            c[bj] = rr == 0 ? (bb + w0 * am2 + w1 * am1 + w2 * a0) : (bb + w0 * am1 + w1 * a0 + w2 * a1); }
        float hm[4];
#pragma unroll
        for (int i = 0; i < 4; ++i) { const float g = c[0][i]; hm[i] = g * __builtin_amdgcn_rcpf(1.f + __builtin_amdgcn_exp2f(-LOG2E * g)) * c[1][i]; }
        u32x2 w; w.x = cvtpk(hm[0], hm[1]); w.y = cvtpk(hm[2], hm[3]);
        *(u32x2*)(HM + (size_t)(pm * 256 + rr) * DFF + j) = w;
    }
}

__device__ __forceinline__ void ffn_fixup_tile(const float* EF, const float* EL, const float* cw, const float* cb, bf16* HM, int pm, int tid) {
    if ((pm & 15) == 0) return;
    for (int it = tid; it < 2 * 704; it += NTHREADS) {
        const int j = (it % 704) * 4, rr = it / 704;
        const int pg = (j >> 7) * 256 + (j & 127);
        f32x4 c[2];
#pragma unroll
        for (int bj = 0; bj < 2; ++bj) { const int pc = pg + 128 * bj, lc = j + DFF * bj;
            const f32x4 am2 = *(const f32x4*)(EL + ((size_t)(pm - 1) * 2 + 0) * NFF2 + pc), am1 = *(const f32x4*)(EL + ((size_t)(pm - 1) * 2 + 1) * NFF2 + pc);
            const f32x4 a0 = *(const f32x4*)(EF + ((size_t)pm * 2 + 0) * NFF2 + pc), a1 = *(const f32x4*)(EF + ((size_t)pm * 2 + 1) * NFF2 + pc);
            const f32x4 w0 = *(const f32x4*)(cw + lc), w1 = *(const f32x4*)(cw + NFF2 + lc), w2 = *(const f32x4*)(cw + 2 * NFF2 + lc), bb = *(const f32x4*)(cb + lc);
            c[bj] = rr == 0 ? (bb + w0 * am2 + w1 * am1 + w2 * a0) : (bb + w0 * am1 + w1 * a0 + w2 * a1); }
        float hm[4];
#pragma unroll
        for (int i = 0; i < 4; ++i) { const float g = c[0][i]; hm[i] = g * __builtin_amdgcn_rcpf(1.f + __builtin_amdgcn_exp2f(-LOG2E * g)) * c[1][i]; }
        u32x2 w; w.x = cvtpk(hm[0], hm[1]); w.y = cvtpk(hm[2], hm[3]);
        *(u32x2*)(HM + (size_t)(pm * 256 + rr) * DFF + j) = w;
    }
}
constexpr int LDS_BYTES = 147456;
constexpr int ITEMS_PER_LAYER = 1024 + 384 + 512 + 512 + 2816 + 1408;
#ifdef FAKE_SYNC
#define GRID_SYNC() __syncthreads()
#else
#define GRID_SYNC() xcd_barrier(bar, wave)
#endif
#ifndef PROBE
#define PROBE 0
#endif
#define PROBE_REP(bit) (((PROBE) >> (bit)) & 1 ? 2 : 1)

__device__ __forceinline__ unsigned char* ws_launder(unsigned char* w) { asm volatile("" : "+s"(w)); return w; }
__global__ void __launch_bounds__(NTHREADS, 2) fwd_kernel(Params p) {
    extern __shared__ __attribute__((aligned(16))) unsigned char lds_raw[];
    LAS unsigned char* lds = (LAS unsigned char*)lds_raw;
    cg::grid_group grid = cg::this_grid();
    const int tid = threadIdx.x, lane = tid & 63, wave = __builtin_amdgcn_readfirstlane(tid >> 6);
    const int G = gridDim.x, bx = blockIdx.x, vcu = (G % 8 == 0) ? (bx % 8) * (G / 8) + bx / 8 : bx;
    const int gw = vcu * NWAVES + wave, ngw = G * NWAVES, gtid = vcu * NTHREADS + tid, ngt = G * NTHREADS;
    unsigned char* ws = p.ws;
    if (tid < 4) ((LAS unsigned*)(lds + 131072))[tid] = 0u;
    __syncthreads();
    const XcdBarrier bar = xcd_barrier_post((unsigned*)(ws + WS_CTL), (volatile LAS unsigned*)(lds + 131072));
#define FRESH_TID(v) int v = wave * 64 + lane_id(); asm volatile("" : "+v"(v))
#define WSL(T, off) ((T*)(ws_launder(ws) + (off)))
#define ROPE WSL(f32x2_t, WS_ROPE)
#define XN WSL(bf16, WS_XN)
#define QO WSL(bf16, WS_QO)
#define KB WSL(bf16, WS_K)
#define VT WSL(bf16, WS_VT)
#define QI WSL(bf16, WS_QI)
#define KI WSL(bf16, WS_KI)
#define WI WSL(float, WS_WI)
#define MASK WSL(unsigned long long, WS_MASK)
#define SSQ WSL(float, WS_SSQ)
#define OB WSL(bf16, WS_OB)
#define DUMMY1 p.out
#define DUMMY2 p.out
#define EF WSL(float, WS_EF)
#define EL WSL(float, WS_EL)
#define HM WSL(bf16, WS_HM)
#define SCR p.out
    LAS float* PART = (LAS float*)(lds + 131072 + 1024);
    {
        LAS float* scr = (LAS float*)(lds + wave * 16384);
        for (int it = gw; it < DEPTH * ITEMS_PER_LAYER; it += ngw) {
            const int l = it / ITEMS_PER_LAYER; int r = it % ITEMS_PER_LAYER; const int kind = l % 3, li = l / 3;
            unsigned char* wl = ws + WS_W + (size_t)l * W_LAYER;
            const float* wqkv = kind == 0 ? p.a_w_qkv + (size_t)li * DM * 3072 : (kind == 1 ? p.b_w_in : p.c_w_qkv);
            const int ldq = kind == 1 ? 3656 : 3072;
            const float* g1 = p.norm1_g + (size_t)l * DM; const float* g2 = p.norm2_g + (size_t)l * DM;
            const float* wo = kind == 0 ? p.a_w_o + (size_t)li * DM * DM : (kind == 1 ? p.b_w_o : p.c_w_o);
            if (r < 1024) { transpose_item(wqkv, DM, ldq, 0, 2048, (bf16*)(wl + WL_QK), 0, 1, g1, scr, r, lane); continue; } r -= 1024;
            if (r < 384) { if (kind == 1) transpose_item(wqkv, DM, ldq, 3072, 584, (bf16*)(wl + WL_QK), 2048, 1, g1, scr, r, lane); continue; } r -= 384;
            if (r < 512) { transpose_item(wqkv, DM, ldq, 2048, 1024, (bf16*)(wl + WL_V), 0, 0, g1, scr, r, lane); continue; } r -= 512;
            if (r < 512) { transpose_item(wo, DM, DM, 0, 1024, (bf16*)(wl + WL_O), 0, 0, nullptr, scr, r, lane); continue; } r -= 512;
            if (r < 2816) { transpose_item(p.ffn_w_in + (size_t)l * DM * NFF2, DM, NFF2, 0, NFF2, (bf16*)(wl + WL_IN), 0, 2, g2, scr, r, lane); continue; } r -= 2816;
            transpose_item(p.ffn_w_down + (size_t)l * DFF * DM, DFF, DM, 0, DM, (bf16*)(wl + WL_D), 0, 0, nullptr, scr, r, lane);
        }
        for (int i = gtid; i < SEQ * 32; i += ngt) {
            const int pos = i >> 5, x = i & 31;
            const float inv = exp2f(-(float)x * (13.287712379549449f / 32.0f));
            const float ang = (float)pos * inv;
            const double rev = (double)ang * 0.15915494309189535; const float fr = (float)(rev - floor(rev));
            ROPE[i] = (f32x2_t){__builtin_amdgcn_cosf(fr), __builtin_amdgcn_sinf(fr)};
        }
        for (int m = gw; m < MTOK; m += ngw) xb_row(p.x + (size_t)m * DM, XN + (size_t)m * DM, SSQ + (size_t)m * 4, lane);
    }
    grid.sync();

    for (int l = 0; l < DEPTH; ++l) {
        const int kind = l % 3, li = l / 3;
        unsigned char* wl = ws + WS_W + (size_t)l * W_LAYER;
        const bf16* WQK = (const bf16*)(wl + WL_QK); const bf16* WV = (const bf16*)(wl + WL_V); const bf16* WO = (const bf16*)(wl + WL_O);
        const bf16* WIN = (const bf16*)(wl + WL_IN); const bf16* WD = (const bf16*)(wl + WL_D);
        for (int rep_ = 0; rep_ < PROBE_REP(0); ++rep_) {
        {
            pg8::Gemm g{XN, WQK, MTOK, kind == 1 ? NQK_B : NQK_A, DM}; pg8::StaticOrder S; S.init(MTOK, g.N, G, bx);
            pg8::EpiQKV E{kind, QO, KB, QI, KI, WI, kind == 1 ? p.b_q_norm : p.a_q_norm + li * HD, kind == 1 ? p.b_k_norm : p.a_k_norm + li * HD, (const pg8::f32x2v*)ROPE, 0.125f * LOG2E, 0.35355339059327373f * 0.125f, SSQ};
#ifndef NO_QKV
            pg8::gemm_phase<pg8::EpiQKV, pg8::StaticOrder, true, true>(lds, g, S, E, wave);
#endif
        }
        {
            pg8::Gemm g{WV, XN, DM, MTOK, DM}; pg8::StaticOrder S; S.init(DM, MTOK, G, bx);
            pg8::EpiVt E{VT, VTP, SSQ};
            pg8::gemm_phase<pg8::EpiVt, pg8::StaticOrder, true, true>(lds, g, S, E, wave);
        }
        }
        GRID_SYNC();
#ifndef NO_A
        for (int rep_ = 0; rep_ < PROBE_REP(1); ++rep_)
        if (kind == 0) { FRESH_TID(t_); const float* gq_ = p.a_q_norm + li * HD; const float* gk_ = p.a_k_norm + li * HD; const float* rb_ = p.a_rel_bias + (size_t)li * NH * 513;
            float mq = fabsf(gq_[t_ & 63]), mk = fabsf(gk_[t_ & 63]), bmax = -1e30f, bmin = 1e30f;
            for (int i = t_; i < NH * 513; i += NTHREADS) { const float v = rb_[i] * LOG2E; bmax = fmaxf(bmax, v); bmin = fminf(bmin, v); }
#pragma unroll
            for (int o = 1; o < 64; o <<= 1) { mq = fmaxf(mq, __shfl_xor(mq, o)); mk = fmaxf(mk, __shfl_xor(mk, o)); bmax = fmaxf(bmax, __shfl_xor(bmax, o)); bmin = fminf(bmin, __shfl_xor(bmin, o)); }
            { LAS float* red = (LAS float*)(lds + 131072 + 1024);
              if ((t_ & 63) == 0) { red[(t_ >> 6) * 2] = bmax; red[(t_ >> 6) * 2 + 1] = bmin; }
              __syncthreads();
#pragma unroll
              for (int w = 0; w < 8; ++w) { bmax = fmaxf(bmax, red[w * 2]); bmin = fminf(bmin, red[w * 2 + 1]); }
              __syncthreads(); }
            const float qk2 = 8.2f * mq * mk * LOG2E, ref = qk2 + bmax;
            if (__builtin_amdgcn_readfirstlane(ref - (bmin - qk2) <= 100.f ? 1 : 0)) attnA_blk<true>(QO, KB, VT, OB, rb_, ref, lds, vcu, G, t_);
            else attnA_blk<false>(QO, KB, VT, OB, rb_, 0.f, lds, vcu, G, t_); }
#endif
        if (kind == 1) {
#ifndef NO_B1
            for (int rep_ = 0; rep_ < PROBE_REP(2); ++rep_)
            { FRESH_TID(t_); b1_phase(QI, KI, WI, SCR + (size_t)bx * 32 * 4096, MASK, lds, vcu, G, t_); }
#endif
            GRID_SYNC();
#ifndef NO_B2
            for (int rep_ = 0; rep_ < PROBE_REP(3); ++rep_)
            { FRESH_TID(t_); float mq = fabsf(p.b_q_norm[t_ & 63]), mk = fabsf(p.b_k_norm[t_ & 63]);
#pragma unroll
              for (int o = 1; o < 64; o <<= 1) { mq = fmaxf(mq, __shfl_xor(mq, o)); mk = fmaxf(mk, __shfl_xor(mk, o)); }
              const float ref = 8.2f * mq * mk * LOG2E;
              if (__builtin_amdgcn_readfirstlane(ref <= 50.f ? 1 : 0)) attnB_blk<true>(QO, KB, VT, OB, MASK, ref, lds, vcu, G, t_);
              else attnB_blk<false>(QO, KB, VT, OB, MASK, 0.f, lds, vcu, G, t_); }
#endif
        }
#ifndef NO_C
        for (int rep_ = 0; rep_ < PROBE_REP(4); ++rep_)
        if (kind == 2) { FRESH_TID(t_); attnC_blk(QO, KB, VT, OB, lds, vcu, G, t_); }
#endif
        GRID_SYNC();
        {
            pg8::Gemm g{OB, WO, MTOK, DM, DM}; pg8::StaticOrder S; S.init(MTOK, DM, G, bx);
            if (PROBE_REP(5) == 2) { pg8::EpiRes E0{l == 0 ? p.x : nullptr, XN, DUMMY1, DM, nullptr, SSQ, PART}; pg8::gemm_phase<pg8::EpiRes, pg8::StaticOrder, true, true>(lds, g, S, E0, wave); }
            pg8::EpiRes E{l == 0 ? p.x : nullptr, XN, nullptr, DM, XN, SSQ, PART};
            pg8::gemm_phase<pg8::EpiRes, pg8::StaticOrder, true, true>(lds, g, S, E, wave);
        }
        GRID_SYNC();
        {
            pg8::Gemm g{XN, WIN, MTOK, NFF2, DM}; pg8::StaticOrder S; S.init(MTOK, NFF2, G, bx);
            pg8::EpiFFN E{HM, p.ffn_conv_w + (size_t)l * 3 * NFF2, p.ffn_conv_b + (size_t)l * NFF2, EF, EL, (LAS pg8::f32x4*)(lds + 131072 + 1024), SSQ};
            for (int rep_ = 0; rep_ < PROBE_REP(7); ++rep_)
            pg8::gemm_phase<pg8::EpiFFN, pg8::StaticOrder, true, true>(lds, g, S, E, wave);
        }
        GRID_SYNC();
        {
            pg8::Gemm g{HM, WD, MTOK, DM, DFF}; pg8::StaticOrder S; S.init(MTOK, DM, G, bx);
            { FRESH_TID(t_); int lastpm = -1;
#pragma unroll 1
              for (int L = bx; L < 512; L += G) {
                  const int w_ = (L & 7) * 64 + (L >> 3), pm_ = (w_ >> 5) * 8 + (w_ & 7);
                  if (pm_ != lastpm) ffn_fixup_tile(EF, EL, p.ffn_conv_w + (size_t)l * 3 * NFF2, p.ffn_conv_b + (size_t)l * NFF2, HM, pm_, t_);
                  lastpm = pm_; }
              asm volatile("s_waitcnt vmcnt(0)" ::: "memory"); __syncthreads(); }
            if (PROBE_REP(9) == 2) { pg8::EpiRes E0{nullptr, XN, DUMMY2, DM, nullptr, SSQ, PART}; pg8::gemm_phase<pg8::EpiRes, pg8::StaticOrder, true, true>(lds, g, S, E0, wave); }
            pg8::EpiRes E{nullptr, XN, l + 1 == DEPTH ? p.out : nullptr, DM, l + 1 == DEPTH ? nullptr : XN, SSQ, PART};
            pg8::gemm_phase<pg8::EpiRes, pg8::StaticOrder, true, true>(lds, g, S, E, wave);
        }
        GRID_SYNC();
    }
}

extern "C" void kernel_launch(void* const* d_in, const int* in_sizes, int n_in, void* d_out, int out_size, void* d_ws, size_t ws_size, hipStream_t stream) {
    static int grid = 0;
    if (grid == 0) {
        if (n_in != 18 || out_size != MTOK * DM || ws_size < WS_END) { fprintf(stderr, "kernel_launch: unexpected shapes (n_in %d out %d ws %zu)\n", n_in, out_size, ws_size); grid = -1; return; }
        int dev = 0, cus = 0, per_cu = 0;
        hipGetDevice(&dev); hipDeviceGetAttribute(&cus, hipDeviceAttributeMultiprocessorCount, dev);
        hipFuncSetAttribute((const void*)fwd_kernel, hipFuncAttributeMaxDynamicSharedMemorySize, LDS_BYTES);
        hipOccupancyMaxActiveBlocksPerMultiprocessor(&per_cu, (const void*)fwd_kernel, NTHREADS, LDS_BYTES);
        if (per_cu < 1) { fprintf(stderr, "kernel_launch: occupancy query says %d blocks per CU\n", per_cu); per_cu = 1; }
        (void)hipGetLastError();
        grid = cus;
    }
    if (grid < 0) return;
    Params p{};
    const float** f = (const float**)&p;
    for (int i = 0; i < 18; ++i) f[i] = (const float*)d_in[i];
    p.out = (float*)d_out; p.ws = (unsigned char*)d_ws;
    if (hipMemsetAsync((char*)d_ws + WS_CTL, 0, CTL_BYTES, stream) != hipSuccess) { fprintf(stderr, "memset failed\n"); return; }
    void* args[] = {&p};
    hipError_t e = hipLaunchCooperativeKernel((const void*)fwd_kernel, dim3(grid), dim3(NTHREADS), args, LDS_BYTES, stream);
    if (e != hipSuccess) fprintf(stderr, "cooperative launch failed: %s (grid %d)\n", hipGetErrorString(e), grid);
}
```

```cpp
#include <hip/hip_runtime.h>
#include <hip/hip_cooperative_groups.h>
#include <cstdio>
#include <cstdint>
namespace cg = cooperative_groups;
namespace pg8 {
#define PG8_LAS __attribute__((address_space(3)))
typedef unsigned short bf16_t;
typedef short bf16x8 __attribute__((ext_vector_type(8)));
typedef float f32x4 __attribute__((ext_vector_type(4)));
typedef unsigned u32x4 __attribute__((ext_vector_type(4)));
constexpr int BM = 256, BK = 64, HALF = 128, HTB = HALF * BK * 2  , STAGE_BYTES = 8 * HTB, NXCD = 8, WGM = 8;

__host__ __device__ __forceinline__ int lds_byte(int r, int c) { const int st = (r >> 4) * 2 + (c >> 5), rr = r & 15, cc = c & 31, ob = rr * 64 + cc * 2; return st * 1024 + (ob ^ (((ob >> 9) & 1) << 5)); }
__host__ __device__ __forceinline__ void stage_rc(int b, int& R, int& C) { const int st = b / 1024, sb = b % 1024, swz = sb ^ (((sb >> 9) & 1) << 5); R = (st >> 1) * 16 + swz / 64; C = (st & 1) * 32 + (swz % 64) / 2; }
__host__ __device__ __forceinline__ int perm32(int rho) { const int n = rho >> 4, i = rho & 15; return 8 * (i >> 2) + 4 * n + (i & 3); }

struct Unit { int pm, pn; };
struct Gemm { const bf16_t* A; const bf16_t* Bt; int M, N, K; };

struct StaticOrder {
    int nM, nN, nwg, G, c;
    __host__ __device__ void init(int M, int N, int G_, int c_) { nM = M / BM; nN = N / BM; nwg = nM * nN; G = G_; c = c_; }
    __host__ __device__ bool next(int i, Unit& u) const {
        const long L = (long)i * G + c; if (L >= nwg) return false;
        int wgid = (int)L; { const int q = nwg / NXCD, r = nwg % NXCD, xcd = wgid % NXCD, off = wgid / NXCD; wgid = (xcd < r ? xcd * (q + 1) : r * (q + 1) + (xcd - r) * q) + off; }
        const int nig = WGM * nN, gid = wgid / nig, fm = gid * WGM, gsz = (nM - fm) < WGM ? (nM - fm) : WGM;
        u.pm = fm + ((wgid % nig) % gsz); u.pn = (wgid % nig) / gsz; return true;
    }
    __device__ __forceinline__ void a_ready(const Unit&) const {}
    __device__ __forceinline__ void done(const Unit&) const {}
};

__device__ __forceinline__ unsigned cvt_pk_bf16(float lo, float hi) { unsigned r; asm volatile("v_cvt_pk_bf16_f32 %0, %1, %2" : "=v"(r) : "v"(lo), "v"(hi)); return r; }
typedef float f32x2 __attribute__((ext_vector_type(2)));
typedef float f32x2v __attribute__((ext_vector_type(2)));
typedef unsigned u32x2v_t __attribute__((ext_vector_type(2)));
struct EpiBf16Plain {
    static constexpr bool PERM = true, AFTER_DRAIN = false;
    bf16_t* O; int ldc;
    __device__ __forceinline__ void operator()(const f32x4 (&acc)[2][2][4][2], const Unit& u, int wr, int wc, int fr, int fq) const {
        const int row0 = u.pm * BM + wr * 64 + fr; const int col0 = u.pn * BM + wc * 32 + 8 * fq;
#pragma unroll
        for (int ai = 0; ai < 2; ++ai)
#pragma unroll
            for (int m = 0; m < 4; ++m) { bf16_t* rowp = O + (size_t)(row0 + ai * HALF + m * 16) * ldc + col0;
#pragma unroll
                for (int bj = 0; bj < 2; ++bj) { const f32x4 v0 = acc[ai][bj][m][0], v1 = acc[ai][bj][m][1];
                    u32x4 w; w.x = cvt_pk_bf16(v0[0], v0[1]); w.y = cvt_pk_bf16(v0[2], v0[3]); w.z = cvt_pk_bf16(v1[0], v1[1]); w.w = cvt_pk_bf16(v1[2], v1[3]);
                    *(u32x4*)(rowp + bj * HALF) = w; } }
    }
};
__device__ __forceinline__ float rstd_of(const float* SSQ, size_t row) { const f32x4 s4 = *(const f32x4*)(SSQ + row * 4); return rsqrtf(((s4[0] + s4[1]) + (s4[2] + s4[3])) * (1.0f / 1024.0f) + 1e-6f); }
struct EpiRes {
    static constexpr bool PERM = true, AFTER_DRAIN = false;
    const float* base32; const bf16_t* base16; float* out32; int ldc; bf16_t* XB; float* SSQ; PG8_LAS float* part;
    __device__ __forceinline__ void operator()(const f32x4 (&acc)[2][2][4][2], const Unit& u, int wr, int wc, int fr_in, int fq_in) const {
        int fr = fr_in, fq = fq_in; asm volatile("" : "+v"(fr), "+v"(fq));
        const int col0 = u.pn * BM + wc * 32 + 8 * fq;
        u32x4 pre[2][4][2];
        if (!base32) {
#pragma unroll
            for (int ai = 0; ai < 2; ++ai)
#pragma unroll
                for (int m = 0; m < 4; ++m)
#pragma unroll
                    for (int bj = 0; bj < 2; ++bj) pre[ai][m][bj] = *(const u32x4*)(base16 + (size_t)(u.pm * BM + ai * HALF + wr * 64 + m * 16 + fr) * ldc + col0 + bj * HALF);
        }
#pragma unroll
        for (int ai = 0; ai < 2; ++ai)
#pragma unroll
            for (int m = 0; m < 4; ++m) { const int rl = ai * HALF + wr * 64 + m * 16 + fr; const size_t off = (size_t)(u.pm * BM + rl) * ldc + col0;
                float ss = 0.f;
#pragma unroll
                for (int bj = 0; bj < 2; ++bj) {
                    f32x4 b0, b1;
                    if (base32) { b0 = *(const f32x4*)(base32 + off + bj * HALF); b1 = *(const f32x4*)(base32 + off + bj * HALF + 4); }
                    else { const u32x4 r = pre[ai][m][bj];
                        b0 = (f32x4){__uint_as_float(r.x << 16), __uint_as_float(r.x & 0xFFFF0000u), __uint_as_float(r.y << 16), __uint_as_float(r.y & 0xFFFF0000u)};
                        b1 = (f32x4){__uint_as_float(r.z << 16), __uint_as_float(r.z & 0xFFFF0000u), __uint_as_float(r.w << 16), __uint_as_float(r.w & 0xFFFF0000u)}; }
                    const f32x4 v0 = b0 + acc[ai][bj][m][0], v1 = b1 + acc[ai][bj][m][1];
                    if (out32) { *(f32x4*)(out32 + off + bj * HALF) = v0; *(f32x4*)(out32 + off + bj * HALF + 4) = v1; }
                    if (XB) { u32x4 w; w.x = cvt_pk_bf16(v0[0], v0[1]); w.y = cvt_pk_bf16(v0[2], v0[3]); w.z = cvt_pk_bf16(v1[0], v1[1]); w.w = cvt_pk_bf16(v1[2], v1[3]); *(u32x4*)(XB + off + bj * HALF) = w;
                        const f32x4 q0 = (f32x4){__uint_as_float(w.x << 16), __uint_as_float(w.x & 0xFFFF0000u), __uint_as_float(w.y << 16), __uint_as_float(w.y & 0xFFFF0000u)};
                        const f32x4 q1 = (f32x4){__uint_as_float(w.z << 16), __uint_as_float(w.z & 0xFFFF0000u), __uint_as_float(w.w << 16), __uint_as_float(w.w & 0xFFFF0000u)};
                        ss += ((q0[0] * q0[0] + q0[1] * q0[1]) + (q0[2] * q0[2] + q0[3] * q0[3])) + ((q1[0] * q1[0] + q1[1] * q1[1]) + (q1[2] * q1[2] + q1[3] * q1[3])); } }
                ss += __shfl_xor(ss, 16); ss += __shfl_xor(ss, 32);
                if (fq == 0) part[rl * 4 + wc] = ss;
                if (base32 && (m & 1)) asm volatile("" ::: "memory"); }
        asm volatile("s_waitcnt lgkmcnt(0)" ::: "memory"); __builtin_amdgcn_s_barrier(); asm volatile("" ::: "memory");
        const int t = (wr * 4 + wc) * 64 + fq * 16 + fr;
        if (t < 256 && XB) { const f32x4 p4 = *(const PG8_LAS f32x4*)(part + t * 4); SSQ[(size_t)(u.pm * BM + t) * 4 + u.pn] = (p4[0] + p4[1]) + (p4[2] + p4[3]); }
    }
};
struct EpiVt {
    static constexpr bool PERM = true, AFTER_DRAIN = false;
    bf16_t* O; int ldc; const float* SSQ;
    __device__ __forceinline__ void operator()(const f32x4 (&acc)[2][2][4][2], const Unit& u, int wr, int wc, int fr_in, int fq_in) const {
        int fr = fr_in, fq = fq_in; asm volatile("" : "+v"(fr), "+v"(fq));
        const int row0 = u.pm * BM + wr * 64 + fr; const int col0 = u.pn * BM + wc * 32 + 8 * fq;
        float rs[2][8];
#pragma unroll
        for (int bj = 0; bj < 2; ++bj)
#pragma unroll
            for (int c = 0; c < 8; ++c) rs[bj][c] = rstd_of(SSQ, (size_t)(col0 + bj * HALF + c));
#pragma unroll
        for (int ai = 0; ai < 2; ++ai)
#pragma unroll
            for (int m = 0; m < 4; ++m) { bf16_t* rowp = O + (size_t)(row0 + ai * HALF + m * 16) * ldc + col0;
#pragma unroll
                for (int bj = 0; bj < 2; ++bj) { const f32x4 v0 = acc[ai][bj][m][0], v1 = acc[ai][bj][m][1];
                    u32x4 w; w.x = cvt_pk_bf16(v0[0] * rs[bj][0], v0[1] * rs[bj][1]); w.y = cvt_pk_bf16(v0[2] * rs[bj][2], v0[3] * rs[bj][3]); w.z = cvt_pk_bf16(v1[0] * rs[bj][4], v1[1] * rs[bj][5]); w.w = cvt_pk_bf16(v1[2] * rs[bj][6], v1[3] * rs[bj][7]);
                    *(u32x4*)(rowp + bj * HALF) = w; } }
    }
};
struct EpiQKV {
    static constexpr bool PERM = true, AFTER_DRAIN = false;
    int kind;
    bf16_t *Q, *K, *QI, *KI; float* WI;
    const float *gq, *gk; const f32x2v* rope; float qscale, wscale; const float* SSQ;
    __device__ __forceinline__ void operator()(const f32x4 (&acc)[2][2][4][2], const Unit& u, int wr, int wc, int fr_in, int fq_in) const {
        int fr = fr_in, fq = fq_in; asm volatile("" : "+v"(fr), "+v"(fq));
        const int hs = u.pn * 4 + wc;
        bf16_t* dst; int ld, col; bool donorm = false, dorope = false; const float* gain = gq; float sc = 1.f;
        if (hs < 16) { dst = Q; ld = 1024; col = hs * 64; donorm = (kind != 2); dorope = (kind == 1); gain = gq; sc = qscale; }
        else if (hs < 32) { dst = K; ld = 1024; col = (hs - 16) * 64; donorm = (kind != 2); dorope = (kind == 1); gain = gk; }
        else if (hs < 40) { dst = QI; ld = 512; col = (hs - 32) * 64; dorope = true; }
        else if (hs == 40) { dst = KI; ld = 64; col = 0; dorope = true; }
        else if (hs == 41) {
            if (fq == 0) {
#pragma unroll
                for (int ai = 0; ai < 2; ++ai)
#pragma unroll
                    for (int m = 0; m < 4; ++m) { const int row = u.pm * BM + ai * HALF + wr * 64 + m * 16 + fr;
                        const float rsw = rstd_of(SSQ, (size_t)row) * wscale; *(f32x4*)(WI + (size_t)row * 8) = acc[ai][0][m][0] * rsw; *(f32x4*)(WI + (size_t)row * 8 + 4) = acc[ai][0][m][1] * rsw; }
            }
            return;
        } else return;
        float g[2][2][4];
#pragma unroll
        for (int bj = 0; bj < 2; ++bj)
#pragma unroll
            for (int n = 0; n < 2; ++n)
#pragma unroll
                for (int i = 0; i < 4; ++i) g[bj][n][i] = donorm ? gain[32 * bj + 8 * fq + 4 * n + i] * sc : sc;
        f32x4 sq[2][4];
#pragma unroll
        for (int ai = 0; ai < 2; ++ai)
#pragma unroll
            for (int m = 0; m < 4; ++m) sq[ai][m] = *(const f32x4*)(SSQ + (size_t)(u.pm * BM + ai * HALF + wr * 64 + m * 16 + fr) * 4);
#pragma unroll
        for (int ai = 0; ai < 2; ++ai) {
#pragma unroll
          for (int mp = 0; mp < 4; ++mp) {
            f32x4 rp4[4][4];
            if (dorope) {
#pragma unroll
                for (int m = mp; m < mp + 1; ++m) { const f32x4* rp = (const f32x4*)(rope + (size_t)((u.pm * BM + ai * HALF + wr * 64 + m * 16 + fr) & 4095) * 32 + 8 * fq);
#pragma unroll
                    for (int k = 0; k < 4; ++k) rp4[m][k] = rp[k]; }
            }
#pragma unroll
            for (int m = mp; m < mp + 1; ++m) {
                const int row = u.pm * BM + ai * HALF + wr * 64 + m * 16 + fr;
                f32x4 v[2][2];
                const float rs0 = rsqrtf(((sq[ai][m][0] + sq[ai][m][1]) + (sq[ai][m][2] + sq[ai][m][3])) * (1.0f / 1024.0f) + 1e-6f);
#pragma unroll
                for (int bj = 0; bj < 2; ++bj)
#pragma unroll
                    for (int n = 0; n < 2; ++n) v[bj][n] = acc[ai][bj][m][n] * rs0;
                float r = 1.f;
                if (donorm) {
                    float ss = 0.f;
#pragma unroll
                    for (int bj = 0; bj < 2; ++bj)
#pragma unroll
                        for (int n = 0; n < 2; ++n) { const f32x4 x = v[bj][n]; ss += (x[0] * x[0] + x[1] * x[1]) + (x[2] * x[2] + x[3] * x[3]); }
                    ss += __shfl_xor(ss, 16); ss += __shfl_xor(ss, 32);
                    r = rsqrtf(ss * (1.0f / 64.0f) + 1e-6f);
                }
#pragma unroll
                for (int bj = 0; bj < 2; ++bj)
#pragma unroll
                    for (int n = 0; n < 2; ++n)
#pragma unroll
                        for (int i = 0; i < 4; ++i) v[bj][n][i] = v[bj][n][i] * r * g[bj][n][i];
                if (dorope) {
#pragma unroll
                    for (int n = 0; n < 2; ++n) { const f32x4 cs0 = rp4[m][2 * n], cs1 = rp4[m][2 * n + 1];
                        const float c_[4] = {cs0[0], cs0[2], cs1[0], cs1[2]}, s_[4] = {cs0[1], cs0[3], cs1[1], cs1[3]};
#pragma unroll
                        for (int i = 0; i < 4; ++i) { const float x1 = v[0][n][i], x2 = v[1][n][i]; v[0][n][i] = x1 * c_[i] - x2 * s_[i]; v[1][n][i] = x2 * c_[i] + x1 * s_[i]; } }
                }
                bf16_t* rowp = dst + (size_t)row * ld + col + 8 * fq;
#pragma unroll
                for (int bj = 0; bj < 2; ++bj) { u32x4 w; w.x = cvt_pk_bf16(v[bj][0][0], v[bj][0][1]); w.y = cvt_pk_bf16(v[bj][0][2], v[bj][0][3]); w.z = cvt_pk_bf16(v[bj][1][0], v[bj][1][1]); w.w = cvt_pk_bf16(v[bj][1][2], v[bj][1][3]);
                    *(u32x4*)(rowp + 32 * bj) = w; }
            }
            asm volatile("" ::: "memory");
          }
        }
    }
};
template <int CTRL, bool BC> __device__ __forceinline__ float pg8_dpp(float x) { return __int_as_float(__builtin_amdgcn_update_dpp(0, __float_as_int(x), CTRL, 0xf, 0xf, BC)); }
#define PG8_FMAC_DPP(v, a, w, CTRL) asm("v_fmac_f32_dpp %0, %1, %2 " CTRL : "+v"(v) : "v"(a), "v"(w))
struct EpiFFN {
    static constexpr bool PERM = true, AFTER_DRAIN = false;
    bf16_t* HM; const float* cw; const float* cb; float* EF; float* EL; PG8_LAS f32x4* halo; const float* SSQ;
    __device__ __forceinline__ void operator()(const f32x4 (&acc_)[2][2][4][2], const Unit& u, int wr, int wc, int fr_in, int fq_in) const {
        int fr = fr_in, fq = fq_in; asm volatile("" : "+v"(fr), "+v"(fq));
        f32x4 (&acc)[2][2][4][2] = const_cast<f32x4 (&)[2][2][4][2]>(acc_);
        f32x4 Wn[2][4];
        { const int jc0 = u.pn * 128 + wc * 32 + 8 * fq;
#pragma unroll
          for (int bj = 0; bj < 2; ++bj) { const float* wp = cw + bj * 2816 + jc0;
              Wn[bj][0] = *(const f32x4*)(wp); Wn[bj][1] = *(const f32x4*)(wp + 5632); Wn[bj][2] = *(const f32x4*)(wp + 2 * 5632); Wn[bj][3] = *(const f32x4*)(cb + bj * 2816 + jc0); } }
#pragma unroll
        for (int ai = 0; ai < 2; ++ai)
#pragma unroll
            for (int m = 0; m < 4; ++m) { const float rs0 = rstd_of(SSQ, (size_t)(u.pm * BM + ai * HALF + wr * 64 + m * 16 + fr));
#pragma unroll
                for (int bj = 0; bj < 2; ++bj)
#pragma unroll
                    for (int n = 0; n < 2; ++n) acc[ai][bj][m][n] = acc[ai][bj][m][n] * rs0; }
        const int pcol = u.pn * 256 + wc * 32 + 8 * fq, jcol = u.pn * 128 + wc * 32 + 8 * fq;
        if (fr >= 14) {
            const int rr = fr - 14;
#pragma unroll
            for (int ai = 0; ai < 2; ++ai)
#pragma unroll
                for (int bj = 0; bj < 2; ++bj)
#pragma unroll
                    for (int n = 0; n < 2; ++n) halo[(((((ai * 2 + wr) * 2 + rr) * 4 + wc) * 2 + bj) * 4 + fq) * 2 + n] = acc[ai][bj][3][n];
            if (wr == 1) { float* e = EL + ((size_t)u.pm * 2 + rr) * 5632 + pcol;
#pragma unroll
                for (int bj = 0; bj < 2; ++bj)
#pragma unroll
                    for (int n = 0; n < 2; ++n) *(f32x4*)(e + bj * 128 + n * 4) = acc[1][bj][3][n]; }
        }
        if (wr == 0 && fr < 2) { float* e = EF + ((size_t)u.pm * 2 + fr) * 5632 + pcol;
#pragma unroll
            for (int bj = 0; bj < 2; ++bj)
#pragma unroll
                for (int n = 0; n < 2; ++n) *(f32x4*)(e + bj * 128 + n * 4) = acc[0][bj][0][n]; }
        asm volatile("s_waitcnt lgkmcnt(0)" ::: "memory"); __builtin_amdgcn_s_barrier(); asm volatile("" ::: "memory");
#pragma unroll
        for (int n = 0; n < 2; ++n) {
            f32x4 W0[2], W1[2], W2[2], Bb[2], W0m[2], W1m[2];
#pragma unroll
            for (int bj = 0; bj < 2; ++bj) { const float* wp = cw + bj * 2816 + jcol + 4 * n;
                if (n == 0) { W0[bj] = Wn[bj][0]; W1[bj] = Wn[bj][1]; W2[bj] = Wn[bj][2]; Bb[bj] = Wn[bj][3]; }
                else { W0[bj] = *(const f32x4*)(wp); W1[bj] = *(const f32x4*)(wp + 5632); W2[bj] = *(const f32x4*)(wp + 2 * 5632); Bb[bj] = *(const f32x4*)(cb + bj * 2816 + jcol + 4 * n); }
                W1m[bj] = fr == 0 ? W1[bj] : (f32x4){0.f, 0.f, 0.f, 0.f}; W0m[bj] = fr < 2 ? W0[bj] : (f32x4){0.f, 0.f, 0.f, 0.f}; }
#pragma unroll
            for (int ai = 0; ai < 2; ++ai)
#pragma unroll
                for (int m = 0; m < 4; ++m) {
                    f32x4 c[2];
#pragma unroll
                    for (int bj = 0; bj < 2; ++bj) {
                        const f32x4 a = acc[ai][bj][m][n];
                        f32x4 t1, t2;
                        if (m > 0) { t1 = (f32x4){0.f, 0.f, 0.f, 0.f}; t2 = t1;
                        } else {
                            t1 = (f32x4){0.f, 0.f, 0.f, 0.f}; t2 = t1;
                            const int sa = (wr == 1) ? ai : 0, sw = (wr == 1) ? 0 : 1;
                            if ((wr == 1 || ai == 1) && fr < 2) {
                                const f32x4 h0 = halo[(((((sa * 2 + sw) * 2 + 0) * 4 + wc) * 2 + bj) * 4 + fq) * 2 + n], h1 = halo[(((((sa * 2 + sw) * 2 + 1) * 4 + wc) * 2 + bj) * 4 + fq) * 2 + n];
                                t1 = (fr == 0) ? h1 : (f32x4){0.f, 0.f, 0.f, 0.f}; t2 = (fr == 0) ? h0 : h1;
                            }
                        }
#pragma unroll
                        for (int i = 0; i < 4; ++i) {
                            const float ax = a[i];
                            float v = __builtin_fmaf(W2[bj][i], ax, Bb[bj][i]);
                            PG8_FMAC_DPP(v, ax, W1[bj][i], "row_shr:1 row_mask:0xf bank_mask:0xf bound_ctrl:1");
                            PG8_FMAC_DPP(v, ax, W0[bj][i], "row_shr:2 row_mask:0xf bank_mask:0xf bound_ctrl:1");
                            if (m > 0) { const float apx = acc[ai][bj][m - 1][n][i];
                                PG8_FMAC_DPP(v, apx, W1m[bj][i], "row_ror:1 row_mask:0xf bank_mask:0xf");
                                PG8_FMAC_DPP(v, apx, W0m[bj][i], "row_ror:2 row_mask:0xf bank_mask:0xf");
                            } else { v = __builtin_fmaf(t1[i], W1[bj][i], v); v = __builtin_fmaf(t2[i], W0[bj][i], v); }
                            c[bj][i] = v;
                        }
                    }
                    float hm[4];
#pragma unroll
                    for (int i = 0; i < 4; ++i) { const float g = c[0][i]; hm[i] = g * __builtin_amdgcn_rcpf(1.f + __builtin_amdgcn_exp2f(-1.4426950408889634f * g)) * c[1][i]; }
                    u32x2v_t w; w.x = cvt_pk_bf16(hm[0], hm[1]); w.y = cvt_pk_bf16(hm[2], hm[3]);
                    *(u32x2v_t*)(HM + (size_t)(u.pm * BM + ai * HALF + wr * 64 + m * 16 + fr) * 2816 + jcol + 4 * n) = w;
                }
        }
    }
};
template <class Epi, class Sched, bool ALIGN_EPI = false, bool SP2 = false>
__device__ __forceinline__ void gemm_phase(PG8_LAS unsigned char* lds, const Gemm g, const Sched& S, const Epi& E, const int wave_s) {
    unsigned ones_l = ~0u; asm volatile("" : "+s"(ones_l)); int tid_l = wave_s * 64 + (int)__builtin_amdgcn_mbcnt_hi(ones_l, __builtin_amdgcn_mbcnt_lo(ones_l, 0u)); asm volatile("" : "+v"(tid_l));
    const int tid = tid_l, wid = __builtin_amdgcn_readfirstlane(tid >> 6), lane = tid & 63, wr = wid >> 2, wc = wid & 3, fr = lane & 15, fq = lane >> 4;
    const int K = g.K, nt = K / BK;
    unsigned voffA[2], voffB[2];
#pragma unroll
    for (int i = 0; i < 2; ++i) { int R, C; stage_rc(tid * 16 + i * 8192, R, C); const int Rb = Epi::PERM ? ((R & ~31) + perm32(R & 31)) : R;
        voffA[i] = (unsigned)(R * K + C) * 2u; voffB[i] = (unsigned)(Rb * K + C) * 2u; }
    const size_t kstep = (size_t)(BK * 2);
    const size_t hstep = (size_t)HALF * K * 2;
    const size_t tstep = 2 * hstep;
    const unsigned ldsw = (unsigned)wid * 1024u;
    const int aoff = lds_byte(wr * 64 + fr, fq * 8), boff = lds_byte(wc * 32 + fr, fq * 8);
#define PG8_SA(b, h) (((b) * 2 + (h)) * HTB)
#define PG8_SB(b, h) ((4 + (b) * 2 + (h)) * HTB)
#define PG8_STAGE(bufoff, gbase, voff) do { _Pragma("unroll") for (int _i = 0; _i < 2; ++_i) \
        __builtin_amdgcn_global_load_lds((const unsigned*)((const char*)(gbase) + (voff)[_i]), (PG8_LAS unsigned*)(lds + (bufoff) + ldsw + _i * 8192), 16, 0, 0); } while (0)
#define PG8_LDA(dst, b, h) do { _Pragma("unroll") for (int m = 0; m < 4; ++m) _Pragma("unroll") for (int k = 0; k < 2; ++k) dst[m][k] = *(const PG8_LAS bf16x8*)(lds + PG8_SA(b, h) + aoff + m * 2048 + k * 1024); } while (0)
#define PG8_LDB(dst, b, h) do { _Pragma("unroll") for (int n = 0; n < 2; ++n) _Pragma("unroll") for (int k = 0; k < 2; ++k) dst[n][k] = *(const PG8_LAS bf16x8*)(lds + PG8_SB(b, h) + boff + n * 2048 + k * 1024); } while (0)
#define PG8_MMA(ai, bj, At, Bt) do { __builtin_amdgcn_s_setprio(1); _Pragma("unroll") for (int m = 0; m < 4; ++m) _Pragma("unroll") for (int n = 0; n < 2; ++n) _Pragma("unroll") for (int k = 0; k < 2; ++k) \
        acc[ai][bj][m][n] = __builtin_amdgcn_mfma_f32_16x16x32_bf16(Bt[n][k], At[m][k], acc[ai][bj][m][n], 0, 0, 0); __builtin_amdgcn_s_setprio(0); } while (0)
#define PG8_WAIT_V(n) asm volatile("s_waitcnt vmcnt(" #n ")" ::: "memory")
#define PG8_WAIT_L(n) asm volatile("s_waitcnt lgkmcnt(" #n ")" ::: "memory")
#define PG8_BAR __builtin_amdgcn_s_barrier()
#define PG8_SCHED __builtin_amdgcn_sched_barrier(0)
    Unit cur, nxt; int ui = 0;
    if (!S.next(0, cur)) return;
    f32x4 acc[2][2][4][2];
#pragma unroll
    for (int a = 0; a < 2; ++a)
#pragma unroll
        for (int b = 0; b < 2; ++b)
#pragma unroll
            for (int m = 0; m < 4; ++m)
#pragma unroll
                for (int n = 0; n < 2; ++n) acc[a][b][m][n] = (f32x4){0.f, 0.f, 0.f, 0.f};
    bf16x8 At[4][2], B0[2][2], B1[2][2];
    const char* cA = (const char*)g.A + (size_t)cur.pm * tstep; const char* cB = (const char*)g.Bt + (size_t)cur.pn * tstep;
    S.a_ready(cur);
    if constexpr (SP2) {
        PG8_STAGE(PG8_SB(0, 0), cB, voffB); PG8_STAGE(PG8_SB(0, 1), cB + hstep, voffB); PG8_STAGE(PG8_SA(0, 0), cA, voffA); PG8_STAGE(PG8_SA(0, 1), cA + hstep, voffA);
        if (wr == 1) PG8_BAR;
        PG8_WAIT_V(2); PG8_BAR;
        PG8_STAGE(PG8_SB(1, 0), cB + kstep, voffB); PG8_STAGE(PG8_SA(1, 0), cA + kstep, voffA); PG8_STAGE(PG8_SB(1, 1), cB + hstep + kstep, voffB);
        PG8_WAIT_V(6); PG8_BAR;
    } else {
        PG8_STAGE(PG8_SB(0, 0), cB, voffB); PG8_STAGE(PG8_SA(0, 0), cA, voffA); PG8_STAGE(PG8_SB(0, 1), cB + hstep, voffB); PG8_STAGE(PG8_SA(0, 1), cA + hstep, voffA);
        if (wr == 1) PG8_BAR;
        PG8_WAIT_V(4); PG8_BAR;
        PG8_STAGE(PG8_SB(1, 0), cB + kstep, voffB); PG8_STAGE(PG8_SA(1, 0), cA + kstep, voffA); PG8_STAGE(PG8_SB(1, 1), cB + hstep + kstep, voffB);
        PG8_WAIT_V(6); PG8_BAR;
    }
    for (;;) {
        const bool has_next = S.next(ui + 1, nxt);
        const char* nA = has_next ? (const char*)g.A + (size_t)nxt.pm * tstep : cA; const char* nB = has_next ? (const char*)g.Bt + (size_t)nxt.pn * tstep : cB;
        for (int t = 0; t < nt; t += 2) {
            const bool last = (t == nt - 2);
            const char* a1 = cA + (size_t)(t + 1) * kstep;
            const char* a2 = last ? nA : cA + (size_t)(t + 2) * kstep; const char* b2 = last ? nB : cB + (size_t)(t + 2) * kstep;
            const char* a3 = a2 + kstep; const char* b3 = b2 + kstep;
            if (last && has_next) S.a_ready(nxt);
            if constexpr (SP2) {
            PG8_LDB(B0, 0, 0); PG8_LDB(B1, 0, 1); PG8_SCHED; PG8_LDA(At, 0, 0); PG8_STAGE(PG8_SA(1, 1), a1 + hstep, voffA);
            PG8_WAIT_V(8); PG8_WAIT_L(0); PG8_BAR; PG8_MMA(0, 0, At, B0); PG8_MMA(0, 1, At, B1); PG8_BAR; PG8_SCHED;
            PG8_LDA(At, 0, 1); PG8_STAGE(PG8_SB(0, 0), b2, voffB); PG8_STAGE(PG8_SB(0, 1), b2 + hstep, voffB); PG8_STAGE(PG8_SA(0, 0), a2, voffA);
            PG8_WAIT_V(8); PG8_WAIT_L(0); PG8_BAR; PG8_MMA(1, 0, At, B0); PG8_MMA(1, 1, At, B1); PG8_BAR; PG8_SCHED;
            PG8_LDB(B0, 1, 0); PG8_LDB(B1, 1, 1); PG8_SCHED; PG8_LDA(At, 1, 0); PG8_STAGE(PG8_SA(0, 1), a2 + hstep, voffA);
            PG8_WAIT_V(8); PG8_WAIT_L(0); PG8_BAR; PG8_MMA(0, 0, At, B0); PG8_MMA(0, 1, At, B1); PG8_BAR; PG8_SCHED;
            PG8_LDA(At, 1, 1); PG8_STAGE(PG8_SB(1, 0), b3, voffB); PG8_STAGE(PG8_SB(1, 1), b3 + hstep, voffB); PG8_STAGE(PG8_SA(1, 0), a3, voffA);
            PG8_WAIT_V(8); PG8_WAIT_L(0); PG8_BAR; PG8_MMA(1, 0, At, B0); PG8_MMA(1, 1, At, B1); PG8_BAR; PG8_SCHED;
            } else {
            PG8_LDB(B0, 0, 0); PG8_SCHED; PG8_LDA(At, 0, 0); PG8_STAGE(PG8_SA(1, 1), a1 + hstep, voffA);
            PG8_WAIT_L(8); PG8_BAR; PG8_WAIT_L(0); PG8_MMA(0, 0, At, B0); PG8_BAR; PG8_SCHED;
            PG8_LDB(B1, 0, 1); PG8_STAGE(PG8_SB(0, 0), b2, voffB);
            PG8_BAR; PG8_WAIT_L(0); PG8_MMA(0, 1, At, B1); PG8_BAR;
            PG8_LDA(At, 0, 1); PG8_STAGE(PG8_SA(0, 0), a2, voffA);
            PG8_BAR; PG8_WAIT_L(0); PG8_MMA(1, 0, At, B0); PG8_BAR; PG8_SCHED;
            PG8_STAGE(PG8_SB(0, 1), b2 + hstep, voffB);
            PG8_WAIT_V(6); PG8_BAR; PG8_MMA(1, 1, At, B1); PG8_BAR;
            PG8_LDB(B0, 1, 0); PG8_SCHED; PG8_LDA(At, 1, 0); PG8_STAGE(PG8_SA(0, 1), a2 + hstep, voffA);
            PG8_WAIT_L(8); PG8_BAR; PG8_WAIT_L(0); PG8_MMA(0, 0, At, B0); PG8_BAR; PG8_SCHED;
            PG8_LDB(B1, 1, 1); PG8_STAGE(PG8_SB(1, 0), b3, voffB);
            PG8_BAR; PG8_WAIT_L(0); PG8_MMA(0, 1, At, B1); PG8_BAR;
            PG8_LDA(At, 1, 1); PG8_STAGE(PG8_SA(1, 0), a3, voffA);
            PG8_BAR; PG8_WAIT_L(0); PG8_MMA(1, 0, At, B0); PG8_BAR; PG8_SCHED;
            PG8_STAGE(PG8_SB(1, 1), b3 + hstep, voffB);
            PG8_WAIT_V(6); PG8_BAR; PG8_MMA(1, 1, At, B1); PG8_BAR;
            }
        }
        if constexpr (ALIGN_EPI) { if (wr == 0) PG8_BAR; }
        if constexpr (!Epi::AFTER_DRAIN) { E(acc, cur, wr, wc, fr, fq); S.done(cur); }
        if (!has_next) break;
#pragma unroll
        for (int a = 0; a < 2; ++a)
#pragma unroll
            for (int b = 0; b < 2; ++b)
#pragma unroll
                for (int m = 0; m < 4; ++m)
#pragma unroll
                    for (int n = 0; n < 2; ++n) acc[a][b][m][n] = (f32x4){0.f, 0.f, 0.f, 0.f};
        cur = nxt; cA = nA; cB = nB; ++ui;
        if constexpr (ALIGN_EPI) { if (wr == 1) PG8_BAR; }
    }
    PG8_WAIT_V(0);
    if constexpr (!ALIGN_EPI) { if (wr == 0) PG8_BAR; }
    PG8_BAR;
    if constexpr (Epi::AFTER_DRAIN) { E.fused(acc, cur, wr, wc, fr, fq, lds, wid, lane); S.done(cur); }
#undef PG8_SA
#undef PG8_SB
#undef PG8_STAGE
#undef PG8_LDA
#undef PG8_LDB
#undef PG8_MMA
#undef PG8_WAIT_V
#undef PG8_WAIT_L
#undef PG8_BAR
#undef PG8_SCHED
}
}
constexpr int SEQ = 4096, NB = 8, DM = 1024, NH = 16, HD = 64, MTOK = NB * SEQ, DFF = 2816, NFF2 = 2 * DFF, DEPTH = 4;
constexpr int NQK_A = 2048, NQK_B = 2816;
constexpr int MHALF = MTOK / 2;
constexpr int VTP = MTOK + 2048 + 128;
constexpr int NTHREADS = 512, NWAVES = 8;
constexpr float LOG2E = 1.4426950408889634f;
constexpr size_t MiB = 1u << 20;
constexpr size_t WS_CTL = 0, CTL_BYTES = 64 * 1024;
constexpr size_t WS_ROPE = 1 * MiB;
constexpr size_t WS_SSQ = 128 * 1024;
constexpr size_t WS_W = 2 * MiB, W_LAYER = 26 * MiB, WL_QK = 0, WL_V = 5632 * 1024, WL_O = WL_V + 2 * MiB, WL_IN = WL_O + 2 * MiB, WL_D = WL_IN + 11 * MiB;
constexpr size_t WS_XN = 106 * MiB, WS_OB = 170 * MiB, WS_SCR = WS_XN;
constexpr size_t WS_QO = 234 * MiB, WS_K = 298 * MiB, WS_VT = 362 * MiB, WS_QI = 431 * MiB, WS_KI = 463 * MiB, WS_WI = 467 * MiB, WS_MASK = 468 * MiB;
constexpr size_t WS_HM = 234 * MiB, WS_EF = 410 * MiB, WS_EL = 416 * MiB, WS_END = 498 * MiB;
static_assert(WL_D + (size_t)DM * DFF * 2 <= W_LAYER, "weights per layer");
static_assert(WS_VT + (size_t)DM * VTP * 2 <= WS_QI && WS_W + DEPTH * W_LAYER <= WS_XN && WS_MASK + 16 * MiB <= WS_END && WS_HM + (size_t)MTOK * DFF * 2 <= WS_EF && WS_EF + (size_t)256 * NFF2 * 4 <= WS_EL && WS_EL + (size_t)256 * NFF2 * 4 <= WS_END, "ws map");

#define LAS __attribute__((address_space(3)))
typedef unsigned short bf16;
typedef short bf16x8 __attribute__((ext_vector_type(8)));
typedef float f32x4 __attribute__((ext_vector_type(4)));
typedef float f32x16 __attribute__((ext_vector_type(16)));
typedef unsigned u32x4 __attribute__((ext_vector_type(4)));
typedef unsigned u32x2 __attribute__((ext_vector_type(2)));
typedef float f32x2_t __attribute__((ext_vector_type(2))); typedef __bf16 bf16x2_t __attribute__((ext_vector_type(2)));
__device__ __forceinline__ unsigned cvtpk(float lo, float hi) { f32x2_t v = {lo, hi}; bf16x2_t b = __builtin_convertvector(v, bf16x2_t); return __builtin_bit_cast(unsigned, b); }
__device__ __forceinline__ float bf2f(unsigned short h) { return __uint_as_float((unsigned)h << 16); }
__device__ __forceinline__ float wave_sum(float v) {
#pragma unroll
    for (int o = 1; o < 64; o <<= 1) v += __shfl_xor(v, o);
    return v;
}
__device__ __forceinline__ unsigned wave_sum_u32(unsigned v) {
    v += (unsigned)__builtin_amdgcn_update_dpp(0, (int)v, 0x111, 0xf, 0xf, true);
    v += (unsigned)__builtin_amdgcn_update_dpp(0, (int)v, 0x112, 0xf, 0xf, true);
    v += (unsigned)__builtin_amdgcn_update_dpp(0, (int)v, 0x114, 0xf, 0xf, true);
    v += (unsigned)__builtin_amdgcn_update_dpp(0, (int)v, 0x118, 0xf, 0xf, true);
    v += (unsigned)__builtin_amdgcn_update_dpp(0, (int)v, 0x142, 0xa, 0xf, true);
    v += (unsigned)__builtin_amdgcn_update_dpp(0, (int)v, 0x143, 0xc, 0xf, true);
    return (unsigned)__builtin_amdgcn_readlane((int)v, 63);
}
__device__ __forceinline__ int lane_id() { unsigned ones = ~0u; asm volatile("" : "+s"(ones)); return (int)__builtin_amdgcn_mbcnt_hi(ones, __builtin_amdgcn_mbcnt_lo(ones, 0u)); }
__device__ __forceinline__ int pi_row(int i) { return (i & ~12) | ((i & 4) << 1) | ((i & 8) >> 1); }

struct Params {
    const float* x; const float* norm1_g; const float* norm2_g;
    const float* a_w_qkv; const float* a_q_norm; const float* a_k_norm; const float* a_rel_bias; const float* a_w_o;
    const float* b_w_in; const float* b_q_norm; const float* b_k_norm; const float* b_w_o;
    const float* c_w_qkv; const float* c_w_o;
    const float* ffn_w_in; const float* ffn_conv_w; const float* ffn_conv_b; const float* ffn_w_down;
    float* out; unsigned char* ws;
};

struct TJob { const float* W; int K, ldw, src_col0, nvalid; bf16* WT; int dst_row0, perm; const float* gk; int item; bool valid; };
__device__ __forceinline__ void tjob_load(const TJob& jb, float (&wv)[32], int lane) {
    const int kblks = jb.K / 64, nb = jb.item / kblks, kb = jb.item % kblks, k0 = 64 * kb, n0 = 32 * nb;
    const int nn = n0 + (lane & 31); const bool ok = nn < jb.nvalid;
#pragma unroll
    for (int i = 0; i < 32; ++i) { const int kk = 2 * i + (lane >> 5); wv[i] = ok ? jb.W[(size_t)(k0 + kk) * jb.ldw + jb.src_col0 + nn] : 0.f; }
}
__device__ __forceinline__ void tjob_finish(const TJob& jb, float (&wv)[32], LAS float* scr, int lane) {
    const int K = jb.K, kblks = K / 64, nb = jb.item / kblks, kb = jb.item % kblks, k0 = 64 * kb, n0 = 32 * nb;
    if (jb.gk) {
#pragma unroll
        for (int i = 0; i < 32; ++i) wv[i] *= jb.gk[k0 + 2 * i + (lane >> 5)];
    }
#pragma unroll
    for (int i = 0; i < 32; ++i) { const int kk = 2 * i + (lane >> 5); scr[kk * 33 + (lane & 31)] = wv[i]; }
    asm volatile("s_waitcnt lgkmcnt(0)" ::: "memory");
    int L = jb.dst_row0 + n0;
    if (jb.perm == 1) { const int l = L & 255; L = (L & ~255) | (((l >> 5) & 1) * 128 + (l >> 6) * 32); }
    else if (jb.perm == 2) { const int hb = L >= DFF ? 1 : 0, c = L - hb * DFF; L = (c >> 7) * 256 + hb * 128 + (c & 127); }
    const int c = lane & 7;
#pragma unroll
    for (int j = 0; j < 4; ++j) { const int n = (lane >> 3) + 8 * j; const LAS float* s = scr + (8 * c) * 33 + n;
        u32x4 o; o.x = cvtpk(s[0 * 33], s[1 * 33]); o.y = cvtpk(s[2 * 33], s[3 * 33]); o.z = cvtpk(s[4 * 33], s[5 * 33]); o.w = cvtpk(s[6 * 33], s[7 * 33]);
        *(u32x4*)(jb.WT + (size_t)(L + n) * K + k0 + 8 * c) = o; }
    asm volatile("s_waitcnt lgkmcnt(0)" ::: "memory");
}
__device__ __forceinline__ void rms_row_to_bf16(const float* xrow, const float* g, bf16* orow, int lane) {
    const f32x4* xr = (const f32x4*)xrow + lane; const f32x4* gr = (const f32x4*)g + lane;
    f32x4 v[4]; float s = 0.f;
#pragma unroll
    for (int j = 0; j < 4; ++j) { v[j] = xr[64 * j]; s += (v[j].x * v[j].x + v[j].y * v[j].y) + (v[j].z * v[j].z + v[j].w * v[j].w); }
    const float rstd = rsqrtf(wave_sum(s) * (1.f / DM) + 1e-6f);
    u32x2* o8 = (u32x2*)orow + lane;
#pragma unroll
    for (int j = 0; j < 4; ++j) { const f32x4 gg = gr[64 * j]; u32x2 w; w.x = cvtpk(v[j].x * rstd * gg.x, v[j].y * rstd * gg.y); w.y = cvtpk(v[j].z * rstd * gg.z, v[j].w * rstd * gg.w); o8[64 * j] = w; }
}
__device__ __forceinline__ void xb_row(const float* xrow, bf16* orow, float* ssq4, int lane) {
    const f32x4* xr = (const f32x4*)xrow + lane;
    f32x4 v[4]; float s = 0.f;
#pragma unroll
    for (int j = 0; j < 4; ++j) { v[j] = xr[64 * j]; s += (v[j].x * v[j].x + v[j].y * v[j].y) + (v[j].z * v[j].z + v[j].w * v[j].w); }
    s = wave_sum(s);
    u32x2* o8 = (u32x2*)orow + lane;
#pragma unroll
    for (int j = 0; j < 4; ++j) { u32x2 w; w.x = cvtpk(v[j].x, v[j].y); w.y = cvtpk(v[j].z, v[j].w); o8[64 * j] = w; }
    if (lane == 0) *(f32x4*)ssq4 = (f32x4){s, 0.f, 0.f, 0.f};
}
__device__ __forceinline__ void norm_phase(const float* X, const float* g, bf16* XN, int gw, int ngw, int lane) {
    for (int m = gw; m < MTOK; m += ngw) rms_row_to_bf16(X + (size_t)m * DM, g, XN + (size_t)m * DM, lane);
}

#define MFMA32(a, b, c) __builtin_amdgcn_mfma_f32_32x32x16_bf16((a), (b), (c), 0, 0, 0)
__device__ __forceinline__ void qk_tile(f32x16& p0, f32x16& p1, const bf16* Kh  , size_t key0, int kpitch, const bf16x8 (&qr)[4], int r32, int hi) {
    const bf16* kp = Kh + (key0 + pi_row(r32)) * (size_t)kpitch + hi * 8;
    p0 = (f32x16){}; p1 = (f32x16){};
#pragma unroll
    for (int d0 = 0; d0 < 4; ++d0) {
        const bf16x8 k0 = *(const bf16x8*)(kp + d0 * 16), k1 = *(const bf16x8*)(kp + (size_t)32 * kpitch + d0 * 16);
        p0 = MFMA32(k0, qr[d0], p0); p1 = MFMA32(k1, qr[d0], p1);
    }
}
__device__ __forceinline__ void pv_tile(f32x16& o0, f32x16& o1, const bf16* Vth  , size_t key0, const f32x16& p0, const f32x16& p1, int r32, int hi) {
    const bf16* vp = Vth + (size_t)r32 * MTOK + key0 + hi * 8;
#pragma unroll
    for (int half = 0; half < 2; ++half)
#pragma unroll
        for (int s = 0; s < 2; ++s) {
            const f32x16& p = half ? p1 : p0;
            u32x4 w; w.x = cvtpk(p[8 * s + 0], p[8 * s + 1]); w.y = cvtpk(p[8 * s + 2], p[8 * s + 3]); w.z = cvtpk(p[8 * s + 4], p[8 * s + 5]); w.w = cvtpk(p[8 * s + 6], p[8 * s + 7]);
            const bf16x8 pf = __builtin_bit_cast(bf16x8, w);
            const bf16x8 v0 = *(const bf16x8*)(vp + half * 32 + s * 16), v1 = *(const bf16x8*)(vp + (size_t)32 * MTOK + half * 32 + s * 16);
            o0 = MFMA32(v0, pf, o0); o1 = MFMA32(v1, pf, o1);
        }
}
__device__ __forceinline__ void load_q(bf16x8 (&qr)[4], const bf16* Q, size_t qrow, int h, int hi) {
#pragma unroll
    for (int d0 = 0; d0 < 4; ++d0) qr[d0] = *(const bf16x8*)(Q + qrow * DM + h * HD + d0 * 16 + hi * 8);
}
__device__ __forceinline__ void store_o(bf16* O, size_t qrow, int h, const f32x16& o0, const f32x16& o1, float rl, int hi) {
    bf16* op = O + qrow * DM + h * HD + 4 * hi;
#pragma unroll
    for (int dh = 0; dh < 2; ++dh)
#pragma unroll
        for (int g = 0; g < 4; ++g) { const f32x16& o = dh ? o1 : o0; u32x2 w; w.x = cvtpk(o[4 * g] * rl, o[4 * g + 1] * rl); w.y = cvtpk(o[4 * g + 2] * rl, o[4 * g + 3] * rl);
            *(u32x2*)(op + 32 * dh + 8 * g) = w; }
}
#define MAX3(a, b, c) __builtin_fmaxf(__builtin_fmaxf((a), (b)), (c))
__device__ __forceinline__ void softmax_step(f32x16& p0, f32x16& p1, float& m, float& l, f32x16& o0, f32x16& o1) {
    float a = MAX3(p0[0], p0[1], p0[2]), b = MAX3(p1[0], p1[1], p1[2]);
#pragma unroll
    for (int r = 3; r < 15; r += 2) { a = MAX3(a, p0[r], p0[r + 1]); b = MAX3(b, p1[r], p1[r + 1]); }
    float mx = MAX3(a, b, p0[15]); mx = fmaxf(mx, p1[15]);
    mx = fmaxf(mx, __shfl_xor(mx, 32));
    const float mn = fmaxf(m, mx);
    if (!__all(mn == m)) {
        const float alpha = __builtin_amdgcn_exp2f(m - mn); m = mn; l *= alpha;
#pragma unroll
        for (int r = 0; r < 16; ++r) { o0[r] *= alpha; o1[r] *= alpha; }
    }
    float s = 0.f;
#pragma unroll
    for (int r = 0; r < 16; ++r) { p0[r] = __builtin_amdgcn_exp2f(p0[r] - mn); p1[r] = __builtin_amdgcn_exp2f(p1[r] - mn); s += p0[r] + p1[r]; }
    l += s;
}
__device__ __forceinline__ void attn_unit_of(int u, int& bh, int& qb) { bh = u >> 7; qb = u & 127; if ((u >> 11) & 1) qb = 127 - qb; }

__device__ __forceinline__ void attnA_phase(const bf16* Q, const bf16* K, const bf16* Vt, bf16* O, const float* rel_bias  , LAS float* biasL, int vw, int nvw, int tid) {
    for (int i = tid; i < 16 * 513; i += NTHREADS) biasL[(i / 513) * 516 + (i % 513)] = rel_bias[i] * LOG2E;
    __syncthreads();
    const int lane = tid & 63, r32 = lane & 31, hi = lane >> 5;
    for (int u = vw; u < NB * NH * 128; u += nvw) {
        int bh, qb; attn_unit_of(u, bh, qb); const int b = bh >> 4, h = bh & 15, c = qb >> 1, qh = qb & 1;
        const size_t qrow = (size_t)b * SEQ + qb * 32 + r32;
        bf16x8 qr[4]; load_q(qr, Q, qrow, h, hi);
        f32x16 o0 = (f32x16){}, o1 = (f32x16){}; float m = -1e30f, l = 0.f;
        const LAS float* bl = biasL + h * 516;
        for (int kt = (c < 8 ? 8 - c : 0); kt <= 8; ++kt) {
            const size_t key0 = (size_t)b * SEQ + (size_t)(c - 8 + kt) * 64;
            f32x16 p0, p1; qk_tile(p0, p1, K + h * HD, key0, DM, qr, r32, hi);
            if (kt >= 4) {
                const int base = (8 - kt) * 64 + qh * 32 + r32 - 8 * hi;
#pragma unroll
                for (int r = 0; r < 16; ++r) { const int d0 = base - (16 * (r >> 3) + (r & 7)); const int d1 = d0 - 32;
                    p0[r] += bl[(d0 < 256 ? d0 : 256) + 256]; p1[r] += bl[(d1 < 256 ? d1 : 256) + 256]; }
            } else { const float bc = bl[512];
#pragma unroll
                for (int r = 0; r < 16; ++r) { p0[r] += bc; p1[r] += bc; } }
            softmax_step(p0, p1, m, l, o0, o1);
            pv_tile(o0, o1, Vt + (size_t)h * HD * MTOK, key0, p0, p1, r32, hi);
        }
        l += __shfl_xor(l, 32);
        store_o(O, qrow, h, o0, o1, 1.0f / l, hi);
    }
}
__device__ __forceinline__ void attnC_phase(const bf16* Q, const bf16* K, const bf16* Vt, bf16* O, int vw, int nvw, int tid) {
    const int lane = tid & 63, r32 = lane & 31, hi = lane >> 5;
    for (int u = vw; u < NB * NH * 128; u += nvw) {
        int bh, qb; attn_unit_of(u, bh, qb); const int b = bh >> 4, h = bh & 15;
        const size_t qrow = (size_t)b * SEQ + qb * 32 + r32; const int t = qb * 32 + r32;
        bf16x8 qr[4]; load_q(qr, Q, qrow, h, hi);
        f32x16 o0 = (f32x16){}, o1 = (f32x16){}; float R = 0.f;
        for (int kt = qb >> 1; kt >= 0; --kt) {
            const size_t key0 = (size_t)b * SEQ + (size_t)kt * 64;
            f32x16 p0, p1; qk_tile(p0, p1, K + h * HD, key0, DM, qr, r32, hi);
            const int kb = kt * 64 + 8 * hi;
            float lk[32], lb[32];
#pragma unroll
            for (int e = 0; e < 32; ++e) { const int r = e & 15, half = e >> 4; const float z = half ? p1[r] : p0[r];
                const int key = kb + 32 * half + 16 * (r >> 3) + (r & 7);
                const float sp = fmaxf(z, 0.f) + __builtin_amdgcn_logf(1.f + __builtin_amdgcn_exp2f(-fabsf(z)));
                const bool valid = key < t;
                lk[e] = valid ? -sp : 0.f; lb[e] = valid ? (z - sp) : -INFINITY; }
            float G[4], ex[32];
#pragma unroll
            for (int gi = 0; gi < 4; ++gi) { float run = 0.f;
#pragma unroll
                for (int i = 7; i >= 0; --i) { ex[gi * 8 + i] = run; run += lk[gi * 8 + i]; }
                G[gi] = run; }
            float Gp[4];
#pragma unroll
            for (int gi = 0; gi < 4; ++gi) Gp[gi] = __shfl_xor(G[gi], 32);
            float suf[4]; float run = 0.f;
#pragma unroll
            for (int gi = 3; gi >= 0; --gi) { suf[gi] = run + (hi == 0 ? Gp[gi] : 0.f); run += G[gi] + Gp[gi]; }
#pragma unroll
            for (int e = 0; e < 32; ++e) { const float a = __builtin_amdgcn_exp2f(lb[e] + R + suf[e >> 3] + ex[e]); if (e < 16) p0[e] = a; else p1[e - 16] = a; }
            R += run;
            pv_tile(o0, o1, Vt + (size_t)h * HD * MTOK, key0, p0, p1, r32, hi);
            if (__all(R < -300.f)) break;
        }
        store_o(O, qrow, h, o0, o1, 1.0f, hi);
    }
}
constexpr int TP = 144;
constexpr int TILE_B = 64 * TP, KVBUF_B = 2 * TILE_B;
constexpr int PAIR_B = 2 * KVBUF_B;
struct KVStage { u32x4 k, v; };
__device__ __forceinline__ void kv_issue(KVStage& st, const bf16* Kh, const bf16* Vth, size_t key0, int tid) {
    const int row = tid >> 3, ch = tid & 7;
    st.k = *(const u32x4*)(Kh + (key0 + row) * DM + ch * 8);
    st.v = *(const u32x4*)(Vth + (size_t)row * VTP + key0 + ch * 8);
}
__device__ __forceinline__ void kv_write(const KVStage& st, LAS unsigned char* buf, int tid) {
    const int row = tid >> 3, ch = tid & 7;
    *(LAS u32x4*)(buf + row * TP + ch * 16) = st.k;
    *(LAS u32x4*)(buf + TILE_B + row * TP + ch * 16) = st.v;
}
template <bool INIT = true> __device__ __forceinline__ void qk_lds(f32x16& p0, f32x16& p1, const LAS unsigned char* buf, const bf16x8 (&qr)[4], int r32, int hi) {
    const LAS unsigned char* kp = buf + pi_row(r32) * TP + hi * 16;
    if (INIT) { p0 = (f32x16){}; p1 = (f32x16){}; }
    bf16x8 kf[8];
#pragma unroll
    for (int d0 = 0; d0 < 4; ++d0) { kf[2 * d0] = *(const LAS bf16x8*)(kp + d0 * 32); kf[2 * d0 + 1] = *(const LAS bf16x8*)(kp + 32 * TP + d0 * 32); }
    __builtin_amdgcn_s_setprio(1);
#pragma unroll
    for (int d0 = 0; d0 < 4; ++d0) { p0 = MFMA32(kf[2 * d0], qr[d0], p0); p1 = MFMA32(kf[2 * d0 + 1], qr[d0], p1); }
    __builtin_amdgcn_s_setprio(0);
}
__device__ __forceinline__ void pv_lds(f32x16& o0, f32x16& o1, const LAS unsigned char* buf, const f32x16& p0, const f32x16& p1, int r32, int hi) {
    const LAS unsigned char* vp = buf + TILE_B + r32 * TP + hi * 16;
    bf16x8 pf[4], vf[8];
#pragma unroll
    for (int half = 0; half < 2; ++half)
#pragma unroll
        for (int s = 0; s < 2; ++s) {
            const f32x16& p = half ? p1 : p0;
            u32x4 w; w.x = cvtpk(p[8 * s + 0], p[8 * s + 1]); w.y = cvtpk(p[8 * s + 2], p[8 * s + 3]); w.z = cvtpk(p[8 * s + 4], p[8 * s + 5]); w.w = cvtpk(p[8 * s + 6], p[8 * s + 7]);
            pf[half * 2 + s] = __builtin_bit_cast(bf16x8, w);
            vf[(half * 2 + s) * 2] = *(const LAS bf16x8*)(vp + half * 64 + s * 32); vf[(half * 2 + s) * 2 + 1] = *(const LAS bf16x8*)(vp + 32 * TP + half * 64 + s * 32);
        }
    __builtin_amdgcn_s_setprio(1);
#pragma unroll
    for (int k = 0; k < 4; ++k) { o0 = MFMA32(vf[2 * k], pf[k], o0); o1 = MFMA32(vf[2 * k + 1], pf[k], o1); }
    __builtin_amdgcn_s_setprio(0);
}
#define WG_BARRIER_L() do { asm volatile("s_waitcnt lgkmcnt(0)" ::: "memory"); __builtin_amdgcn_s_barrier(); asm volatile("" ::: "memory"); } while (0)
#define WG_BARRIER() do { asm volatile("s_waitcnt vmcnt(0) lgkmcnt(0)" ::: "memory"); __builtin_amdgcn_s_barrier(); asm volatile("" ::: "memory"); } while (0)
__device__ __forceinline__ void blk_unit_of(int u, int& bh, int& ub) { bh = u >> 4; ub = u & 15; if ((u >> 8) & 1) ub = 15 - ub; }

template <bool FIXED> __device__ __forceinline__ void attnA_blk(const bf16* Q, const bf16* K, const bf16* Vt, bf16* O, const float* rel_bias, float ref, LAS unsigned char* lds, int vcu, int G, int tid) {
    LAS float* biasL = (LAS float*)(lds + 2 * PAIR_B);
    for (int i = tid; i < 16 * 513; i += NTHREADS) biasL[(i / 513) * 516 + (i % 513)] = rel_bias[i] * LOG2E - (FIXED ? ref : 0.f);
    __syncthreads();
    const int lane = tid & 63, r32 = lane & 31, hi = lane >> 5, wid = __builtin_amdgcn_readfirstlane(tid >> 6);
#pragma unroll 1
    for (int u = vcu; u < NB * NH * 16; u += G) {
        int bh, ub; blk_unit_of(u, bh, ub); const int b = bh >> 4, h = bh & 15, qb = ub * 8 + wid, c = qb >> 1, qh = qb & 1;
        const size_t qrow = (size_t)b * SEQ + qb * 32 + r32;
        bf16x8 qr[4]; load_q(qr, Q, qrow, h, hi);
        f32x16 o0 = (f32x16){}, o1 = (f32x16){}; float m = -1e30f, l = 0.f;
        const LAS float* bl = biasL + h * 516;
        const bf16* Kh = K + h * HD; const bf16* Vth = Vt + (size_t)h * HD * VTP;
        const int c0 = ub * 4, t_lo = c0 >= 8 ? c0 - 8 : 0, t_hi = c0 + 3;
        const size_t kbase = (size_t)b * SEQ; const int ntl = t_hi - t_lo + 1;
        KVStage sa, sb;
        kv_issue(sa, Kh, Vth, kbase + (size_t)t_lo * 64, tid); kv_issue(sb, Kh, Vth, kbase + (size_t)(t_lo + 1) * 64, tid);
        kv_write(sa, lds, tid); kv_write(sb, lds + KVBUF_B, tid); WG_BARRIER();
#define ATT_PAIR(IT) do { const int it_ = (IT); LAS unsigned char* pb = lds + ((it_ >> 1) & 1) * PAIR_B; \
            if (it_ + 2 < ntl) { kv_issue(sa, Kh, Vth, kbase + (size_t)(t_lo + it_ + 2) * 64, tid); kv_issue(sb, Kh, Vth, kbase + (size_t)(t_lo + it_ + 3) * 64, tid); } \
            { const int t = t_lo + it_; LAS unsigned char* buf = pb; ATT_COMPUTE } \
            { const int t = t_lo + it_ + 1; LAS unsigned char* buf = pb + KVBUF_B; ATT_COMPUTE } \
            if (it_ + 2 < ntl) { LAS unsigned char* nb = lds + (((it_ >> 1) + 1) & 1) * PAIR_B; kv_write(sa, nb, tid); kv_write(sb, nb + KVBUF_B, tid); } \
            WG_BARRIER_L(); } while (0)
#define ATT_COMPUTE             if (t >= c - 8 && t <= c) { \
                const int kt = t - c + 8; \
                f32x16 p0, p1; \
                if (kt > 4) { \
                    const LAS float* bp = bl + ((8 - kt) * 64 + qh * 32 + r32 - 8 * hi + 256); \
_Pragma("unroll") \
                    for (int r = 0; r < 16; ++r) { p0[r] = bp[-(16 * (r >> 3) + (r & 7))]; p1[r] = bp[-(16 * (r >> 3) + (r & 7)) - 32]; } \
                } else if (kt == 4) { \
                    const int base = 4 * 64 + qh * 32 + r32 - 8 * hi; \
_Pragma("unroll") \
                    for (int r = 0; r < 16; ++r) { const int d0 = base - (16 * (r >> 3) + (r & 7)); const int d1 = d0 - 32; \
                        p0[r] = bl[(d0 < 256 ? d0 : 256) + 256]; p1[r] = bl[(d1 < 256 ? d1 : 256) + 256]; } \
                } else { const float bc = bl[512]; \
_Pragma("unroll") \
                    for (int r = 0; r < 16; ++r) { p0[r] = bc; p1[r] = bc; } } \
                qk_lds<false>(p0, p1, buf, qr, r32, hi); \
                if (FIXED) { float sacc = 0.f; \
_Pragma("unroll") \
                    for (int r = 0; r < 16; ++r) { p0[r] = __builtin_amdgcn_exp2f(p0[r]); p1[r] = __builtin_amdgcn_exp2f(p1[r]); sacc += p0[r] + p1[r]; } \
                    l += sacc; \
                } else softmax_step(p0, p1, m, l, o0, o1); \
                pv_lds(o0, o1, buf, p0, p1, r32, hi); \
            }
#pragma unroll 1
        for (int it = 0; it < ntl; it += 2) ATT_PAIR(it);
#undef ATT_COMPUTE
        l += __shfl_xor(l, 32);
        store_o(O, qrow, h, o0, o1, 1.0f / l, hi);
    }
}
__device__ __forceinline__ void b_mask_init(f32x16& p0, f32x16& p1, unsigned long long mw, int hi, float ref) {
    const int n0 = (int)~((unsigned)mw >> (8 * hi)), n1 = (int)~((unsigned)(mw >> 32) >> (8 * hi));
#pragma unroll
    for (int r = 0; r < 16; ++r) { const int bit = 16 * (r >> 3) + (r & 7);
        p0[r] = __int_as_float(__builtin_amdgcn_sbfe(n0, bit, 1) & (int)0xFF800000) - ref; p1[r] = __int_as_float(__builtin_amdgcn_sbfe(n1, bit, 1) & (int)0xFF800000) - ref; }
}
__device__ __forceinline__ float exp_tile(f32x16& p0, f32x16& p1) {
    float sacc = 0.f;
#pragma unroll
    for (int r = 0; r < 16; ++r) { p0[r] = __builtin_amdgcn_exp2f(p0[r]); p1[r] = __builtin_amdgcn_exp2f(p1[r]);
#ifdef PB2_EXPX
        p0[r] = __builtin_amdgcn_exp2f(__builtin_amdgcn_logf(p0[r])); p1[r] = __builtin_amdgcn_exp2f(__builtin_amdgcn_logf(p1[r]));
#endif
        sacc += p0[r] + p1[r]; }
    return sacc;
}
template <bool FIXED> __device__ __forceinline__ void attnB_blk(const bf16* Q, const bf16* K, const bf16* Vt, bf16* O, const unsigned long long* MASK, float ref, LAS unsigned char* lds, int vcu, int G, int tid) {
    const int lane = tid & 63, r32 = lane & 31, hi = lane >> 5, wid = __builtin_amdgcn_readfirstlane(tid >> 6);
#pragma unroll 1
    for (int u = vcu; u < NB * NH * 16; u += G) {
        int bh, ub; blk_unit_of(u, bh, ub); const int b = bh >> 4, h = bh & 15, qb = ub * 8 + wid;
        const size_t qrow = (size_t)b * SEQ + qb * 32 + r32;
        bf16x8 qr[4]; load_q(qr, Q, qrow, h, hi);
        f32x16 o0 = (f32x16){}, o1 = (f32x16){}; float m = -1e30f, l = 0.f;
        const u32x4* mrow2 = (const u32x4*)(MASK + qrow * 64);
        const int ntile = (qb >> 1) + 1, t_hi = ub * 4 + 3;
        const bf16* Kh = K + h * HD; const bf16* Vth = Vt + (size_t)h * HD * VTP;
        const size_t kbase = (size_t)b * SEQ; const int ntl = t_hi + 1;
#ifndef PB2_LOOPX
#define PB2_LOOPX 1
#endif
        for (int rep2 = 0; rep2 < PB2_LOOPX; ++rep2) {
        KVStage sa, sb;
        kv_issue(sa, Kh, Vth, kbase, tid); kv_issue(sb, Kh, Vth, kbase + 64, tid);
        u32x4 mnext = mrow2[0];
        kv_write(sa, lds, tid); kv_write(sb, lds + KVBUF_B, tid); WG_BARRIER();
#pragma unroll 1
        for (int it = 0; it < ntl; it += 2) {
            LAS unsigned char* pb = lds + ((it >> 1) & 1) * PAIR_B;
            u32x4 mcur = mnext; asm volatile("" : "+v"(mcur));
            if (it + 2 < ntl) { kv_issue(sa, Kh, Vth, kbase + (size_t)(it + 2) * 64, tid); kv_issue(sb, Kh, Vth, kbase + (size_t)(it + 3) * 64, tid); }
            if (it + 2 < ntile) mnext = mrow2[(it >> 1) + 1];
            const unsigned long long ma = (it < ntile) ? ((unsigned long long)mcur.y << 32 | mcur.x) : 0ull, mb = (it + 1 < ntile) ? ((unsigned long long)mcur.w << 32 | mcur.z) : 0ull;
#pragma unroll
            for (int k = 0; k < 2; ++k) {
                if (it + k < ntile) {
                    LAS unsigned char* buf = pb + k * KVBUF_B;
                    f32x16 p0, p1; b_mask_init(p0, p1, k ? mb : ma, hi, FIXED ? ref : 0.f);
                    qk_lds<false>(p0, p1, buf, qr, r32, hi);
                    if (FIXED) l += exp_tile(p0, p1); else softmax_step(p0, p1, m, l, o0, o1);
                    pv_lds(o0, o1, buf, p0, p1, r32, hi);
                }
            }
            if (it + 2 < ntl) { LAS unsigned char* nb = lds + (((it >> 1) + 1) & 1) * PAIR_B; kv_write(sa, nb, tid); kv_write(sb, nb + KVBUF_B, tid);
#ifdef PB2_STAGEX
                kv_issue(sa, Kh, Vth, kbase + (size_t)(it + 2) * 64, tid); kv_issue(sb, Kh, Vth, kbase + (size_t)(it + 3) * 64, tid); kv_write(sa, nb, tid); kv_write(sb, nb + KVBUF_B, tid);
#endif
            }
            WG_BARRIER_L();
#ifdef PB2_BARX
            WG_BARRIER(); WG_BARRIER();
#endif
        }
        }
        l += __shfl_xor(l, 32);
        store_o(O, qrow, h, o0, o1, 1.0f / l, hi);
    }
}
__device__ __forceinline__ void attnC_blk(const bf16* Q, const bf16* K, const bf16* Vt, bf16* O, LAS unsigned char* lds, int vcu, int G, int tid) {
    const int lane = tid & 63, r32 = lane & 31, hi = lane >> 5, wid = __builtin_amdgcn_readfirstlane(tid >> 6);
    LAS unsigned* flags = (LAS unsigned*)(lds + 2 * KVBUF_B);
#pragma unroll 1
    for (int u = vcu; u < NB * NH * 16; u += G) {
        int bh, ub; blk_unit_of(u, bh, ub); const int b = bh >> 4, h = bh & 15, qb = ub * 8 + wid;
        const size_t qrow = (size_t)b * SEQ + qb * 32 + r32; const int tq = qb * 32 + r32;
        bf16x8 qr[4]; load_q(qr, Q, qrow, h, hi);
        f32x16 o0 = (f32x16){}, o1 = (f32x16){}; float R = 0.f; bool done = false;
        const int t_hi = ub * 4 + 3, t_me = qb >> 1;
        const bf16* Kh = K + h * HD; const bf16* Vth = Vt + (size_t)h * HD * VTP;
        KVStage st; kv_issue(st, Kh, Vth, (size_t)b * SEQ + (size_t)t_hi * 64, tid); kv_write(st, lds, tid); WG_BARRIER();
#pragma unroll 1
        for (int t = t_hi, it = 0; t >= 0; --t, ++it) {
            LAS unsigned char* buf = lds + (it & 1) * KVBUF_B;
            if (t > 0) kv_issue(st, Kh, Vth, (size_t)b * SEQ + (size_t)(t - 1) * 64, tid);
            if (t <= t_me && !done) {
                f32x16 p0, p1; qk_lds(p0, p1, buf, qr, r32, hi);
                const int kb = t * 64 + 8 * hi;
                const bool diag = (t == t_me);
                float lk[32], lb[32];
#pragma unroll
                for (int e = 0; e < 32; ++e) { const int r = e & 15, half = e >> 4; const float z = half ? p1[r] : p0[r];
                    const float sp = __builtin_amdgcn_logf(1.f + __builtin_amdgcn_exp2f(fminf(z, 80.f)));
                    lk[e] = -sp; lb[e] = z - sp; }
                if (diag) {
#pragma unroll
                    for (int e = 0; e < 32; ++e) { const int r = e & 15, half = e >> 4; const int key = kb + 32 * half + 16 * (r >> 3) + (r & 7);
                        const bool valid = key < tq; lk[e] = valid ? lk[e] : 0.f; lb[e] = valid ? lb[e] : -INFINITY; }
                }
                float Gs[4], ex[32];
#pragma unroll
                for (int gi = 0; gi < 4; ++gi) { float run = 0.f;
#pragma unroll
                    for (int i = 7; i >= 0; --i) { ex[gi * 8 + i] = run; run += lk[gi * 8 + i]; }
                    Gs[gi] = run; }
                float Gp[4];
#pragma unroll
                for (int gi = 0; gi < 4; ++gi) Gp[gi] = __shfl_xor(Gs[gi], 32);
                float suf[4]; float run = 0.f;
#pragma unroll
                for (int gi = 3; gi >= 0; --gi) { suf[gi] = R + run + (hi == 0 ? Gp[gi] : 0.f); run += Gs[gi] + Gp[gi]; }
#pragma unroll
                for (int e = 0; e < 32; ++e) { const float a = __builtin_amdgcn_exp2f(lb[e] + (suf[e >> 3] + ex[e])); if (e < 16) p0[e] = a; else p1[e - 16] = a; }
                R += run;
                pv_lds(o0, o1, buf, p0, p1, r32, hi);
                done = __all(R < -152.f);
            }
            if (lane == 0) flags[(it & 1) * 8 + wid] = (done || t == 0) ? 0u : 1u;
            if (t > 0) kv_write(st, lds + ((it + 1) & 1) * KVBUF_B, tid);
            WG_BARRIER_L();
            unsigned any = 0u;
#pragma unroll
            for (int w = 0; w < 8; ++w) any |= flags[(it & 1) * 8 + w];
            if (any == 0u) break;
        }
        store_o(O, qrow, h, o0, o1, 1.0f, hi);
        WG_BARRIER();
    }
}
#define XB_TMO      128
#define XB_XCNT(j)  (256  + 64 * (j))
#define XB_XSUB(j)  (1280 + 64 * (j))
#define XB_XGEN(j)  (2304 + 64 * (j))
#define XB_TOP      3328
#define XB_TOPGEN   3392
#define XCD_BAR_WORDS 3456
#define XB_SPIN_CAP (1u << 18)

__device__ __forceinline__ unsigned xb_ld(unsigned* p)              { return __hip_atomic_load(p, __ATOMIC_RELAXED, __HIP_MEMORY_SCOPE_AGENT); }
__device__ __forceinline__ unsigned xb_add(unsigned* p, unsigned v) { return __hip_atomic_fetch_add(p, v, __ATOMIC_RELAXED, __HIP_MEMORY_SCOPE_AGENT); }
__device__ __forceinline__ unsigned xb_xcc_id() { return (unsigned)__builtin_amdgcn_s_getreg((3 << 11) | 20) & 0xFu; }
#define XB_SPIN(cond, bar) do { unsigned _sp = 0; while (cond) { __builtin_amdgcn_s_sleep(1); \
    if ((++_sp & 255u) == 0u) { if (xb_ld(&(bar)[XB_TMO])) break; if (_sp > XB_SPIN_CAP) { atomicAdd(&(bar)[XB_TMO], 1u); break; } } } } while (0)

struct XcdBarrier {
    unsigned* bar; unsigned x;
    volatile LAS unsigned* st;
};

__device__ __forceinline__ XcdBarrier xcd_barrier_post(unsigned* bar, volatile LAS unsigned* st) {
    XcdBarrier b; b.bar = bar; b.x = xb_xcc_id(); b.st = st;
    if (threadIdx.x == 0) (void)xb_add(&bar[XB_XCNT(b.x)], 1u);
    return b;
}
__device__ __forceinline__ void xcd_barrier_complete(unsigned* bar, unsigned x, unsigned& nloc, unsigned& nx) {
    const unsigned G = gridDim.x * gridDim.y * gridDim.z;
    unsigned sum, cnt, mine, sp = 0u;
    for (;;) {
        sum = 0u; cnt = 0u; mine = 0u;
#pragma unroll
        for (unsigned j = 0; j < 16; ++j) { const unsigned c = xb_ld(&bar[XB_XCNT(j)]); sum += c; cnt += (c > 0u) ? 1u : 0u; mine = (j == x) ? c : mine; }
        if (sum == G) break;
        __builtin_amdgcn_s_sleep(1);
        if ((++sp & 255u) == 0u) { if (xb_ld(&bar[XB_TMO])) break; if (sp > XB_SPIN_CAP) { atomicAdd(&bar[XB_TMO], 1u); break; } }
    }
    nloc = mine > 0u ? mine : 1u; nx = cnt > 0u ? cnt : 1u;
}

__device__ __forceinline__ void xcd_barrier(const XcdBarrier& b, int g_wave_id) {
    asm volatile("s_waitcnt vmcnt(0)" ::: "memory");
    __syncthreads();
    if (g_wave_id == 0 && lane_id() == 0) {
        unsigned* bar = b.bar;
        __builtin_amdgcn_s_waitcnt(0);
        unsigned nloc = b.st[0], nx = b.st[1];
        if (nloc == 0u) { xcd_barrier_complete(bar, b.x, nloc, nx); b.st[0] = nloc; b.st[1] = nx; }
        const unsigned old = xb_add(&bar[XB_XSUB(b.x)], 1u);
        const unsigned gen = old / nloc;
        if (old + 1u == (gen + 1u) * nloc) {
            __builtin_amdgcn_fence(__ATOMIC_RELEASE, "agent");
            asm volatile("s_waitcnt vmcnt(0)" ::: "memory");
            const unsigned og = xb_add(&bar[XB_TOP], 1u);
            const unsigned tg = og / nx;
            if (og + 1u == (tg + 1u) * nx) xb_add(&bar[XB_TOPGEN], 1u);
            else XB_SPIN(xb_ld(&bar[XB_TOPGEN]) == tg, bar);
            __builtin_amdgcn_fence(__ATOMIC_ACQUIRE, "agent");
            xb_add(&bar[XB_XGEN(b.x)], 1u);
            asm volatile("s_waitcnt vmcnt(0)" ::: "memory");
        } else {
            XB_SPIN(xb_ld(&bar[XB_XGEN(b.x)]) == gen, bar);
            __builtin_amdgcn_fence(__ATOMIC_ACQUIRE, "agent");
            asm volatile("s_waitcnt vmcnt(0)" ::: "memory");
        }
    }
    __syncthreads();
}
constexpr int QI_PITCH = 520;
__device__ __forceinline__ void b1_phase(const bf16* QI, const bf16* KI, const float* WI, float* SCRb  , unsigned long long* MASK,
                                         LAS unsigned char* lds, int vcu, int G, int tid) {
    const int lane = tid & 63, r32 = lane & 31, hi = lane >> 5, wid = __builtin_amdgcn_readfirstlane(tid >> 6);
    LAS bf16* qs = (LAS bf16*)lds;
#pragma unroll 1
    for (int u0 = vcu, rnd = 0; u0 < NB * 128; u0 += G, ++rnd) {
        const int b = u0 >> 7; int qb = u0 & 127; if (rnd & 1) qb = 127 - qb;
        const size_t tok0 = (size_t)b * SEQ + qb * 32;
        const int ntile = (qb >> 1) + 1, limit = ntile * 64;
        for (int i = tid; i < 32 * 64; i += NTHREADS) { const int q = i >> 6, c = i & 63; *(LAS u32x4*)(qs + q * QI_PITCH + c * 8) = *(const u32x4*)(QI + (tok0 + q) * 512 + c * 8); }
        LAS float* wl = (LAS float*)(lds + 32 * QI_PITCH * 2);
        if (tid < 256) wl[tid] = WI[tok0 * 8 + tid];
        __syncthreads();
#ifndef B1_SCORE_REP
#define B1_SCORE_REP 1
#endif
#ifndef B1_TOPK_REP
#define B1_TOPK_REP 1
#endif
#ifndef B1_NO_SCORE
        for (int rep_ = 0; rep_ < B1_SCORE_REP; ++rep_)
#pragma unroll 1
        for (int kt = wid; kt < ntile; kt += NWAVES) {
            const size_t key0 = (size_t)b * SEQ + (size_t)kt * 64;
            const bf16* kp = KI + (key0 + pi_row(r32)) * 64 + hi * 8;
            bf16x8 kf0[4], kf1[4];
#pragma unroll
            for (int d0 = 0; d0 < 4; ++d0) { kf0[d0] = *(const bf16x8*)(kp + d0 * 16); kf1[d0] = *(const bf16x8*)(kp + 32 * 64 + d0 * 16); }
            f32x16 s0 = (f32x16){}, s1 = (f32x16){};
            int qoff = r32 * QI_PITCH + hi * 8; asm volatile("" : "+v"(qoff));
#pragma unroll 1
            for (int hh = 0; hh < 8; ++hh) {
                f32x16 a0 = (f32x16){}, a1 = (f32x16){};
                const float wh = wl[r32 * 8 + hh];
#pragma unroll
                for (int d0 = 0; d0 < 4; ++d0) { const bf16x8 qf = *(const LAS bf16x8*)(qs + qoff + hh * 64 + d0 * 16); a0 = MFMA32(kf0[d0], qf, a0); a1 = MFMA32(kf1[d0], qf, a1); }
#pragma unroll
                for (int r = 0; r < 16; ++r) { s0[r] = __builtin_fmaf(wh, __builtin_fmaxf(a0[r], 0.f), s0[r]); s1[r] = __builtin_fmaf(wh, __builtin_fmaxf(a1[r], 0.f), s1[r]); }
            }
            float* sp = SCRb + (size_t)r32 * 4096 + kt * 64 + 8 * hi;
#pragma unroll
            for (int half = 0; half < 2; ++half)
#pragma unroll
                for (int s = 0; s < 2; ++s) { const f32x16& p = half ? s1 : s0;
                    *(f32x4*)(sp + 32 * half + 16 * s) = (f32x4){p[8 * s], p[8 * s + 1], p[8 * s + 2], p[8 * s + 3]};
                    *(f32x4*)(sp + 32 * half + 16 * s + 4) = (f32x4){p[8 * s + 4], p[8 * s + 5], p[8 * s + 6], p[8 * s + 7]}; }
        }
#endif
        asm volatile("s_waitcnt vmcnt(0)" ::: "memory");
        __syncthreads();
#ifndef B1_NO_TOPK
#pragma unroll 1
        for (int qq = 0; qq < 4 * B1_TOPK_REP; ++qq) {
            const int q = wid * 4 + (qq & 3);
            const float* srow = SCRb + (size_t)q * 4096 + lane;
            unsigned uu[64];
#pragma unroll
            for (int j = 0; j < 64; ++j) { unsigned key = 0u; if (j < ntile) { const float f = srow[j * 64] + 0.0f; const unsigned bts = __float_as_uint(f); key = bts ^ ((bts >> 31) ? 0xFFFFFFFFu : 0x80000000u); } uu[j] = key; }
            unsigned T = 1u;
            if (limit > 256) {
                unsigned kmax = 0u;
#pragma unroll
                for (int j = 0; j < 64; ++j) kmax = uu[j] > kmax ? uu[j] : kmax;
#pragma unroll
                for (int o = 1; o < 64; o <<= 1) { const unsigned t_ = (unsigned)__shfl_xor((int)kmax, o); kmax = t_ > kmax ? t_ : kmax; }
                kmax = (unsigned)__builtin_amdgcn_readfirstlane((int)kmax);
                unsigned a = 1u, b = kmax + 1u; if (b == 0u) b = 0xFFFFFFFFu;
                float fa = (float)(limit - 256) + 0.5f, fb = -255.5f; int side = 0;
                bool done = false;
                if (b > 0x80000001u) {
                    unsigned less = 0u;
#pragma unroll
                    for (int j = 0; j < 64; ++j) less += (uu[j] < 0x80000000u) ? 1u : 0u;
                    const int cnt = 4096 - (int)wave_sum_u32(less);
                    if (cnt == 256) { a = 0x80000000u; done = true; }
                    else if (cnt > 256) { a = 0x80000000u; fa = (float)(cnt - 256) + 0.5f; }
                    else { b = 0x80000000u; fb = (float)(cnt - 256) + 0.5f; }
                }
#pragma unroll 1
                for (int iter = 0; iter < 64 && !done; ++iter) {
                    if (b - a <= 1u) break;
                    unsigned c;
                    if (iter < 12) { const float t = fa * __builtin_amdgcn_rcpf(fa - fb); c = a + (unsigned)(t * (float)(b - a)); if (c <= a) c = a + 1u; if (c >= b) c = b - 1u; }
                    else c = a + ((b - a) >> 1);
                    unsigned less = 0u;
#pragma unroll
                    for (int j = 0; j < 64; ++j) less += (uu[j] < c) ? 1u : 0u;
                    const int cnt = 4096 - (int)wave_sum_u32(less);
                    if (cnt == 256) { a = c; break; }
                    if (cnt > 256) { a = c; fa = (float)(cnt - 256) + 0.5f; if (side > 0) fb *= 0.5f; side = 1; }
                    else { b = c; fb = (float)(cnt - 256) + 0.5f; if (side < 0) fa *= 0.5f; side = -1; }
                }
                T = a;
            }
            int ngt = 0;
#pragma unroll
            for (int j = 0; j < 64; ++j) ngt += __popcll(__ballot(uu[j] > T));
            const int need = (limit > 256) ? (256 - ngt) : 4096;
            int c = 0; unsigned long long myword = 0ull;
#pragma unroll
            for (int j = 0; j < 64; ++j) {
                const bool eq = (uu[j] == T); const unsigned long long eqm = __ballot(eq);
                const int below = __builtin_amdgcn_mbcnt_hi((unsigned)(eqm >> 32), __builtin_amdgcn_mbcnt_lo((unsigned)eqm, 0u));
                const bool sel = (uu[j] > T) || (eq && (c + below < need));
                const unsigned long long word = __ballot(sel);
                c += __popcll(eqm);
                if (lane == j) myword = word;
            }
            if (lane < ntile) MASK[(tok0 + q) * 64 + lane] = myword;
        }
#endif
        __syncthreads();
    }
}
__device__ __forceinline__ void attnB_phase(const bf16* Q, const bf16* K, const bf16* Vt, bf16* O, const unsigned long long* MASK, int vw, int nvw, int tid) {
    const int lane = tid & 63, r32 = lane & 31, hi = lane >> 5;
    for (int u = vw; u < NB * NH * 128; u += nvw) {
        int bh, qb; attn_unit_of(u, bh, qb); const int b = bh >> 4, h = bh & 15;
        const size_t qrow = (size_t)b * SEQ + qb * 32 + r32;
        bf16x8 qr[4]; load_q(qr, Q, qrow, h, hi);
        f32x16 o0 = (f32x16){}, o1 = (f32x16){}; float m = -1e30f, l = 0.f;
        const unsigned long long* mrow = MASK + qrow * 64;
        const int ntile = (qb >> 1) + 1;
        for (int kt = 0; kt < ntile; ++kt) {
            const size_t key0 = (size_t)b * SEQ + (size_t)kt * 64;
            const unsigned long long mw = mrow[kt];
            f32x16 p0, p1; qk_tile(p0, p1, K + h * HD, key0, DM, qr, r32, hi);
            const unsigned m0 = (unsigned)mw >> (8 * hi), m1 = (unsigned)(mw >> 32) >> (8 * hi);
#pragma unroll
            for (int r = 0; r < 16; ++r) { const int bit = 16 * (r >> 3) + (r & 7);
                p0[r] = ((m0 >> bit) & 1u) ? p0[r] : -INFINITY; p1[r] = ((m1 >> bit) & 1u) ? p1[r] : -INFINITY; }
            softmax_step(p0, p1, m, l, o0, o1);
            pv_tile(o0, o1, Vt + (size_t)h * HD * MTOK, key0, p0, p1, r32, hi);
        }
        l += __shfl_xor(l, 32);
        store_o(O, qrow, h, o0, o1, 1.0f / l, hi);
    }
}
__device__ __forceinline__ void conv_phase(const bf16* A, bf16* HM, const float* cw  , const float* cb  , int gtid, int ngt) {
    constexpr int CG = DFF / 8, RUN = 32, NRUN = MHALF / RUN;
    for (int it = gtid; it < CG * NRUN; it += ngt) {
        const int cgp = it % CG, run = it / CG, c0 = cgp * 8, r0 = run * RUN;
        float wg[3][8], wu[3][8], bg[8], bu[8];
#pragma unroll
        for (int i = 0; i < 8; ++i) { bg[i] = cb[c0 + i]; bu[i] = cb[DFF + c0 + i];
#pragma unroll
            for (int k = 0; k < 3; ++k) { wg[k][i] = cw[k * NFF2 + c0 + i]; wu[k][i] = cw[k * NFF2 + DFF + c0 + i]; } }
        float g1[8], g2[8], u1[8], u2[8];
        const bool seqstart = (r0 & (SEQ - 1)) == 0;
#pragma unroll
        for (int i = 0; i < 8; ++i) { g1[i] = g2[i] = u1[i] = u2[i] = 0.f; }
        if (!seqstart) {
            const u32x4 a1 = *(const u32x4*)(A + (size_t)(r0 - 1) * NFF2 + c0), a2 = *(const u32x4*)(A + (size_t)(r0 - 2) * NFF2 + c0);
            const u32x4 b1 = *(const u32x4*)(A + (size_t)(r0 - 1) * NFF2 + DFF + c0), b2 = *(const u32x4*)(A + (size_t)(r0 - 2) * NFF2 + DFF + c0);
#pragma unroll
            for (int i = 0; i < 4; ++i) { g1[2 * i] = __uint_as_float(a1[i] << 16); g1[2 * i + 1] = __uint_as_float(a1[i] & 0xFFFF0000u); g2[2 * i] = __uint_as_float(a2[i] << 16); g2[2 * i + 1] = __uint_as_float(a2[i] & 0xFFFF0000u);
                u1[2 * i] = __uint_as_float(b1[i] << 16); u1[2 * i + 1] = __uint_as_float(b1[i] & 0xFFFF0000u); u2[2 * i] = __uint_as_float(b2[i] << 16); u2[2 * i + 1] = __uint_as_float(b2[i] & 0xFFFF0000u); }
        }
        for (int r = r0; r < r0 + RUN; ++r) {
            const u32x4 a0 = *(const u32x4*)(A + (size_t)r * NFF2 + c0), b0 = *(const u32x4*)(A + (size_t)r * NFF2 + DFF + c0);
            float g0[8], u0[8], hm[8];
#pragma unroll
            for (int i = 0; i < 4; ++i) { g0[2 * i] = __uint_as_float(a0[i] << 16); g0[2 * i + 1] = __uint_as_float(a0[i] & 0xFFFF0000u); u0[2 * i] = __uint_as_float(b0[i] << 16); u0[2 * i + 1] = __uint_as_float(b0[i] & 0xFFFF0000u); }
#pragma unroll
            for (int i = 0; i < 8; ++i) { const float cgv = bg[i] + wg[0][i] * g2[i] + wg[1][i] * g1[i] + wg[2][i] * g0[i]; const float cuv = bu[i] + wu[0][i] * u2[i] + wu[1][i] * u1[i] + wu[2][i] * u0[i];
                hm[i] = cgv / (1.f + __expf(-cgv)) * cuv; g2[i] = g1[i]; g1[i] = g0[i]; u2[i] = u1[i]; u1[i] = u0[i]; }
            u32x4 o; o.x = cvtpk(hm[0], hm[1]); o.y = cvtpk(hm[2], hm[3]); o.z = cvtpk(hm[4], hm[5]); o.w = cvtpk(hm[6], hm[7]);
            *(u32x4*)(HM + (size_t)r * DFF + c0) = o;
        }
    }
}

__device__ __forceinline__ void ffn_fixup(const float* EF, const float* EL, const float* cw, const float* cb, bf16* HM, int gtid, int ngt) {
    for (int it = gtid; it < 128 * 2 * 704; it += ngt) {
        const int j = (it % 704) * 4, rr = (it / 704) & 1, pm = it / 1408;
        if ((pm & 15) == 0) continue;
        const int pg = (j >> 7) * 256 + (j & 127);
        f32x4 c[2];
#pragma unroll
        for (int bj = 0; bj < 2; ++bj) { const int pc = pg + 128 * bj, lc = j + DFF * bj;
            const f32x4 am2 = *(const f32x4*)(EL + ((size_t)(pm - 1) * 2 + 0) * NFF2 + pc), am1 = *(const f32x4*)(EL + ((size_t)(pm - 1) * 2 + 1) * NFF2 + pc);
            const f32x4 a0 = *(const f32x4*)(EF + ((size_t)pm * 2 + 0) * NFF2 + pc), a1 = *(const f32x4*)(EF + ((size_t)pm * 2 + 1) * NFF2 + pc);
            const f32x4 w0 = *(const f32x4*)(cw + lc), w1 = *(const f32x4*)(cw + NFF2 + lc), w2 = *(const f32x4*)(cw + 2 * NFF2 + lc), bb = *(const f32x4*)(cb + lc);
            c[bj] = rr == 0 ? (bb + w0 * am2 + w1 * am1 + w2 * a0) : (bb + w0 * am1 + w1 * a0 + w2 * a1); }
        float hm[4];
#pragma unroll
        for (int i = 0; i < 4; ++i) { const float g = c[0][i]; hm[i] = g * __builtin_amdgcn_rcpf(1.f + __builtin_amdgcn_exp2f(-LOG2E * g)) * c[1][i]; }
        u32x2 w; w.x = cvtpk(hm[0], hm[1]); w.y = cvtpk(hm[2], hm[3]);
        *(u32x2*)(HM + (size_t)(pm * 256 + rr) * DFF + j) = w;
    }
}

__device__ __forceinline__ void ffn_fixup_tile(const float* EF, const float* EL, const float* cw, const float* cb, bf16* HM, int pm, int tid) {
    if ((pm & 15) == 0) return;
    for (int it = tid; it < 2 * 704; it += NTHREADS) {
        const int j = (it % 704) * 4, rr = it / 704;
        const int pg = (j >> 7) * 256 + (j & 127);
        f32x4 c[2];
#pragma unroll
        for (int bj = 0; bj < 2; ++bj) { const int pc = pg + 128 * bj, lc = j + DFF * bj;
            const f32x4 am2 = *(const f32x4*)(EL + ((size_t)(pm - 1) * 2 + 0) * NFF2 + pc), am1 = *(const f32x4*)(EL + ((size_t)(pm - 1) * 2 + 1) * NFF2 + pc);
            const f32x4 a0 = *(const f32x4*)(EF + ((size_t)pm * 2 + 0) * NFF2 + pc), a1 = *(const f32x4*)(EF + ((size_t)pm * 2 + 1) * NFF2 + pc);
            const f32x4 w0 = *(const f32x4*)(cw + lc), w1 = *(const f32x4*)(cw + NFF2 + lc), w2 = *(const f32x4*)(cw + 2 * NFF2 + lc), bb = *(const f32x4*)(cb + lc);
            c[bj] = rr == 0 ? (bb + w0 * am2 + w1 * am1 + w2 * a0) : (bb + w0 * am1 + w1 * a0 + w2 * a1); }
        float hm[4];
#pragma unroll
        for (int i = 0; i < 4; ++i) { const float g = c[0][i]; hm[i] = g * __builtin_amdgcn_rcpf(1.f + __builtin_amdgcn_exp2f(-LOG2E * g)) * c[1][i]; }
        u32x2 w; w.x = cvtpk(hm[0], hm[1]); w.y = cvtpk(hm[2], hm[3]);
        *(u32x2*)(HM + (size_t)(pm * 256 + rr) * DFF + j) = w;
    }
}
constexpr int LDS_BYTES = 147456;
constexpr int ITEMS_PER_LAYER = 1024 + 384 + 512 + 512 + 2816 + 1408;
#ifdef FAKE_SYNC
#define GRID_SYNC() __syncthreads()
#else
#define GRID_SYNC() xcd_barrier(bar, wave)
#endif
#ifndef PROBE
#define PROBE 0
#endif
#ifndef FIXED_A_LIMIT
#define FIXED_A_LIMIT 100.f
#define FIXED_B_LIMIT 50.f
#endif
#define PROBE_REP(bit) (((PROBE) >> (bit)) & 1 ? 2 : 1)

__device__ __forceinline__ unsigned char* ws_launder(unsigned char* w) { asm volatile("" : "+s"(w)); return w; }
__device__ __forceinline__ size_t ws_zero() { size_t z = 0; asm volatile("" : "+s"(z)); return z; }
__global__ void __launch_bounds__(NTHREADS, 2) fwd_kernel(Params p) {
    extern __shared__ __attribute__((aligned(16))) unsigned char lds_raw[];
    LAS unsigned char* lds = (LAS unsigned char*)lds_raw;
    cg::grid_group grid = cg::this_grid();
    const int tid = threadIdx.x, lane = tid & 63, wave = __builtin_amdgcn_readfirstlane(tid >> 6);
    const int G = gridDim.x, bx = blockIdx.x, vcu = (G % 8 == 0) ? (bx % 8) * (G / 8) + bx / 8 : bx;
    const int gw = vcu * NWAVES + wave, ngw = G * NWAVES, gtid = vcu * NTHREADS + tid, ngt = G * NTHREADS;
    unsigned char* ws = p.ws;
    if (tid < 4) ((LAS unsigned*)(lds + 131072))[tid] = 0u;
    __syncthreads();
    const XcdBarrier bar = xcd_barrier_post((unsigned*)(ws + WS_CTL), (volatile LAS unsigned*)(lds + 131072));
#define FRESH_TID(v) int v = wave * 64 + lane_id(); asm volatile("" : "+v"(v))
#define WSL(T, off) ((T*)(ws + ws_zero() + (off)))
#define ROPE WSL(f32x2_t, WS_ROPE)
#define XN WSL(bf16, WS_XN)
#define QO WSL(bf16, WS_QO)
#define KB WSL(bf16, WS_K)
#define VT WSL(bf16, WS_VT)
#define QI WSL(bf16, WS_QI)
#define KI WSL(bf16, WS_KI)
#define WI WSL(float, WS_WI)
#define MASK WSL(unsigned long long, WS_MASK)
#define SSQ WSL(float, WS_SSQ)
#define OB WSL(bf16, WS_OB)
#define DUMMY1 p.out
#define DUMMY2 p.out
#define EF WSL(float, WS_EF)
#define EL WSL(float, WS_EL)
#define HM WSL(bf16, WS_HM)
#define SCR p.out
    LAS float* PART = (LAS float*)(lds + 131072 + 1024);
    {
        LAS float* scr = (LAS float*)(lds + wave * 16896);
#define TJOB_DECODE(JB, IT) do { const int it_ = (IT); JB.valid = it_ < DEPTH * ITEMS_PER_LAYER; if (JB.valid) { \
            const int l = it_ / ITEMS_PER_LAYER; int r = it_ % ITEMS_PER_LAYER; const int kind = l % 3, li = l / 3; \
            unsigned char* wl = ws + WS_W + (size_t)l * W_LAYER; \
            const float* wqkv = kind == 0 ? p.a_w_qkv + (size_t)li * DM * 3072 : (kind == 1 ? p.b_w_in : p.c_w_qkv); \
            const int ldq = kind == 1 ? 3656 : 3072; \
            const float* g1 = p.norm1_g + (size_t)l * DM; const float* g2 = p.norm2_g + (size_t)l * DM; \
            const float* wo = kind == 0 ? p.a_w_o + (size_t)li * DM * DM : (kind == 1 ? p.b_w_o : p.c_w_o); \
            if (r < 1024) JB = TJob{wqkv, DM, ldq, 0, 2048, (bf16*)(wl + WL_QK), 0, 1, g1, r, true}; \
            else if (r < 1408) { JB = TJob{wqkv, DM, ldq, 3072, 584, (bf16*)(wl + WL_QK), 2048, 1, g1, r - 1024, kind == 1}; } \
            else if (r < 1920) JB = TJob{wqkv, DM, ldq, 2048, 1024, (bf16*)(wl + WL_V), 0, 0, g1, r - 1408, true}; \
            else if (r < 2432) JB = TJob{wo, DM, DM, 0, 1024, (bf16*)(wl + WL_O), 0, 0, nullptr, r - 1920, true}; \
            else if (r < 5248) JB = TJob{p.ffn_w_in + (size_t)l * DM * NFF2, DM, NFF2, 0, NFF2, (bf16*)(wl + WL_IN), 0, 2, g2, r - 2432, true}; \
            else JB = TJob{p.ffn_w_down + (size_t)l * DFF * DM, DFF, DM, 0, DM, (bf16*)(wl + WL_D), 0, 0, nullptr, r - 5248, true}; } } while (0)
        for (int it = gw; it < DEPTH * ITEMS_PER_LAYER; it += 2 * ngw) {
            TJob ja, jb; TJOB_DECODE(ja, it); TJOB_DECODE(jb, it + ngw);
            float wa[32], wb[32];
            if (ja.valid) tjob_load(ja, wa, lane);
            if (jb.valid) tjob_load(jb, wb, lane);
            if (ja.valid) tjob_finish(ja, wa, scr, lane);
            if (jb.valid) tjob_finish(jb, wb, scr + 64 * 33, lane);
        }
#undef TJOB_DECODE
        for (int i = gtid; i < SEQ * 32; i += ngt) {
            const int pos = i >> 5, x = i & 31;
            const float inv = exp2f(-(float)x * (13.287712379549449f / 32.0f));
            const float ang = (float)pos * inv;
            const double rev = (double)ang * 0.15915494309189535; const float fr = (float)(rev - floor(rev));
            ROPE[i] = (f32x2_t){__builtin_amdgcn_cosf(fr), __builtin_amdgcn_sinf(fr)};
        }
        for (int m = gw; m < MTOK; m += ngw) xb_row(p.x + (size_t)m * DM, XN + (size_t)m * DM, SSQ + (size_t)m * 4, lane);
    }
    __syncthreads();
    if (tid < 4) ((LAS unsigned*)(lds + 131072))[tid] = 0u;
    __syncthreads();
    grid.sync();

    for (int l = 0; l < DEPTH; ++l) {
        const int kind = l % 3, li = l / 3;
        unsigned char* wl = ws + WS_W + (size_t)l * W_LAYER;
        const bf16* WQK = (const bf16*)(wl + WL_QK); const bf16* WV = (const bf16*)(wl + WL_V); const bf16* WO = (const bf16*)(wl + WL_O);
        const bf16* WIN = (const bf16*)(wl + WL_IN); const bf16* WD = (const bf16*)(wl + WL_D);
        for (int rep_ = 0; rep_ < PROBE_REP(0); ++rep_) {
        {
            pg8::Gemm g{XN, WQK, MTOK, kind == 1 ? NQK_B : NQK_A, DM}; pg8::StaticOrder S; S.init(MTOK, g.N, G, bx);
            pg8::EpiQKV E{kind, QO, KB, QI, KI, WI, kind == 1 ? p.b_q_norm : p.a_q_norm + li * HD, kind == 1 ? p.b_k_norm : p.a_k_norm + li * HD, (const pg8::f32x2v*)ROPE, 0.125f * LOG2E, 0.35355339059327373f * 0.125f, SSQ};
#ifndef NO_QKV
            pg8::gemm_phase<pg8::EpiQKV, pg8::StaticOrder, true, true>(lds, g, S, E, wave);
#endif
        }
        {
            pg8::Gemm g{WV, XN, DM, MTOK, DM}; pg8::StaticOrder S; S.init(DM, MTOK, G, bx);
            pg8::EpiVt E{VT, VTP, SSQ};
            pg8::gemm_phase<pg8::EpiVt, pg8::StaticOrder, true, true>(lds, g, S, E, wave);
        }
        }
        GRID_SYNC();
#ifndef NO_A
        for (int rep_ = 0; rep_ < PROBE_REP(1); ++rep_)
        if (kind == 0) { FRESH_TID(t_); const float* gq_ = p.a_q_norm + li * HD; const float* gk_ = p.a_k_norm + li * HD; const float* rb_ = p.a_rel_bias + (size_t)li * NH * 513;
            float mq = fabsf(gq_[t_ & 63]), mk = fabsf(gk_[t_ & 63]), bmax = -1e30f, bmin = 1e30f;
            for (int i = t_; i < NH * 513; i += NTHREADS) { const float v = rb_[i] * LOG2E; bmax = fmaxf(bmax, v); bmin = fminf(bmin, v); }
#pragma unroll
            for (int o = 1; o < 64; o <<= 1) { mq = fmaxf(mq, __shfl_xor(mq, o)); mk = fmaxf(mk, __shfl_xor(mk, o)); bmax = fmaxf(bmax, __shfl_xor(bmax, o)); bmin = fminf(bmin, __shfl_xor(bmin, o)); }
            { LAS float* red = (LAS float*)(lds + 131072 + 1024);
              if ((t_ & 63) == 0) { red[(t_ >> 6) * 2] = bmax; red[(t_ >> 6) * 2 + 1] = bmin; }
              __syncthreads();
#pragma unroll
              for (int w = 0; w < 8; ++w) { bmax = fmaxf(bmax, red[w * 2]); bmin = fminf(bmin, red[w * 2 + 1]); }
              __syncthreads(); }
            const float qk2 = 8.2f * mq * mk * LOG2E, ref = qk2 + bmax;
            if (__builtin_amdgcn_readfirstlane(ref - (bmin - qk2) <= FIXED_A_LIMIT ? 1 : 0)) attnA_blk<true>(QO, KB, VT, OB, rb_, ref, lds, vcu, G, t_);
            else attnA_blk<false>(QO, KB, VT, OB, rb_, 0.f, lds, vcu, G, t_); }
#endif
        if (kind == 1) {
#ifndef NO_B1
            for (int rep_ = 0; rep_ < PROBE_REP(2); ++rep_)
            { FRESH_TID(t_); b1_phase(QI, KI, WI, SCR + (size_t)bx * 32 * 4096, MASK, lds, vcu, G, t_); }
#endif
            GRID_SYNC();
#ifndef NO_B2
            for (int rep_ = 0; rep_ < PROBE_REP(3); ++rep_)
            { FRESH_TID(t_); float mq = fabsf(p.b_q_norm[t_ & 63]), mk = fabsf(p.b_k_norm[t_ & 63]);
#pragma unroll
              for (int o = 1; o < 64; o <<= 1) { mq = fmaxf(mq, __shfl_xor(mq, o)); mk = fmaxf(mk, __shfl_xor(mk, o)); }
              const float ref = 8.2f * mq * mk * LOG2E;
              if (__builtin_amdgcn_readfirstlane(ref <= FIXED_B_LIMIT ? 1 : 0)) attnB_blk<true>(QO, KB, VT, OB, MASK, ref, lds, vcu, G, t_);
              else attnB_blk<false>(QO, KB, VT, OB, MASK, 0.f, lds, vcu, G, t_); }
#endif
        }
#ifndef NO_C
        for (int rep_ = 0; rep_ < PROBE_REP(4); ++rep_)
        if (kind == 2) { FRESH_TID(t_); attnC_blk(QO, KB, VT, OB, lds, vcu, G, t_); }
#endif
        GRID_SYNC();
        {
            pg8::Gemm g{OB, WO, MTOK, DM, DM}; pg8::StaticOrder S; S.init(MTOK, DM, G, bx);
            if (PROBE_REP(5) == 2) { pg8::EpiRes E0{l == 0 ? p.x : nullptr, XN, DUMMY1, DM, nullptr, SSQ, PART}; pg8::gemm_phase<pg8::EpiRes, pg8::StaticOrder, true, true>(lds, g, S, E0, wave); }
            pg8::EpiRes E{l == 0 ? p.x : nullptr, XN, nullptr, DM, XN, SSQ, PART};
            pg8::gemm_phase<pg8::EpiRes, pg8::StaticOrder, true, true>(lds, g, S, E, wave);
        }
        GRID_SYNC();
        {
            pg8::Gemm g{XN, WIN, MTOK, NFF2, DM}; pg8::StaticOrder S; S.init(MTOK, NFF2, G, bx);
            pg8::EpiFFN E{HM, p.ffn_conv_w + (size_t)l * 3 * NFF2, p.ffn_conv_b + (size_t)l * NFF2, EF, EL, (LAS pg8::f32x4*)(lds + 131072 + 1024), SSQ};
            for (int rep_ = 0; rep_ < PROBE_REP(7); ++rep_)
            pg8::gemm_phase<pg8::EpiFFN, pg8::StaticOrder, true, true>(lds, g, S, E, wave);
        }
        GRID_SYNC();
        {
            pg8::Gemm g{HM, WD, MTOK, DM, DFF}; pg8::StaticOrder S; S.init(MTOK, DM, G, bx);
            { FRESH_TID(t_); int lastpm = -1;
#pragma unroll 1
              for (int L = bx; L < 512; L += G) {
                  const int w_ = (L & 7) * 64 + (L >> 3), pm_ = (w_ >> 5) * 8 + (w_ & 7);
                  if (pm_ != lastpm) ffn_fixup_tile(EF, EL, p.ffn_conv_w + (size_t)l * 3 * NFF2, p.ffn_conv_b + (size_t)l * NFF2, HM, pm_, t_);
                  lastpm = pm_; }
              asm volatile("s_waitcnt vmcnt(0)" ::: "memory"); __syncthreads(); }
            if (PROBE_REP(9) == 2) { pg8::EpiRes E0{nullptr, XN, DUMMY2, DM, nullptr, SSQ, PART}; pg8::gemm_phase<pg8::EpiRes, pg8::StaticOrder, true, true>(lds, g, S, E0, wave); }
            pg8::EpiRes E{nullptr, XN, l + 1 == DEPTH ? p.out : nullptr, DM, l + 1 == DEPTH ? nullptr : XN, SSQ, PART};
            pg8::gemm_phase<pg8::EpiRes, pg8::StaticOrder, true, true>(lds, g, S, E, wave);
        }
        GRID_SYNC();
    }
}

extern "C" void kernel_launch(void* const* d_in, const int* in_sizes, int n_in, void* d_out, int out_size, void* d_ws, size_t ws_size, hipStream_t stream) {
    static int grid = 0;
    if (grid == 0) {
        if (n_in != 18 || out_size != MTOK * DM || ws_size < WS_END) { fprintf(stderr, "kernel_launch: unexpected shapes (n_in %d out %d ws %zu)\n", n_in, out_size, ws_size); grid = -1; return; }
        int dev = 0, cus = 0, per_cu = 0;
        hipGetDevice(&dev); hipDeviceGetAttribute(&cus, hipDeviceAttributeMultiprocessorCount, dev);
        hipFuncSetAttribute((const void*)fwd_kernel, hipFuncAttributeMaxDynamicSharedMemorySize, LDS_BYTES);
        hipOccupancyMaxActiveBlocksPerMultiprocessor(&per_cu, (const void*)fwd_kernel, NTHREADS, LDS_BYTES);
        if (per_cu < 1) { fprintf(stderr, "kernel_launch: occupancy query says %d blocks per CU\n", per_cu); per_cu = 1; }
        (void)hipGetLastError();
        grid = cus;
    }
    if (grid < 0) return;
    Params p{};
    const float** f = (const float**)&p;
    for (int i = 0; i < 18; ++i) f[i] = (const float*)d_in[i];
    p.out = (float*)d_out; p.ws = (unsigned char*)d_ws;
    if (hipMemsetAsync((char*)d_ws + WS_CTL, 0, CTL_BYTES, stream) != hipSuccess) { fprintf(stderr, "memset failed\n"); return; }
    void* args[] = {&p};
    hipError_t e = hipLaunchCooperativeKernel((const void*)fwd_kernel, dim3(grid), dim3(NTHREADS), args, LDS_BYTES, stream);
    if (e != hipSuccess) fprintf(stderr, "cooperative launch failed: %s (grid %d)\n", hipGetErrorString(e), grid);
}
```

```cpp
#include <hip/hip_runtime.h>
#include <hip/hip_cooperative_groups.h>
#include <cstdio>
#include <cstdint>
namespace cg = cooperative_groups;
namespace pg8 {
#define PG8_LAS __attribute__((address_space(3)))
typedef unsigned short bf16_t;
typedef short bf16x8 __attribute__((ext_vector_type(8)));
typedef float f32x4 __attribute__((ext_vector_type(4)));
typedef unsigned u32x4 __attribute__((ext_vector_type(4)));
constexpr int BM = 256, BK = 64, HALF = 128, HTB = HALF * BK * 2  , STAGE_BYTES = 8 * HTB, NXCD = 8, WGM = 8;

__host__ __device__ __forceinline__ int lds_byte(int r, int c) { const int st = (r >> 4) * 2 + (c >> 5), rr = r & 15, cc = c & 31, ob = rr * 64 + cc * 2; return st * 1024 + (ob ^ (((ob >> 9) & 1) << 5)); }
__host__ __device__ __forceinline__ void stage_rc(int b, int& R, int& C) { const int st = b / 1024, sb = b % 1024, swz = sb ^ (((sb >> 9) & 1) << 5); R = (st >> 1) * 16 + swz / 64; C = (st & 1) * 32 + (swz % 64) / 2; }
__host__ __device__ __forceinline__ int perm32(int rho) { const int n = rho >> 4, i = rho & 15; return 8 * (i >> 2) + 4 * n + (i & 3); }

struct Unit { int pm, pn; };
struct Gemm { const bf16_t* A; const bf16_t* Bt; int M, N, K; };

struct StaticOrder {
    int nM, nN, nwg, G, c;
    __host__ __device__ void init(int M, int N, int G_, int c_) { nM = M / BM; nN = N / BM; nwg = nM * nN; G = G_; c = c_; }
    __host__ __device__ bool next(int i, Unit& u) const {
        const long L = (long)i * G + c; if (L >= nwg) return false;
        int wgid = (int)L; { const int q = nwg / NXCD, r = nwg % NXCD, xcd = wgid % NXCD, off = wgid / NXCD; wgid = (xcd < r ? xcd * (q + 1) : r * (q + 1) + (xcd - r) * q) + off; }
        const int nig = WGM * nN, gid = wgid / nig, fm = gid * WGM, gsz = (nM - fm) < WGM ? (nM - fm) : WGM;
        u.pm = fm + ((wgid % nig) % gsz); u.pn = (wgid % nig) / gsz; return true;
    }
    __device__ __forceinline__ void a_ready(const Unit&) const {}
    __device__ __forceinline__ void done(const Unit&) const {}
};

__device__ __forceinline__ unsigned cvt_pk_bf16(float lo, float hi) { unsigned r; asm volatile("v_cvt_pk_bf16_f32 %0, %1, %2" : "=v"(r) : "v"(lo), "v"(hi)); return r; }
typedef float f32x2 __attribute__((ext_vector_type(2)));
typedef float f32x2v __attribute__((ext_vector_type(2)));
typedef unsigned u32x2v_t __attribute__((ext_vector_type(2)));
struct EpiBf16Plain {
    static constexpr bool PERM = true, AFTER_DRAIN = false;
    bf16_t* O; int ldc;
    __device__ __forceinline__ void operator()(const f32x4 (&acc)[2][2][4][2], const Unit& u, int wr, int wc, int fr, int fq) const {
        const int row0 = u.pm * BM + wr * 64 + fr; const int col0 = u.pn * BM + wc * 32 + 8 * fq;
#pragma unroll
        for (int ai = 0; ai < 2; ++ai)
#pragma unroll
            for (int m = 0; m < 4; ++m) { bf16_t* rowp = O + (size_t)(row0 + ai * HALF + m * 16) * ldc + col0;
#pragma unroll
                for (int bj = 0; bj < 2; ++bj) { const f32x4 v0 = acc[ai][bj][m][0], v1 = acc[ai][bj][m][1];
                    u32x4 w; w.x = cvt_pk_bf16(v0[0], v0[1]); w.y = cvt_pk_bf16(v0[2], v0[3]); w.z = cvt_pk_bf16(v1[0], v1[1]); w.w = cvt_pk_bf16(v1[2], v1[3]);
                    *(u32x4*)(rowp + bj * HALF) = w; } }
    }
};
__device__ __forceinline__ float rstd_of(const float* SSQ, size_t row) { const f32x4 s4 = *(const f32x4*)(SSQ + row * 4); return rsqrtf(((s4[0] + s4[1]) + (s4[2] + s4[3])) * (1.0f / 1024.0f) + 1e-6f); }
struct EpiRes {
    static constexpr bool PERM = true, AFTER_DRAIN = false;
    const float* base32; const bf16_t* base16; float* out32; int ldc; bf16_t* XB; float* SSQ; PG8_LAS float* part;
    __device__ __forceinline__ void operator()(const f32x4 (&acc)[2][2][4][2], const Unit& u, int wr, int wc, int fr_in, int fq_in) const {
        int fr = fr_in, fq = fq_in; asm volatile("" : "+v"(fr), "+v"(fq));
        const int col0 = u.pn * BM + wc * 32 + 8 * fq;
        u32x4 pre[2][4][2];
        if (!base32) {
#pragma unroll
            for (int ai = 0; ai < 2; ++ai)
#pragma unroll
                for (int m = 0; m < 4; ++m)
#pragma unroll
                    for (int bj = 0; bj < 2; ++bj) pre[ai][m][bj] = *(const u32x4*)(base16 + (size_t)(u.pm * BM + ai * HALF + wr * 64 + m * 16 + fr) * ldc + col0 + bj * HALF);
        }
#pragma unroll
        for (int ai = 0; ai < 2; ++ai)
#pragma unroll
            for (int m = 0; m < 4; ++m) { const int rl = ai * HALF + wr * 64 + m * 16 + fr; const size_t off = (size_t)(u.pm * BM + rl) * ldc + col0;
                float ss = 0.f;
#pragma unroll
                for (int bj = 0; bj < 2; ++bj) {
                    f32x4 b0, b1;
                    if (base32) { b0 = *(const f32x4*)(base32 + off + bj * HALF); b1 = *(const f32x4*)(base32 + off + bj * HALF + 4); }
                    else { const u32x4 r = pre[ai][m][bj];
                        b0 = (f32x4){__uint_as_float(r.x << 16), __uint_as_float(r.x & 0xFFFF0000u), __uint_as_float(r.y << 16), __uint_as_float(r.y & 0xFFFF0000u)};
                        b1 = (f32x4){__uint_as_float(r.z << 16), __uint_as_float(r.z & 0xFFFF0000u), __uint_as_float(r.w << 16), __uint_as_float(r.w & 0xFFFF0000u)}; }
                    const f32x4 v0 = b0 + acc[ai][bj][m][0], v1 = b1 + acc[ai][bj][m][1];
                    if (out32) { *(f32x4*)(out32 + off + bj * HALF) = v0; *(f32x4*)(out32 + off + bj * HALF + 4) = v1; }
                    if (XB) { u32x4 w; w.x = cvt_pk_bf16(v0[0], v0[1]); w.y = cvt_pk_bf16(v0[2], v0[3]); w.z = cvt_pk_bf16(v1[0], v1[1]); w.w = cvt_pk_bf16(v1[2], v1[3]); *(u32x4*)(XB + off + bj * HALF) = w;
                        const f32x4 q0 = (f32x4){__uint_as_float(w.x << 16), __uint_as_float(w.x & 0xFFFF0000u), __uint_as_float(w.y << 16), __uint_as_float(w.y & 0xFFFF0000u)};
                        const f32x4 q1 = (f32x4){__uint_as_float(w.z << 16), __uint_as_float(w.z & 0xFFFF0000u), __uint_as_float(w.w << 16), __uint_as_float(w.w & 0xFFFF0000u)};
                        ss += ((q0[0] * q0[0] + q0[1] * q0[1]) + (q0[2] * q0[2] + q0[3] * q0[3])) + ((q1[0] * q1[0] + q1[1] * q1[1]) + (q1[2] * q1[2] + q1[3] * q1[3])); } }
                ss += __shfl_xor(ss, 16); ss += __shfl_xor(ss, 32);
                if (fq == 0) part[rl * 4 + wc] = ss;
                if (base32 && (m & 1)) asm volatile("" ::: "memory"); }
        asm volatile("s_waitcnt lgkmcnt(0)" ::: "memory"); __builtin_amdgcn_s_barrier(); asm volatile("" ::: "memory");
        const int t = (wr * 4 + wc) * 64 + fq * 16 + fr;
        if (t < 256 && XB) { const f32x4 p4 = *(const PG8_LAS f32x4*)(part + t * 4); SSQ[(size_t)(u.pm * BM + t) * 4 + u.pn] = (p4[0] + p4[1]) + (p4[2] + p4[3]); }
    }
};
struct EpiVt {
    static constexpr bool PERM = true, AFTER_DRAIN = false;
    bf16_t* O; int ldc; const float* SSQ;
    __device__ __forceinline__ void operator()(const f32x4 (&acc)[2][2][4][2], const Unit& u, int wr, int wc, int fr_in, int fq_in) const {
        int fr = fr_in, fq = fq_in; asm volatile("" : "+v"(fr), "+v"(fq));
        const int row0 = u.pm * BM + wr * 64 + fr; const int col0 = u.pn * BM + wc * 32 + 8 * fq;
        float rs[2][8];
#pragma unroll
        for (int bj = 0; bj < 2; ++bj)
#pragma unroll
            for (int c = 0; c < 8; ++c) rs[bj][c] = rstd_of(SSQ, (size_t)(col0 + bj * HALF + c));
#pragma unroll
        for (int ai = 0; ai < 2; ++ai)
#pragma unroll
            for (int m = 0; m < 4; ++m) { bf16_t* rowp = O + (size_t)(row0 + ai * HALF + m * 16) * ldc + col0;
#pragma unroll
                for (int bj = 0; bj < 2; ++bj) { const f32x4 v0 = acc[ai][bj][m][0], v1 = acc[ai][bj][m][1];
                    u32x4 w; w.x = cvt_pk_bf16(v0[0] * rs[bj][0], v0[1] * rs[bj][1]); w.y = cvt_pk_bf16(v0[2] * rs[bj][2], v0[3] * rs[bj][3]); w.z = cvt_pk_bf16(v1[0] * rs[bj][4], v1[1] * rs[bj][5]); w.w = cvt_pk_bf16(v1[2] * rs[bj][6], v1[3] * rs[bj][7]);
                    *(u32x4*)(rowp + bj * HALF) = w; } }
    }
};
struct EpiQKV {
    static constexpr bool PERM = true, AFTER_DRAIN = false;
    int kind;
    bf16_t *Q, *K, *QI, *KI; float* WI;
    const float *gq, *gk; const f32x2v* rope; float qscale, wscale; const float* SSQ;
    __device__ __forceinline__ void operator()(const f32x4 (&acc)[2][2][4][2], const Unit& u, int wr, int wc, int fr_in, int fq_in) const {
        int fr = fr_in, fq = fq_in; asm volatile("" : "+v"(fr), "+v"(fq));
        const int hs = u.pn * 4 + wc;
        bf16_t* dst; int ld, col; bool donorm = false, dorope = false; const float* gain = gq; float sc = 1.f;
        if (hs < 16) { dst = Q; ld = 1024; col = hs * 64; donorm = (kind != 2); dorope = (kind == 1); gain = gq; sc = qscale; }
        else if (hs < 32) { dst = K; ld = 1024; col = (hs - 16) * 64; donorm = (kind != 2); dorope = (kind == 1); gain = gk; }
        else if (hs < 40) { dst = QI; ld = 512; col = (hs - 32) * 64; dorope = true; }
        else if (hs == 40) { dst = KI; ld = 64; col = 0; dorope = true; }
        else if (hs == 41) {
            if (fq == 0) {
#pragma unroll
                for (int ai = 0; ai < 2; ++ai)
#pragma unroll
                    for (int m = 0; m < 4; ++m) { const int row = u.pm * BM + ai * HALF + wr * 64 + m * 16 + fr;
                        const float rsw = rstd_of(SSQ, (size_t)row) * wscale; *(f32x4*)(WI + (size_t)row * 8) = acc[ai][0][m][0] * rsw; *(f32x4*)(WI + (size_t)row * 8 + 4) = acc[ai][0][m][1] * rsw; }
            }
            return;
        } else return;
        float g[2][2][4];
#pragma unroll
        for (int bj = 0; bj < 2; ++bj)
#pragma unroll
            for (int n = 0; n < 2; ++n)
#pragma unroll
                for (int i = 0; i < 4; ++i) g[bj][n][i] = donorm ? gain[32 * bj + 8 * fq + 4 * n + i] * sc : sc;
        f32x4 sq[2][4];
#pragma unroll
        for (int ai = 0; ai < 2; ++ai)
#pragma unroll
            for (int m = 0; m < 4; ++m) sq[ai][m] = *(const f32x4*)(SSQ + (size_t)(u.pm * BM + ai * HALF + wr * 64 + m * 16 + fr) * 4);
#pragma unroll
        for (int ai = 0; ai < 2; ++ai) {
#pragma unroll
          for (int mp = 0; mp < 4; ++mp) {
            f32x4 rp4[4][4];
            if (dorope) {
#pragma unroll
                for (int m = mp; m < mp + 1; ++m) { const f32x4* rp = (const f32x4*)(rope + (size_t)((u.pm * BM + ai * HALF + wr * 64 + m * 16 + fr) & 4095) * 32 + 8 * fq);
#pragma unroll
                    for (int k = 0; k < 4; ++k) rp4[m][k] = rp[k]; }
            }
#pragma unroll
            for (int m = mp; m < mp + 1; ++m) {
                const int row = u.pm * BM + ai * HALF + wr * 64 + m * 16 + fr;
                f32x4 v[2][2];
                const float rs0 = rsqrtf(((sq[ai][m][0] + sq[ai][m][1]) + (sq[ai][m][2] + sq[ai][m][3])) * (1.0f / 1024.0f) + 1e-6f);
#pragma unroll
                for (int bj = 0; bj < 2; ++bj)
#pragma unroll
                    for (int n = 0; n < 2; ++n) v[bj][n] = acc[ai][bj][m][n] * rs0;
                float r = 1.f;
                if (donorm) {
                    float ss = 0.f;
#pragma unroll
                    for (int bj = 0; bj < 2; ++bj)
#pragma unroll
                        for (int n = 0; n < 2; ++n) { const f32x4 x = v[bj][n]; ss += (x[0] * x[0] + x[1] * x[1]) + (x[2] * x[2] + x[3] * x[3]); }
                    ss += __shfl_xor(ss, 16); ss += __shfl_xor(ss, 32);
                    r = rsqrtf(ss * (1.0f / 64.0f) + 1e-6f);
                }
#pragma unroll
                for (int bj = 0; bj < 2; ++bj)
#pragma unroll
                    for (int n = 0; n < 2; ++n)
#pragma unroll
                        for (int i = 0; i < 4; ++i) v[bj][n][i] = v[bj][n][i] * r * g[bj][n][i];
                if (dorope) {
#pragma unroll
                    for (int n = 0; n < 2; ++n) { const f32x4 cs0 = rp4[m][2 * n], cs1 = rp4[m][2 * n + 1];
                        const float c_[4] = {cs0[0], cs0[2], cs1[0], cs1[2]}, s_[4] = {cs0[1], cs0[3], cs1[1], cs1[3]};
#pragma unroll
                        for (int i = 0; i < 4; ++i) { const float x1 = v[0][n][i], x2 = v[1][n][i]; v[0][n][i] = x1 * c_[i] - x2 * s_[i]; v[1][n][i] = x2 * c_[i] + x1 * s_[i]; } }
                }
                bf16_t* rowp = dst + (size_t)row * ld + col + 8 * fq;
#pragma unroll
                for (int bj = 0; bj < 2; ++bj) { u32x4 w; w.x = cvt_pk_bf16(v[bj][0][0], v[bj][0][1]); w.y = cvt_pk_bf16(v[bj][0][2], v[bj][0][3]); w.z = cvt_pk_bf16(v[bj][1][0], v[bj][1][1]); w.w = cvt_pk_bf16(v[bj][1][2], v[bj][1][3]);
                    *(u32x4*)(rowp + 32 * bj) = w; }
            }
            asm volatile("" ::: "memory");
          }
        }
    }
};
template <int CTRL, bool BC> __device__ __forceinline__ float pg8_dpp(float x) { return __int_as_float(__builtin_amdgcn_update_dpp(0, __float_as_int(x), CTRL, 0xf, 0xf, BC)); }
#define PG8_FMAC_DPP(v, a, w, CTRL) asm("v_fmac_f32_dpp %0, %1, %2 " CTRL : "+v"(v) : "v"(a), "v"(w))
struct EpiFFN {
    static constexpr bool PERM = true, AFTER_DRAIN = false;
    bf16_t* HM; const float* cw; const float* cb; float* EF; float* EL; PG8_LAS f32x4* halo; const float* SSQ;
    __device__ __forceinline__ void operator()(const f32x4 (&acc_)[2][2][4][2], const Unit& u, int wr, int wc, int fr_in, int fq_in) const {
        int fr = fr_in, fq = fq_in; asm volatile("" : "+v"(fr), "+v"(fq));
        f32x4 (&acc)[2][2][4][2] = const_cast<f32x4 (&)[2][2][4][2]>(acc_);
        f32x4 Wn[2][4];
        { const int jc0 = u.pn * 128 + wc * 32 + 8 * fq;
#pragma unroll
          for (int bj = 0; bj < 2; ++bj) { const float* wp = cw + bj * 2816 + jc0;
              Wn[bj][0] = *(const f32x4*)(wp); Wn[bj][1] = *(const f32x4*)(wp + 5632); Wn[bj][2] = *(const f32x4*)(wp + 2 * 5632); Wn[bj][3] = *(const f32x4*)(cb + bj * 2816 + jc0); } }
#pragma unroll
        for (int ai = 0; ai < 2; ++ai)
#pragma unroll
            for (int m = 0; m < 4; ++m) { const float rs0 = rstd_of(SSQ, (size_t)(u.pm * BM + ai * HALF + wr * 64 + m * 16 + fr));
#pragma unroll
                for (int bj = 0; bj < 2; ++bj)
#pragma unroll
                    for (int n = 0; n < 2; ++n) acc[ai][bj][m][n] = acc[ai][bj][m][n] * rs0; }
        const int pcol = u.pn * 256 + wc * 32 + 8 * fq, jcol = u.pn * 128 + wc * 32 + 8 * fq;
        if (fr >= 14) {
            const int rr = fr - 14;
#pragma unroll
            for (int ai = 0; ai < 2; ++ai)
#pragma unroll
                for (int bj = 0; bj < 2; ++bj)
#pragma unroll
                    for (int n = 0; n < 2; ++n) halo[(((((ai * 2 + wr) * 2 + rr) * 4 + wc) * 2 + bj) * 4 + fq) * 2 + n] = acc[ai][bj][3][n];
            if (wr == 1) { float* e = EL + ((size_t)u.pm * 2 + rr) * 5632 + pcol;
#pragma unroll
                for (int bj = 0; bj < 2; ++bj)
#pragma unroll
                    for (int n = 0; n < 2; ++n) *(f32x4*)(e + bj * 128 + n * 4) = acc[1][bj][3][n]; }
        }
        if (wr == 0 && fr < 2) { float* e = EF + ((size_t)u.pm * 2 + fr) * 5632 + pcol;
#pragma unroll
            for (int bj = 0; bj < 2; ++bj)
#pragma unroll
                for (int n = 0; n < 2; ++n) *(f32x4*)(e + bj * 128 + n * 4) = acc[0][bj][0][n]; }
        asm volatile("s_waitcnt lgkmcnt(0)" ::: "memory"); __builtin_amdgcn_s_barrier(); asm volatile("" ::: "memory");
#pragma unroll
        for (int n = 0; n < 2; ++n) {
            f32x4 W0[2], W1[2], W2[2], Bb[2], W0m[2], W1m[2];
#pragma unroll
            for (int bj = 0; bj < 2; ++bj) { const float* wp = cw + bj * 2816 + jcol + 4 * n;
                if (n == 0) { W0[bj] = Wn[bj][0]; W1[bj] = Wn[bj][1]; W2[bj] = Wn[bj][2]; Bb[bj] = Wn[bj][3]; }
                else { W0[bj] = *(const f32x4*)(wp); W1[bj] = *(const f32x4*)(wp + 5632); W2[bj] = *(const f32x4*)(wp + 2 * 5632); Bb[bj] = *(const f32x4*)(cb + bj * 2816 + jcol + 4 * n); }
                W1m[bj] = fr == 0 ? W1[bj] : (f32x4){0.f, 0.f, 0.f, 0.f}; W0m[bj] = fr < 2 ? W0[bj] : (f32x4){0.f, 0.f, 0.f, 0.f}; }
#pragma unroll
            for (int ai = 0; ai < 2; ++ai)
#pragma unroll
                for (int m = 0; m < 4; ++m) {
                    f32x4 c[2];
#pragma unroll
                    for (int bj = 0; bj < 2; ++bj) {
                        const f32x4 a = acc[ai][bj][m][n];
                        f32x4 t1, t2;
                        if (m > 0) { t1 = (f32x4){0.f, 0.f, 0.f, 0.f}; t2 = t1;
                        } else {
                            t1 = (f32x4){0.f, 0.f, 0.f, 0.f}; t2 = t1;
                            const int sa = (wr == 1) ? ai : 0, sw = (wr == 1) ? 0 : 1;
                            if ((wr == 1 || ai == 1) && fr < 2) {
                                const f32x4 h0 = halo[(((((sa * 2 + sw) * 2 + 0) * 4 + wc) * 2 + bj) * 4 + fq) * 2 + n], h1 = halo[(((((sa * 2 + sw) * 2 + 1) * 4 + wc) * 2 + bj) * 4 + fq) * 2 + n];
                                t1 = (fr == 0) ? h1 : (f32x4){0.f, 0.f, 0.f, 0.f}; t2 = (fr == 0) ? h0 : h1;
                            }
                        }
#pragma unroll
                        for (int i = 0; i < 4; ++i) {
                            const float ax = a[i];
                            float v = __builtin_fmaf(W2[bj][i], ax, Bb[bj][i]);
                            PG8_FMAC_DPP(v, ax, W1[bj][i], "row_shr:1 row_mask:0xf bank_mask:0xf bound_ctrl:1");
                            PG8_FMAC_DPP(v, ax, W0[bj][i], "row_shr:2 row_mask:0xf bank_mask:0xf bound_ctrl:1");
                            if (m > 0) { const float apx = acc[ai][bj][m - 1][n][i];
                                PG8_FMAC_DPP(v, apx, W1m[bj][i], "row_ror:1 row_mask:0xf bank_mask:0xf");
                                PG8_FMAC_DPP(v, apx, W0m[bj][i], "row_ror:2 row_mask:0xf bank_mask:0xf");
                            } else { v = __builtin_fmaf(t1[i], W1[bj][i], v); v = __builtin_fmaf(t2[i], W0[bj][i], v); }
                            c[bj][i] = v;
                        }
                    }
                    float hm[4];
#pragma unroll
                    for (int i = 0; i < 4; ++i) { const float g = c[0][i]; hm[i] = g * __builtin_amdgcn_rcpf(1.f + __builtin_amdgcn_exp2f(-1.4426950408889634f * g)) * c[1][i]; }
                    u32x2v_t w; w.x = cvt_pk_bf16(hm[0], hm[1]); w.y = cvt_pk_bf16(hm[2], hm[3]);
                    *(u32x2v_t*)(HM + (size_t)(u.pm * BM + ai * HALF + wr * 64 + m * 16 + fr) * 2816 + jcol + 4 * n) = w;
                }
        }
    }
};
template <class Epi, class Sched, bool ALIGN_EPI = false, bool SP2 = false>
__device__ __forceinline__ void gemm_phase(PG8_LAS unsigned char* lds, const Gemm g, const Sched& S, const Epi& E, const int wave_s) {
    unsigned ones_l = ~0u; asm volatile("" : "+s"(ones_l)); int tid_l = wave_s * 64 + (int)__builtin_amdgcn_mbcnt_hi(ones_l, __builtin_amdgcn_mbcnt_lo(ones_l, 0u)); asm volatile("" : "+v"(tid_l));
    const int tid = tid_l, wid = __builtin_amdgcn_readfirstlane(tid >> 6), lane = tid & 63, wr = wid >> 2, wc = wid & 3, fr = lane & 15, fq = lane >> 4;
    const int K = g.K, nt = K / BK;
    unsigned voffA[2], voffB[2];
#pragma unroll
    for (int i = 0; i < 2; ++i) { int R, C; stage_rc(tid * 16 + i * 8192, R, C); const int Rb = Epi::PERM ? ((R & ~31) + perm32(R & 31)) : R;
        voffA[i] = (unsigned)(R * K + C) * 2u; voffB[i] = (unsigned)(Rb * K + C) * 2u; }
    const size_t kstep = (size_t)(BK * 2);
    const size_t hstep = (size_t)HALF * K * 2;
    const size_t tstep = 2 * hstep;
    const unsigned ldsw = (unsigned)wid * 1024u;
    const int aoff = lds_byte(wr * 64 + fr, fq * 8), boff = lds_byte(wc * 32 + fr, fq * 8);
#define PG8_SA(b, h) (((b) * 2 + (h)) * HTB)
#define PG8_SB(b, h) ((4 + (b) * 2 + (h)) * HTB)
#define PG8_STAGE(bufoff, gbase, voff) do { _Pragma("unroll") for (int _i = 0; _i < 2; ++_i) \
        __builtin_amdgcn_global_load_lds((const unsigned*)((const char*)(gbase) + (voff)[_i]), (PG8_LAS unsigned*)(lds + (bufoff) + ldsw + _i * 8192), 16, 0, 0); } while (0)
#define PG8_LDA(dst, b, h) do { _Pragma("unroll") for (int m = 0; m < 4; ++m) _Pragma("unroll") for (int k = 0; k < 2; ++k) dst[m][k] = *(const PG8_LAS bf16x8*)(lds + PG8_SA(b, h) + aoff + m * 2048 + k * 1024); } while (0)
#define PG8_LDB(dst, b, h) do { _Pragma("unroll") for (int n = 0; n < 2; ++n) _Pragma("unroll") for (int k = 0; k < 2; ++k) dst[n][k] = *(const PG8_LAS bf16x8*)(lds + PG8_SB(b, h) + boff + n * 2048 + k * 1024); } while (0)
#define PG8_MMA(ai, bj, At, Bt) do { __builtin_amdgcn_s_setprio(1); _Pragma("unroll") for (int m = 0; m < 4; ++m) _Pragma("unroll") for (int n = 0; n < 2; ++n) _Pragma("unroll") for (int k = 0; k < 2; ++k) \
        acc[ai][bj][m][n] = __builtin_amdgcn_mfma_f32_16x16x32_bf16(Bt[n][k], At[m][k], acc[ai][bj][m][n], 0, 0, 0); __builtin_amdgcn_s_setprio(0); } while (0)
#define PG8_WAIT_V(n) asm volatile("s_waitcnt vmcnt(" #n ")" ::: "memory")
#define PG8_WAIT_L(n) asm volatile("s_waitcnt lgkmcnt(" #n ")" ::: "memory")
#define PG8_BAR __builtin_amdgcn_s_barrier()
#define PG8_SCHED __builtin_amdgcn_sched_barrier(0)
    Unit cur, nxt; int ui = 0;
    if (!S.next(0, cur)) return;
    f32x4 acc[2][2][4][2];
#pragma unroll
    for (int a = 0; a < 2; ++a)
#pragma unroll
        for (int b = 0; b < 2; ++b)
#pragma unroll
            for (int m = 0; m < 4; ++m)
#pragma unroll
                for (int n = 0; n < 2; ++n) acc[a][b][m][n] = (f32x4){0.f, 0.f, 0.f, 0.f};
    bf16x8 At[4][2], B0[2][2], B1[2][2];
    const char* cA = (const char*)g.A + (size_t)cur.pm * tstep; const char* cB = (const char*)g.Bt + (size_t)cur.pn * tstep;
    S.a_ready(cur);
    if constexpr (SP2) {
        PG8_STAGE(PG8_SB(0, 0), cB, voffB); PG8_STAGE(PG8_SB(0, 1), cB + hstep, voffB); PG8_STAGE(PG8_SA(0, 0), cA, voffA); PG8_STAGE(PG8_SA(0, 1), cA + hstep, voffA);
        if (wr == 1) PG8_BAR;
        PG8_WAIT_V(2); PG8_BAR;
        PG8_STAGE(PG8_SB(1, 0), cB + kstep, voffB); PG8_STAGE(PG8_SA(1, 0), cA + kstep, voffA); PG8_STAGE(PG8_SB(1, 1), cB + hstep + kstep, voffB);
        PG8_WAIT_V(6); PG8_BAR;
    } else {
        PG8_STAGE(PG8_SB(0, 0), cB, voffB); PG8_STAGE(PG8_SA(0, 0), cA, voffA); PG8_STAGE(PG8_SB(0, 1), cB + hstep, voffB); PG8_STAGE(PG8_SA(0, 1), cA + hstep, voffA);
        if (wr == 1) PG8_BAR;
        PG8_WAIT_V(4); PG8_BAR;
        PG8_STAGE(PG8_SB(1, 0), cB + kstep, voffB); PG8_STAGE(PG8_SA(1, 0), cA + kstep, voffA); PG8_STAGE(PG8_SB(1, 1), cB + hstep + kstep, voffB);
        PG8_WAIT_V(6); PG8_BAR;
    }
    for (;;) {
        const bool has_next = S.next(ui + 1, nxt);
        const char* nA = has_next ? (const char*)g.A + (size_t)nxt.pm * tstep : cA; const char* nB = has_next ? (const char*)g.Bt + (size_t)nxt.pn * tstep : cB;
        for (int t = 0; t < nt; t += 2) {
            const bool last = (t == nt - 2);
            const char* a1 = cA + (size_t)(t + 1) * kstep;
            const char* a2 = last ? nA : cA + (size_t)(t + 2) * kstep; const char* b2 = last ? nB : cB + (size_t)(t + 2) * kstep;
            const char* a3 = a2 + kstep; const char* b3 = b2 + kstep;
            if (last && has_next) S.a_ready(nxt);
            if constexpr (SP2) {
            PG8_LDB(B0, 0, 0); PG8_LDB(B1, 0, 1); PG8_SCHED; PG8_LDA(At, 0, 0); PG8_STAGE(PG8_SA(1, 1), a1 + hstep, voffA);
            PG8_WAIT_V(8); PG8_WAIT_L(0); PG8_BAR; PG8_MMA(0, 0, At, B0); PG8_MMA(0, 1, At, B1); PG8_BAR; PG8_SCHED;
            PG8_LDA(At, 0, 1); PG8_STAGE(PG8_SB(0, 0), b2, voffB); PG8_STAGE(PG8_SB(0, 1), b2 + hstep, voffB); PG8_STAGE(PG8_SA(0, 0), a2, voffA);
            PG8_WAIT_V(8); PG8_WAIT_L(0); PG8_BAR; PG8_MMA(1, 0, At, B0); PG8_MMA(1, 1, At, B1); PG8_BAR; PG8_SCHED;
            PG8_LDB(B0, 1, 0); PG8_LDB(B1, 1, 1); PG8_SCHED; PG8_LDA(At, 1, 0); PG8_STAGE(PG8_SA(0, 1), a2 + hstep, voffA);
            PG8_WAIT_V(8); PG8_WAIT_L(0); PG8_BAR; PG8_MMA(0, 0, At, B0); PG8_MMA(0, 1, At, B1); PG8_BAR; PG8_SCHED;
            PG8_LDA(At, 1, 1); PG8_STAGE(PG8_SB(1, 0), b3, voffB); PG8_STAGE(PG8_SB(1, 1), b3 + hstep, voffB); PG8_STAGE(PG8_SA(1, 0), a3, voffA);
            PG8_WAIT_V(8); PG8_WAIT_L(0); PG8_BAR; PG8_MMA(1, 0, At, B0); PG8_MMA(1, 1, At, B1); PG8_BAR; PG8_SCHED;
            } else {
            PG8_LDB(B0, 0, 0); PG8_SCHED; PG8_LDA(At, 0, 0); PG8_STAGE(PG8_SA(1, 1), a1 + hstep, voffA);
            PG8_WAIT_L(8); PG8_BAR; PG8_WAIT_L(0); PG8_MMA(0, 0, At, B0); PG8_BAR; PG8_SCHED;
            PG8_LDB(B1, 0, 1); PG8_STAGE(PG8_SB(0, 0), b2, voffB);
            PG8_BAR; PG8_WAIT_L(0); PG8_MMA(0, 1, At, B1); PG8_BAR;
            PG8_LDA(At, 0, 1); PG8_STAGE(PG8_SA(0, 0), a2, voffA);
            PG8_BAR; PG8_WAIT_L(0); PG8_MMA(1, 0, At, B0); PG8_BAR; PG8_SCHED;
            PG8_STAGE(PG8_SB(0, 1), b2 + hstep, voffB);
            PG8_WAIT_V(6); PG8_BAR; PG8_MMA(1, 1, At, B1); PG8_BAR;
            PG8_LDB(B0, 1, 0); PG8_SCHED; PG8_LDA(At, 1, 0); PG8_STAGE(PG8_SA(0, 1), a2 + hstep, voffA);
            PG8_WAIT_L(8); PG8_BAR; PG8_WAIT_L(0); PG8_MMA(0, 0, At, B0); PG8_BAR; PG8_SCHED;
            PG8_LDB(B1, 1, 1); PG8_STAGE(PG8_SB(1, 0), b3, voffB);
            PG8_BAR; PG8_WAIT_L(0); PG8_MMA(0, 1, At, B1); PG8_BAR;
            PG8_LDA(At, 1, 1); PG8_STAGE(PG8_SA(1, 0), a3, voffA);
            PG8_BAR; PG8_WAIT_L(0); PG8_MMA(1, 0, At, B0); PG8_BAR; PG8_SCHED;
            PG8_STAGE(PG8_SB(1, 1), b3 + hstep, voffB);
            PG8_WAIT_V(6); PG8_BAR; PG8_MMA(1, 1, At, B1); PG8_BAR;
            }
        }
        if constexpr (ALIGN_EPI) { if (wr == 0) PG8_BAR; }
        if constexpr (!Epi::AFTER_DRAIN) { E(acc, cur, wr, wc, fr, fq); S.done(cur); }
        if (!has_next) break;
#pragma unroll
        for (int a = 0; a < 2; ++a)
#pragma unroll
            for (int b = 0; b < 2; ++b)
#pragma unroll
                for (int m = 0; m < 4; ++m)
#pragma unroll
                    for (int n = 0; n < 2; ++n) acc[a][b][m][n] = (f32x4){0.f, 0.f, 0.f, 0.f};
        cur = nxt; cA = nA; cB = nB; ++ui;
        if constexpr (ALIGN_EPI) { if (wr == 1) PG8_BAR; }
    }
    PG8_WAIT_V(0);
    if constexpr (!ALIGN_EPI) { if (wr == 0) PG8_BAR; }
    PG8_BAR;
    if constexpr (Epi::AFTER_DRAIN) { E.fused(acc, cur, wr, wc, fr, fq, lds, wid, lane); S.done(cur); }
#undef PG8_SA
#undef PG8_SB
#undef PG8_STAGE
#undef PG8_LDA
#undef PG8_LDB
#undef PG8_MMA
#undef PG8_WAIT_V
#undef PG8_WAIT_L
#undef PG8_BAR
#undef PG8_SCHED
}
}
constexpr int SEQ = 4096, NB = 8, DM = 1024, NH = 16, HD = 64, MTOK = NB * SEQ, DFF = 2816, NFF2 = 2 * DFF, DEPTH = 4;
constexpr int NQK_A = 2048, NQK_B = 2816;
constexpr int MHALF = MTOK / 2;
constexpr int VTP = MTOK + 2048 + 128;
constexpr int NTHREADS = 512, NWAVES = 8;
constexpr float LOG2E = 1.4426950408889634f;
constexpr size_t MiB = 1u << 20;
constexpr size_t WS_CTL = 0, CTL_BYTES = 64 * 1024;
constexpr size_t WS_ROPE = 1 * MiB;
constexpr size_t WS_SSQ = 128 * 1024;
constexpr size_t WS_W = 2 * MiB, W_LAYER = 26 * MiB, WL_QK = 0, WL_V = 5632 * 1024, WL_O = WL_V + 2 * MiB, WL_IN = WL_O + 2 * MiB, WL_D = WL_IN + 11 * MiB;
constexpr size_t WS_XN = 106 * MiB, WS_OB = 170 * MiB, WS_SCR = WS_XN;
constexpr size_t WS_QO = 234 * MiB, WS_K = 298 * MiB, WS_VT = 362 * MiB, WS_QI = 431 * MiB, WS_KI = 463 * MiB, WS_WI = 467 * MiB, WS_MASK = 468 * MiB;
constexpr size_t WS_HM = 234 * MiB, WS_EF = 410 * MiB, WS_EL = 416 * MiB, WS_END = 498 * MiB;
static_assert(WL_D + (size_t)DM * DFF * 2 <= W_LAYER, "weights per layer");
static_assert(WS_VT + (size_t)DM * VTP * 2 <= WS_QI && WS_W + DEPTH * W_LAYER <= WS_XN && WS_MASK + 16 * MiB <= WS_END && WS_HM + (size_t)MTOK * DFF * 2 <= WS_EF && WS_EF + (size_t)256 * NFF2 * 4 <= WS_EL && WS_EL + (size_t)256 * NFF2 * 4 <= WS_END, "ws map");

#define LAS __attribute__((address_space(3)))
typedef unsigned short bf16;
typedef short bf16x8 __attribute__((ext_vector_type(8)));
typedef float f32x4 __attribute__((ext_vector_type(4)));
typedef float f32x16 __attribute__((ext_vector_type(16)));
typedef unsigned u32x4 __attribute__((ext_vector_type(4)));
typedef unsigned u32x2 __attribute__((ext_vector_type(2)));
typedef float f32x2_t __attribute__((ext_vector_type(2))); typedef __bf16 bf16x2_t __attribute__((ext_vector_type(2)));
__device__ __forceinline__ unsigned cvtpk(float lo, float hi) { f32x2_t v = {lo, hi}; bf16x2_t b = __builtin_convertvector(v, bf16x2_t); return __builtin_bit_cast(unsigned, b); }
__device__ __forceinline__ float bf2f(unsigned short h) { return __uint_as_float((unsigned)h << 16); }
__device__ __forceinline__ float wave_sum(float v) {
#pragma unroll
    for (int o = 1; o < 64; o <<= 1) v += __shfl_xor(v, o);
    return v;
}
__device__ __forceinline__ unsigned wave_sum_u32(unsigned v) {
    v += (unsigned)__builtin_amdgcn_update_dpp(0, (int)v, 0x111, 0xf, 0xf, true);
    v += (unsigned)__builtin_amdgcn_update_dpp(0, (int)v, 0x112, 0xf, 0xf, true);
    v += (unsigned)__builtin_amdgcn_update_dpp(0, (int)v, 0x114, 0xf, 0xf, true);
    v += (unsigned)__builtin_amdgcn_update_dpp(0, (int)v, 0x118, 0xf, 0xf, true);
    v += (unsigned)__builtin_amdgcn_update_dpp(0, (int)v, 0x142, 0xa, 0xf, true);
    v += (unsigned)__builtin_amdgcn_update_dpp(0, (int)v, 0x143, 0xc, 0xf, true);
    return (unsigned)__builtin_amdgcn_readlane((int)v, 63);
}
__device__ __forceinline__ int lane_id() { unsigned ones = ~0u; asm volatile("" : "+s"(ones)); return (int)__builtin_amdgcn_mbcnt_hi(ones, __builtin_amdgcn_mbcnt_lo(ones, 0u)); }
__device__ __forceinline__ int pi_row(int i) { return (i & ~12) | ((i & 4) << 1) | ((i & 8) >> 1); }

struct Params {
    const float* x; const float* norm1_g; const float* norm2_g;
    const float* a_w_qkv; const float* a_q_norm; const float* a_k_norm; const float* a_rel_bias; const float* a_w_o;
    const float* b_w_in; const float* b_q_norm; const float* b_k_norm; const float* b_w_o;
    const float* c_w_qkv; const float* c_w_o;
    const float* ffn_w_in; const float* ffn_conv_w; const float* ffn_conv_b; const float* ffn_w_down;
    float* out; unsigned char* ws;
};

__device__ __forceinline__ void transpose_item(const float* W, int K, int ldw, int src_col0, int nvalid, bf16* WT, int dst_row0, int perm, const float* gk, LAS float* scr, int item, int lane) {
    const int kblks = K / 64, nb = item / kblks, kb = item % kblks, k0 = 64 * kb, n0 = 32 * nb;
    const int nn = n0 + (lane & 31); const bool ok = nn < nvalid;
    float wv[32];
#pragma unroll
    for (int i = 0; i < 32; ++i) { const int kk = 2 * i + (lane >> 5); wv[i] = ok ? W[(size_t)(k0 + kk) * ldw + src_col0 + nn] : 0.f; }
    if (gk) {
#pragma unroll
        for (int i = 0; i < 32; ++i) wv[i] *= gk[k0 + 2 * i + (lane >> 5)];
    }
#pragma unroll
    for (int i = 0; i < 32; ++i) { const int kk = 2 * i + (lane >> 5); scr[kk * 33 + (lane & 31)] = wv[i]; }
    asm volatile("s_waitcnt lgkmcnt(0)" ::: "memory");
    int L = dst_row0 + n0;
    if (perm == 1) { const int l = L & 255; L = (L & ~255) | (((l >> 5) & 1) * 128 + (l >> 6) * 32); }
    else if (perm == 2) { const int hb = L >= DFF ? 1 : 0, c = L - hb * DFF; L = (c >> 7) * 256 + hb * 128 + (c & 127); }
    const int c = lane & 7;
#pragma unroll
    for (int j = 0; j < 4; ++j) { const int n = (lane >> 3) + 8 * j; const LAS float* s = scr + (8 * c) * 33 + n;
        u32x4 o; o.x = cvtpk(s[0 * 33], s[1 * 33]); o.y = cvtpk(s[2 * 33], s[3 * 33]); o.z = cvtpk(s[4 * 33], s[5 * 33]); o.w = cvtpk(s[6 * 33], s[7 * 33]);
        *(u32x4*)(WT + (size_t)(L + n) * K + k0 + 8 * c) = o; }
    asm volatile("s_waitcnt lgkmcnt(0)" ::: "memory");
}
__device__ __forceinline__ void rms_row_to_bf16(const float* xrow, const float* g, bf16* orow, int lane) {
    const f32x4* xr = (const f32x4*)xrow + lane; const f32x4* gr = (const f32x4*)g + lane;
    f32x4 v[4]; float s = 0.f;
#pragma unroll
    for (int j = 0; j < 4; ++j) { v[j] = xr[64 * j]; s += (v[j].x * v[j].x + v[j].y * v[j].y) + (v[j].z * v[j].z + v[j].w * v[j].w); }
    const float rstd = rsqrtf(wave_sum(s) * (1.f / DM) + 1e-6f);
    u32x2* o8 = (u32x2*)orow + lane;
#pragma unroll
    for (int j = 0; j < 4; ++j) { const f32x4 gg = gr[64 * j]; u32x2 w; w.x = cvtpk(v[j].x * rstd * gg.x, v[j].y * rstd * gg.y); w.y = cvtpk(v[j].z * rstd * gg.z, v[j].w * rstd * gg.w); o8[64 * j] = w; }
}
__device__ __forceinline__ void xb_row(const float* xrow, bf16* orow, float* ssq4, int lane) {
    const f32x4* xr = (const f32x4*)xrow + lane;
    f32x4 v[4]; float s = 0.f;
#pragma unroll
    for (int j = 0; j < 4; ++j) { v[j] = xr[64 * j]; s += (v[j].x * v[j].x + v[j].y * v[j].y) + (v[j].z * v[j].z + v[j].w * v[j].w); }
    s = wave_sum(s);
    u32x2* o8 = (u32x2*)orow + lane;
#pragma unroll
    for (int j = 0; j < 4; ++j) { u32x2 w; w.x = cvtpk(v[j].x, v[j].y); w.y = cvtpk(v[j].z, v[j].w); o8[64 * j] = w; }
    if (lane == 0) *(f32x4*)ssq4 = (f32x4){s, 0.f, 0.f, 0.f};
}
__device__ __forceinline__ void norm_phase(const float* X, const float* g, bf16* XN, int gw, int ngw, int lane) {
    for (int m = gw; m < MTOK; m += ngw) rms_row_to_bf16(X + (size_t)m * DM, g, XN + (size_t)m * DM, lane);
}

#define MFMA32(a, b, c) __builtin_amdgcn_mfma_f32_32x32x16_bf16((a), (b), (c), 0, 0, 0)
__device__ __forceinline__ void qk_tile(f32x16& p0, f32x16& p1, const bf16* Kh  , size_t key0, int kpitch, const bf16x8 (&qr)[4], int r32, int hi) {
    const bf16* kp = Kh + (key0 + pi_row(r32)) * (size_t)kpitch + hi * 8;
    p0 = (f32x16){}; p1 = (f32x16){};
#pragma unroll
    for (int d0 = 0; d0 < 4; ++d0) {
        const bf16x8 k0 = *(const bf16x8*)(kp + d0 * 16), k1 = *(const bf16x8*)(kp + (size_t)32 * kpitch + d0 * 16);
        p0 = MFMA32(k0, qr[d0], p0); p1 = MFMA32(k1, qr[d0], p1);
    }
}
__device__ __forceinline__ void pv_tile(f32x16& o0, f32x16& o1, const bf16* Vth  , size_t key0, const f32x16& p0, const f32x16& p1, int r32, int hi) {
    const bf16* vp = Vth + (size_t)r32 * MTOK + key0 + hi * 8;
#pragma unroll
    for (int half = 0; half < 2; ++half)
#pragma unroll
        for (int s = 0; s < 2; ++s) {
            const f32x16& p = half ? p1 : p0;
            u32x4 w; w.x = cvtpk(p[8 * s + 0], p[8 * s + 1]); w.y = cvtpk(p[8 * s + 2], p[8 * s + 3]); w.z = cvtpk(p[8 * s + 4], p[8 * s + 5]); w.w = cvtpk(p[8 * s + 6], p[8 * s + 7]);
            const bf16x8 pf = __builtin_bit_cast(bf16x8, w);
            const bf16x8 v0 = *(const bf16x8*)(vp + half * 32 + s * 16), v1 = *(const bf16x8*)(vp + (size_t)32 * MTOK + half * 32 + s * 16);
            o0 = MFMA32(v0, pf, o0); o1 = MFMA32(v1, pf, o1);
        }
}
__device__ __forceinline__ void load_q(bf16x8 (&qr)[4], const bf16* Q, size_t qrow, int h, int hi) {
#pragma unroll
    for (int d0 = 0; d0 < 4; ++d0) qr[d0] = *(const bf16x8*)(Q + qrow * DM + h * HD + d0 * 16 + hi * 8);
}
__device__ __forceinline__ void store_o(bf16* O, size_t qrow, int h, const f32x16& o0, const f32x16& o1, float rl, int hi) {
    bf16* op = O + qrow * DM + h * HD + 4 * hi;
#pragma unroll
    for (int dh = 0; dh < 2; ++dh)
#pragma unroll
        for (int g = 0; g < 4; ++g) { const f32x16& o = dh ? o1 : o0; u32x2 w; w.x = cvtpk(o[4 * g] * rl, o[4 * g + 1] * rl); w.y = cvtpk(o[4 * g + 2] * rl, o[4 * g + 3] * rl);
            *(u32x2*)(op + 32 * dh + 8 * g) = w; }
}
#define MAX3(a, b, c) __builtin_fmaxf(__builtin_fmaxf((a), (b)), (c))
__device__ __forceinline__ void softmax_step(f32x16& p0, f32x16& p1, float& m, float& l, f32x16& o0, f32x16& o1) {
    float a = MAX3(p0[0], p0[1], p0[2]), b = MAX3(p1[0], p1[1], p1[2]);
#pragma unroll
    for (int r = 3; r < 15; r += 2) { a = MAX3(a, p0[r], p0[r + 1]); b = MAX3(b, p1[r], p1[r + 1]); }
    float mx = MAX3(a, b, p0[15]); mx = fmaxf(mx, p1[15]);
    mx = fmaxf(mx, __shfl_xor(mx, 32));
    const float mn = fmaxf(m, mx);
    if (!__all(mn == m)) {
        const float alpha = __builtin_amdgcn_exp2f(m - mn); m = mn; l *= alpha;
#pragma unroll
        for (int r = 0; r < 16; ++r) { o0[r] *= alpha; o1[r] *= alpha; }
    }
    float s = 0.f;
#pragma unroll
    for (int r = 0; r < 16; ++r) { p0[r] = __builtin_amdgcn_exp2f(p0[r] - mn); p1[r] = __builtin_amdgcn_exp2f(p1[r] - mn); s += p0[r] + p1[r]; }
    l += s;
}
__device__ __forceinline__ void attn_unit_of(int u, int& bh, int& qb) { bh = u >> 7; qb = u & 127; if ((u >> 11) & 1) qb = 127 - qb; }

__device__ __forceinline__ void attnA_phase(const bf16* Q, const bf16* K, const bf16* Vt, bf16* O, const float* rel_bias  , LAS float* biasL, int vw, int nvw, int tid) {
    for (int i = tid; i < 16 * 513; i += NTHREADS) biasL[(i / 513) * 516 + (i % 513)] = rel_bias[i] * LOG2E;
    __syncthreads();
    const int lane = tid & 63, r32 = lane & 31, hi = lane >> 5;
    for (int u = vw; u < NB * NH * 128; u += nvw) {
        int bh, qb; attn_unit_of(u, bh, qb); const int b = bh >> 4, h = bh & 15, c = qb >> 1, qh = qb & 1;
        const size_t qrow = (size_t)b * SEQ + qb * 32 + r32;
        bf16x8 qr[4]; load_q(qr, Q, qrow, h, hi);
        f32x16 o0 = (f32x16){}, o1 = (f32x16){}; float m = -1e30f, l = 0.f;
        const LAS float* bl = biasL + h * 516;
        for (int kt = (c < 8 ? 8 - c : 0); kt <= 8; ++kt) {
            const size_t key0 = (size_t)b * SEQ + (size_t)(c - 8 + kt) * 64;
            f32x16 p0, p1; qk_tile(p0, p1, K + h * HD, key0, DM, qr, r32, hi);
            if (kt >= 4) {
                const int base = (8 - kt) * 64 + qh * 32 + r32 - 8 * hi;
#pragma unroll
                for (int r = 0; r < 16; ++r) { const int d0 = base - (16 * (r >> 3) + (r & 7)); const int d1 = d0 - 32;
                    p0[r] += bl[(d0 < 256 ? d0 : 256) + 256]; p1[r] += bl[(d1 < 256 ? d1 : 256) + 256]; }
            } else { const float bc = bl[512];
#pragma unroll
                for (int r = 0; r < 16; ++r) { p0[r] += bc; p1[r] += bc; } }
            softmax_step(p0, p1, m, l, o0, o1);
            pv_tile(o0, o1, Vt + (size_t)h * HD * MTOK, key0, p0, p1, r32, hi);
        }
        l += __shfl_xor(l, 32);
        store_o(O, qrow, h, o0, o1, 1.0f / l, hi);
    }
}
__device__ __forceinline__ void attnC_phase(const bf16* Q, const bf16* K, const bf16* Vt, bf16* O, int vw, int nvw, int tid) {
    const int lane = tid & 63, r32 = lane & 31, hi = lane >> 5;
    for (int u = vw; u < NB * NH * 128; u += nvw) {
        int bh, qb; attn_unit_of(u, bh, qb); const int b = bh >> 4, h = bh & 15;
        const size_t qrow = (size_t)b * SEQ + qb * 32 + r32; const int t = qb * 32 + r32;
        bf16x8 qr[4]; load_q(qr, Q, qrow, h, hi);
        f32x16 o0 = (f32x16){}, o1 = (f32x16){}; float R = 0.f;
        for (int kt = qb >> 1; kt >= 0; --kt) {
            const size_t key0 = (size_t)b * SEQ + (size_t)kt * 64;
            f32x16 p0, p1; qk_tile(p0, p1, K + h * HD, key0, DM, qr, r32, hi);
            const int kb = kt * 64 + 8 * hi;
            float lk[32], lb[32];
#pragma unroll
            for (int e = 0; e < 32; ++e) { const int r = e & 15, half = e >> 4; const float z = half ? p1[r] : p0[r];
                const int key = kb + 32 * half + 16 * (r >> 3) + (r & 7);
                const float sp = fmaxf(z, 0.f) + __builtin_amdgcn_logf(1.f + __builtin_amdgcn_exp2f(-fabsf(z)));
                const bool valid = key < t;
                lk[e] = valid ? -sp : 0.f; lb[e] = valid ? (z - sp) : -INFINITY; }
            float G[4], ex[32];
#pragma unroll
            for (int gi = 0; gi < 4; ++gi) { float run = 0.f;
#pragma unroll
                for (int i = 7; i >= 0; --i) { ex[gi * 8 + i] = run; run += lk[gi * 8 + i]; }
                G[gi] = run; }
            float Gp[4];
#pragma unroll
            for (int gi = 0; gi < 4; ++gi) Gp[gi] = __shfl_xor(G[gi], 32);
            float suf[4]; float run = 0.f;
#pragma unroll
            for (int gi = 3; gi >= 0; --gi) { suf[gi] = run + (hi == 0 ? Gp[gi] : 0.f); run += G[gi] + Gp[gi]; }
#pragma unroll
            for (int e = 0; e < 32; ++e) { const float a = __builtin_amdgcn_exp2f(lb[e] + R + suf[e >> 3] + ex[e]); if (e < 16) p0[e] = a; else p1[e - 16] = a; }
            R += run;
            pv_tile(o0, o1, Vt + (size_t)h * HD * MTOK, key0, p0, p1, r32, hi);
            if (__all(R < -300.f)) break;
        }
        store_o(O, qrow, h, o0, o1, 1.0f, hi);
    }
}
constexpr int TP = 144;
constexpr int TILE_B = 64 * TP, KVBUF_B = 2 * TILE_B;
constexpr int PAIR_B = 2 * KVBUF_B;
struct KVStage { u32x4 k, v; };
__device__ __forceinline__ void kv_issue(KVStage& st, const bf16* Kh, const bf16* Vth, size_t key0, int tid) {
    const int row = tid >> 3, ch = tid & 7;
    st.k = *(const u32x4*)(Kh + (key0 + row) * DM + ch * 8);
    st.v = *(const u32x4*)(Vth + (size_t)row * VTP + key0 + ch * 8);
}
__device__ __forceinline__ void kv_write(const KVStage& st, LAS unsigned char* buf, int tid) {
    const int row = tid >> 3, ch = tid & 7;
    *(LAS u32x4*)(buf + row * TP + ch * 16) = st.k;
    *(LAS u32x4*)(buf + TILE_B + row * TP + ch * 16) = st.v;
}
template <bool INIT = true> __device__ __forceinline__ void qk_lds(f32x16& p0, f32x16& p1, const LAS unsigned char* buf, const bf16x8 (&qr)[4], int r32, int hi) {
    const LAS unsigned char* kp = buf + pi_row(r32) * TP + hi * 16;
    if (INIT) { p0 = (f32x16){}; p1 = (f32x16){}; }
    bf16x8 kf[8];
#pragma unroll
    for (int d0 = 0; d0 < 4; ++d0) { kf[2 * d0] = *(const LAS bf16x8*)(kp + d0 * 32); kf[2 * d0 + 1] = *(const LAS bf16x8*)(kp + 32 * TP + d0 * 32); }
    __builtin_amdgcn_s_setprio(1);
#pragma unroll
    for (int d0 = 0; d0 < 4; ++d0) { p0 = MFMA32(kf[2 * d0], qr[d0], p0); p1 = MFMA32(kf[2 * d0 + 1], qr[d0], p1); }
    __builtin_amdgcn_s_setprio(0);
}
__device__ __forceinline__ void pv_lds(f32x16& o0, f32x16& o1, const LAS unsigned char* buf, const f32x16& p0, const f32x16& p1, int r32, int hi) {
    const LAS unsigned char* vp = buf + TILE_B + r32 * TP + hi * 16;
    bf16x8 pf[4], vf[8];
#pragma unroll
    for (int half = 0; half < 2; ++half)
#pragma unroll
        for (int s = 0; s < 2; ++s) {
            const f32x16& p = half ? p1 : p0;
            u32x4 w; w.x = cvtpk(p[8 * s + 0], p[8 * s + 1]); w.y = cvtpk(p[8 * s + 2], p[8 * s + 3]); w.z = cvtpk(p[8 * s + 4], p[8 * s + 5]); w.w = cvtpk(p[8 * s + 6], p[8 * s + 7]);
            pf[half * 2 + s] = __builtin_bit_cast(bf16x8, w);
            vf[(half * 2 + s) * 2] = *(const LAS bf16x8*)(vp + half * 64 + s * 32); vf[(half * 2 + s) * 2 + 1] = *(const LAS bf16x8*)(vp + 32 * TP + half * 64 + s * 32);
        }
    __builtin_amdgcn_s_setprio(1);
#pragma unroll
    for (int k = 0; k < 4; ++k) { o0 = MFMA32(vf[2 * k], pf[k], o0); o1 = MFMA32(vf[2 * k + 1], pf[k], o1); }
    __builtin_amdgcn_s_setprio(0);
}
#define WG_BARRIER_L() do { asm volatile("s_waitcnt lgkmcnt(0)" ::: "memory"); __builtin_amdgcn_s_barrier(); asm volatile("" ::: "memory"); } while (0)
#define WG_BARRIER() do { asm volatile("s_waitcnt vmcnt(0) lgkmcnt(0)" ::: "memory"); __builtin_amdgcn_s_barrier(); asm volatile("" ::: "memory"); } while (0)
__device__ __forceinline__ void blk_unit_of(int u, int& bh, int& ub) { bh = u >> 4; ub = u & 15; if ((u >> 8) & 1) ub = 15 - ub; }

template <bool FIXED> __device__ __forceinline__ void attnA_blk(const bf16* Q, const bf16* K, const bf16* Vt, bf16* O, const float* rel_bias, float ref, LAS unsigned char* lds, int vcu, int G, int tid) {
    LAS float* biasL = (LAS float*)(lds + 2 * PAIR_B);
    for (int i = tid; i < 16 * 513; i += NTHREADS) biasL[(i / 513) * 516 + (i % 513)] = rel_bias[i] * LOG2E - (FIXED ? ref : 0.f);
    __syncthreads();
    const int lane = tid & 63, r32 = lane & 31, hi = lane >> 5, wid = __builtin_amdgcn_readfirstlane(tid >> 6);
#pragma unroll 1
    for (int u = vcu; u < NB * NH * 16; u += G) {
        int bh, ub; blk_unit_of(u, bh, ub); const int b = bh >> 4, h = bh & 15, qb = ub * 8 + wid, c = qb >> 1, qh = qb & 1;
        const size_t qrow = (size_t)b * SEQ + qb * 32 + r32;
        bf16x8 qr[4]; load_q(qr, Q, qrow, h, hi);
        f32x16 o0 = (f32x16){}, o1 = (f32x16){}; float m = -1e30f, l = 0.f;
        const LAS float* bl = biasL + h * 516;
        const bf16* Kh = K + h * HD; const bf16* Vth = Vt + (size_t)h * HD * VTP;
        const int c0 = ub * 4, t_lo = c0 >= 8 ? c0 - 8 : 0, t_hi = c0 + 3;
        const size_t kbase = (size_t)b * SEQ; const int ntl = t_hi - t_lo + 1;
        KVStage sa, sb;
        kv_issue(sa, Kh, Vth, kbase + (size_t)t_lo * 64, tid); kv_issue(sb, Kh, Vth, kbase + (size_t)(t_lo + 1) * 64, tid);
        kv_write(sa, lds, tid); kv_write(sb, lds + KVBUF_B, tid); WG_BARRIER();
#define ATT_PAIR(IT) do { const int it_ = (IT); LAS unsigned char* pb = lds + ((it_ >> 1) & 1) * PAIR_B; \
            if (it_ + 2 < ntl) { kv_issue(sa, Kh, Vth, kbase + (size_t)(t_lo + it_ + 2) * 64, tid); kv_issue(sb, Kh, Vth, kbase + (size_t)(t_lo + it_ + 3) * 64, tid); } \
            { const int t = t_lo + it_; LAS unsigned char* buf = pb; ATT_COMPUTE } \
            { const int t = t_lo + it_ + 1; LAS unsigned char* buf = pb + KVBUF_B; ATT_COMPUTE } \
            if (it_ + 2 < ntl) { LAS unsigned char* nb = lds + (((it_ >> 1) + 1) & 1) * PAIR_B; kv_write(sa, nb, tid); kv_write(sb, nb + KVBUF_B, tid); } \
            WG_BARRIER_L(); } while (0)
#define ATT_COMPUTE             if (t >= c - 8 && t <= c) { \
                const int kt = t - c + 8; \
                f32x16 p0, p1; \
                if (kt > 4) { \
                    const LAS float* bp = bl + ((8 - kt) * 64 + qh * 32 + r32 - 8 * hi + 256); \
_Pragma("unroll") \
                    for (int r = 0; r < 16; ++r) { p0[r] = bp[-(16 * (r >> 3) + (r & 7))]; p1[r] = bp[-(16 * (r >> 3) + (r & 7)) - 32]; } \
                } else if (kt == 4) { \
                    const int base = 4 * 64 + qh * 32 + r32 - 8 * hi; \
_Pragma("unroll") \
                    for (int r = 0; r < 16; ++r) { const int d0 = base - (16 * (r >> 3) + (r & 7)); const int d1 = d0 - 32; \
                        p0[r] = bl[(d0 < 256 ? d0 : 256) + 256]; p1[r] = bl[(d1 < 256 ? d1 : 256) + 256]; } \
                } else { const float bc = bl[512]; \
_Pragma("unroll") \
                    for (int r = 0; r < 16; ++r) { p0[r] = bc; p1[r] = bc; } } \
                qk_lds<false>(p0, p1, buf, qr, r32, hi); \
                if (FIXED) { float sacc = 0.f; \
_Pragma("unroll") \
                    for (int r = 0; r < 16; ++r) { p0[r] = __builtin_amdgcn_exp2f(p0[r]); p1[r] = __builtin_amdgcn_exp2f(p1[r]); sacc += p0[r] + p1[r]; } \
                    l += sacc; \
                } else softmax_step(p0, p1, m, l, o0, o1); \
                pv_lds(o0, o1, buf, p0, p1, r32, hi); \
            }
#pragma unroll 1
        for (int it = 0; it < ntl; it += 2) ATT_PAIR(it);
#undef ATT_COMPUTE
        l += __shfl_xor(l, 32);
        store_o(O, qrow, h, o0, o1, 1.0f / l, hi);
    }
}
__device__ __forceinline__ void b_mask_init(f32x16& p0, f32x16& p1, unsigned long long mw, int hi, float ref) {
    const int n0 = (int)~((unsigned)mw >> (8 * hi)), n1 = (int)~((unsigned)(mw >> 32) >> (8 * hi));
#pragma unroll
    for (int r = 0; r < 16; ++r) { const int bit = 16 * (r >> 3) + (r & 7);
        p0[r] = __int_as_float(__builtin_amdgcn_sbfe(n0, bit, 1) & (int)0xFF800000) - ref; p1[r] = __int_as_float(__builtin_amdgcn_sbfe(n1, bit, 1) & (int)0xFF800000) - ref; }
}
__device__ __forceinline__ float exp_tile(f32x16& p0, f32x16& p1) {
    float sacc = 0.f;
#pragma unroll
    for (int r = 0; r < 16; ++r) { p0[r] = __builtin_amdgcn_exp2f(p0[r]); p1[r] = __builtin_amdgcn_exp2f(p1[r]);
#ifdef PB2_EXPX
        p0[r] = __builtin_amdgcn_exp2f(__builtin_amdgcn_logf(p0[r])); p1[r] = __builtin_amdgcn_exp2f(__builtin_amdgcn_logf(p1[r]));
#endif
        sacc += p0[r] + p1[r]; }
    return sacc;
}
template <bool FIXED> __device__ __forceinline__ void attnB_blk(const bf16* Q, const bf16* K, const bf16* Vt, bf16* O, const unsigned long long* MASK, float ref, LAS unsigned char* lds, int vcu, int G, int tid) {
    const int lane = tid & 63, r32 = lane & 31, hi = lane >> 5, wid = __builtin_amdgcn_readfirstlane(tid >> 6);
#pragma unroll 1
    for (int u = vcu; u < NB * NH * 16; u += G) {
        int bh, ub; blk_unit_of(u, bh, ub); const int b = bh >> 4, h = bh & 15, qb = ub * 8 + wid;
        const size_t qrow = (size_t)b * SEQ + qb * 32 + r32;
        bf16x8 qr[4]; load_q(qr, Q, qrow, h, hi);
        f32x16 o0 = (f32x16){}, o1 = (f32x16){}; float m = -1e30f, l = 0.f;
        const u32x4* mrow2 = (const u32x4*)(MASK + qrow * 64);
        const int ntile = (qb >> 1) + 1, t_hi = ub * 4 + 3;
        const bf16* Kh = K + h * HD; const bf16* Vth = Vt + (size_t)h * HD * VTP;
        const size_t kbase = (size_t)b * SEQ; const int ntl = t_hi + 1;
#ifndef PB2_LOOPX
#define PB2_LOOPX 1
#endif
        for (int rep2 = 0; rep2 < PB2_LOOPX; ++rep2) {
        KVStage sa, sb;
        kv_issue(sa, Kh, Vth, kbase, tid); kv_issue(sb, Kh, Vth, kbase + 64, tid);
        u32x4 mnext = mrow2[0];
        kv_write(sa, lds, tid); kv_write(sb, lds + KVBUF_B, tid); WG_BARRIER();
#pragma unroll 1
        for (int it = 0; it < ntl; it += 2) {
            LAS unsigned char* pb = lds + ((it >> 1) & 1) * PAIR_B;
            u32x4 mcur = mnext; asm volatile("" : "+v"(mcur));
            if (it + 2 < ntl) { kv_issue(sa, Kh, Vth, kbase + (size_t)(it + 2) * 64, tid); kv_issue(sb, Kh, Vth, kbase + (size_t)(it + 3) * 64, tid); }
            if (it + 2 < ntile) mnext = mrow2[(it >> 1) + 1];
            const unsigned long long ma = (it < ntile) ? ((unsigned long long)mcur.y << 32 | mcur.x) : 0ull, mb = (it + 1 < ntile) ? ((unsigned long long)mcur.w << 32 | mcur.z) : 0ull;
#pragma unroll
            for (int k = 0; k < 2; ++k) {
                if (it + k < ntile) {
                    LAS unsigned char* buf = pb + k * KVBUF_B;
                    f32x16 p0, p1; b_mask_init(p0, p1, k ? mb : ma, hi, FIXED ? ref : 0.f);
                    qk_lds<false>(p0, p1, buf, qr, r32, hi);
                    if (FIXED) l += exp_tile(p0, p1); else softmax_step(p0, p1, m, l, o0, o1);
                    pv_lds(o0, o1, buf, p0, p1, r32, hi);
                }
            }
            if (it + 2 < ntl) { LAS unsigned char* nb = lds + (((it >> 1) + 1) & 1) * PAIR_B; kv_write(sa, nb, tid); kv_write(sb, nb + KVBUF_B, tid);
#ifdef PB2_STAGEX
                kv_issue(sa, Kh, Vth, kbase + (size_t)(it + 2) * 64, tid); kv_issue(sb, Kh, Vth, kbase + (size_t)(it + 3) * 64, tid); kv_write(sa, nb, tid); kv_write(sb, nb + KVBUF_B, tid);
#endif
            }
            WG_BARRIER_L();
#ifdef PB2_BARX
            WG_BARRIER(); WG_BARRIER();
#endif
        }
        }
        l += __shfl_xor(l, 32);
        store_o(O, qrow, h, o0, o1, 1.0f / l, hi);
    }
}
__device__ __forceinline__ void attnC_blk(const bf16* Q, const bf16* K, const bf16* Vt, bf16* O, LAS unsigned char* lds, int vcu, int G, int tid) {
    const int lane = tid & 63, r32 = lane & 31, hi = lane >> 5, wid = __builtin_amdgcn_readfirstlane(tid >> 6);
    LAS unsigned* flags = (LAS unsigned*)(lds + 2 * KVBUF_B);
#pragma unroll 1
    for (int u = vcu; u < NB * NH * 16; u += G) {
        int bh, ub; blk_unit_of(u, bh, ub); const int b = bh >> 4, h = bh & 15, qb = ub * 8 + wid;
        const size_t qrow = (size_t)b * SEQ + qb * 32 + r32; const int tq = qb * 32 + r32;
        bf16x8 qr[4]; load_q(qr, Q, qrow, h, hi);
        f32x16 o0 = (f32x16){}, o1 = (f32x16){}; float R = 0.f; bool done = false;
        const int t_hi = ub * 4 + 3, t_me = qb >> 1;
        const bf16* Kh = K + h * HD; const bf16* Vth = Vt + (size_t)h * HD * VTP;
        KVStage st; kv_issue(st, Kh, Vth, (size_t)b * SEQ + (size_t)t_hi * 64, tid); kv_write(st, lds, tid); WG_BARRIER();
#pragma unroll 1
        for (int t = t_hi, it = 0; t >= 0; --t, ++it) {
            LAS unsigned char* buf = lds + (it & 1) * KVBUF_B;
            if (t > 0) kv_issue(st, Kh, Vth, (size_t)b * SEQ + (size_t)(t - 1) * 64, tid);
            if (t <= t_me && !done) {
                f32x16 p0, p1; qk_lds(p0, p1, buf, qr, r32, hi);
                const int kb = t * 64 + 8 * hi;
                const bool diag = (t == t_me);
                float lk[32], lb[32];
#pragma unroll
                for (int e = 0; e < 32; ++e) { const int r = e & 15, half = e >> 4; const float z = half ? p1[r] : p0[r];
                    const float sp = __builtin_amdgcn_logf(1.f + __builtin_amdgcn_exp2f(fminf(z, 80.f)));
                    lk[e] = -sp; lb[e] = z - sp; }
                if (diag) {
#pragma unroll
                    for (int e = 0; e < 32; ++e) { const int r = e & 15, half = e >> 4; const int key = kb + 32 * half + 16 * (r >> 3) + (r & 7);
                        const bool valid = key < tq; lk[e] = valid ? lk[e] : 0.f; lb[e] = valid ? lb[e] : -INFINITY; }
                }
                float Gs[4], ex[32];
#pragma unroll
                for (int gi = 0; gi < 4; ++gi) { float run = 0.f;
#pragma unroll
                    for (int i = 7; i >= 0; --i) { ex[gi * 8 + i] = run; run += lk[gi * 8 + i]; }
                    Gs[gi] = run; }
                float Gp[4];
#pragma unroll
                for (int gi = 0; gi < 4; ++gi) Gp[gi] = __shfl_xor(Gs[gi], 32);
                float suf[4]; float run = 0.f;
#pragma unroll
                for (int gi = 3; gi >= 0; --gi) { suf[gi] = R + run + (hi == 0 ? Gp[gi] : 0.f); run += Gs[gi] + Gp[gi]; }
#pragma unroll
                for (int e = 0; e < 32; ++e) { const float a = __builtin_amdgcn_exp2f(lb[e] + (suf[e >> 3] + ex[e])); if (e < 16) p0[e] = a; else p1[e - 16] = a; }
                R += run;
                pv_lds(o0, o1, buf, p0, p1, r32, hi);
                done = __all(R < -152.f);
            }
            if (lane == 0) flags[(it & 1) * 8 + wid] = (done || t == 0) ? 0u : 1u;
            if (t > 0) kv_write(st, lds + ((it + 1) & 1) * KVBUF_B, tid);
            WG_BARRIER_L();
            unsigned any = 0u;
#pragma unroll
            for (int w = 0; w < 8; ++w) any |= flags[(it & 1) * 8 + w];
            if (any == 0u) break;
        }
        store_o(O, qrow, h, o0, o1, 1.0f, hi);
        WG_BARRIER();
    }
}
#define XB_TMO      128
#define XB_XCNT(j)  (256  + 64 * (j))
#define XB_XSUB(j)  (1280 + 64 * (j))
#define XB_XGEN(j)  (2304 + 64 * (j))
#define XB_TOP      3328
#define XB_TOPGEN   3392
#define XCD_BAR_WORDS 3456
#define XB_SPIN_CAP (1u << 18)

__device__ __forceinline__ unsigned xb_ld(unsigned* p)              { return __hip_atomic_load(p, __ATOMIC_RELAXED, __HIP_MEMORY_SCOPE_AGENT); }
__device__ __forceinline__ unsigned xb_add(unsigned* p, unsigned v) { return __hip_atomic_fetch_add(p, v, __ATOMIC_RELAXED, __HIP_MEMORY_SCOPE_AGENT); }
__device__ __forceinline__ unsigned xb_xcc_id() { return (unsigned)__builtin_amdgcn_s_getreg((3 << 11) | 20) & 0xFu; }
#define XB_SPIN(cond, bar) do { unsigned _sp = 0; while (cond) { __builtin_amdgcn_s_sleep(1); \
    if ((++_sp & 255u) == 0u) { if (xb_ld(&(bar)[XB_TMO])) break; if (_sp > XB_SPIN_CAP) { atomicAdd(&(bar)[XB_TMO], 1u); break; } } } } while (0)

struct XcdBarrier {
    unsigned* bar; unsigned x;
    volatile LAS unsigned* st;
};

__device__ __forceinline__ XcdBarrier xcd_barrier_post(unsigned* bar, volatile LAS unsigned* st) {
    XcdBarrier b; b.bar = bar; b.x = xb_xcc_id(); b.st = st;
    if (threadIdx.x == 0) (void)xb_add(&bar[XB_XCNT(b.x)], 1u);
    return b;
}
__device__ __forceinline__ void xcd_barrier_complete(unsigned* bar, unsigned x, unsigned& nloc, unsigned& nx) {
    const unsigned G = gridDim.x * gridDim.y * gridDim.z;
    unsigned sum, cnt, mine, sp = 0u;
    for (;;) {
        sum = 0u; cnt = 0u; mine = 0u;
#pragma unroll
        for (unsigned j = 0; j < 16; ++j) { const unsigned c = xb_ld(&bar[XB_XCNT(j)]); sum += c; cnt += (c > 0u) ? 1u : 0u; mine = (j == x) ? c : mine; }
        if (sum == G) break;
        __builtin_amdgcn_s_sleep(1);
        if ((++sp & 255u) == 0u) { if (xb_ld(&bar[XB_TMO])) break; if (sp > XB_SPIN_CAP) { atomicAdd(&bar[XB_TMO], 1u); break; } }
    }
    nloc = mine > 0u ? mine : 1u; nx = cnt > 0u ? cnt : 1u;
}

__device__ __forceinline__ void xcd_barrier(const XcdBarrier& b, int g_wave_id) {
    asm volatile("s_waitcnt vmcnt(0)" ::: "memory");
    __syncthreads();
    if (g_wave_id == 0 && lane_id() == 0) {
        unsigned* bar = b.bar;
        __builtin_amdgcn_s_waitcnt(0);
        unsigned nloc = b.st[0], nx = b.st[1];
        if (nloc == 0u) { xcd_barrier_complete(bar, b.x, nloc, nx); b.st[0] = nloc; b.st[1] = nx; }
        const unsigned old = xb_add(&bar[XB_XSUB(b.x)], 1u);
        const unsigned gen = old / nloc;
        if (old + 1u == (gen + 1u) * nloc) {
            __builtin_amdgcn_fence(__ATOMIC_RELEASE, "agent");
            asm volatile("s_waitcnt vmcnt(0)" ::: "memory");
            const unsigned og = xb_add(&bar[XB_TOP], 1u);
            const unsigned tg = og / nx;
            if (og + 1u == (tg + 1u) * nx) xb_add(&bar[XB_TOPGEN], 1u);
            else XB_SPIN(xb_ld(&bar[XB_TOPGEN]) == tg, bar);
            __builtin_amdgcn_fence(__ATOMIC_ACQUIRE, "agent");
            xb_add(&bar[XB_XGEN(b.x)], 1u);
            asm volatile("s_waitcnt vmcnt(0)" ::: "memory");
        } else {
            XB_SPIN(xb_ld(&bar[XB_XGEN(b.x)]) == gen, bar);
            __builtin_amdgcn_fence(__ATOMIC_ACQUIRE, "agent");
            asm volatile("s_waitcnt vmcnt(0)" ::: "memory");
        }
    }
    __syncthreads();
}
constexpr int QI_PITCH = 520;
__device__ __forceinline__ void b1_phase(const bf16* QI, const bf16* KI, const float* WI, float* SCRb  , unsigned long long* MASK,
                                         LAS unsigned char* lds, int vcu, int G, int tid) {
    const int lane = tid & 63, r32 = lane & 31, hi = lane >> 5, wid = __builtin_amdgcn_readfirstlane(tid >> 6);
    LAS bf16* qs = (LAS bf16*)lds;
#pragma unroll 1
    for (int u0 = vcu, rnd = 0; u0 < NB * 128; u0 += G, ++rnd) {
        const int b = u0 >> 7; int qb = u0 & 127; if (rnd & 1) qb = 127 - qb;
        const size_t tok0 = (size_t)b * SEQ + qb * 32;
        const int ntile = (qb >> 1) + 1, limit = ntile * 64;
        for (int i = tid; i < 32 * 64; i += NTHREADS) { const int q = i >> 6, c = i & 63; *(LAS u32x4*)(qs + q * QI_PITCH + c * 8) = *(const u32x4*)(QI + (tok0 + q) * 512 + c * 8); }
        LAS float* wl = (LAS float*)(lds + 32 * QI_PITCH * 2);
        if (tid < 256) wl[tid] = WI[tok0 * 8 + tid];
        __syncthreads();
#ifndef B1_SCORE_REP
#define B1_SCORE_REP 1
#endif
#ifndef B1_TOPK_REP
#define B1_TOPK_REP 1
#endif
#ifndef B1_NO_SCORE
        for (int rep_ = 0; rep_ < B1_SCORE_REP; ++rep_)
#pragma unroll 1
        for (int kt = wid; kt < ntile; kt += NWAVES) {
            const size_t key0 = (size_t)b * SEQ + (size_t)kt * 64;
            const bf16* kp = KI + (key0 + pi_row(r32)) * 64 + hi * 8;
            bf16x8 kf0[4], kf1[4];
#pragma unroll
            for (int d0 = 0; d0 < 4; ++d0) { kf0[d0] = *(const bf16x8*)(kp + d0 * 16); kf1[d0] = *(const bf16x8*)(kp + 32 * 64 + d0 * 16); }
            f32x16 s0 = (f32x16){}, s1 = (f32x16){};
            int qoff = r32 * QI_PITCH + hi * 8; asm volatile("" : "+v"(qoff));
#pragma unroll 1
            for (int hh = 0; hh < 8; ++hh) {
                f32x16 a0 = (f32x16){}, a1 = (f32x16){};
                const float wh = wl[r32 * 8 + hh];
#pragma unroll
                for (int d0 = 0; d0 < 4; ++d0) { const bf16x8 qf = *(const LAS bf16x8*)(qs + qoff + hh * 64 + d0 * 16); a0 = MFMA32(kf0[d0], qf, a0); a1 = MFMA32(kf1[d0], qf, a1); }
#pragma unroll
                for (int r = 0; r < 16; ++r) { s0[r] = __builtin_fmaf(wh, __builtin_fmaxf(a0[r], 0.f), s0[r]); s1[r] = __builtin_fmaf(wh, __builtin_fmaxf(a1[r], 0.f), s1[r]); }
            }
            float* sp = SCRb + (size_t)r32 * 4096 + kt * 64 + 8 * hi;
#pragma unroll
            for (int half = 0; half < 2; ++half)
#pragma unroll
                for (int s = 0; s < 2; ++s) { const f32x16& p = half ? s1 : s0;
                    *(f32x4*)(sp + 32 * half + 16 * s) = (f32x4){p[8 * s], p[8 * s + 1], p[8 * s + 2], p[8 * s + 3]};
                    *(f32x4*)(sp + 32 * half + 16 * s + 4) = (f32x4){p[8 * s + 4], p[8 * s + 5], p[8 * s + 6], p[8 * s + 7]}; }
        }
#endif
        asm volatile("s_waitcnt vmcnt(0)" ::: "memory");
        __syncthreads();
#ifndef B1_NO_TOPK
#pragma unroll 1
        for (int qq = 0; qq < 4 * B1_TOPK_REP; ++qq) {
            const int q = wid * 4 + (qq & 3);
            const float* srow = SCRb + (size_t)q * 4096 + lane;
            unsigned uu[64];
#pragma unroll
            for (int j = 0; j < 64; ++j) { unsigned key = 0u; if (j < ntile) { const float f = srow[j * 64] + 0.0f; const unsigned bts = __float_as_uint(f); key = bts ^ ((bts >> 31) ? 0xFFFFFFFFu : 0x80000000u); } uu[j] = key; }
            unsigned T = 1u;
            bool exact = (limit <= 256);
            if (limit > 256) {
                unsigned kmax = 0u;
#pragma unroll
                for (int j = 0; j < 64; ++j) kmax = uu[j] > kmax ? uu[j] : kmax;
#pragma unroll
                for (int o = 1; o < 64; o <<= 1) { const unsigned t_ = (unsigned)__shfl_xor((int)kmax, o); kmax = t_ > kmax ? t_ : kmax; }
                kmax = (unsigned)__builtin_amdgcn_readfirstlane((int)kmax);
                unsigned a = 1u, b = kmax + 1u; if (b == 0u) b = 0xFFFFFFFFu;
                float fa = (float)(limit - 256) + 0.5f, fb = -255.5f; int side = 0;
                bool done = false;
                if (b > 0x80000001u) {
                    unsigned less = 0u;
#pragma unroll
                    for (int j = 0; j < 64; ++j) less += (uu[j] < 0x80000000u) ? 1u : 0u;
                    const int cnt = 4096 - (int)wave_sum_u32(less);
                    if (cnt == 256) { a = 0x80000000u; done = true; exact = true; }
                    else if (cnt > 256) { a = 0x80000000u; fa = (float)(cnt - 256) + 0.5f; }
                    else { b = 0x80000000u; fb = (float)(cnt - 256) + 0.5f; }
                }
#pragma unroll 1
                for (int iter = 0; iter < 64 && !done; ++iter) {
                    if (b - a <= 1u) break;
                    unsigned c;
                    if (iter < 12) { const float t = fa * __builtin_amdgcn_rcpf(fa - fb); c = a + (unsigned)(t * (float)(b - a)); if (c <= a) c = a + 1u; if (c >= b) c = b - 1u; }
                    else c = a + ((b - a) >> 1);
                    unsigned less = 0u;
#pragma unroll
                    for (int j = 0; j < 64; ++j) less += (uu[j] < c) ? 1u : 0u;
                    const int cnt = 4096 - (int)wave_sum_u32(less);
                    if (cnt == 256) { a = c; exact = true; break; }
                    if (cnt > 256) { a = c; fa = (float)(cnt - 256) + 0.5f; if (side > 0) fb *= 0.5f; side = 1; }
                    else { b = c; fb = (float)(cnt - 256) + 0.5f; if (side < 0) fa *= 0.5f; side = -1; }
                }
                T = a;
            }
            unsigned long long myword = 0ull;
            if (exact) {
#pragma unroll
                for (int j = 0; j < 64; ++j) { const unsigned long long word = __ballot(uu[j] >= T); if (lane == j) myword = word; }
            } else {
            int ngt = 0;
#pragma unroll
            for (int j = 0; j < 64; ++j) ngt += __popcll(__ballot(uu[j] > T));
            const int need = (limit > 256) ? (256 - ngt) : 4096;
            int c = 0;
#pragma unroll
            for (int j = 0; j < 64; ++j) {
                const bool eq = (uu[j] == T); const unsigned long long eqm = __ballot(eq);
                const int below = __builtin_amdgcn_mbcnt_hi((unsigned)(eqm >> 32), __builtin_amdgcn_mbcnt_lo((unsigned)eqm, 0u));
                const bool sel = (uu[j] > T) || (eq && (c + below < need));
                const unsigned long long word = __ballot(sel);
                c += __popcll(eqm);
                if (lane == j) myword = word;
            }
            }
            if (lane < ntile) MASK[(tok0 + q) * 64 + lane] = myword;
        }
#endif
        __syncthreads();
    }
}
__device__ __forceinline__ void attnB_phase(const bf16* Q, const bf16* K, const bf16* Vt, bf16* O, const unsigned long long* MASK, int vw, int nvw, int tid) {
    const int lane = tid & 63, r32 = lane & 31, hi = lane >> 5;
    for (int u = vw; u < NB * NH * 128; u += nvw) {
        int bh, qb; attn_unit_of(u, bh, qb); const int b = bh >> 4, h = bh & 15;
        const size_t qrow = (size_t)b * SEQ + qb * 32 + r32;
        bf16x8 qr[4]; load_q(qr, Q, qrow, h, hi);
        f32x16 o0 = (f32x16){}, o1 = (f32x16){}; float m = -1e30f, l = 0.f;
        const unsigned long long* mrow = MASK + qrow * 64;
        const int ntile = (qb >> 1) + 1;
        for (int kt = 0; kt < ntile; ++kt) {
            const size_t key0 = (size_t)b * SEQ + (size_t)kt * 64;
            const unsigned long long mw = mrow[kt];
            f32x16 p0, p1; qk_tile(p0, p1, K + h * HD, key0, DM, qr, r32, hi);
            const unsigned m0 = (unsigned)mw >> (8 * hi), m1 = (unsigned)(mw >> 32) >> (8 * hi);
#pragma unroll
            for (int r = 0; r < 16; ++r) { const int bit = 16 * (r >> 3) + (r & 7);
                p0[r] = ((m0 >> bit) & 1u) ? p0[r] : -INFINITY; p1[r] = ((m1 >> bit) & 1u) ? p1[r] : -INFINITY; }
            softmax_step(p0, p1, m, l, o0, o1);
            pv_tile(o0, o1, Vt + (size_t)h * HD * MTOK, key0, p0, p1, r32, hi);
        }
        l += __shfl_xor(l, 32);
        store_o(O, qrow, h, o0, o1, 1.0f / l, hi);
    }
}
__device__ __forceinline__ void conv_phase(const bf16* A, bf16* HM, const float* cw  , const float* cb  , int gtid, int ngt) {
    constexpr int CG = DFF / 8, RUN = 32, NRUN = MHALF / RUN;
    for (int it = gtid; it < CG * NRUN; it += ngt) {
        const int cgp = it % CG, run = it / CG, c0 = cgp * 8, r0 = run * RUN;
        float wg[3][8], wu[3][8], bg[8], bu[8];
#pragma unroll
        for (int i = 0; i < 8; ++i) { bg[i] = cb[c0 + i]; bu[i] = cb[DFF + c0 + i];
#pragma unroll
            for (int k = 0; k < 3; ++k) { wg[k][i] = cw[k * NFF2 + c0 + i]; wu[k][i] = cw[k * NFF2 + DFF + c0 + i]; } }
        float g1[8], g2[8], u1[8], u2[8];
        const bool seqstart = (r0 & (SEQ - 1)) == 0;
#pragma unroll
        for (int i = 0; i < 8; ++i) { g1[i] = g2[i] = u1[i] = u2[i] = 0.f; }
        if (!seqstart) {
            const u32x4 a1 = *(const u32x4*)(A + (size_t)(r0 - 1) * NFF2 + c0), a2 = *(const u32x4*)(A + (size_t)(r0 - 2) * NFF2 + c0);
            const u32x4 b1 = *(const u32x4*)(A + (size_t)(r0 - 1) * NFF2 + DFF + c0), b2 = *(const u32x4*)(A + (size_t)(r0 - 2) * NFF2 + DFF + c0);
#pragma unroll
            for (int i = 0; i < 4; ++i) { g1[2 * i] = __uint_as_float(a1[i] << 16); g1[2 * i + 1] = __uint_as_float(a1[i] & 0xFFFF0000u); g2[2 * i] = __uint_as_float(a2[i] << 16); g2[2 * i + 1] = __uint_as_float(a2[i] & 0xFFFF0000u);
                u1[2 * i] = __uint_as_float(b1[i] << 16); u1[2 * i + 1] = __uint_as_float(b1[i] & 0xFFFF0000u); u2[2 * i] = __uint_as_float(b2[i] << 16); u2[2 * i + 1] = __uint_as_float(b2[i] & 0xFFFF0000u); }
        }
        for (int r = r0; r < r0 + RUN; ++r) {
            const u32x4 a0 = *(const u32x4*)(A + (size_t)r * NFF2 + c0), b0 = *(const u32x4*)(A + (size_t)r * NFF2 + DFF + c0);
            float g0[8], u0[8], hm[8];
#pragma unroll
            for (int i = 0; i < 4; ++i) { g0[2 * i] = __uint_as_float(a0[i] << 16); g0[2 * i + 1] = __uint_as_float(a0[i] & 0xFFFF0000u); u0[2 * i] = __uint_as_float(b0[i] << 16); u0[2 * i + 1] = __uint_as_float(b0[i] & 0xFFFF0000u); }
#pragma unroll
            for (int i = 0; i < 8; ++i) { const float cgv = bg[i] + wg[0][i] * g2[i] + wg[1][i] * g1[i] + wg[2][i] * g0[i]; const float cuv = bu[i] + wu[0][i] * u2[i] + wu[1][i] * u1[i] + wu[2][i] * u0[i];
                hm[i] = cgv / (1.f + __expf(-cgv)) * cuv; g2[i] = g1[i]; g1[i] = g0[i]; u2[i] = u1[i]; u1[i] = u0[i]; }
            u32x4 o; o.x = cvtpk(hm[0], hm[1]); o.y = cvtpk(hm[2], hm[3]); o.z = cvtpk(hm[4], hm[5]); o.w = cvtpk(hm[6], hm[7]);
            *(u32x4*)(HM + (size_t)r * DFF + c0) = o;
        }
    }
}

__device__ __forceinline__ void ffn_fixup(const float* EF, const float* EL, const float* cw, const float* cb, bf16* HM, int gtid, int ngt) {
    for (int it = gtid; it < 128 * 2 * 704; it += ngt) {
        const int j = (it % 704) * 4, rr = (it / 704) & 1, pm = it / 1408;
        if ((pm & 15) == 0) continue;
        const int pg = (j >> 7) * 256 + (j & 127);
        f32x4 c[2];
#pragma unroll
        for (int bj = 0; bj < 2; ++bj) { const int pc = pg + 128 * bj, lc = j + DFF * bj;
            const f32x4 am2 = *(const f32x4*)(EL + ((size_t)(pm - 1) * 2 + 0) * NFF2 + pc), am1 = *(const f32x4*)(EL + ((size_t)(pm - 1) * 2 + 1) * NFF2 + pc);
            const f32x4 a0 = *(const f32x4*)(EF + ((size_t)pm * 2 + 0) * NFF2 + pc), a1 = *(const f32x4*)(EF + ((size_t)pm * 2 + 1) * NFF2 + pc);
            const f32x4 w0 = *(const f32x4*)(cw + lc), w1 = *(const f32x4*)(cw + NFF2 + lc), w2 = *(const f32x4*)(cw + 2 * NFF2 + lc), bb = *(const f32x4*)(cb + lc);
            c[bj] = rr == 0 ? (bb + w0 * am2 + w1 * am1 + w2 * a0) : (bb + w0 * am1 + w1 * a0 + w2 * a1); }
        float hm[4];
#pragma unroll
        for (int i = 0; i < 4; ++i) { const float g = c[0][i]; hm[i] = g * __builtin_amdgcn_rcpf(1.f + __builtin_amdgcn_exp2f(-LOG2E * g)) * c[1][i]; }
        u32x2 w; w.x = cvtpk(hm[0], hm[1]); w.y = cvtpk(hm[2], hm[3]);
        *(u32x2*)(HM + (size_t)(pm * 256 + rr) * DFF + j) = w;
    }
}

__device__ __forceinline__ void ffn_fixup_tile(const float* EF, const float* EL, const float* cw, const float* cb, bf16* HM, int pm, int tid) {
    if ((pm & 15) == 0) return;
    for (int it = tid; it < 2 * 704; it += NTHREADS) {
        const int j = (it % 704) * 4, rr = it / 704;
        const int pg = (j >> 7) * 256 + (j & 127);
        f32x4 c[2];
#pragma unroll
        for (int bj = 0; bj < 2; ++bj) { const int pc = pg + 128 * bj, lc = j + DFF * bj;
            const f32x4 am2 = *(const f32x4*)(EL + ((size_t)(pm - 1) * 2 + 0) * NFF2 + pc), am1 = *(const f32x4*)(EL + ((size_t)(pm - 1) * 2 + 1) * NFF2 + pc);
            const f32x4 a0 = *(const f32x4*)(EF + ((size_t)pm * 2 + 0) * NFF2 + pc), a1 = *(const f32x4*)(EF + ((size_t)pm * 2 + 1) * NFF2 + pc);
            const f32x4 w0 = *(const f32x4*)(cw + lc), w1 = *(const f32x4*)(cw + NFF2 + lc), w2 = *(const f32x4*)(cw + 2 * NFF2 + lc), bb = *(const f32x4*)(cb + lc);
            c[bj] = rr == 0 ? (bb + w0 * am2 + w1 * am1 + w2 * a0) : (bb + w0 * am1 + w1 * a0 + w2 * a1); }
        float hm[4];
#pragma unroll
        for (int i = 0; i < 4; ++i) { const float g = c[0][i]; hm[i] = g * __builtin_amdgcn_rcpf(1.f + __builtin_amdgcn_exp2f(-LOG2E * g)) * c[1][i]; }
        u32x2 w; w.x = cvtpk(hm[0], hm[1]); w.y = cvtpk(hm[2], hm[3]);
        *(u32x2*)(HM + (size_t)(pm * 256 + rr) * DFF + j) = w;
    }
}
constexpr int LDS_BYTES = 147456;
constexpr int ITEMS_PER_LAYER = 1024 + 384 + 512 + 512 + 2816 + 1408;
#ifdef FAKE_SYNC
#define GRID_SYNC() __syncthreads()
#else
#define GRID_SYNC() xcd_barrier(bar, wave)
#endif
#ifndef PROBE
#define PROBE 0
#endif
#ifndef FIXED_A_LIMIT
#define FIXED_A_LIMIT 100.f
#define FIXED_B_LIMIT 50.f
#endif
#define PROBE_REP(bit) (((PROBE) >> (bit)) & 1 ? 2 : 1)

__device__ __forceinline__ unsigned char* ws_launder(unsigned char* w) { asm volatile("" : "+s"(w)); return w; }
__device__ __forceinline__ size_t ws_zero() { size_t z = 0; asm volatile("" : "+s"(z)); return z; }
__global__ void __launch_bounds__(NTHREADS, 2) fwd_kernel(Params p) {
    extern __shared__ __attribute__((aligned(16))) unsigned char lds_raw[];
    LAS unsigned char* lds = (LAS unsigned char*)lds_raw;
    cg::grid_group grid = cg::this_grid();
    const int tid = threadIdx.x, lane = tid & 63, wave = __builtin_amdgcn_readfirstlane(tid >> 6);
    const int G = gridDim.x, bx = blockIdx.x, vcu = (G % 8 == 0) ? (bx % 8) * (G / 8) + bx / 8 : bx;
    const int gw = vcu * NWAVES + wave, ngw = G * NWAVES, gtid = vcu * NTHREADS + tid, ngt = G * NTHREADS;
    unsigned char* ws = p.ws;
    if (tid < 4) ((LAS unsigned*)(lds + 131072))[tid] = 0u;
    __syncthreads();
    const XcdBarrier bar = xcd_barrier_post((unsigned*)(ws + WS_CTL), (volatile LAS unsigned*)(lds + 131072));
#define FRESH_TID(v) int v = wave * 64 + lane_id(); asm volatile("" : "+v"(v))
#define WSL(T, off) ((T*)(ws + ws_zero() + (off)))
#define ROPE WSL(f32x2_t, WS_ROPE)
#define XN WSL(bf16, WS_XN)
#define QO WSL(bf16, WS_QO)
#define KB WSL(bf16, WS_K)
#define VT WSL(bf16, WS_VT)
#define QI WSL(bf16, WS_QI)
#define KI WSL(bf16, WS_KI)
#define WI WSL(float, WS_WI)
#define MASK WSL(unsigned long long, WS_MASK)
#define SSQ WSL(float, WS_SSQ)
#define OB WSL(bf16, WS_OB)
#define DUMMY1 p.out
#define DUMMY2 p.out
#define EF WSL(float, WS_EF)
#define EL WSL(float, WS_EL)
#define HM WSL(bf16, WS_HM)
#define SCR p.out
    LAS float* PART = (LAS float*)(lds + 131072 + 1024);
    {
        LAS float* scr = (LAS float*)(lds + wave * 16384);
        for (int it = gw; it < DEPTH * ITEMS_PER_LAYER; it += ngw) {
            const int l = it / ITEMS_PER_LAYER; int r = it % ITEMS_PER_LAYER; const int kind = l % 3, li = l / 3;
            unsigned char* wl = ws + WS_W + (size_t)l * W_LAYER;
            const float* wqkv = kind == 0 ? p.a_w_qkv + (size_t)li * DM * 3072 : (kind == 1 ? p.b_w_in : p.c_w_qkv);
            const int ldq = kind == 1 ? 3656 : 3072;
            const float* g1 = p.norm1_g + (size_t)l * DM; const float* g2 = p.norm2_g + (size_t)l * DM;
            const float* wo = kind == 0 ? p.a_w_o + (size_t)li * DM * DM : (kind == 1 ? p.b_w_o : p.c_w_o);
            if (r < 1024) { transpose_item(wqkv, DM, ldq, 0, 2048, (bf16*)(wl + WL_QK), 0, 1, g1, scr, r, lane); continue; } r -= 1024;
            if (r < 384) { if (kind == 1) transpose_item(wqkv, DM, ldq, 3072, 584, (bf16*)(wl + WL_QK), 2048, 1, g1, scr, r, lane); continue; } r -= 384;
            if (r < 512) { transpose_item(wqkv, DM, ldq, 2048, 1024, (bf16*)(wl + WL_V), 0, 0, g1, scr, r, lane); continue; } r -= 512;
            if (r < 512) { transpose_item(wo, DM, DM, 0, 1024, (bf16*)(wl + WL_O), 0, 0, nullptr, scr, r, lane); continue; } r -= 512;
            if (r < 2816) { transpose_item(p.ffn_w_in + (size_t)l * DM * NFF2, DM, NFF2, 0, NFF2, (bf16*)(wl + WL_IN), 0, 2, g2, scr, r, lane); continue; } r -= 2816;
            transpose_item(p.ffn_w_down + (size_t)l * DFF * DM, DFF, DM, 0, DM, (bf16*)(wl + WL_D), 0, 0, nullptr, scr, r, lane);
        }
        for (int i = gtid; i < SEQ * 32; i += ngt) {
            const int pos = i >> 5, x = i & 31;
            const float inv = exp2f(-(float)x * (13.287712379549449f / 32.0f));
            const float ang = (float)pos * inv;
            const double rev = (double)ang * 0.15915494309189535; const float fr = (float)(rev - floor(rev));
            ROPE[i] = (f32x2_t){__builtin_amdgcn_cosf(fr), __builtin_amdgcn_sinf(fr)};
        }
        for (int m = gw; m < MTOK; m += ngw) xb_row(p.x + (size_t)m * DM, XN + (size_t)m * DM, SSQ + (size_t)m * 4, lane);
    }
    grid.sync();

    for (int l = 0; l < DEPTH; ++l) {
        const int kind = l % 3, li = l / 3;
        unsigned char* wl = ws + WS_W + (size_t)l * W_LAYER;
        const bf16* WQK = (const bf16*)(wl + WL_QK); const bf16* WV = (const bf16*)(wl + WL_V); const bf16* WO = (const bf16*)(wl + WL_O);
        const bf16* WIN = (const bf16*)(wl + WL_IN); const bf16* WD = (const bf16*)(wl + WL_D);
        for (int rep_ = 0; rep_ < PROBE_REP(0); ++rep_) {
        {
            pg8::Gemm g{XN, WQK, MTOK, kind == 1 ? NQK_B : NQK_A, DM}; pg8::StaticOrder S; S.init(MTOK, g.N, G, bx);
            pg8::EpiQKV E{kind, QO, KB, QI, KI, WI, kind == 1 ? p.b_q_norm : p.a_q_norm + li * HD, kind == 1 ? p.b_k_norm : p.a_k_norm + li * HD, (const pg8::f32x2v*)ROPE, 0.125f * LOG2E, 0.35355339059327373f * 0.125f, SSQ};
#ifndef NO_QKV
            pg8::gemm_phase<pg8::EpiQKV, pg8::StaticOrder, true, true>(lds, g, S, E, wave);
#endif
        }
        {
            pg8::Gemm g{WV, XN, DM, MTOK, DM}; pg8::StaticOrder S; S.init(DM, MTOK, G, bx);
            pg8::EpiVt E{VT, VTP, SSQ};
            pg8::gemm_phase<pg8::EpiVt, pg8::StaticOrder, true, true>(lds, g, S, E, wave);
        }
        }
        GRID_SYNC();
#ifndef NO_A
        for (int rep_ = 0; rep_ < PROBE_REP(1); ++rep_)
        if (kind == 0) { FRESH_TID(t_); const float* gq_ = p.a_q_norm + li * HD; const float* gk_ = p.a_k_norm + li * HD; const float* rb_ = p.a_rel_bias + (size_t)li * NH * 513;
            float mq = fabsf(gq_[t_ & 63]), mk = fabsf(gk_[t_ & 63]), bmax = -1e30f, bmin = 1e30f;
            for (int i = t_; i < NH * 513; i += NTHREADS) { const float v = rb_[i] * LOG2E; bmax = fmaxf(bmax, v); bmin = fminf(bmin, v); }
#pragma unroll
            for (int o = 1; o < 64; o <<= 1) { mq = fmaxf(mq, __shfl_xor(mq, o)); mk = fmaxf(mk, __shfl_xor(mk, o)); bmax = fmaxf(bmax, __shfl_xor(bmax, o)); bmin = fminf(bmin, __shfl_xor(bmin, o)); }
            { LAS float* red = (LAS float*)(lds + 131072 + 1024);
              if ((t_ & 63) == 0) { red[(t_ >> 6) * 2] = bmax; red[(t_ >> 6) * 2 + 1] = bmin; }
              __syncthreads();
#pragma unroll
              for (int w = 0; w < 8; ++w) { bmax = fmaxf(bmax, red[w * 2]); bmin = fminf(bmin, red[w * 2 + 1]); }
              __syncthreads(); }
            const float qk2 = 8.2f * mq * mk * LOG2E, ref = qk2 + bmax;
            if (__builtin_amdgcn_readfirstlane(ref - (bmin - qk2) <= FIXED_A_LIMIT ? 1 : 0)) attnA_blk<true>(QO, KB, VT, OB, rb_, ref, lds, vcu, G, t_);
            else attnA_blk<false>(QO, KB, VT, OB, rb_, 0.f, lds, vcu, G, t_); }
#endif
        if (kind == 1) {
#ifndef NO_B1
            for (int rep_ = 0; rep_ < PROBE_REP(2); ++rep_)
            { FRESH_TID(t_); b1_phase(QI, KI, WI, SCR + (size_t)bx * 32 * 4096, MASK, lds, vcu, G, t_); }
#endif
            GRID_SYNC();
#ifndef NO_B2
            for (int rep_ = 0; rep_ < PROBE_REP(3); ++rep_)
            { FRESH_TID(t_); float mq = fabsf(p.b_q_norm[t_ & 63]), mk = fabsf(p.b_k_norm[t_ & 63]);
#pragma unroll
              for (int o = 1; o < 64; o <<= 1) { mq = fmaxf(mq, __shfl_xor(mq, o)); mk = fmaxf(mk, __shfl_xor(mk, o)); }
              const float ref = 8.2f * mq * mk * LOG2E;
              if (__builtin_amdgcn_readfirstlane(ref <= FIXED_B_LIMIT ? 1 : 0)) attnB_blk<true>(QO, KB, VT, OB, MASK, ref, lds, vcu, G, t_);
              else attnB_blk<false>(QO, KB, VT, OB, MASK, 0.f, lds, vcu, G, t_); }
#endif
        }
#ifndef NO_C
        for (int rep_ = 0; rep_ < PROBE_REP(4); ++rep_)
        if (kind == 2) { FRESH_TID(t_); attnC_blk(QO, KB, VT, OB, lds, vcu, G, t_); }
#endif
        GRID_SYNC();
        {
            pg8::Gemm g{OB, WO, MTOK, DM, DM}; pg8::StaticOrder S; S.init(MTOK, DM, G, bx);
            if (PROBE_REP(5) == 2) { pg8::EpiRes E0{l == 0 ? p.x : nullptr, XN, DUMMY1, DM, nullptr, SSQ, PART}; pg8::gemm_phase<pg8::EpiRes, pg8::StaticOrder, true, true>(lds, g, S, E0, wave); }
            pg8::EpiRes E{l == 0 ? p.x : nullptr, XN, nullptr, DM, XN, SSQ, PART};
            pg8::gemm_phase<pg8::EpiRes, pg8::StaticOrder, true, true>(lds, g, S, E, wave);
        }
        GRID_SYNC();
        {
            pg8::Gemm g{XN, WIN, MTOK, NFF2, DM}; pg8::StaticOrder S; S.init(MTOK, NFF2, G, bx);
            pg8::EpiFFN E{HM, p.ffn_conv_w + (size_t)l * 3 * NFF2, p.ffn_conv_b + (size_t)l * NFF2, EF, EL, (LAS pg8::f32x4*)(lds + 131072 + 1024), SSQ};
            for (int rep_ = 0; rep_ < PROBE_REP(7); ++rep_)
            pg8::gemm_phase<pg8::EpiFFN, pg8::StaticOrder, true, true>(lds, g, S, E, wave);
        }
        GRID_SYNC();
        {
            pg8::Gemm g{HM, WD, MTOK, DM, DFF}; pg8::StaticOrder S; S.init(MTOK, DM, G, bx);
            { FRESH_TID(t_); int lastpm = -1;
#pragma unroll 1
              for (int L = bx; L < 512; L += G) {
                  const int w_ = (L & 7) * 64 + (L >> 3), pm_ = (w_ >> 5) * 8 + (w_ & 7);
                  if (pm_ != lastpm) ffn_fixup_tile(EF, EL, p.ffn_conv_w + (size_t)l * 3 * NFF2, p.ffn_conv_b + (size_t)l * NFF2, HM, pm_, t_);
                  lastpm = pm_; }
              asm volatile("s_waitcnt vmcnt(0)" ::: "memory"); __syncthreads(); }
            if (PROBE_REP(9) == 2) { pg8::EpiRes E0{nullptr, XN, DUMMY2, DM, nullptr, SSQ, PART}; pg8::gemm_phase<pg8::EpiRes, pg8::StaticOrder, true, true>(lds, g, S, E0, wave); }
            pg8::EpiRes E{nullptr, XN, l + 1 == DEPTH ? p.out : nullptr, DM, l + 1 == DEPTH ? nullptr : XN, SSQ, PART};
            pg8::gemm_phase<pg8::EpiRes, pg8::StaticOrder, true, true>(lds, g, S, E, wave);
        }
        GRID_SYNC();
    }
}

extern "C" void kernel_launch(void* const* d_in, const int* in_sizes, int n_in, void* d_out, int out_size, void* d_ws, size_t ws_size, hipStream_t stream) {
    static int grid = 0;
    if (grid == 0) {
        if (n_in != 18 || out_size != MTOK * DM || ws_size < WS_END) { fprintf(stderr, "kernel_launch: unexpected shapes (n_in %d out %d ws %zu)\n", n_in, out_size, ws_size); grid = -1; return; }
        int dev = 0, cus = 0, per_cu = 0;
        hipGetDevice(&dev); hipDeviceGetAttribute(&cus, hipDeviceAttributeMultiprocessorCount, dev);
        hipFuncSetAttribute((const void*)fwd_kernel, hipFuncAttributeMaxDynamicSharedMemorySize, LDS_BYTES);
        hipOccupancyMaxActiveBlocksPerMultiprocessor(&per_cu, (const void*)fwd_kernel, NTHREADS, LDS_BYTES);
        if (per_cu < 1) { fprintf(stderr, "kernel_launch: occupancy query says %d blocks per CU\n", per_cu); per_cu = 1; }
        (void)hipGetLastError();
        grid = cus;
    }
    if (grid < 0) return;
    Params p{};
    const float** f = (const float**)&p;
    for (int i = 0; i < 18; ++i) f[i] = (const float*)d_in[i];
    p.out = (float*)d_out; p.ws = (unsigned char*)d_ws;
    if (hipMemsetAsync((char*)d_ws + WS_CTL, 0, CTL_BYTES, stream) != hipSuccess) { fprintf(stderr, "memset failed\n"); return; }
    void* args[] = {&p};
    hipError_t e = hipLaunchCooperativeKernel((const void*)fwd_kernel, dim3(grid), dim3(NTHREADS), args, LDS_BYTES, stream);
    if (e != hipSuccess) fprintf(stderr, "cooperative launch failed: %s (grid %d)\n", hipGetErrorString(e), grid);
}
```

```cpp
#include <hip/hip_runtime.h>
#include <hip/hip_cooperative_groups.h>
#include <cstdio>
#include <cstdint>
namespace cg = cooperative_groups;
namespace pg8 {
#define PG8_LAS __attribute__((address_space(3)))
typedef unsigned short bf16_t;
typedef short bf16x8 __attribute__((ext_vector_type(8)));
typedef float f32x4 __attribute__((ext_vector_type(4)));
typedef unsigned u32x4 __attribute__((ext_vector_type(4)));
constexpr int BM = 256, BK = 64, HALF = 128, HTB = HALF * BK * 2  , STAGE_BYTES = 8 * HTB, NXCD = 8, WGM = 8;

__host__ __device__ __forceinline__ int lds_byte(int r, int c) { const int st = (r >> 4) * 2 + (c >> 5), rr = r & 15, cc = c & 31, ob = rr * 64 + cc * 2; return st * 1024 + (ob ^ (((ob >> 9) & 1) << 5)); }
__host__ __device__ __forceinline__ void stage_rc(int b, int& R, int& C) { const int st = b / 1024, sb = b % 1024, swz = sb ^ (((sb >> 9) & 1) << 5); R = (st >> 1) * 16 + swz / 64; C = (st & 1) * 32 + (swz % 64) / 2; }
__host__ __device__ __forceinline__ int perm32(int rho) { const int n = rho >> 4, i = rho & 15; return 8 * (i >> 2) + 4 * n + (i & 3); }

struct Unit { int pm, pn; };
struct Gemm { const bf16_t* A; const bf16_t* Bt; int M, N, K; };

struct StaticOrder {
    int nM, nN, nwg, G, c;
    __host__ __device__ void init(int M, int N, int G_, int c_) { nM = M / BM; nN = N / BM; nwg = nM * nN; G = G_; c = c_; }
    __host__ __device__ bool next(int i, Unit& u) const {
        const long L = (long)i * G + c; if (L >= nwg) return false;
        int wgid = (int)L; { const int q = nwg / NXCD, r = nwg % NXCD, xcd = wgid % NXCD, off = wgid / NXCD; wgid = (xcd < r ? xcd * (q + 1) : r * (q + 1) + (xcd - r) * q) + off; }
        const int nig = WGM * nN, gid = wgid / nig, fm = gid * WGM, gsz = (nM - fm) < WGM ? (nM - fm) : WGM;
        u.pm = fm + ((wgid % nig) % gsz); u.pn = (wgid % nig) / gsz; return true;
    }
    __device__ __forceinline__ void a_ready(const Unit&) const {}
    __device__ __forceinline__ void done(const Unit&) const {}
};

__device__ __forceinline__ unsigned cvt_pk_bf16(float lo, float hi) { unsigned r; asm volatile("v_cvt_pk_bf16_f32 %0, %1, %2" : "=v"(r) : "v"(lo), "v"(hi)); return r; }
typedef float f32x2 __attribute__((ext_vector_type(2)));
typedef float f32x2v __attribute__((ext_vector_type(2)));
typedef unsigned u32x2v_t __attribute__((ext_vector_type(2)));
struct EpiBf16Plain {
    static constexpr bool PERM = true, AFTER_DRAIN = false;
    bf16_t* O; int ldc;
    __device__ __forceinline__ void operator()(const f32x4 (&acc)[2][2][4][2], const Unit& u, int wr, int wc, int fr, int fq) const {
        const int row0 = u.pm * BM + wr * 64 + fr; const int col0 = u.pn * BM + wc * 32 + 8 * fq;
#pragma unroll
        for (int ai = 0; ai < 2; ++ai)
#pragma unroll
            for (int m = 0; m < 4; ++m) { bf16_t* rowp = O + (size_t)(row0 + ai * HALF + m * 16) * ldc + col0;
#pragma unroll
                for (int bj = 0; bj < 2; ++bj) { const f32x4 v0 = acc[ai][bj][m][0], v1 = acc[ai][bj][m][1];
                    u32x4 w; w.x = cvt_pk_bf16(v0[0], v0[1]); w.y = cvt_pk_bf16(v0[2], v0[3]); w.z = cvt_pk_bf16(v1[0], v1[1]); w.w = cvt_pk_bf16(v1[2], v1[3]);
                    *(u32x4*)(rowp + bj * HALF) = w; } }
    }
};
__device__ __forceinline__ float rstd_of(const float* SSQ, size_t row) { const f32x4 s4 = *(const f32x4*)(SSQ + row * 4); return rsqrtf(((s4[0] + s4[1]) + (s4[2] + s4[3])) * (1.0f / 1024.0f) + 1e-6f); }
struct EpiRes {
    static constexpr bool PERM = true, AFTER_DRAIN = false;
    const float* base32; const bf16_t* base16; float* out32; int ldc; bf16_t* XB; float* SSQ; PG8_LAS float* part;
    __device__ __forceinline__ void operator()(const f32x4 (&acc)[2][2][4][2], const Unit& u, int wr, int wc, int fr_in, int fq_in) const {
        int fr = fr_in, fq = fq_in; asm volatile("" : "+v"(fr), "+v"(fq));
        const int col0 = u.pn * BM + wc * 32 + 8 * fq;
        u32x4 pre[2][4][2];
        if (!base32) {
#pragma unroll
            for (int ai = 0; ai < 2; ++ai)
#pragma unroll
                for (int m = 0; m < 4; ++m)
#pragma unroll
                    for (int bj = 0; bj < 2; ++bj) pre[ai][m][bj] = *(const u32x4*)(base16 + (size_t)(u.pm * BM + ai * HALF + wr * 64 + m * 16 + fr) * ldc + col0 + bj * HALF);
        }
#pragma unroll
        for (int ai = 0; ai < 2; ++ai)
#pragma unroll
            for (int m = 0; m < 4; ++m) { const int rl = ai * HALF + wr * 64 + m * 16 + fr; const size_t off = (size_t)(u.pm * BM + rl) * ldc + col0;
                float ss = 0.f;
#pragma unroll
                for (int bj = 0; bj < 2; ++bj) {
                    f32x4 b0, b1;
                    if (base32) { b0 = *(const f32x4*)(base32 + off + bj * HALF); b1 = *(const f32x4*)(base32 + off + bj * HALF + 4); }
                    else { const u32x4 r = pre[ai][m][bj];
                        b0 = (f32x4){__uint_as_float(r.x << 16), __uint_as_float(r.x & 0xFFFF0000u), __uint_as_float(r.y << 16), __uint_as_float(r.y & 0xFFFF0000u)};
                        b1 = (f32x4){__uint_as_float(r.z << 16), __uint_as_float(r.z & 0xFFFF0000u), __uint_as_float(r.w << 16), __uint_as_float(r.w & 0xFFFF0000u)}; }
                    const f32x4 v0 = b0 + acc[ai][bj][m][0], v1 = b1 + acc[ai][bj][m][1];
                    if (out32) { *(f32x4*)(out32 + off + bj * HALF) = v0; *(f32x4*)(out32 + off + bj * HALF + 4) = v1; }
                    if (XB) { u32x4 w; w.x = cvt_pk_bf16(v0[0], v0[1]); w.y = cvt_pk_bf16(v0[2], v0[3]); w.z = cvt_pk_bf16(v1[0], v1[1]); w.w = cvt_pk_bf16(v1[2], v1[3]); *(u32x4*)(XB + off + bj * HALF) = w;
                        const f32x4 q0 = (f32x4){__uint_as_float(w.x << 16), __uint_as_float(w.x & 0xFFFF0000u), __uint_as_float(w.y << 16), __uint_as_float(w.y & 0xFFFF0000u)};
                        const f32x4 q1 = (f32x4){__uint_as_float(w.z << 16), __uint_as_float(w.z & 0xFFFF0000u), __uint_as_float(w.w << 16), __uint_as_float(w.w & 0xFFFF0000u)};
                        ss += ((q0[0] * q0[0] + q0[1] * q0[1]) + (q0[2] * q0[2] + q0[3] * q0[3])) + ((q1[0] * q1[0] + q1[1] * q1[1]) + (q1[2] * q1[2] + q1[3] * q1[3])); } }
                ss += __shfl_xor(ss, 16); ss += __shfl_xor(ss, 32);
                if (fq == 0) part[rl * 4 + wc] = ss;
                if (base32 && (m & 1)) asm volatile("" ::: "memory"); }
        asm volatile("s_waitcnt lgkmcnt(0)" ::: "memory"); __builtin_amdgcn_s_barrier(); asm volatile("" ::: "memory");
        const int t = (wr * 4 + wc) * 64 + fq * 16 + fr;
        if (t < 256 && XB) { const f32x4 p4 = *(const PG8_LAS f32x4*)(part + t * 4); SSQ[(size_t)(u.pm * BM + t) * 4 + u.pn] = (p4[0] + p4[1]) + (p4[2] + p4[3]); }
    }
};
struct EpiVt {
    static constexpr bool PERM = true, AFTER_DRAIN = false;
    bf16_t* O; int ldc; const float* SSQ;
    __device__ __forceinline__ void operator()(const f32x4 (&acc)[2][2][4][2], const Unit& u, int wr, int wc, int fr_in, int fq_in) const {
        int fr = fr_in, fq = fq_in; asm volatile("" : "+v"(fr), "+v"(fq));
        const int row0 = u.pm * BM + wr * 64 + fr; const int col0 = u.pn * BM + wc * 32 + 8 * fq;
        float rs[2][8];
#pragma unroll
        for (int bj = 0; bj < 2; ++bj)
#pragma unroll
            for (int c = 0; c < 8; ++c) rs[bj][c] = rstd_of(SSQ, (size_t)(col0 + bj * HALF + c));
#pragma unroll
        for (int ai = 0; ai < 2; ++ai)
#pragma unroll
            for (int m = 0; m < 4; ++m) { bf16_t* rowp = O + (size_t)(row0 + ai * HALF + m * 16) * ldc + col0;
#pragma unroll
                for (int bj = 0; bj < 2; ++bj) { const f32x4 v0 = acc[ai][bj][m][0], v1 = acc[ai][bj][m][1];
                    u32x4 w; w.x = cvt_pk_bf16(v0[0] * rs[bj][0], v0[1] * rs[bj][1]); w.y = cvt_pk_bf16(v0[2] * rs[bj][2], v0[3] * rs[bj][3]); w.z = cvt_pk_bf16(v1[0] * rs[bj][4], v1[1] * rs[bj][5]); w.w = cvt_pk_bf16(v1[2] * rs[bj][6], v1[3] * rs[bj][7]);
                    *(u32x4*)(rowp + bj * HALF) = w; } }
    }
};
struct EpiQKV {
    static constexpr bool PERM = true, AFTER_DRAIN = false;
    int kind;
    bf16_t *Q, *K, *QI, *KI; float* WI;
    const float *gq, *gk; const f32x2v* rope; float qscale, wscale; const float* SSQ;
    __device__ __forceinline__ void operator()(const f32x4 (&acc)[2][2][4][2], const Unit& u, int wr, int wc, int fr_in, int fq_in) const {
        int fr = fr_in, fq = fq_in; asm volatile("" : "+v"(fr), "+v"(fq));
        const int hs = u.pn * 4 + wc;
        bf16_t* dst; int ld, col; bool donorm = false, dorope = false; const float* gain = gq; float sc = 1.f;
        if (hs < 16) { dst = Q; ld = 1024; col = hs * 64; donorm = (kind != 2); dorope = (kind == 1); gain = gq; sc = qscale; }
        else if (hs < 32) { dst = K; ld = 1024; col = (hs - 16) * 64; donorm = (kind != 2); dorope = (kind == 1); gain = gk; }
        else if (hs < 40) { dst = QI; ld = 512; col = (hs - 32) * 64; dorope = true; }
        else if (hs == 40) { dst = KI; ld = 64; col = 0; dorope = true; }
        else if (hs == 41) {
            if (fq == 0) {
#pragma unroll
                for (int ai = 0; ai < 2; ++ai)
#pragma unroll
                    for (int m = 0; m < 4; ++m) { const int row = u.pm * BM + ai * HALF + wr * 64 + m * 16 + fr;
                        const float rsw = rstd_of(SSQ, (size_t)row) * wscale; *(f32x4*)(WI + (size_t)row * 8) = acc[ai][0][m][0] * rsw; *(f32x4*)(WI + (size_t)row * 8 + 4) = acc[ai][0][m][1] * rsw; }
            }
            return;
        } else return;
        float g[2][2][4];
#pragma unroll
        for (int bj = 0; bj < 2; ++bj)
#pragma unroll
            for (int n = 0; n < 2; ++n)
#pragma unroll
                for (int i = 0; i < 4; ++i) g[bj][n][i] = donorm ? gain[32 * bj + 8 * fq + 4 * n + i] * sc : sc;
        f32x4 sq[2][4];
#pragma unroll
        for (int ai = 0; ai < 2; ++ai)
#pragma unroll
            for (int m = 0; m < 4; ++m) sq[ai][m] = *(const f32x4*)(SSQ + (size_t)(u.pm * BM + ai * HALF + wr * 64 + m * 16 + fr) * 4);
#pragma unroll
        for (int ai = 0; ai < 2; ++ai) {
#pragma unroll
          for (int mp = 0; mp < 4; ++mp) {
            f32x4 rp4[4][4];
            if (dorope) {
#pragma unroll
                for (int m = mp; m < mp + 1; ++m) { const f32x4* rp = (const f32x4*)(rope + (size_t)((u.pm * BM + ai * HALF + wr * 64 + m * 16 + fr) & 4095) * 32 + 8 * fq);
#pragma unroll
                    for (int k = 0; k < 4; ++k) rp4[m][k] = rp[k]; }
            }
#pragma unroll
            for (int m = mp; m < mp + 1; ++m) {
                const int row = u.pm * BM + ai * HALF + wr * 64 + m * 16 + fr;
                f32x4 v[2][2];
                const float rs0 = rsqrtf(((sq[ai][m][0] + sq[ai][m][1]) + (sq[ai][m][2] + sq[ai][m][3])) * (1.0f / 1024.0f) + 1e-6f);
#pragma unroll
                for (int bj = 0; bj < 2; ++bj)
#pragma unroll
                    for (int n = 0; n < 2; ++n) v[bj][n] = acc[ai][bj][m][n] * rs0;
                float r = 1.f;
                if (donorm) {
                    float ss = 0.f;
#pragma unroll
                    for (int bj = 0; bj < 2; ++bj)
#pragma unroll
                        for (int n = 0; n < 2; ++n) { const f32x4 x = v[bj][n]; ss += (x[0] * x[0] + x[1] * x[1]) + (x[2] * x[2] + x[3] * x[3]); }
                    ss += __shfl_xor(ss, 16); ss += __shfl_xor(ss, 32);
                    r = rsqrtf(ss * (1.0f / 64.0f) + 1e-6f);
                }
#pragma unroll
                for (int bj = 0; bj < 2; ++bj)
#pragma unroll
                    for (int n = 0; n < 2; ++n)
#pragma unroll
                        for (int i = 0; i < 4; ++i) v[bj][n][i] = v[bj][n][i] * r * g[bj][n][i];
                if (dorope) {
#pragma unroll
                    for (int n = 0; n < 2; ++n) { const f32x4 cs0 = rp4[m][2 * n], cs1 = rp4[m][2 * n + 1];
                        const float c_[4] = {cs0[0], cs0[2], cs1[0], cs1[2]}, s_[4] = {cs0[1], cs0[3], cs1[1], cs1[3]};
#pragma unroll
                        for (int i = 0; i < 4; ++i) { const float x1 = v[0][n][i], x2 = v[1][n][i]; v[0][n][i] = x1 * c_[i] - x2 * s_[i]; v[1][n][i] = x2 * c_[i] + x1 * s_[i]; } }
                }
                bf16_t* rowp = dst + (size_t)row * ld + col + 8 * fq;
#pragma unroll
                for (int bj = 0; bj < 2; ++bj) { u32x4 w; w.x = cvt_pk_bf16(v[bj][0][0], v[bj][0][1]); w.y = cvt_pk_bf16(v[bj][0][2], v[bj][0][3]); w.z = cvt_pk_bf16(v[bj][1][0], v[bj][1][1]); w.w = cvt_pk_bf16(v[bj][1][2], v[bj][1][3]);
                    *(u32x4*)(rowp + 32 * bj) = w; }
            }
            asm volatile("" ::: "memory");
          }
        }
    }
};
template <int CTRL, bool BC> __device__ __forceinline__ float pg8_dpp(float x) { return __int_as_float(__builtin_amdgcn_update_dpp(0, __float_as_int(x), CTRL, 0xf, 0xf, BC)); }
#define PG8_FMAC_DPP(v, a, w, CTRL) asm("v_fmac_f32_dpp %0, %1, %2 " CTRL : "+v"(v) : "v"(a), "v"(w))
struct EpiFFN {
    static constexpr bool PERM = true, AFTER_DRAIN = false;
    bf16_t* HM; const float* cw; const float* cb; float* EF; float* EL; PG8_LAS f32x4* halo; const float* SSQ;
    __device__ __forceinline__ void operator()(const f32x4 (&acc_)[2][2][4][2], const Unit& u, int wr, int wc, int fr_in, int fq_in) const {
        int fr = fr_in, fq = fq_in; asm volatile("" : "+v"(fr), "+v"(fq));
        f32x4 (&acc)[2][2][4][2] = const_cast<f32x4 (&)[2][2][4][2]>(acc_);
        f32x4 Wn[2][4];
        { const int jc0 = u.pn * 128 + wc * 32 + 8 * fq;
#pragma unroll
          for (int bj = 0; bj < 2; ++bj) { const float* wp = cw + bj * 2816 + jc0;
              Wn[bj][0] = *(const f32x4*)(wp); Wn[bj][1] = *(const f32x4*)(wp + 5632); Wn[bj][2] = *(const f32x4*)(wp + 2 * 5632); Wn[bj][3] = *(const f32x4*)(cb + bj * 2816 + jc0); } }
#pragma unroll
        for (int ai = 0; ai < 2; ++ai)
#pragma unroll
            for (int m = 0; m < 4; ++m) { const float rs0 = rstd_of(SSQ, (size_t)(u.pm * BM + ai * HALF + wr * 64 + m * 16 + fr));
#pragma unroll
                for (int bj = 0; bj < 2; ++bj)
#pragma unroll
                    for (int n = 0; n < 2; ++n) acc[ai][bj][m][n] = acc[ai][bj][m][n] * rs0; }
        const int pcol = u.pn * 256 + wc * 32 + 8 * fq, jcol = u.pn * 128 + wc * 32 + 8 * fq;
        if (fr >= 14) {
            const int rr = fr - 14;
#pragma unroll
            for (int ai = 0; ai < 2; ++ai)
#pragma unroll
                for (int bj = 0; bj < 2; ++bj)
#pragma unroll
                    for (int n = 0; n < 2; ++n) halo[(((((ai * 2 + wr) * 2 + rr) * 4 + wc) * 2 + bj) * 4 + fq) * 2 + n] = acc[ai][bj][3][n];
            if (wr == 1) { float* e = EL + ((size_t)u.pm * 2 + rr) * 5632 + pcol;
#pragma unroll
                for (int bj = 0; bj < 2; ++bj)
#pragma unroll
                    for (int n = 0; n < 2; ++n) *(f32x4*)(e + bj * 128 + n * 4) = acc[1][bj][3][n]; }
        }
        if (wr == 0 && fr < 2) { float* e = EF + ((size_t)u.pm * 2 + fr) * 5632 + pcol;
#pragma unroll
            for (int bj = 0; bj < 2; ++bj)
#pragma unroll
                for (int n = 0; n < 2; ++n) *(f32x4*)(e + bj * 128 + n * 4) = acc[0][bj][0][n]; }
        asm volatile("s_waitcnt lgkmcnt(0)" ::: "memory"); __builtin_amdgcn_s_barrier(); asm volatile("" ::: "memory");
#pragma unroll
        for (int n = 0; n < 2; ++n) {
            f32x4 W0[2], W1[2], W2[2], Bb[2], W0m[2], W1m[2];
#pragma unroll
            for (int bj = 0; bj < 2; ++bj) { const float* wp = cw + bj * 2816 + jcol + 4 * n;
                if (n == 0) { W0[bj] = Wn[bj][0]; W1[bj] = Wn[bj][1]; W2[bj] = Wn[bj][2]; Bb[bj] = Wn[bj][3]; }
                else { W0[bj] = *(const f32x4*)(wp); W1[bj] = *(const f32x4*)(wp + 5632); W2[bj] = *(const f32x4*)(wp + 2 * 5632); Bb[bj] = *(const f32x4*)(cb + bj * 2816 + jcol + 4 * n); }
                W1m[bj] = fr == 0 ? W1[bj] : (f32x4){0.f, 0.f, 0.f, 0.f}; W0m[bj] = fr < 2 ? W0[bj] : (f32x4){0.f, 0.f, 0.f, 0.f}; }
#pragma unroll
            for (int ai = 0; ai < 2; ++ai)
#pragma unroll
                for (int m = 0; m < 4; ++m) {
                    f32x4 c[2];
#pragma unroll
                    for (int bj = 0; bj < 2; ++bj) {
                        const f32x4 a = acc[ai][bj][m][n];
                        f32x4 t1, t2;
                        if (m > 0) { t1 = (f32x4){0.f, 0.f, 0.f, 0.f}; t2 = t1;
                        } else {
                            t1 = (f32x4){0.f, 0.f, 0.f, 0.f}; t2 = t1;
                            const int sa = (wr == 1) ? ai : 0, sw = (wr == 1) ? 0 : 1;
                            if ((wr == 1 || ai == 1) && fr < 2) {
                                const f32x4 h0 = halo[(((((sa * 2 + sw) * 2 + 0) * 4 + wc) * 2 + bj) * 4 + fq) * 2 + n], h1 = halo[(((((sa * 2 + sw) * 2 + 1) * 4 + wc) * 2 + bj) * 4 + fq) * 2 + n];
                                t1 = (fr == 0) ? h1 : (f32x4){0.f, 0.f, 0.f, 0.f}; t2 = (fr == 0) ? h0 : h1;
                            }
                        }
#pragma unroll
                        for (int i = 0; i < 4; ++i) {
                            const float ax = a[i];
                            float v = __builtin_fmaf(W2[bj][i], ax, Bb[bj][i]);
                            PG8_FMAC_DPP(v, ax, W1[bj][i], "row_shr:1 row_mask:0xf bank_mask:0xf bound_ctrl:1");
                            PG8_FMAC_DPP(v, ax, W0[bj][i], "row_shr:2 row_mask:0xf bank_mask:0xf bound_ctrl:1");
                            if (m > 0) { const float apx = acc[ai][bj][m - 1][n][i];
                                PG8_FMAC_DPP(v, apx, W1m[bj][i], "row_ror:1 row_mask:0xf bank_mask:0xf");
                                PG8_FMAC_DPP(v, apx, W0m[bj][i], "row_ror:2 row_mask:0xf bank_mask:0xf");
                            } else { v = __builtin_fmaf(t1[i], W1[bj][i], v); v = __builtin_fmaf(t2[i], W0[bj][i], v); }
                            c[bj][i] = v;
                        }
                    }
                    float hm[4];
#pragma unroll
                    for (int i = 0; i < 4; ++i) { const float g = c[0][i]; hm[i] = g * __builtin_amdgcn_rcpf(1.f + __builtin_amdgcn_exp2f(-1.4426950408889634f * g)) * c[1][i]; }
                    u32x2v_t w; w.x = cvt_pk_bf16(hm[0], hm[1]); w.y = cvt_pk_bf16(hm[2], hm[3]);
                    *(u32x2v_t*)(HM + (size_t)(u.pm * BM + ai * HALF + wr * 64 + m * 16 + fr) * 2816 + jcol + 4 * n) = w;
                }
        }
    }
};
template <class Epi, class Sched, bool ALIGN_EPI = false, bool SP2 = false>
__device__ __forceinline__ void gemm_phase(PG8_LAS unsigned char* lds, const Gemm g, const Sched& S, const Epi& E, const int wave_s) {
    unsigned ones_l = ~0u; asm volatile("" : "+s"(ones_l)); int tid_l = wave_s * 64 + (int)__builtin_amdgcn_mbcnt_hi(ones_l, __builtin_amdgcn_mbcnt_lo(ones_l, 0u)); asm volatile("" : "+v"(tid_l));
    const int tid = tid_l, wid = __builtin_amdgcn_readfirstlane(tid >> 6), lane = tid & 63, wr = wid >> 2, wc = wid & 3, fr = lane & 15, fq = lane >> 4;
    const int K = g.K, nt = K / BK;
    unsigned voffA[2], voffB[2];
#pragma unroll
    for (int i = 0; i < 2; ++i) { int R, C; stage_rc(tid * 16 + i * 8192, R, C); const int Rb = Epi::PERM ? ((R & ~31) + perm32(R & 31)) : R;
        voffA[i] = (unsigned)(R * K + C) * 2u; voffB[i] = (unsigned)(Rb * K + C) * 2u; }
    const size_t kstep = (size_t)(BK * 2);
    const size_t hstep = (size_t)HALF * K * 2;
    const size_t tstep = 2 * hstep;
    const unsigned ldsw = (unsigned)wid * 1024u;
    const int aoff = lds_byte(wr * 64 + fr, fq * 8), boff = lds_byte(wc * 32 + fr, fq * 8);
#define PG8_SA(b, h) (((b) * 2 + (h)) * HTB)
#define PG8_SB(b, h) ((4 + (b) * 2 + (h)) * HTB)
#define PG8_STAGE(bufoff, gbase, voff) do { _Pragma("unroll") for (int _i = 0; _i < 2; ++_i) \
        __builtin_amdgcn_global_load_lds((const unsigned*)((const char*)(gbase) + (voff)[_i]), (PG8_LAS unsigned*)(lds + (bufoff) + ldsw + _i * 8192), 16, 0, 0); } while (0)
#define PG8_LDA(dst, b, h) do { _Pragma("unroll") for (int m = 0; m < 4; ++m) _Pragma("unroll") for (int k = 0; k < 2; ++k) dst[m][k] = *(const PG8_LAS bf16x8*)(lds + PG8_SA(b, h) + aoff + m * 2048 + k * 1024); } while (0)
#define PG8_LDB(dst, b, h) do { _Pragma("unroll") for (int n = 0; n < 2; ++n) _Pragma("unroll") for (int k = 0; k < 2; ++k) dst[n][k] = *(const PG8_LAS bf16x8*)(lds + PG8_SB(b, h) + boff + n * 2048 + k * 1024); } while (0)
#define PG8_MMA(ai, bj, At, Bt) do { __builtin_amdgcn_s_setprio(1); _Pragma("unroll") for (int m = 0; m < 4; ++m) _Pragma("unroll") for (int n = 0; n < 2; ++n) _Pragma("unroll") for (int k = 0; k < 2; ++k) \
        acc[ai][bj][m][n] = __builtin_amdgcn_mfma_f32_16x16x32_bf16(Bt[n][k], At[m][k], acc[ai][bj][m][n], 0, 0, 0); __builtin_amdgcn_s_setprio(0); } while (0)
#define PG8_WAIT_V(n) asm volatile("s_waitcnt vmcnt(" #n ")" ::: "memory")
#define PG8_WAIT_L(n) asm volatile("s_waitcnt lgkmcnt(" #n ")" ::: "memory")
#define PG8_BAR __builtin_amdgcn_s_barrier()
#define PG8_SCHED __builtin_amdgcn_sched_barrier(0)
    Unit cur, nxt; int ui = 0;
    if (!S.next(0, cur)) return;
    f32x4 acc[2][2][4][2];
#pragma unroll
    for (int a = 0; a < 2; ++a)
#pragma unroll
        for (int b = 0; b < 2; ++b)
#pragma unroll
            for (int m = 0; m < 4; ++m)
#pragma unroll
                for (int n = 0; n < 2; ++n) acc[a][b][m][n] = (f32x4){0.f, 0.f, 0.f, 0.f};
    bf16x8 At[4][2], B0[2][2], B1[2][2];
    const char* cA = (const char*)g.A + (size_t)cur.pm * tstep; const char* cB = (const char*)g.Bt + (size_t)cur.pn * tstep;
    S.a_ready(cur);
    if constexpr (SP2) {
        PG8_STAGE(PG8_SB(0, 0), cB, voffB); PG8_STAGE(PG8_SB(0, 1), cB + hstep, voffB); PG8_STAGE(PG8_SA(0, 0), cA, voffA); PG8_STAGE(PG8_SA(0, 1), cA + hstep, voffA);
        if (wr == 1) PG8_BAR;
        PG8_WAIT_V(2); PG8_BAR;
        PG8_STAGE(PG8_SB(1, 0), cB + kstep, voffB); PG8_STAGE(PG8_SA(1, 0), cA + kstep, voffA); PG8_STAGE(PG8_SB(1, 1), cB + hstep + kstep, voffB);
        PG8_WAIT_V(6); PG8_BAR;
    } else {
        PG8_STAGE(PG8_SB(0, 0), cB, voffB); PG8_STAGE(PG8_SA(0, 0), cA, voffA); PG8_STAGE(PG8_SB(0, 1), cB + hstep, voffB); PG8_STAGE(PG8_SA(0, 1), cA + hstep, voffA);
        if (wr == 1) PG8_BAR;
        PG8_WAIT_V(4); PG8_BAR;
        PG8_STAGE(PG8_SB(1, 0), cB + kstep, voffB); PG8_STAGE(PG8_SA(1, 0), cA + kstep, voffA); PG8_STAGE(PG8_SB(1, 1), cB + hstep + kstep, voffB);
        PG8_WAIT_V(6); PG8_BAR;
    }
    for (;;) {
        const bool has_next = S.next(ui + 1, nxt);
        const char* nA = has_next ? (const char*)g.A + (size_t)nxt.pm * tstep : cA; const char* nB = has_next ? (const char*)g.Bt + (size_t)nxt.pn * tstep : cB;
        for (int t = 0; t < nt; t += 2) {
            const bool last = (t == nt - 2);
            const char* a1 = cA + (size_t)(t + 1) * kstep;
            const char* a2 = last ? nA : cA + (size_t)(t + 2) * kstep; const char* b2 = last ? nB : cB + (size_t)(t + 2) * kstep;
            const char* a3 = a2 + kstep; const char* b3 = b2 + kstep;
            if (last && has_next) S.a_ready(nxt);
            if constexpr (SP2) {
            PG8_LDB(B0, 0, 0); PG8_LDB(B1, 0, 1); PG8_SCHED; PG8_LDA(At, 0, 0); PG8_STAGE(PG8_SA(1, 1), a1 + hstep, voffA);
            PG8_WAIT_V(8); PG8_WAIT_L(0); PG8_BAR; PG8_MMA(0, 0, At, B0); PG8_MMA(0, 1, At, B1); PG8_BAR; PG8_SCHED;
            PG8_LDA(At, 0, 1); PG8_STAGE(PG8_SB(0, 0), b2, voffB); PG8_STAGE(PG8_SB(0, 1), b2 + hstep, voffB); PG8_STAGE(PG8_SA(0, 0), a2, voffA);
            PG8_WAIT_V(8); PG8_WAIT_L(0); PG8_BAR; PG8_MMA(1, 0, At, B0); PG8_MMA(1, 1, At, B1); PG8_BAR; PG8_SCHED;
            PG8_LDB(B0, 1, 0); PG8_LDB(B1, 1, 1); PG8_SCHED; PG8_LDA(At, 1, 0); PG8_STAGE(PG8_SA(0, 1), a2 + hstep, voffA);
            PG8_WAIT_V(8); PG8_WAIT_L(0); PG8_BAR; PG8_MMA(0, 0, At, B0); PG8_MMA(0, 1, At, B1); PG8_BAR; PG8_SCHED;
            PG8_LDA(At, 1, 1); PG8_STAGE(PG8_SB(1, 0), b3, voffB); PG8_STAGE(PG8_SB(1, 1), b3 + hstep, voffB); PG8_STAGE(PG8_SA(1, 0), a3, voffA);
            PG8_WAIT_V(8); PG8_WAIT_L(0); PG8_BAR; PG8_MMA(1, 0, At, B0); PG8_MMA(1, 1, At, B1); PG8_BAR; PG8_SCHED;
            } else {
            PG8_LDB(B0, 0, 0); PG8_SCHED; PG8_LDA(At, 0, 0); PG8_STAGE(PG8_SA(1, 1), a1 + hstep, voffA);
            PG8_WAIT_L(8); PG8_BAR; PG8_WAIT_L(0); PG8_MMA(0, 0, At, B0); PG8_BAR; PG8_SCHED;
            PG8_LDB(B1, 0, 1); PG8_STAGE(PG8_SB(0, 0), b2, voffB);
            PG8_BAR; PG8_WAIT_L(0); PG8_MMA(0, 1, At, B1); PG8_BAR;
            PG8_LDA(At, 0, 1); PG8_STAGE(PG8_SA(0, 0), a2, voffA);
            PG8_BAR; PG8_WAIT_L(0); PG8_MMA(1, 0, At, B0); PG8_BAR; PG8_SCHED;
            PG8_STAGE(PG8_SB(0, 1), b2 + hstep, voffB);
            PG8_WAIT_V(6); PG8_BAR; PG8_MMA(1, 1, At, B1); PG8_BAR;
            PG8_LDB(B0, 1, 0); PG8_SCHED; PG8_LDA(At, 1, 0); PG8_STAGE(PG8_SA(0, 1), a2 + hstep, voffA);
            PG8_WAIT_L(8); PG8_BAR; PG8_WAIT_L(0); PG8_MMA(0, 0, At, B0); PG8_BAR; PG8_SCHED;
            PG8_LDB(B1, 1, 1); PG8_STAGE(PG8_SB(1, 0), b3, voffB);
            PG8_BAR; PG8_WAIT_L(0); PG8_MMA(0, 1, At, B1); PG8_BAR;
            PG8_LDA(At, 1, 1); PG8_STAGE(PG8_SA(1, 0), a3, voffA);
            PG8_BAR; PG8_WAIT_L(0); PG8_MMA(1, 0, At, B0); PG8_BAR; PG8_SCHED;
            PG8_STAGE(PG8_SB(1, 1), b3 + hstep, voffB);
            PG8_WAIT_V(6); PG8_BAR; PG8_MMA(1, 1, At, B1); PG8_BAR;
            }
        }
        if constexpr (ALIGN_EPI) { if (wr == 0) PG8_BAR; }
        if constexpr (!Epi::AFTER_DRAIN) { E(acc, cur, wr, wc, fr, fq); S.done(cur); }
        if (!has_next) break;
#pragma unroll
        for (int a = 0; a < 2; ++a)
#pragma unroll
            for (int b = 0; b < 2; ++b)
#pragma unroll
                for (int m = 0; m < 4; ++m)
#pragma unroll
                    for (int n = 0; n < 2; ++n) acc[a][b][m][n] = (f32x4){0.f, 0.f, 0.f, 0.f};
        cur = nxt; cA = nA; cB = nB; ++ui;
        if constexpr (ALIGN_EPI) { if (wr == 1) PG8_BAR; }
    }
    PG8_WAIT_V(0);
    if constexpr (!ALIGN_EPI) { if (wr == 0) PG8_BAR; }
    PG8_BAR;
    if constexpr (Epi::AFTER_DRAIN) { E.fused(acc, cur, wr, wc, fr, fq, lds, wid, lane); S.done(cur); }
#undef PG8_SA
#undef PG8_SB
#undef PG8_STAGE
#undef PG8_LDA
#undef PG8_LDB
#undef PG8_MMA
#undef PG8_WAIT_V
#undef PG8_WAIT_L
#undef PG8_BAR
#undef PG8_SCHED
}
}
constexpr int SEQ = 4096, NB = 8, DM = 1024, NH = 16, HD = 64, MTOK = NB * SEQ, DFF = 2816, NFF2 = 2 * DFF, DEPTH = 4;
constexpr int NQK_A = 2048, NQK_B = 2816;
constexpr int MHALF = MTOK / 2;
constexpr int VTP = MTOK + 2048 + 128;
constexpr int NTHREADS = 512, NWAVES = 8;
constexpr float LOG2E = 1.4426950408889634f;
constexpr size_t MiB = 1u << 20;
constexpr size_t WS_CTL = 0, CTL_BYTES = 64 * 1024;
constexpr size_t WS_ROPE = 1 * MiB;
constexpr size_t WS_SSQ = 128 * 1024;
constexpr size_t WS_W = 2 * MiB, W_LAYER = 26 * MiB, WL_QK = 0, WL_V = 5632 * 1024, WL_O = WL_V + 2 * MiB, WL_IN = WL_O + 2 * MiB, WL_D = WL_IN + 11 * MiB;
constexpr size_t WS_XN = 106 * MiB, WS_OB = 170 * MiB, WS_SCR = WS_XN;
constexpr size_t WS_QO = 234 * MiB, WS_K = 298 * MiB, WS_VT = 362 * MiB, WS_QI = 431 * MiB, WS_KI = 463 * MiB, WS_WI = 467 * MiB, WS_MASK = 468 * MiB;
constexpr size_t WS_HM = 234 * MiB, WS_EF = 410 * MiB, WS_EL = 416 * MiB, WS_END = 498 * MiB;
static_assert(WL_D + (size_t)DM * DFF * 2 <= W_LAYER, "weights per layer");
static_assert(WS_VT + (size_t)DM * VTP * 2 <= WS_QI && WS_W + DEPTH * W_LAYER <= WS_XN && WS_MASK + 16 * MiB <= WS_END && WS_HM + (size_t)MTOK * DFF * 2 <= WS_EF && WS_EF + (size_t)256 * NFF2 * 4 <= WS_EL && WS_EL + (size_t)256 * NFF2 * 4 <= WS_END, "ws map");

#define LAS __attribute__((address_space(3)))
typedef unsigned short bf16;
typedef short bf16x8 __attribute__((ext_vector_type(8)));
typedef float f32x4 __attribute__((ext_vector_type(4)));
typedef float f32x16 __attribute__((ext_vector_type(16)));
typedef unsigned u32x4 __attribute__((ext_vector_type(4)));
typedef unsigned u32x2 __attribute__((ext_vector_type(2)));
typedef float f32x2_t __attribute__((ext_vector_type(2))); typedef __bf16 bf16x2_t __attribute__((ext_vector_type(2)));
__device__ __forceinline__ unsigned cvtpk(float lo, float hi) { f32x2_t v = {lo, hi}; bf16x2_t b = __builtin_convertvector(v, bf16x2_t); return __builtin_bit_cast(unsigned, b); }
__device__ __forceinline__ float bf2f(unsigned short h) { return __uint_as_float((unsigned)h << 16); }
__device__ __forceinline__ float wave_sum(float v) {
#pragma unroll
    for (int o = 1; o < 64; o <<= 1) v += __shfl_xor(v, o);
    return v;
}
__device__ __forceinline__ unsigned wave_sum_u32(unsigned v) {
    v += (unsigned)__builtin_amdgcn_update_dpp(0, (int)v, 0x111, 0xf, 0xf, true);
    v += (unsigned)__builtin_amdgcn_update_dpp(0, (int)v, 0x112, 0xf, 0xf, true);
    v += (unsigned)__builtin_amdgcn_update_dpp(0, (int)v, 0x114, 0xf, 0xf, true);
    v += (unsigned)__builtin_amdgcn_update_dpp(0, (int)v, 0x118, 0xf, 0xf, true);
    v += (unsigned)__builtin_amdgcn_update_dpp(0, (int)v, 0x142, 0xa, 0xf, true);
    v += (unsigned)__builtin_amdgcn_update_dpp(0, (int)v, 0x143, 0xc, 0xf, true);
    return (unsigned)__builtin_amdgcn_readlane((int)v, 63);
}
__device__ __forceinline__ int lane_id() { unsigned ones = ~0u; asm volatile("" : "+s"(ones)); return (int)__builtin_amdgcn_mbcnt_hi(ones, __builtin_amdgcn_mbcnt_lo(ones, 0u)); }
__device__ __forceinline__ int pi_row(int i) { return (i & ~12) | ((i & 4) << 1) | ((i & 8) >> 1); }

struct Params {
    const float* x; const float* norm1_g; const float* norm2_g;
    const float* a_w_qkv; const float* a_q_norm; const float* a_k_norm; const float* a_rel_bias; const float* a_w_o;
    const float* b_w_in; const float* b_q_norm; const float* b_k_norm; const float* b_w_o;
    const float* c_w_qkv; const float* c_w_o;
    const float* ffn_w_in; const float* ffn_conv_w; const float* ffn_conv_b; const float* ffn_w_down;
    float* out; unsigned char* ws;
};

__device__ __forceinline__ void transpose_item(const float* W, int K, int ldw, int src_col0, int nvalid, bf16* WT, int dst_row0, int perm, const float* gk, LAS float* scr, int item, int lane) {
    const int kblks = K / 64, nb = item / kblks, kb = item % kblks, k0 = 64 * kb, n0 = 32 * nb;
    const int nn = n0 + (lane & 31); const bool ok = nn < nvalid;
    float wv[32];
#pragma unroll
    for (int i = 0; i < 32; ++i) { const int kk = 2 * i + (lane >> 5); wv[i] = ok ? W[(size_t)(k0 + kk) * ldw + src_col0 + nn] : 0.f; }
    if (gk) {
#pragma unroll
        for (int i = 0; i < 32; ++i) wv[i] *= gk[k0 + 2 * i + (lane >> 5)];
    }
#pragma unroll
    for (int i = 0; i < 32; ++i) { const int kk = 2 * i + (lane >> 5); scr[kk * 33 + (lane & 31)] = wv[i]; }
    asm volatile("s_waitcnt lgkmcnt(0)" ::: "memory");
    int L = dst_row0 + n0;
    if (perm == 1) { const int l = L & 255; L = (L & ~255) | (((l >> 5) & 1) * 128 + (l >> 6) * 32); }
    else if (perm == 2) { const int hb = L >= DFF ? 1 : 0, c = L - hb * DFF; L = (c >> 7) * 256 + hb * 128 + (c & 127); }
    const int c = lane & 7;
#pragma unroll
    for (int j = 0; j < 4; ++j) { const int n = (lane >> 3) + 8 * j; const LAS float* s = scr + (8 * c) * 33 + n;
        u32x4 o; o.x = cvtpk(s[0 * 33], s[1 * 33]); o.y = cvtpk(s[2 * 33], s[3 * 33]); o.z = cvtpk(s[4 * 33], s[5 * 33]); o.w = cvtpk(s[6 * 33], s[7 * 33]);
        *(u32x4*)(WT + (size_t)(L + n) * K + k0 + 8 * c) = o; }
    asm volatile("s_waitcnt lgkmcnt(0)" ::: "memory");
}
__device__ __forceinline__ void rms_row_to_bf16(const float* xrow, const float* g, bf16* orow, int lane) {
    const f32x4* xr = (const f32x4*)xrow + lane; const f32x4* gr = (const f32x4*)g + lane;
    f32x4 v[4]; float s = 0.f;
#pragma unroll
    for (int j = 0; j < 4; ++j) { v[j] = xr[64 * j]; s += (v[j].x * v[j].x + v[j].y * v[j].y) + (v[j].z * v[j].z + v[j].w * v[j].w); }
    const float rstd = rsqrtf(wave_sum(s) * (1.f / DM) + 1e-6f);
    u32x2* o8 = (u32x2*)orow + lane;
#pragma unroll
    for (int j = 0; j < 4; ++j) { const f32x4 gg = gr[64 * j]; u32x2 w; w.x = cvtpk(v[j].x * rstd * gg.x, v[j].y * rstd * gg.y); w.y = cvtpk(v[j].z * rstd * gg.z, v[j].w * rstd * gg.w); o8[64 * j] = w; }
}
__device__ __forceinline__ void xb_row(const float* xrow, bf16* orow, float* ssq4, int lane) {
    const f32x4* xr = (const f32x4*)xrow + lane;
    f32x4 v[4]; float s = 0.f;
#pragma unroll
    for (int j = 0; j < 4; ++j) { v[j] = xr[64 * j]; s += (v[j].x * v[j].x + v[j].y * v[j].y) + (v[j].z * v[j].z + v[j].w * v[j].w); }
    s = wave_sum(s);
    u32x2* o8 = (u32x2*)orow + lane;
#pragma unroll
    for (int j = 0; j < 4; ++j) { u32x2 w; w.x = cvtpk(v[j].x, v[j].y); w.y = cvtpk(v[j].z, v[j].w); o8[64 * j] = w; }
    if (lane == 0) *(f32x4*)ssq4 = (f32x4){s, 0.f, 0.f, 0.f};
}
__device__ __forceinline__ void norm_phase(const float* X, const float* g, bf16* XN, int gw, int ngw, int lane) {
    for (int m = gw; m < MTOK; m += ngw) rms_row_to_bf16(X + (size_t)m * DM, g, XN + (size_t)m * DM, lane);
}

#define MFMA32(a, b, c) __builtin_amdgcn_mfma_f32_32x32x16_bf16((a), (b), (c), 0, 0, 0)
__device__ __forceinline__ void qk_tile(f32x16& p0, f32x16& p1, const bf16* Kh  , size_t key0, int kpitch, const bf16x8 (&qr)[4], int r32, int hi) {
    const bf16* kp = Kh + (key0 + pi_row(r32)) * (size_t)kpitch + hi * 8;
    p0 = (f32x16){}; p1 = (f32x16){};
#pragma unroll
    for (int d0 = 0; d0 < 4; ++d0) {
        const bf16x8 k0 = *(const bf16x8*)(kp + d0 * 16), k1 = *(const bf16x8*)(kp + (size_t)32 * kpitch + d0 * 16);
        p0 = MFMA32(k0, qr[d0], p0); p1 = MFMA32(k1, qr[d0], p1);
    }
}
__device__ __forceinline__ void pv_tile(f32x16& o0, f32x16& o1, const bf16* Vth  , size_t key0, const f32x16& p0, const f32x16& p1, int r32, int hi) {
    const bf16* vp = Vth + (size_t)r32 * MTOK + key0 + hi * 8;
#pragma unroll
    for (int half = 0; half < 2; ++half)
#pragma unroll
        for (int s = 0; s < 2; ++s) {
            const f32x16& p = half ? p1 : p0;
            u32x4 w; w.x = cvtpk(p[8 * s + 0], p[8 * s + 1]); w.y = cvtpk(p[8 * s + 2], p[8 * s + 3]); w.z = cvtpk(p[8 * s + 4], p[8 * s + 5]); w.w = cvtpk(p[8 * s + 6], p[8 * s + 7]);
            const bf16x8 pf = __builtin_bit_cast(bf16x8, w);
            const bf16x8 v0 = *(const bf16x8*)(vp + half * 32 + s * 16), v1 = *(const bf16x8*)(vp + (size_t)32 * MTOK + half * 32 + s * 16);
            o0 = MFMA32(v0, pf, o0); o1 = MFMA32(v1, pf, o1);
        }
}
__device__ __forceinline__ void load_q(bf16x8 (&qr)[4], const bf16* Q, size_t qrow, int h, int hi) {
#pragma unroll
    for (int d0 = 0; d0 < 4; ++d0) qr[d0] = *(const bf16x8*)(Q + qrow * DM + h * HD + d0 * 16 + hi * 8);
}
__device__ __forceinline__ void store_o(bf16* O, size_t qrow, int h, const f32x16& o0, const f32x16& o1, float rl, int hi) {
    bf16* op = O + qrow * DM + h * HD + 4 * hi;
#pragma unroll
    for (int dh = 0; dh < 2; ++dh)
#pragma unroll
        for (int g = 0; g < 4; ++g) { const f32x16& o = dh ? o1 : o0; u32x2 w; w.x = cvtpk(o[4 * g] * rl, o[4 * g + 1] * rl); w.y = cvtpk(o[4 * g + 2] * rl, o[4 * g + 3] * rl);
            *(u32x2*)(op + 32 * dh + 8 * g) = w; }
}
#define MAX3(a, b, c) __builtin_fmaxf(__builtin_fmaxf((a), (b)), (c))
__device__ __forceinline__ void softmax_step(f32x16& p0, f32x16& p1, float& m, float& l, f32x16& o0, f32x16& o1) {
    float a = MAX3(p0[0], p0[1], p0[2]), b = MAX3(p1[0], p1[1], p1[2]);
#pragma unroll
    for (int r = 3; r < 15; r += 2) { a = MAX3(a, p0[r], p0[r + 1]); b = MAX3(b, p1[r], p1[r + 1]); }
    float mx = MAX3(a, b, p0[15]); mx = fmaxf(mx, p1[15]);
    mx = fmaxf(mx, __shfl_xor(mx, 32));
    const float mn = fmaxf(m, mx);
    if (!__all(mn == m)) {
        const float alpha = __builtin_amdgcn_exp2f(m - mn); m = mn; l *= alpha;
#pragma unroll
        for (int r = 0; r < 16; ++r) { o0[r] *= alpha; o1[r] *= alpha; }
    }
    float s = 0.f;
#pragma unroll
    for (int r = 0; r < 16; ++r) { p0[r] = __builtin_amdgcn_exp2f(p0[r] - mn); p1[r] = __builtin_amdgcn_exp2f(p1[r] - mn); s += p0[r] + p1[r]; }
    l += s;
}
__device__ __forceinline__ void attn_unit_of(int u, int& bh, int& qb) { bh = u >> 7; qb = u & 127; if ((u >> 11) & 1) qb = 127 - qb; }

__device__ __forceinline__ void attnA_phase(const bf16* Q, const bf16* K, const bf16* Vt, bf16* O, const float* rel_bias  , LAS float* biasL, int vw, int nvw, int tid) {
    for (int i = tid; i < 16 * 513; i += NTHREADS) biasL[(i / 513) * 516 + (i % 513)] = rel_bias[i] * LOG2E;
    __syncthreads();
    const int lane = tid & 63, r32 = lane & 31, hi = lane >> 5;
    for (int u = vw; u < NB * NH * 128; u += nvw) {
        int bh, qb; attn_unit_of(u, bh, qb); const int b = bh >> 4, h = bh & 15, c = qb >> 1, qh = qb & 1;
        const size_t qrow = (size_t)b * SEQ + qb * 32 + r32;
        bf16x8 qr[4]; load_q(qr, Q, qrow, h, hi);
        f32x16 o0 = (f32x16){}, o1 = (f32x16){}; float m = -1e30f, l = 0.f;
        const LAS float* bl = biasL + h * 516;
        for (int kt = (c < 8 ? 8 - c : 0); kt <= 8; ++kt) {
            const size_t key0 = (size_t)b * SEQ + (size_t)(c - 8 + kt) * 64;
            f32x16 p0, p1; qk_tile(p0, p1, K + h * HD, key0, DM, qr, r32, hi);
            if (kt >= 4) {
                const int base = (8 - kt) * 64 + qh * 32 + r32 - 8 * hi;
#pragma unroll
                for (int r = 0; r < 16; ++r) { const int d0 = base - (16 * (r >> 3) + (r & 7)); const int d1 = d0 - 32;
                    p0[r] += bl[(d0 < 256 ? d0 : 256) + 256]; p1[r] += bl[(d1 < 256 ? d1 : 256) + 256]; }
            } else { const float bc = bl[512];
#pragma unroll
                for (int r = 0; r < 16; ++r) { p0[r] += bc; p1[r] += bc; } }
            softmax_step(p0, p1, m, l, o0, o1);
            pv_tile(o0, o1, Vt + (size_t)h * HD * MTOK, key0, p0, p1, r32, hi);
        }
        l += __shfl_xor(l, 32);
        store_o(O, qrow, h, o0, o1, 1.0f / l, hi);
    }
}
__device__ __forceinline__ void attnC_phase(const bf16* Q, const bf16* K, const bf16* Vt, bf16* O, int vw, int nvw, int tid) {
    const int lane = tid & 63, r32 = lane & 31, hi = lane >> 5;
    for (int u = vw; u < NB * NH * 128; u += nvw) {
        int bh, qb; attn_unit_of(u, bh, qb); const int b = bh >> 4, h = bh & 15;
        const size_t qrow = (size_t)b * SEQ + qb * 32 + r32; const int t = qb * 32 + r32;
        bf16x8 qr[4]; load_q(qr, Q, qrow, h, hi);
        f32x16 o0 = (f32x16){}, o1 = (f32x16){}; float R = 0.f;
        for (int kt = qb >> 1; kt >= 0; --kt) {
            const size_t key0 = (size_t)b * SEQ + (size_t)kt * 64;
            f32x16 p0, p1; qk_tile(p0, p1, K + h * HD, key0, DM, qr, r32, hi);
            const int kb = kt * 64 + 8 * hi;
            float lk[32], lb[32];
#pragma unroll
            for (int e = 0; e < 32; ++e) { const int r = e & 15, half = e >> 4; const float z = half ? p1[r] : p0[r];
                const int key = kb + 32 * half + 16 * (r >> 3) + (r & 7);
                const float sp = fmaxf(z, 0.f) + __builtin_amdgcn_logf(1.f + __builtin_amdgcn_exp2f(-fabsf(z)));
                const bool valid = key < t;
                lk[e] = valid ? -sp : 0.f; lb[e] = valid ? (z - sp) : -INFINITY; }
            float G[4], ex[32];
#pragma unroll
            for (int gi = 0; gi < 4; ++gi) { float run = 0.f;
#pragma unroll
                for (int i = 7; i >= 0; --i) { ex[gi * 8 + i] = run; run += lk[gi * 8 + i]; }
                G[gi] = run; }
            float Gp[4];
#pragma unroll
            for (int gi = 0; gi < 4; ++gi) Gp[gi] = __shfl_xor(G[gi], 32);
            float suf[4]; float run = 0.f;
#pragma unroll
            for (int gi = 3; gi >= 0; --gi) { suf[gi] = run + (hi == 0 ? Gp[gi] : 0.f); run += G[gi] + Gp[gi]; }
#pragma unroll
            for (int e = 0; e < 32; ++e) { const float a = __builtin_amdgcn_exp2f(lb[e] + R + suf[e >> 3] + ex[e]); if (e < 16) p0[e] = a; else p1[e - 16] = a; }
            R += run;
            pv_tile(o0, o1, Vt + (size_t)h * HD * MTOK, key0, p0, p1, r32, hi);
            if (__all(R < -300.f)) break;
        }
        store_o(O, qrow, h, o0, o1, 1.0f, hi);
    }
}
constexpr int TP = 144;
constexpr int TILE_B = 64 * TP, KVBUF_B = 2 * TILE_B;
constexpr int PAIR_B = 2 * KVBUF_B;
struct KVStage { u32x4 k, v; };
__device__ __forceinline__ void kv_issue(KVStage& st, const bf16* Kh, const bf16* Vth, size_t key0, int tid) {
    const int row = tid >> 3, ch = tid & 7;
    st.k = *(const u32x4*)(Kh + (key0 + row) * DM + ch * 8);
    st.v = *(const u32x4*)(Vth + (size_t)row * VTP + key0 + ch * 8);
}
__device__ __forceinline__ void kv_write(const KVStage& st, LAS unsigned char* buf, int tid) {
    const int row = tid >> 3, ch = tid & 7;
    *(LAS u32x4*)(buf + row * TP + ch * 16) = st.k;
    *(LAS u32x4*)(buf + TILE_B + row * TP + ch * 16) = st.v;
}
template <bool INIT = true> __device__ __forceinline__ void qk_lds(f32x16& p0, f32x16& p1, const LAS unsigned char* buf, const bf16x8 (&qr)[4], int r32, int hi) {
    const LAS unsigned char* kp = buf + pi_row(r32) * TP + hi * 16;
    if (INIT) { p0 = (f32x16){}; p1 = (f32x16){}; }
    bf16x8 kf[8];
#pragma unroll
    for (int d0 = 0; d0 < 4; ++d0) { kf[2 * d0] = *(const LAS bf16x8*)(kp + d0 * 32); kf[2 * d0 + 1] = *(const LAS bf16x8*)(kp + 32 * TP + d0 * 32); }
    __builtin_amdgcn_s_setprio(1);
#pragma unroll
    for (int d0 = 0; d0 < 4; ++d0) { p0 = MFMA32(kf[2 * d0], qr[d0], p0); p1 = MFMA32(kf[2 * d0 + 1], qr[d0], p1); }
    __builtin_amdgcn_s_setprio(0);
}
__device__ __forceinline__ void pv_lds(f32x16& o0, f32x16& o1, const LAS unsigned char* buf, const f32x16& p0, const f32x16& p1, int r32, int hi) {
    const LAS unsigned char* vp = buf + TILE_B + r32 * TP + hi * 16;
    bf16x8 pf[4], vf[8];
#pragma unroll
    for (int half = 0; half < 2; ++half)
#pragma unroll
        for (int s = 0; s < 2; ++s) {
            const f32x16& p = half ? p1 : p0;
            u32x4 w; w.x = cvtpk(p[8 * s + 0], p[8 * s + 1]); w.y = cvtpk(p[8 * s + 2], p[8 * s + 3]); w.z = cvtpk(p[8 * s + 4], p[8 * s + 5]); w.w = cvtpk(p[8 * s + 6], p[8 * s + 7]);
            pf[half * 2 + s] = __builtin_bit_cast(bf16x8, w);
            vf[(half * 2 + s) * 2] = *(const LAS bf16x8*)(vp + half * 64 + s * 32); vf[(half * 2 + s) * 2 + 1] = *(const LAS bf16x8*)(vp + 32 * TP + half * 64 + s * 32);
        }
    __builtin_amdgcn_s_setprio(1);
#pragma unroll
    for (int k = 0; k < 4; ++k) { o0 = MFMA32(vf[2 * k], pf[k], o0); o1 = MFMA32(vf[2 * k + 1], pf[k], o1); }
    __builtin_amdgcn_s_setprio(0);
}
#define WG_BARRIER_L() do { asm volatile("s_waitcnt lgkmcnt(0)" ::: "memory"); __builtin_amdgcn_s_barrier(); asm volatile("" ::: "memory"); } while (0)
#define WG_BARRIER() do { asm volatile("s_waitcnt vmcnt(0) lgkmcnt(0)" ::: "memory"); __builtin_amdgcn_s_barrier(); asm volatile("" ::: "memory"); } while (0)
__device__ __forceinline__ void blk_unit_of(int u, int& bh, int& ub) { bh = u >> 4; ub = u & 15; if ((u >> 8) & 1) ub = 15 - ub; }

template <bool FIXED> __device__ __forceinline__ void attnA_blk(const bf16* Q, const bf16* K, const bf16* Vt, bf16* O, const float* rel_bias, float ref, LAS unsigned char* lds, int vcu, int G, int tid) {
    LAS float* biasL = (LAS float*)(lds + 2 * PAIR_B);
    for (int i = tid; i < 16 * 513; i += NTHREADS) biasL[(i / 513) * 516 + (i % 513)] = rel_bias[i] * LOG2E - (FIXED ? ref : 0.f);
    __syncthreads();
    const int lane = tid & 63, r32 = lane & 31, hi = lane >> 5, wid = __builtin_amdgcn_readfirstlane(tid >> 6);
#pragma unroll 1
    for (int u = vcu; u < NB * NH * 16; u += G) {
        int bh, ub; blk_unit_of(u, bh, ub); const int b = bh >> 4, h = bh & 15, qb = ub * 8 + wid, c = qb >> 1, qh = qb & 1;
        const size_t qrow = (size_t)b * SEQ + qb * 32 + r32;
        bf16x8 qr[4]; load_q(qr, Q, qrow, h, hi);
        f32x16 o0 = (f32x16){}, o1 = (f32x16){}; float m = -1e30f, l = 0.f;
        const LAS float* bl = biasL + h * 516;
        const bf16* Kh = K + h * HD; const bf16* Vth = Vt + (size_t)h * HD * VTP;
        const int c0 = ub * 4, t_lo = c0 >= 8 ? c0 - 8 : 0, t_hi = c0 + 3;
        const size_t kbase = (size_t)b * SEQ; const int ntl = t_hi - t_lo + 1;
        KVStage sa, sb;
        kv_issue(sa, Kh, Vth, kbase + (size_t)t_lo * 64, tid); kv_issue(sb, Kh, Vth, kbase + (size_t)(t_lo + 1) * 64, tid);
        kv_write(sa, lds, tid); kv_write(sb, lds + KVBUF_B, tid); WG_BARRIER();
#define ATT_PAIR(IT) do { const int it_ = (IT); LAS unsigned char* pb = lds + ((it_ >> 1) & 1) * PAIR_B; \
            if (it_ + 2 < ntl) { kv_issue(sa, Kh, Vth, kbase + (size_t)(t_lo + it_ + 2) * 64, tid); kv_issue(sb, Kh, Vth, kbase + (size_t)(t_lo + it_ + 3) * 64, tid); } \
            { const int t = t_lo + it_; LAS unsigned char* buf = pb; ATT_COMPUTE } \
            { const int t = t_lo + it_ + 1; LAS unsigned char* buf = pb + KVBUF_B; ATT_COMPUTE } \
            if (it_ + 2 < ntl) { LAS unsigned char* nb = lds + (((it_ >> 1) + 1) & 1) * PAIR_B; kv_write(sa, nb, tid); kv_write(sb, nb + KVBUF_B, tid); } \
            WG_BARRIER_L(); } while (0)
#define ATT_COMPUTE             if (t >= c - 8 && t <= c) { \
                const int kt = t - c + 8; \
                f32x16 p0, p1; \
                if (kt > 4) { \
                    const LAS float* bp = bl + ((8 - kt) * 64 + qh * 32 + r32 - 8 * hi + 256); \
_Pragma("unroll") \
                    for (int r = 0; r < 16; ++r) { p0[r] = bp[-(16 * (r >> 3) + (r & 7))]; p1[r] = bp[-(16 * (r >> 3) + (r & 7)) - 32]; } \
                } else if (kt == 4) { \
                    const int base = 4 * 64 + qh * 32 + r32 - 8 * hi; \
_Pragma("unroll") \
                    for (int r = 0; r < 16; ++r) { const int d0 = base - (16 * (r >> 3) + (r & 7)); const int d1 = d0 - 32; \
                        p0[r] = bl[(d0 < 256 ? d0 : 256) + 256]; p1[r] = bl[(d1 < 256 ? d1 : 256) + 256]; } \
                } else { const float bc = bl[512]; \
_Pragma("unroll") \
                    for (int r = 0; r < 16; ++r) { p0[r] = bc; p1[r] = bc; } } \
                qk_lds<false>(p0, p1, buf, qr, r32, hi); \
                if (FIXED) { float sacc = 0.f; \
_Pragma("unroll") \
                    for (int r = 0; r < 16; ++r) { p0[r] = __builtin_amdgcn_exp2f(p0[r]); p1[r] = __builtin_amdgcn_exp2f(p1[r]); sacc += p0[r] + p1[r]; } \
                    l += sacc; \
                } else softmax_step(p0, p1, m, l, o0, o1); \
                pv_lds(o0, o1, buf, p0, p1, r32, hi); \
            }
#pragma unroll 1
        for (int it = 0; it < ntl; it += 2) ATT_PAIR(it);
#undef ATT_COMPUTE
        l += __shfl_xor(l, 32);
        store_o(O, qrow, h, o0, o1, 1.0f / l, hi);
    }
}
__device__ __forceinline__ void b_mask_init(f32x16& p0, f32x16& p1, unsigned long long mw, int hi, float ref) {
    const int n0 = (int)~((unsigned)mw >> (8 * hi)), n1 = (int)~((unsigned)(mw >> 32) >> (8 * hi));
#pragma unroll
    for (int r = 0; r < 16; ++r) { const int bit = 16 * (r >> 3) + (r & 7);
        p0[r] = __int_as_float(__builtin_amdgcn_sbfe(n0, bit, 1) & (int)0xFF800000) - ref; p1[r] = __int_as_float(__builtin_amdgcn_sbfe(n1, bit, 1) & (int)0xFF800000) - ref; }
}
__device__ __forceinline__ float exp_tile(f32x16& p0, f32x16& p1) {
    float sacc = 0.f;
#pragma unroll
    for (int r = 0; r < 16; ++r) { p0[r] = __builtin_amdgcn_exp2f(p0[r]); p1[r] = __builtin_amdgcn_exp2f(p1[r]);
#ifdef PB2_EXPX
        p0[r] = __builtin_amdgcn_exp2f(__builtin_amdgcn_logf(p0[r])); p1[r] = __builtin_amdgcn_exp2f(__builtin_amdgcn_logf(p1[r]));
#endif
        sacc += p0[r] + p1[r]; }
    return sacc;
}
template <bool FIXED> __device__ __forceinline__ void attnB_blk(const bf16* Q, const bf16* K, const bf16* Vt, bf16* O, const unsigned long long* MASK, float ref, LAS unsigned char* lds, int vcu, int G, int tid) {
    const int lane = tid & 63, r32 = lane & 31, hi = lane >> 5, wid = __builtin_amdgcn_readfirstlane(tid >> 6);
#pragma unroll 1
    for (int u = vcu; u < NB * NH * 16; u += G) {
        int bh, ub; blk_unit_of(u, bh, ub); const int b = bh >> 4, h = bh & 15, qb = ub * 8 + wid;
        const size_t qrow = (size_t)b * SEQ + qb * 32 + r32;
        bf16x8 qr[4]; load_q(qr, Q, qrow, h, hi);
        f32x16 o0 = (f32x16){}, o1 = (f32x16){}; float m = -1e30f, l = 0.f;
        const u32x4* mrow2 = (const u32x4*)(MASK + qrow * 64);
        const int ntile = (qb >> 1) + 1, t_hi = ub * 4 + 3;
        const bf16* Kh = K + h * HD; const bf16* Vth = Vt + (size_t)h * HD * VTP;
        const size_t kbase = (size_t)b * SEQ; const int ntl = t_hi + 1;
#ifndef PB2_LOOPX
#define PB2_LOOPX 1
#endif
        for (int rep2 = 0; rep2 < PB2_LOOPX; ++rep2) {
        KVStage sa, sb;
        kv_issue(sa, Kh, Vth, kbase, tid); kv_issue(sb, Kh, Vth, kbase + 64, tid);
        u32x4 mnext = mrow2[0];
        kv_write(sa, lds, tid); kv_write(sb, lds + KVBUF_B, tid); WG_BARRIER();
#pragma unroll 1
        for (int it = 0; it < ntl; it += 2) {
            LAS unsigned char* pb = lds + ((it >> 1) & 1) * PAIR_B;
            u32x4 mcur = mnext; asm volatile("" : "+v"(mcur));
            if (it + 2 < ntl) { kv_issue(sa, Kh, Vth, kbase + (size_t)(it + 2) * 64, tid); kv_issue(sb, Kh, Vth, kbase + (size_t)(it + 3) * 64, tid); }
            if (it + 2 < ntile) mnext = mrow2[(it >> 1) + 1];
            const unsigned long long ma = (it < ntile) ? ((unsigned long long)mcur.y << 32 | mcur.x) : 0ull, mb = (it + 1 < ntile) ? ((unsigned long long)mcur.w << 32 | mcur.z) : 0ull;
#pragma unroll
            for (int k = 0; k < 2; ++k) {
                if (it + k < ntile) {
                    LAS unsigned char* buf = pb + k * KVBUF_B;
                    f32x16 p0, p1; b_mask_init(p0, p1, k ? mb : ma, hi, FIXED ? ref : 0.f);
                    qk_lds<false>(p0, p1, buf, qr, r32, hi);
                    if (FIXED) l += exp_tile(p0, p1); else softmax_step(p0, p1, m, l, o0, o1);
                    pv_lds(o0, o1, buf, p0, p1, r32, hi);
                }
            }
            if (it + 2 < ntl) { LAS unsigned char* nb = lds + (((it >> 1) + 1) & 1) * PAIR_B; kv_write(sa, nb, tid); kv_write(sb, nb + KVBUF_B, tid);
#ifdef PB2_STAGEX
                kv_issue(sa, Kh, Vth, kbase + (size_t)(it + 2) * 64, tid); kv_issue(sb, Kh, Vth, kbase + (size_t)(it + 3) * 64, tid); kv_write(sa, nb, tid); kv_write(sb, nb + KVBUF_B, tid);
#endif
            }
            WG_BARRIER_L();
#ifdef PB2_BARX
            WG_BARRIER(); WG_BARRIER();
#endif
        }
        }
        l += __shfl_xor(l, 32);
        store_o(O, qrow, h, o0, o1, 1.0f / l, hi);
    }
}
__device__ __forceinline__ void attnC_blk(const bf16* Q, const bf16* K, const bf16* Vt, bf16* O, LAS unsigned char* lds, int vcu, int G, int tid) {
    const int lane = tid & 63, r32 = lane & 31, hi = lane >> 5, wid = __builtin_amdgcn_readfirstlane(tid >> 6);
    LAS unsigned* flags = (LAS unsigned*)(lds + 2 * KVBUF_B);
#pragma unroll 1
    for (int u = vcu; u < NB * NH * 16; u += G) {
        int bh, ub; blk_unit_of(u, bh, ub); const int b = bh >> 4, h = bh & 15, qb = ub * 8 + wid;
        const size_t qrow = (size_t)b * SEQ + qb * 32 + r32; const int tq = qb * 32 + r32;
        bf16x8 qr[4]; load_q(qr, Q, qrow, h, hi);
        f32x16 o0 = (f32x16){}, o1 = (f32x16){}; float R = 0.f; bool done = false;
        const int t_hi = ub * 4 + 3, t_me = qb >> 1;
        const bf16* Kh = K + h * HD; const bf16* Vth = Vt + (size_t)h * HD * VTP;
        KVStage st; kv_issue(st, Kh, Vth, (size_t)b * SEQ + (size_t)t_hi * 64, tid); kv_write(st, lds, tid); WG_BARRIER();
#pragma unroll 1
        for (int t = t_hi, it = 0; t >= 0; --t, ++it) {
            LAS unsigned char* buf = lds + (it & 1) * KVBUF_B;
            if (t > 0) kv_issue(st, Kh, Vth, (size_t)b * SEQ + (size_t)(t - 1) * 64, tid);
            if (t <= t_me && !done) {
                f32x16 p0, p1; qk_lds(p0, p1, buf, qr, r32, hi);
                const int kb = t * 64 + 8 * hi;
                const bool diag = (t == t_me);
                float lk[32], lb[32];
#pragma unroll
                for (int e = 0; e < 32; ++e) { const int r = e & 15, half = e >> 4; const float z = half ? p1[r] : p0[r];
                    const float sp = __builtin_amdgcn_logf(1.f + __builtin_amdgcn_exp2f(fminf(z, 80.f)));
                    lk[e] = -sp; lb[e] = z - sp; }
                if (diag) {
#pragma unroll
                    for (int e = 0; e < 32; ++e) { const int r = e & 15, half = e >> 4; const int key = kb + 32 * half + 16 * (r >> 3) + (r & 7);
                        const bool valid = key < tq; lk[e] = valid ? lk[e] : 0.f; lb[e] = valid ? lb[e] : -INFINITY; }
                }
                float Gs[4], ex[32];
#pragma unroll
                for (int gi = 0; gi < 4; ++gi) { float run = 0.f;
#pragma unroll
                    for (int i = 7; i >= 0; --i) { ex[gi * 8 + i] = run; run += lk[gi * 8 + i]; }
                    Gs[gi] = run; }
                float Gp[4];
#pragma unroll
                for (int gi = 0; gi < 4; ++gi) Gp[gi] = __shfl_xor(Gs[gi], 32);
                float suf[4]; float run = 0.f;
#pragma unroll
                for (int gi = 3; gi >= 0; --gi) { suf[gi] = R + run + (hi == 0 ? Gp[gi] : 0.f); run += Gs[gi] + Gp[gi]; }
#pragma unroll
                for (int e = 0; e < 32; ++e) { const float a = __builtin_amdgcn_exp2f(lb[e] + (suf[e >> 3] + ex[e])); if (e < 16) p0[e] = a; else p1[e - 16] = a; }
                R += run;
                pv_lds(o0, o1, buf, p0, p1, r32, hi);
                done = __all(R < -152.f);
            }
            if (lane == 0) flags[(it & 1) * 8 + wid] = (done || t == 0) ? 0u : 1u;
            if (t > 0) kv_write(st, lds + ((it + 1) & 1) * KVBUF_B, tid);
            WG_BARRIER_L();
            unsigned any = 0u;
#pragma unroll
            for (int w = 0; w < 8; ++w) any |= flags[(it & 1) * 8 + w];
            if (any == 0u) break;
        }
        store_o(O, qrow, h, o0, o1, 1.0f, hi);
        WG_BARRIER();
    }
}
#define XB_TMO      128
#define XB_XCNT(j)  (256  + 64 * (j))
#define XB_XSUB(j)  (1280 + 64 * (j))
#define XB_XGEN(j)  (2304 + 64 * (j))
#define XB_TOP      3328
#define XB_TOPGEN   3392
#define XCD_BAR_WORDS 3456
#define XB_SPIN_CAP (1u << 18)

__device__ __forceinline__ unsigned xb_ld(unsigned* p)              { return __hip_atomic_load(p, __ATOMIC_RELAXED, __HIP_MEMORY_SCOPE_AGENT); }
__device__ __forceinline__ unsigned xb_add(unsigned* p, unsigned v) { return __hip_atomic_fetch_add(p, v, __ATOMIC_RELAXED, __HIP_MEMORY_SCOPE_AGENT); }
__device__ __forceinline__ unsigned xb_xcc_id() { return (unsigned)__builtin_amdgcn_s_getreg((3 << 11) | 20) & 0xFu; }
#define XB_SPIN(cond, bar) do { unsigned _sp = 0; while (cond) { __builtin_amdgcn_s_sleep(1); \
    if ((++_sp & 255u) == 0u) { if (xb_ld(&(bar)[XB_TMO])) break; if (_sp > XB_SPIN_CAP) { atomicAdd(&(bar)[XB_TMO], 1u); break; } } } } while (0)

struct XcdBarrier {
    unsigned* bar; unsigned x;
    volatile LAS unsigned* st;
};

__device__ __forceinline__ XcdBarrier xcd_barrier_post(unsigned* bar, volatile LAS unsigned* st) {
    XcdBarrier b; b.bar = bar; b.x = xb_xcc_id(); b.st = st;
    if (threadIdx.x == 0) (void)xb_add(&bar[XB_XCNT(b.x)], 1u);
    return b;
}
__device__ __forceinline__ void xcd_barrier_complete(unsigned* bar, unsigned x, unsigned& nloc, unsigned& nx) {
    const unsigned G = gridDim.x * gridDim.y * gridDim.z;
    unsigned sum, cnt, mine, sp = 0u;
    for (;;) {
        sum = 0u; cnt = 0u; mine = 0u;
#pragma unroll
        for (unsigned j = 0; j < 16; ++j) { const unsigned c = xb_ld(&bar[XB_XCNT(j)]); sum += c; cnt += (c > 0u) ? 1u : 0u; mine = (j == x) ? c : mine; }
        if (sum == G) break;
        __builtin_amdgcn_s_sleep(1);
        if ((++sp & 255u) == 0u) { if (xb_ld(&bar[XB_TMO])) break; if (sp > XB_SPIN_CAP) { atomicAdd(&bar[XB_TMO], 1u); break; } }
    }
    nloc = mine > 0u ? mine : 1u; nx = cnt > 0u ? cnt : 1u;
}

__device__ __forceinline__ void xcd_barrier(const XcdBarrier& b, int g_wave_id) {
    asm volatile("s_waitcnt vmcnt(0)" ::: "memory");
    __syncthreads();
    if (g_wave_id == 0 && lane_id() == 0) {
        unsigned* bar = b.bar;
        __builtin_amdgcn_s_waitcnt(0);
        unsigned nloc = b.st[0], nx = b.st[1];
        if (nloc == 0u) { xcd_barrier_complete(bar, b.x, nloc, nx); b.st[0] = nloc; b.st[1] = nx; }
        const unsigned old = xb_add(&bar[XB_XSUB(b.x)], 1u);
        const unsigned gen = old / nloc;
        if (old + 1u == (gen + 1u) * nloc) {
            __builtin_amdgcn_fence(__ATOMIC_RELEASE, "agent");
            asm volatile("s_waitcnt vmcnt(0)" ::: "memory");
            const unsigned og = xb_add(&bar[XB_TOP], 1u);
            const unsigned tg = og / nx;
            if (og + 1u == (tg + 1u) * nx) xb_add(&bar[XB_TOPGEN], 1u);
            else XB_SPIN(xb_ld(&bar[XB_TOPGEN]) == tg, bar);
            __builtin_amdgcn_fence(__ATOMIC_ACQUIRE, "agent");
            xb_add(&bar[XB_XGEN(b.x)], 1u);
            asm volatile("s_waitcnt vmcnt(0)" ::: "memory");
        } else {
            XB_SPIN(xb_ld(&bar[XB_XGEN(b.x)]) == gen, bar);
            __builtin_amdgcn_fence(__ATOMIC_ACQUIRE, "agent");
            asm volatile("s_waitcnt vmcnt(0)" ::: "memory");
        }
    }
    __syncthreads();
}
__device__ __forceinline__ void cnt_lt4(unsigned& l0, unsigned& l1, unsigned& l2, unsigned& l3, unsigned u0, unsigned u1, unsigned u2, unsigned u3, unsigned c) {
    unsigned long long m0, m1, m2, m3;
    asm("v_cmp_lt_u32_e64 %4, %8, %12\n\tv_cmp_lt_u32_e64 %5, %9, %12\n\tv_cmp_lt_u32_e64 %6, %10, %12\n\tv_cmp_lt_u32_e64 %7, %11, %12\n\t"
        "v_addc_co_u32_e64 %0, %4, %0, 0, %4\n\tv_addc_co_u32_e64 %1, %5, %1, 0, %5\n\tv_addc_co_u32_e64 %2, %6, %2, 0, %6\n\tv_addc_co_u32_e64 %3, %7, %3, 0, %7"
        : "+v"(l0), "+v"(l1), "+v"(l2), "+v"(l3), "=&s"(m0), "=&s"(m1), "=&s"(m2), "=&s"(m3)
        : "v"(u0), "v"(u1), "v"(u2), "v"(u3), "v"(c));
}
constexpr int QI_PITCH = 520;
__device__ __forceinline__ void b1_phase(const bf16* QI, const bf16* KI, const float* WI, float* SCRb  , unsigned long long* MASK,
                                         LAS unsigned char* lds, int vcu, int G, int tid) {
    const int lane = tid & 63, r32 = lane & 31, hi = lane >> 5, wid = __builtin_amdgcn_readfirstlane(tid >> 6);
    LAS bf16* qs = (LAS bf16*)lds;
#pragma unroll 1
    for (int u0 = vcu, rnd = 0; u0 < NB * 128; u0 += G, ++rnd) {
        const int b = u0 >> 7; int qb = u0 & 127; if (rnd & 1) qb = 127 - qb;
        const size_t tok0 = (size_t)b * SEQ + qb * 32;
        const int ntile = (qb >> 1) + 1, limit = ntile * 64;
        for (int i = tid; i < 32 * 64; i += NTHREADS) { const int q = i >> 6, c = i & 63; *(LAS u32x4*)(qs + q * QI_PITCH + c * 8) = *(const u32x4*)(QI + (tok0 + q) * 512 + c * 8); }
        LAS float* wl = (LAS float*)(lds + 32 * QI_PITCH * 2);
        if (tid < 256) wl[tid] = WI[tok0 * 8 + tid];
        __syncthreads();
#ifndef B1_SCORE_REP
#define B1_SCORE_REP 1
#endif
#ifndef B1_TOPK_REP
#define B1_TOPK_REP 1
#endif
#ifndef B1_NO_SCORE
        for (int rep_ = 0; rep_ < B1_SCORE_REP; ++rep_)
#pragma unroll 1
        for (int kt = wid; kt < ntile; kt += NWAVES) {
            const size_t key0 = (size_t)b * SEQ + (size_t)kt * 64;
            const bf16* kp = KI + (key0 + pi_row(r32)) * 64 + hi * 8;
            bf16x8 kf0[4], kf1[4];
#pragma unroll
            for (int d0 = 0; d0 < 4; ++d0) { kf0[d0] = *(const bf16x8*)(kp + d0 * 16); kf1[d0] = *(const bf16x8*)(kp + 32 * 64 + d0 * 16); }
            f32x16 s0 = (f32x16){}, s1 = (f32x16){};
            int qoff = r32 * QI_PITCH + hi * 8; asm volatile("" : "+v"(qoff));
#pragma unroll 1
            for (int hh = 0; hh < 8; ++hh) {
                f32x16 a0 = (f32x16){}, a1 = (f32x16){};
                const float wh = wl[r32 * 8 + hh];
#pragma unroll
                for (int d0 = 0; d0 < 4; ++d0) { const bf16x8 qf = *(const LAS bf16x8*)(qs + qoff + hh * 64 + d0 * 16); a0 = MFMA32(kf0[d0], qf, a0); a1 = MFMA32(kf1[d0], qf, a1); }
#pragma unroll
                for (int r = 0; r < 16; ++r) { s0[r] = __builtin_fmaf(wh, __builtin_fmaxf(a0[r], 0.f), s0[r]); s1[r] = __builtin_fmaf(wh, __builtin_fmaxf(a1[r], 0.f), s1[r]); }
            }
            float* sp = SCRb + (size_t)r32 * 4096 + kt * 64 + 8 * hi;
#pragma unroll
            for (int half = 0; half < 2; ++half)
#pragma unroll
                for (int s = 0; s < 2; ++s) { const f32x16& p = half ? s1 : s0;
                    *(f32x4*)(sp + 32 * half + 16 * s) = (f32x4){p[8 * s], p[8 * s + 1], p[8 * s + 2], p[8 * s + 3]};
                    *(f32x4*)(sp + 32 * half + 16 * s + 4) = (f32x4){p[8 * s + 4], p[8 * s + 5], p[8 * s + 6], p[8 * s + 7]}; }
        }
#endif
        asm volatile("s_waitcnt vmcnt(0)" ::: "memory");
        __syncthreads();
#ifndef B1_NO_TOPK
#pragma unroll 1
        for (int qq = 0; qq < 4 * B1_TOPK_REP; ++qq) {
            const int q = wid * 4 + (qq & 3);
            const float* srow = SCRb + (size_t)q * 4096 + lane;
            unsigned uu[64];
#pragma unroll
            for (int j = 0; j < 64; ++j) { unsigned key = 0u; if (j < ntile) { const float f = srow[j * 64] + 0.0f; const unsigned bts = __float_as_uint(f); key = bts ^ ((bts >> 31) ? 0xFFFFFFFFu : 0x80000000u); } uu[j] = key; }
            unsigned T = 1u;
            bool exact = (limit <= 256);
            if (limit > 256) {
                unsigned kmax = 0u;
#pragma unroll
                for (int j = 0; j < 64; ++j) kmax = uu[j] > kmax ? uu[j] : kmax;
#pragma unroll
                for (int o = 1; o < 64; o <<= 1) { const unsigned t_ = (unsigned)__shfl_xor((int)kmax, o); kmax = t_ > kmax ? t_ : kmax; }
                kmax = (unsigned)__builtin_amdgcn_readfirstlane((int)kmax);
                unsigned a = 1u, b = kmax + 1u; if (b == 0u) b = 0xFFFFFFFFu;
                float fa = (float)(limit - 256) + 0.5f, fb = -255.5f; int side = 0;
                bool done = false;
                if (b > 0x80000001u) {
                    unsigned l0 = 0u, l1 = 0u, l2 = 0u, l3 = 0u; const unsigned csign = 0x80000000u;
#pragma unroll
                    for (int j = 0; j < 64; j += 4) cnt_lt4(l0, l1, l2, l3, uu[j], uu[j + 1], uu[j + 2], uu[j + 3], csign);
                    const unsigned less = (l0 + l1) + (l2 + l3);
                    const int cnt = 4096 - (int)wave_sum_u32(less);
                    if (cnt == 256) { a = 0x80000000u; done = true; exact = true; }
                    else if (cnt > 256) { a = 0x80000000u; fa = (float)(cnt - 256) + 0.5f; }
                    else { b = 0x80000000u; fb = (float)(cnt - 256) + 0.5f; }
                }
#pragma unroll 1
                for (int iter = 0; iter < 64 && !done; ++iter) {
                    if (b - a <= 1u) break;
                    unsigned c;
                    if (iter < 12) { const float t = fa * __builtin_amdgcn_rcpf(fa - fb); c = a + (unsigned)(t * (float)(b - a)); if (c <= a) c = a + 1u; if (c >= b) c = b - 1u; }
                    else c = a + ((b - a) >> 1);
                    unsigned l0 = 0u, l1 = 0u, l2 = 0u, l3 = 0u;
#pragma unroll
                    for (int j = 0; j < 64; j += 4) cnt_lt4(l0, l1, l2, l3, uu[j], uu[j + 1], uu[j + 2], uu[j + 3], c);
                    const unsigned less = (l0 + l1) + (l2 + l3);
                    const int cnt = 4096 - (int)wave_sum_u32(less);
                    if (cnt == 256) { a = c; exact = true; break; }
                    if (cnt > 256) { a = c; fa = (float)(cnt - 256) + 0.5f; if (side > 0) fb *= 0.5f; side = 1; }
                    else { b = c; fb = (float)(cnt - 256) + 0.5f; if (side < 0) fa *= 0.5f; side = -1; }
                }
                T = a;
            }
            unsigned long long myword = 0ull;
            if (exact) {
#pragma unroll
                for (int j = 0; j < 64; ++j) { const unsigned long long word = __ballot(uu[j] >= T); if (lane == j) myword = word; }
            } else {
            int ngt = 0;
#pragma unroll
            for (int j = 0; j < 64; ++j) ngt += __popcll(__ballot(uu[j] > T));
            const int need = (limit > 256) ? (256 - ngt) : 4096;
            int c = 0;
#pragma unroll
            for (int j = 0; j < 64; ++j) {
                const bool eq = (uu[j] == T); const unsigned long long eqm = __ballot(eq);
                const int below = __builtin_amdgcn_mbcnt_hi((unsigned)(eqm >> 32), __builtin_amdgcn_mbcnt_lo((unsigned)eqm, 0u));
                const bool sel = (uu[j] > T) || (eq && (c + below < need));
                const unsigned long long word = __ballot(sel);
                c += __popcll(eqm);
                if (lane == j) myword = word;
            }
            }
            if (lane < ntile) MASK[(tok0 + q) * 64 + lane] = myword;
        }
#endif
        __syncthreads();
    }
}
__device__ __forceinline__ void attnB_phase(const bf16* Q, const bf16* K, const bf16* Vt, bf16* O, const unsigned long long* MASK, int vw, int nvw, int tid) {
    const int lane = tid & 63, r32 = lane & 31, hi = lane >> 5;
    for (int u = vw; u < NB * NH * 128; u += nvw) {
        int bh, qb; attn_unit_of(u, bh, qb); const int b = bh >> 4, h = bh & 15;
        const size_t qrow = (size_t)b * SEQ + qb * 32 + r32;
        bf16x8 qr[4]; load_q(qr, Q, qrow, h, hi);
        f32x16 o0 = (f32x16){}, o1 = (f32x16){}; float m = -1e30f, l = 0.f;
        const unsigned long long* mrow = MASK + qrow * 64;
        const int ntile = (qb >> 1) + 1;
        for (int kt = 0; kt < ntile; ++kt) {
            const size_t key0 = (size_t)b * SEQ + (size_t)kt * 64;
            const unsigned long long mw = mrow[kt];
            f32x16 p0, p1; qk_tile(p0, p1, K + h * HD, key0, DM, qr, r32, hi);
            const unsigned m0 = (unsigned)mw >> (8 * hi), m1 = (unsigned)(mw >> 32) >> (8 * hi);
#pragma unroll
            for (int r = 0; r < 16; ++r) { const int bit = 16 * (r >> 3) + (r & 7);
                p0[r] = ((m0 >> bit) & 1u) ? p0[r] : -INFINITY; p1[r] = ((m1 >> bit) & 1u) ? p1[r] : -INFINITY; }
            softmax_step(p0, p1, m, l, o0, o1);
            pv_tile(o0, o1, Vt + (size_t)h * HD * MTOK, key0, p0, p1, r32, hi);
        }
        l += __shfl_xor(l, 32);
        store_o(O, qrow, h, o0, o1, 1.0f / l, hi);
    }
}
__device__ __forceinline__ void conv_phase(const bf16* A, bf16* HM, const float* cw  , const float* cb  , int gtid, int ngt) {
    constexpr int CG = DFF / 8, RUN = 32, NRUN = MHALF / RUN;
    for (int it = gtid; it < CG * NRUN; it += ngt) {
        const int cgp = it % CG, run = it / CG, c0 = cgp * 8, r0 = run * RUN;
        float wg[3][8], wu[3][8], bg[8], bu[8];
#pragma unroll
        for (int i = 0; i < 8; ++i) { bg[i] = cb[c0 + i]; bu[i] = cb[DFF + c0 + i];
#pragma unroll
            for (int k = 0; k < 3; ++k) { wg[k][i] = cw[k * NFF2 + c0 + i]; wu[k][i] = cw[k * NFF2 + DFF + c0 + i]; } }
        float g1[8], g2[8], u1[8], u2[8];
        const bool seqstart = (r0 & (SEQ - 1)) == 0;
#pragma unroll
        for (int i = 0; i < 8; ++i) { g1[i] = g2[i] = u1[i] = u2[i] = 0.f; }
        if (!seqstart) {
            const u32x4 a1 = *(const u32x4*)(A + (size_t)(r0 - 1) * NFF2 + c0), a2 = *(const u32x4*)(A + (size_t)(r0 - 2) * NFF2 + c0);
            const u32x4 b1 = *(const u32x4*)(A + (size_t)(r0 - 1) * NFF2 + DFF + c0), b2 = *(const u32x4*)(A + (size_t)(r0 - 2) * NFF2 + DFF + c0);
#pragma unroll
            for (int i = 0; i < 4; ++i) { g1[2 * i] = __uint_as_float(a1[i] << 16); g1[2 * i + 1] = __uint_as_float(a1[i] & 0xFFFF0000u); g2[2 * i] = __uint_as_float(a2[i] << 16); g2[2 * i + 1] = __uint_as_float(a2[i] & 0xFFFF0000u);
                u1[2 * i] = __uint_as_float(b1[i] << 16); u1[2 * i + 1] = __uint_as_float(b1[i] & 0xFFFF0000u); u2[2 * i] = __uint_as_float(b2[i] << 16); u2[2 * i + 1] = __uint_as_float(b2[i] & 0xFFFF0000u); }
        }
        for (int r = r0; r < r0 + RUN; ++r) {
            const u32x4 a0 = *(const u32x4*)(A + (size_t)r * NFF2 + c0), b0 = *(const u32x4*)(A + (size_t)r * NFF2 + DFF + c0);
            float g0[8], u0[8], hm[8];
#pragma unroll
            for (int i = 0; i < 4; ++i) { g0[2 * i] = __uint_as_float(a0[i] << 16); g0[2 * i + 1] = __uint_as_float(a0[i] & 0xFFFF0000u); u0[2 * i] = __uint_as_float(b0[i] << 16); u0[2 * i + 1] = __uint_as_float(b0[i] & 0xFFFF0000u); }
#pragma unroll
            for (int i = 0; i < 8; ++i) { const float cgv = bg[i] + wg[0][i] * g2[i] + wg[1][i] * g1[i] + wg[2][i] * g0[i]; const float cuv = bu[i] + wu[0][i] * u2[i] + wu[1][i] * u1[i] + wu[2][i] * u0[i];
                hm[i] = cgv / (1.f + __expf(-cgv)) * cuv; g2[i] = g1[i]; g1[i] = g0[i]; u2[i] = u1[i]; u1[i] = u0[i]; }
            u32x4 o; o.x = cvtpk(hm[0], hm[1]); o.y = cvtpk(hm[2], hm[3]); o.z = cvtpk(hm[4], hm[5]); o.w = cvtpk(hm[6], hm[7]);
            *(u32x4*)(HM + (size_t)r * DFF + c0) = o;
        }
    }
}

__device__ __forceinline__ void ffn_fixup(const float* EF, const float* EL, const float* cw, const float* cb, bf16* HM, int gtid, int ngt) {
    for (int it = gtid; it < 128 * 2 * 704; it += ngt) {
        const int j = (it % 704) * 4, rr = (it / 704) & 1, pm = it / 1408;
        if ((pm & 15) == 0) continue;
        const int pg = (j >> 7) * 256 + (j & 127);
        f32x4 c[2];
#pragma unroll
        for (int bj = 0; bj < 2; ++bj) { const int pc = pg + 128 * bj, lc = j + DFF * bj;
            const f32x4 am2 = *(const f32x4*)(EL + ((size_t)(pm - 1) * 2 + 0) * NFF2 + pc), am1 = *(const f32x4*)(EL + ((size_t)(pm - 1) * 2 + 1) * NFF2 + pc);
            const f32x4 a0 = *(const f32x4*)(EF + ((size_t)pm * 2 + 0) * NFF2 + pc), a1 = *(const f32x4*)(EF + ((size_t)pm * 2 + 1) * NFF2 + pc);
            const f32x4 w0 = *(const f32x4*)(cw + lc), w1 = *(const f32x4*)(cw + NFF2 + lc), w2 = *(const f32x4*)(cw + 2 * NFF2 + lc), bb = *(const f32x4*)(cb + lc);
            c[bj] = rr == 0 ? (bb + w0 * am2 + w1 * am1 + w2 * a0) : (bb + w0 * am1 + w1 * a0 + w2 * a1); }
        float hm[4];
#pragma unroll
        for (int i = 0; i < 4; ++i) { const float g = c[0][i]; hm[i] = g * __builtin_amdgcn_rcpf(1.f + __builtin_amdgcn_exp2f(-LOG2E * g)) * c[1][i]; }
        u32x2 w; w.x = cvtpk(hm[0], hm[1]); w.y = cvtpk(hm[2], hm[3]);
        *(u32x2*)(HM + (size_t)(pm * 256 + rr) * DFF + j) = w;
    }
}

__device__ __forceinline__ void ffn_fixup_tile(const float* EF, const float* EL, const float* cw, const float* cb, bf16* HM, int pm, int tid) {
    if ((pm & 15) == 0) return;
    for (int it = tid; it < 2 * 704; it += NTHREADS) {
        const int j = (it % 704) * 4, rr = it / 704;
        const int pg = (j >> 7) * 256 + (j & 127);
        f32x4 c[2];
#pragma unroll
        for (int bj = 0; bj < 2; ++bj) { const int pc = pg + 128 * bj, lc = j + DFF * bj;
            const f32x4 am2 = *(const f32x4*)(EL + ((size_t)(pm - 1) * 2 + 0) * NFF2 + pc), am1 = *(const f32x4*)(EL + ((size_t)(pm - 1) * 2 + 1) * NFF2 + pc);
            const f32x4 a0 = *(const f32x4*)(EF + ((size_t)pm * 2 + 0) * NFF2 + pc), a1 = *(const f32x4*)(EF + ((size_t)pm * 2 + 1) * NFF2 + pc);
            const f32x4 w0 = *(const f32x4*)(cw + lc), w1 = *(const f32x4*)(cw + NFF2 + lc), w2 = *(const f32x4*)(cw + 2 * NFF2 + lc), bb = *(const f32x4*)(cb + lc);
            c[bj] = rr == 0 ? (bb + w0 * am2 + w1 * am1 + w2 * a0) : (bb + w0 * am1 + w1 * a0 + w2 * a1); }
        float hm[4];
#pragma unroll
        for (int i = 0; i < 4; ++i) { const float g = c[0][i]; hm[i] = g * __builtin_amdgcn_rcpf(1.f + __builtin_amdgcn_exp2f(-LOG2E * g)) * c[1][i]; }
        u32x2 w; w.x = cvtpk(hm[0], hm[1]); w.y = cvtpk(hm[2], hm[3]);
        *(u32x2*)(HM + (size_t)(pm * 256 + rr) * DFF + j) = w;
    }
}
constexpr int LDS_BYTES = 147456;
constexpr int ITEMS_PER_LAYER = 1024 + 384 + 512 + 512 + 2816 + 1408;
#ifdef FAKE_SYNC
#define GRID_SYNC() __syncthreads()
#else
#define GRID_SYNC() xcd_barrier(bar, wave)
#endif
#ifndef PROBE
#define PROBE 0
#endif
#ifndef FIXED_A_LIMIT
#define FIXED_A_LIMIT 100.f
#define FIXED_B_LIMIT 50.f
#endif
#define PROBE_REP(bit) (((PROBE) >> (bit)) & 1 ? 2 : 1)

__device__ __forceinline__ unsigned char* ws_launder(unsigned char* w) { asm volatile("" : "+s"(w)); return w; }
__device__ __forceinline__ size_t ws_zero() { size_t z = 0; asm volatile("" : "+s"(z)); return z; }
__global__ void __launch_bounds__(NTHREADS, 2) fwd_kernel(Params p) {
    extern __shared__ __attribute__((aligned(16))) unsigned char lds_raw[];
    LAS unsigned char* lds = (LAS unsigned char*)lds_raw;
    cg::grid_group grid = cg::this_grid();
    const int tid = threadIdx.x, lane = tid & 63, wave = __builtin_amdgcn_readfirstlane(tid >> 6);
    const int G = gridDim.x, bx = blockIdx.x, vcu = (G % 8 == 0) ? (bx % 8) * (G / 8) + bx / 8 : bx;
    const int gw = vcu * NWAVES + wave, ngw = G * NWAVES, gtid = vcu * NTHREADS + tid, ngt = G * NTHREADS;
    unsigned char* ws = p.ws;
    if (tid < 4) ((LAS unsigned*)(lds + 131072))[tid] = 0u;
    __syncthreads();
    const XcdBarrier bar = xcd_barrier_post((unsigned*)(ws + WS_CTL), (volatile LAS unsigned*)(lds + 131072));
#define FRESH_TID(v) int v = wave * 64 + lane_id(); asm volatile("" : "+v"(v))
#define WSL(T, off) ((T*)(ws + ws_zero() + (off)))
#define ROPE WSL(f32x2_t, WS_ROPE)
#define XN WSL(bf16, WS_XN)
#define QO WSL(bf16, WS_QO)
#define KB WSL(bf16, WS_K)
#define VT WSL(bf16, WS_VT)
#define QI WSL(bf16, WS_QI)
#define KI WSL(bf16, WS_KI)
#define WI WSL(float, WS_WI)
#define MASK WSL(unsigned long long, WS_MASK)
#define SSQ WSL(float, WS_SSQ)
#define OB WSL(bf16, WS_OB)
#define DUMMY1 p.out
#define DUMMY2 p.out
#define EF WSL(float, WS_EF)
#define EL WSL(float, WS_EL)
#define HM WSL(bf16, WS_HM)
#define SCR p.out
    LAS float* PART = (LAS float*)(lds + 131072 + 1024);
    {
        LAS float* scr = (LAS float*)(lds + wave * 16384);
        for (int it = gw; it < DEPTH * ITEMS_PER_LAYER; it += ngw) {
            const int l = it / ITEMS_PER_LAYER; int r = it % ITEMS_PER_LAYER; const int kind = l % 3, li = l / 3;
            unsigned char* wl = ws + WS_W + (size_t)l * W_LAYER;
            const float* wqkv = kind == 0 ? p.a_w_qkv + (size_t)li * DM * 3072 : (kind == 1 ? p.b_w_in : p.c_w_qkv);
            const int ldq = kind == 1 ? 3656 : 3072;
            const float* g1 = p.norm1_g + (size_t)l * DM; const float* g2 = p.norm2_g + (size_t)l * DM;
            const float* wo = kind == 0 ? p.a_w_o + (size_t)li * DM * DM : (kind == 1 ? p.b_w_o : p.c_w_o);
            if (r < 1024) { transpose_item(wqkv, DM, ldq, 0, 2048, (bf16*)(wl + WL_QK), 0, 1, g1, scr, r, lane); continue; } r -= 1024;
            if (r < 384) { if (kind == 1) transpose_item(wqkv, DM, ldq, 3072, 584, (bf16*)(wl + WL_QK), 2048, 1, g1, scr, r, lane); continue; } r -= 384;
            if (r < 512) { transpose_item(wqkv, DM, ldq, 2048, 1024, (bf16*)(wl + WL_V), 0, 0, g1, scr, r, lane); continue; } r -= 512;
            if (r < 512) { transpose_item(wo, DM, DM, 0, 1024, (bf16*)(wl + WL_O), 0, 0, nullptr, scr, r, lane); continue; } r -= 512;
            if (r < 2816) { transpose_item(p.ffn_w_in + (size_t)l * DM * NFF2, DM, NFF2, 0, NFF2, (bf16*)(wl + WL_IN), 0, 2, g2, scr, r, lane); continue; } r -= 2816;
            transpose_item(p.ffn_w_down + (size_t)l * DFF * DM, DFF, DM, 0, DM, (bf16*)(wl + WL_D), 0, 0, nullptr, scr, r, lane);
        }
        for (int i = gtid; i < SEQ * 32; i += ngt) {
            const int pos = i >> 5, x = i & 31;
            const float inv = exp2f(-(float)x * (13.287712379549449f / 32.0f));
            const float ang = (float)pos * inv;
            const double rev = (double)ang * 0.15915494309189535; const float fr = (float)(rev - floor(rev));
            ROPE[i] = (f32x2_t){__builtin_amdgcn_cosf(fr), __builtin_amdgcn_sinf(fr)};
        }
        for (int m = gw; m < MTOK; m += ngw) xb_row(p.x + (size_t)m * DM, XN + (size_t)m * DM, SSQ + (size_t)m * 4, lane);
    }
    grid.sync();

    for (int l = 0; l < DEPTH; ++l) {
        const int kind = l % 3, li = l / 3;
        unsigned char* wl = ws + WS_W + (size_t)l * W_LAYER;
        const bf16* WQK = (const bf16*)(wl + WL_QK); const bf16* WV = (const bf16*)(wl + WL_V); const bf16* WO = (const bf16*)(wl + WL_O);
        const bf16* WIN = (const bf16*)(wl + WL_IN); const bf16* WD = (const bf16*)(wl + WL_D);
        for (int rep_ = 0; rep_ < PROBE_REP(0); ++rep_) {
        {
            pg8::Gemm g{XN, WQK, MTOK, kind == 1 ? NQK_B : NQK_A, DM}; pg8::StaticOrder S; S.init(MTOK, g.N, G, bx);
            pg8::EpiQKV E{kind, QO, KB, QI, KI, WI, kind == 1 ? p.b_q_norm : p.a_q_norm + li * HD, kind == 1 ? p.b_k_norm : p.a_k_norm + li * HD, (const pg8::f32x2v*)ROPE, 0.125f * LOG2E, 0.35355339059327373f * 0.125f, SSQ};
#ifndef NO_QKV
            pg8::gemm_phase<pg8::EpiQKV, pg8::StaticOrder, true, true>(lds, g, S, E, wave);
#endif
        }
        {
            pg8::Gemm g{WV, XN, DM, MTOK, DM}; pg8::StaticOrder S; S.init(DM, MTOK, G, bx);
            pg8::EpiVt E{VT, VTP, SSQ};
            pg8::gemm_phase<pg8::EpiVt, pg8::StaticOrder, true, true>(lds, g, S, E, wave);
        }
        }
        GRID_SYNC();
#ifndef NO_A
        for (int rep_ = 0; rep_ < PROBE_REP(1); ++rep_)
        if (kind == 0) { FRESH_TID(t_); const float* gq_ = p.a_q_norm + li * HD; const float* gk_ = p.a_k_norm + li * HD; const float* rb_ = p.a_rel_bias + (size_t)li * NH * 513;
            float mq = fabsf(gq_[t_ & 63]), mk = fabsf(gk_[t_ & 63]), bmax = -1e30f, bmin = 1e30f;
            for (int i = t_; i < NH * 513; i += NTHREADS) { const float v = rb_[i] * LOG2E; bmax = fmaxf(bmax, v); bmin = fminf(bmin, v); }
#pragma unroll
            for (int o = 1; o < 64; o <<= 1) { mq = fmaxf(mq, __shfl_xor(mq, o)); mk = fmaxf(mk, __shfl_xor(mk, o)); bmax = fmaxf(bmax, __shfl_xor(bmax, o)); bmin = fminf(bmin, __shfl_xor(bmin, o)); }
            { LAS float* red = (LAS float*)(lds + 131072 + 1024);
              if ((t_ & 63) == 0) { red[(t_ >> 6) * 2] = bmax; red[(t_ >> 6) * 2 + 1] = bmin; }
              __syncthreads();
#pragma unroll
              for (int w = 0; w < 8; ++w) { bmax = fmaxf(bmax, red[w * 2]); bmin = fminf(bmin, red[w * 2 + 1]); }
              __syncthreads(); }
            const float qk2 = 8.2f * mq * mk * LOG2E, ref = qk2 + bmax;
            if (__builtin_amdgcn_readfirstlane(ref - (bmin - qk2) <= FIXED_A_LIMIT ? 1 : 0)) attnA_blk<true>(QO, KB, VT, OB, rb_, ref, lds, vcu, G, t_);
            else attnA_blk<false>(QO, KB, VT, OB, rb_, 0.f, lds, vcu, G, t_); }
#endif
        if (kind == 1) {
#ifndef NO_B1
            for (int rep_ = 0; rep_ < PROBE_REP(2); ++rep_)
            { FRESH_TID(t_); b1_phase(QI, KI, WI, SCR + (size_t)bx * 32 * 4096, MASK, lds, vcu, G, t_); }
#endif
            GRID_SYNC();
#ifndef NO_B2
            for (int rep_ = 0; rep_ < PROBE_REP(3); ++rep_)
            { FRESH_TID(t_); float mq = fabsf(p.b_q_norm[t_ & 63]), mk = fabsf(p.b_k_norm[t_ & 63]);
#pragma unroll
              for (int o = 1; o < 64; o <<= 1) { mq = fmaxf(mq, __shfl_xor(mq, o)); mk = fmaxf(mk, __shfl_xor(mk, o)); }
              const float ref = 8.2f * mq * mk * LOG2E;
              if (__builtin_amdgcn_readfirstlane(ref <= FIXED_B_LIMIT ? 1 : 0)) attnB_blk<true>(QO, KB, VT, OB, MASK, ref, lds, vcu, G, t_);
              else attnB_blk<false>(QO, KB, VT, OB, MASK, 0.f, lds, vcu, G, t_); }
#endif
        }
#ifndef NO_C
        for (int rep_ = 0; rep_ < PROBE_REP(4); ++rep_)
        if (kind == 2) { FRESH_TID(t_); attnC_blk(QO, KB, VT, OB, lds, vcu, G, t_); }
#endif
        GRID_SYNC();
        {
            pg8::Gemm g{OB, WO, MTOK, DM, DM}; pg8::StaticOrder S; S.init(MTOK, DM, G, bx);
            if (PROBE_REP(5) == 2) { pg8::EpiRes E0{l == 0 ? p.x : nullptr, XN, DUMMY1, DM, nullptr, SSQ, PART}; pg8::gemm_phase<pg8::EpiRes, pg8::StaticOrder, true, true>(lds, g, S, E0, wave); }
            pg8::EpiRes E{l == 0 ? p.x : nullptr, XN, nullptr, DM, XN, SSQ, PART};
            pg8::gemm_phase<pg8::EpiRes, pg8::StaticOrder, true, true>(lds, g, S, E, wave);
        }
        GRID_SYNC();
        {
            pg8::Gemm g{XN, WIN, MTOK, NFF2, DM}; pg8::StaticOrder S; S.init(MTOK, NFF2, G, bx);
            pg8::EpiFFN E{HM, p.ffn_conv_w + (size_t)l * 3 * NFF2, p.ffn_conv_b + (size_t)l * NFF2, EF, EL, (LAS pg8::f32x4*)(lds + 131072 + 1024), SSQ};
            for (int rep_ = 0; rep_ < PROBE_REP(7); ++rep_)
            pg8::gemm_phase<pg8::EpiFFN, pg8::StaticOrder, true, true>(lds, g, S, E, wave);
        }
        GRID_SYNC();
        {
            pg8::Gemm g{HM, WD, MTOK, DM, DFF}; pg8::StaticOrder S; S.init(MTOK, DM, G, bx);
            { FRESH_TID(t_); int lastpm = -1;
#pragma unroll 1
              for (int L = bx; L < 512; L += G) {
                  const int w_ = (L & 7) * 64 + (L >> 3), pm_ = (w_ >> 5) * 8 + (w_ & 7);
                  if (pm_ != lastpm) ffn_fixup_tile(EF, EL, p.ffn_conv_w + (size_t)l * 3 * NFF2, p.ffn_conv_b + (size_t)l * NFF2, HM, pm_, t_);
                  lastpm = pm_; }
              asm volatile("s_waitcnt vmcnt(0)" ::: "memory"); __syncthreads(); }
            if (PROBE_REP(9) == 2) { pg8::EpiRes E0{nullptr, XN, DUMMY2, DM, nullptr, SSQ, PART}; pg8::gemm_phase<pg8::EpiRes, pg8::StaticOrder, true, true>(lds, g, S, E0, wave); }
            pg8::EpiRes E{nullptr, XN, l + 1 == DEPTH ? p.out : nullptr, DM, l + 1 == DEPTH ? nullptr : XN, SSQ, PART};
            pg8::gemm_phase<pg8::EpiRes, pg8::StaticOrder, true, true>(lds, g, S, E, wave);
        }
        GRID_SYNC();
    }
}

extern "C" void kernel_launch(void* const* d_in, const int* in_sizes, int n_in, void* d_out, int out_size, void* d_ws, size_t ws_size, hipStream_t stream) {
    static int grid = 0;
    if (grid == 0) {
        if (n_in != 18 || out_size != MTOK * DM || ws_size < WS_END) { fprintf(stderr, "kernel_launch: unexpected shapes (n_in %d out %d ws %zu)\n", n_in, out_size, ws_size); grid = -1; return; }
        int dev = 0, cus = 0, per_cu = 0;
        hipGetDevice(&dev); hipDeviceGetAttribute(&cus, hipDeviceAttributeMultiprocessorCount, dev);
        hipFuncSetAttribute((const void*)fwd_kernel, hipFuncAttributeMaxDynamicSharedMemorySize, LDS_BYTES);
        hipOccupancyMaxActiveBlocksPerMultiprocessor(&per_cu, (const void*)fwd_kernel, NTHREADS, LDS_BYTES);
        if (per_cu < 1) { fprintf(stderr, "kernel_launch: occupancy query says %d blocks per CU\n", per_cu); per_cu = 1; }
        (void)hipGetLastError();
        grid = cus;
    }
    if (grid < 0) return;
    Params p{};
    const float** f = (const float**)&p;
    for (int i = 0; i < 18; ++i) f[i] = (const float*)d_in[i];
    p.out = (float*)d_out; p.ws = (unsigned char*)d_ws;
    if (hipMemsetAsync((char*)d_ws + WS_CTL, 0, CTL_BYTES, stream) != hipSuccess) { fprintf(stderr, "memset failed\n"); return; }
    void* args[] = {&p};
    hipError_t e = hipLaunchCooperativeKernel((const void*)fwd_kernel, dim3(grid), dim3(NTHREADS), args, LDS_BYTES, stream);
    if (e != hipSuccess) fprintf(stderr, "cooperative launch failed: %s (grid %d)\n", hipGetErrorString(e), grid);
}
```
